# Optimizing an MI355X kernel written in HIP

```python
import jax, jax.numpy as jnp
from jax import lax
import numpy as np

D_MODEL = 1024
BATCH = 16
SEQ = 2048
DEPTH = 1

HEAD_DIM = 64
N_Q_HEADS = 8
N_KV_HEADS = 2
Q_PER_KV = N_Q_HEADS // N_KV_HEADS
ATTN_WIDTH = N_Q_HEADS * HEAD_DIM
KV_WIDTH = N_KV_HEADS * HEAD_DIM
WINDOW = 128
ATT_BLOCK = 128
CHUNK = 128
N_SG_GROUPS = 8
SG_GROUP_DIM = 64
SG_WIDTH = N_SG_GROUPS * SG_GROUP_DIM
SPLIT_SIZES = (ATTN_WIDTH, KV_WIDTH, KV_WIDTH, SG_WIDTH, SG_WIDTH, D_MODEL, D_MODEL)
IN_WIDTH = sum(SPLIT_SIZES)
SPLIT_POINTS = tuple(int(v) for v in np.cumsum(SPLIT_SIZES)[:-1])
N_EXPERTS = 32
TOP_K = 4
D_EXPERT = D_MODEL
SWIGLU_LIMIT = 7.0
SWIGLU_ALPHA = 1.702
MOE_BLOCK = 256
NORM_EPS = 1e-6

kernel_name = 'hybrid_gmlp_swa_sink_moe_block'


def rmsnorm(x, g):
    xf = x.astype(jnp.float32)
    xf = xf * lax.rsqrt(jnp.mean(xf * xf, axis=-1, keepdims=True) + NORM_EPS)
    return (xf * g.astype(jnp.float32)).astype(x.dtype)


def layernorm(x, g, b):
    xf = x.astype(jnp.float32)
    mu = jnp.mean(xf, axis=-1, keepdims=True)
    var = jnp.mean(jnp.square(xf - mu), axis=-1, keepdims=True)
    y = (xf - mu) * lax.rsqrt(var + NORM_EPS) * g.astype(jnp.float32) + b.astype(jnp.float32)
    return y.astype(x.dtype)


def alibi_slopes(n_heads):
    return jnp.asarray(2.0 ** (-8.0 * np.arange(1, n_heads + 1) / n_heads), dtype=jnp.float32)


def sliding_window_attention(q, k, v, sinks):
    B, S, _ = q.shape
    nb = S // ATT_BLOCK
    q = q.reshape(B, nb, ATT_BLOCK, N_KV_HEADS, Q_PER_KV, HEAD_DIM)
    k = k.reshape(B, nb, ATT_BLOCK, N_KV_HEADS, HEAD_DIM)
    v = v.reshape(B, nb, ATT_BLOCK, N_KV_HEADS, HEAD_DIM)

    def with_prev(t):
        prev = jnp.pad(t[:, :-1], ((0, 0), (1, 0), (0, 0), (0, 0), (0, 0)))
        return jnp.concatenate([prev, t], axis=2)

    kb, vb = with_prev(k), with_prev(v)
    scores = jnp.einsum('bnqhgd,bnkhd->bnhgqk', q, kb,
                        preferred_element_type=jnp.float32) * (HEAD_DIM ** -0.5)
    qi = jnp.arange(ATT_BLOCK)[:, None]
    kj = jnp.arange(2 * ATT_BLOCK)[None, :]
    dist = qi + ATT_BLOCK - kj
    in_win = (dist >= 0) & (dist < WINDOW)
    blk = jnp.arange(nb)[:, None, None]
    mask = in_win[None] & ((blk > 0) | (kj[None] >= ATT_BLOCK))
    slopes = alibi_slopes(N_Q_HEADS).reshape(N_KV_HEADS, Q_PER_KV)
    logits = scores - slopes[:, :, None, None] * dist.astype(jnp.float32)
    logits = jnp.where(mask[None, :, None, None], logits, -jnp.inf)
    sink = sinks.astype(jnp.float32).reshape(N_KV_HEADS, Q_PER_KV)[None, None, :, :, None, None]
    m = jnp.maximum(jnp.max(logits, axis=-1, keepdims=True), sink)
    p = jnp.exp(logits - m)
    probs = p / (jnp.sum(p, axis=-1, keepdims=True) + jnp.exp(sink - m))
    out = jnp.einsum('bnhgqk,bnkhd->bnqhgd', probs.astype(v.dtype), vb)
    return out.reshape(B, S, ATTN_WIDTH)


def chunked_spatial_gating(u, v, ln_g, ln_b, w_s, b_s):
    B, S, _ = u.shape
    nc = S // CHUNK
    vn = layernorm(v, ln_g, ln_b).reshape(B, nc, CHUNK, N_SG_GROUPS, SG_GROUP_DIM)
    causal = jnp.tril(jnp.ones((CHUNK, CHUNK), dtype=bool))
    w = jnp.where(causal[None], w_s, 0.0).astype(vn.dtype)
    mixed = jnp.einsum('gts,bcsgd->bctgd', w, vn) + b_s.T.astype(vn.dtype)[None, None, :, :, None]
    return u * mixed.reshape(B, S, SG_WIDTH)


def moe_ffn(h, w_router, b_router, w1, b1, w2, b2):
    B, S, D = h.shape
    T = B * S
    xt = h.reshape(T, D)
    logits = (xt @ w_router).astype(jnp.float32) + b_router.astype(jnp.float32)
    top_vals, top_idx = lax.top_k(logits, TOP_K)
    gates = jax.nn.softmax(top_vals, axis=-1)
    A = T * TOP_K
    flat_e = top_idx.reshape(A)
    flat_tok = jnp.arange(A, dtype=jnp.int32) // TOP_K
    flat_w = gates.reshape(A)
    order = jnp.argsort(flat_e, stable=True)
    se, stok, sw = flat_e[order], flat_tok[order], flat_w[order]
    counts = jnp.bincount(flat_e, length=N_EXPERTS)
    padded = (counts + MOE_BLOCK - 1) // MOE_BLOCK * MOE_BLOCK
    starts = jnp.cumsum(counts) - counts
    pends = jnp.cumsum(padded)
    pstarts = pends - padded
    slot = pstarts[se] + (jnp.arange(A, dtype=jnp.int32) - starts[se])
    n_blocks = -(-A // MOE_BLOCK) + N_EXPERTS
    P = n_blocks * MOE_BLOCK
    slot_tok = jnp.full((P,), T, dtype=jnp.int32).at[slot].set(stok)
    slot_w = jnp.zeros((P,), dtype=jnp.float32).at[slot].set(sw)
    block_start = jnp.arange(n_blocks, dtype=pends.dtype) * MOE_BLOCK
    block_e = jnp.minimum(jnp.searchsorted(pends, block_start, side='right'), N_EXPERTS - 1)
    x_pad = jnp.concatenate([xt, jnp.zeros((1, D), xt.dtype)], axis=0)
    xs = x_pad[slot_tok].reshape(n_blocks, MOE_BLOCK, D)

    def expert_block(args):
        xb, e = args
        hb = xb @ w1[e] + b1[e]
        g, lin = hb[:, :D_EXPERT], hb[:, D_EXPERT:]
        g = jnp.minimum(g, SWIGLU_LIMIT)
        lin = jnp.clip(lin, -SWIGLU_LIMIT, SWIGLU_LIMIT)
        act = g * jax.nn.sigmoid(SWIGLU_ALPHA * g) * (lin + 1.0)
        return act @ w2[e] + b2[e]

    ys = lax.map(expert_block, (xs, block_e)).reshape(P, D)
    ys = ys * slot_w[:, None].astype(ys.dtype)
    out = jax.ops.segment_sum(ys, slot_tok, num_segments=T + 1)[:T]
    return out.reshape(B, S, D)


def setup_inputs(seed: int = 0) -> dict:
    key = jax.random.key(seed)
    ks = jax.random.split(key, 28)
    L, D, E, I = DEPTH, D_MODEL, N_EXPERTS, D_EXPERT
    nrm = lambda k, shape, s: jax.random.normal(k, shape, jnp.float32) * s
    gain = lambda k, shape: 1.0 + 0.05 * jax.random.normal(k, shape, jnp.float32)
    return {
        'x': nrm(ks[0], (BATCH, SEQ, D), 1.0),
        'c': nrm(ks[1], (BATCH, D), 1.0),
        'w_mod': nrm(ks[2], (L, D, 6 * D), D ** -0.5),
        'b_mod': nrm(ks[3], (L, 6 * D), 0.02),
        'g_pre_mix': gain(ks[4], (L, D)),
        'g_post_mix': gain(ks[5], (L, D)),
        'w_in': nrm(ks[6], (L, D, IN_WIDTH), D ** -0.5),
        'b_in': nrm(ks[7], (L, IN_WIDTH), 0.02),
        'attn_sinks': nrm(ks[8], (L, N_Q_HEADS), 0.5),
        'sg_ln_g': gain(ks[9], (L, SG_WIDTH)),
        'sg_ln_b': nrm(ks[10], (L, SG_WIDTH), 0.02),
        'sg_w': nrm(ks[11], (L, N_SG_GROUPS, CHUNK, CHUNK), CHUNK ** -0.5),
        'sg_b': gain(ks[12], (L, N_SG_GROUPS, CHUNK)),
        'w_br_attn': nrm(ks[13], (L, ATTN_WIDTH, D), ATTN_WIDTH ** -0.5),
        'w_br_sg': nrm(ks[14], (L, SG_WIDTH, D), SG_WIDTH ** -0.5),
        'w_out': nrm(ks[15], (L, D, D), D ** -0.5),
        'b_out': nrm(ks[16], (L, D), 0.02),
        'g_pre_ffn': gain(ks[17], (L, D)),
        'g_post_ffn': gain(ks[18], (L, D)),
        'w_router': nrm(ks[19], (L, D, E), D ** -0.5),
        'b_router': nrm(ks[20], (L, E), 0.01),
        'w_mlp1': nrm(ks[21], (L, E, D, 2 * I), D ** -0.5),
        'b_mlp1': nrm(ks[22], (L, E, 2 * I), 0.02),
        'w_mlp2': nrm(ks[23], (L, E, I, D), I ** -0.5),
        'b_mlp2': nrm(ks[24], (L, E, D), 0.02),
    }


def reference(x, c, w_mod, b_mod, g_pre_mix, g_post_mix, w_in, b_in, attn_sinks,
              sg_ln_g, sg_ln_b, sg_w, sg_b, w_br_attn, w_br_sg, w_out, b_out,
              g_pre_ffn, g_post_ffn, w_router, b_router, w_mlp1, b_mlp1, w_mlp2, b_mlp2):
    c_act = jax.nn.silu(c)
    for l in range(DEPTH):
        mod = (c_act @ w_mod[l] + b_mod[l])[:, None, :]
        shift1, scale1, gate1, shift2, scale2, gate2 = jnp.split(mod, 6, axis=-1)

        h = rmsnorm(x, g_pre_mix[l]) * (1.0 + scale1) + shift1
        z = h @ w_in[l] + b_in[l]
        q, k, v, u_sg, v_sg, g_att, g_sg = jnp.split(z, SPLIT_POINTS, axis=-1)
        y_att = sliding_window_attention(q, k, v, attn_sinks[l])
        y_sg = chunked_spatial_gating(jax.nn.gelu(u_sg), jax.nn.gelu(v_sg),
                                      sg_ln_g[l], sg_ln_b[l], sg_w[l], sg_b[l])
        merged = (jax.nn.sigmoid(g_att) * (y_att @ w_br_attn[l])
                  + jax.nn.sigmoid(g_sg) * (y_sg @ w_br_sg[l]))
        y = merged @ w_out[l] + b_out[l]
        x = x + gate1 * rmsnorm(y, g_post_mix[l])

        h = rmsnorm(x, g_pre_ffn[l]) * (1.0 + scale2) + shift2
        y = moe_ffn(h, w_router[l], b_router[l], w_mlp1[l], b_mlp1[l], w_mlp2[l], b_mlp2[l])
        x = x + gate2 * rmsnorm(y, g_post_ffn[l])
    return x
```

```cpp
#include <hip/hip_runtime.h>
#include <hip/hip_cooperative_groups.h>
#include <cstdio>
#include <cstdint>
namespace cg = cooperative_groups;

#ifndef MK_ONE_LAUNCH
#define MK_ONE_LAUNCH 0
#endif

#define LAS __attribute__((address_space(3)))
typedef unsigned short bf16_t;
typedef short bf16x8 __attribute__((ext_vector_type(8)));
typedef float f32x4 __attribute__((ext_vector_type(4)));
typedef unsigned u32x4 __attribute__((ext_vector_type(4)));
typedef unsigned u32x2 __attribute__((ext_vector_type(2)));

constexpr int D = 1024, BATCH = 16, SEQ = 2048, T = BATCH * SEQ;
constexpr int NZ = 3840;
constexpr int ZQ = 0, ZK = 512, ZV = 640, ZU = 768, ZVS = 1280, ZGA = 1792, ZGS = 2816;
constexpr int NE = 32, TOPK = 4, DE = 1024;
constexpr int KSPLIT = 16;
constexpr float EPS = 1e-6f;
constexpr int LISTCAP = T;
constexpr int APAD = T * TOPK + NE * 256;

constexpr size_t MiB = 1u << 20;
constexpr size_t WS_CTL = 0, CTL_BYTES = 1 * MiB;
constexpr size_t WS_MODP = 1 * MiB;
constexpr size_t WS_WIN = 8 * MiB;
constexpr size_t WS_WBA = 16 * MiB, WS_WBS = 17 * MiB;
constexpr size_t WS_WOUT = 18 * MiB;
constexpr size_t WS_W1 = 24 * MiB;
constexpr size_t WS_W2 = 152 * MiB;
constexpr size_t WS_H2 = 216 * MiB;
constexpr size_t WS_Z = 280 * MiB;
constexpr size_t WS_YATT = 520 * MiB, WS_YSG = 552 * MiB;
constexpr size_t WS_H = 584 * MiB;
constexpr size_t WS_Y = 648 * MiB;
constexpr size_t WS_ACT = 280 * MiB;
constexpr size_t WS_YS = 552 * MiB;
constexpr size_t WS_LISTS = 824 * MiB;
constexpr size_t WS_TOKINFO = 828 * MiB;
constexpr size_t WS_END = 832 * MiB;
constexpr int CW_CNT = 64;

constexpr int RING_BYTES = 131072;
constexpr int MISC_OFF = RING_BYTES;
constexpr int LDS_BYTES = 147456;
constexpr int NWAVES = 8, NTHREADS = 512;

__device__ __forceinline__ float bf2f(unsigned h) { return __uint_as_float(h << 16); }
__device__ __forceinline__ unsigned f2bf(float f) { unsigned u = __float_as_uint(f); return (u + 0x7fffu + ((u >> 16) & 1u)) >> 16; }
__device__ __forceinline__ unsigned pk2(float lo, float hi) { return f2bf(lo) | (f2bf(hi) << 16); }
__device__ __forceinline__ void unpack8(const u32x4 r, float* o) {
    o[0] = __uint_as_float(r.x << 16); o[1] = __uint_as_float(r.x & 0xffff0000u);
    o[2] = __uint_as_float(r.y << 16); o[3] = __uint_as_float(r.y & 0xffff0000u);
    o[4] = __uint_as_float(r.z << 16); o[5] = __uint_as_float(r.z & 0xffff0000u);
    o[6] = __uint_as_float(r.w << 16); o[7] = __uint_as_float(r.w & 0xffff0000u);
}
__device__ __forceinline__ float wave_sum(float v) {
#pragma unroll
    for (int o = 1; o < 64; o <<= 1) v += __shfl_xor(v, o);
    return v;
}
__device__ __forceinline__ float sigmoidf_(float x) { return __builtin_amdgcn_rcpf(1.f + __expf(-x)); }
__device__ __forceinline__ float gelu_tanh(float x) { const float u = 0.7978845608028654f * (x + 0.044715f * x * x * x); return x * __builtin_amdgcn_rcpf(1.f + __expf(-2.f * u)); }

struct Frame { LAS unsigned char* lds; int tid, lane, wave, G; };

namespace pg8 {
constexpr int BM = 256, BK = 64, HALF = 128, HTB = HALF * BK * 2, STAGE_BYTES = 8 * HTB, NXCD = 8, WGM = 8;
__host__ __device__ __forceinline__ int lds_byte(int r, int c) { const int st = (r >> 4) * 2 + (c >> 5), rr = r & 15, cc = c & 31, ob = rr * 64 + cc * 2; return st * 1024 + (ob ^ (((ob >> 9) & 1) << 5)); }
__host__ __device__ __forceinline__ void stage_rc(int b, int& R, int& C) { const int st = b / 1024, sb = b % 1024, swz = sb ^ (((sb >> 9) & 1) << 5); R = (st >> 1) * 16 + swz / 64; C = (st & 1) * 32 + (swz % 64) / 2; }
__host__ __device__ __forceinline__ int perm32(int rho) { const int n = rho >> 4, i = rho & 15; return 8 * (i >> 2) + 4 * n + (i & 3); }
__device__ __forceinline__ unsigned cvt_pk_bf16(float lo, float hi) { unsigned r; asm volatile("v_cvt_pk_bf16_f32 %0, %1, %2" : "=v"(r) : "v"(lo), "v"(hi)); return r; }

struct Unit { const char* A; const char* B; const int* tl; int pm, pn, e, kind, rowbase, nvalid; };
__device__ __forceinline__ const char* uptr(const char* p) { const unsigned long long v = (unsigned long long)p;
    const unsigned lo = __builtin_amdgcn_readfirstlane((unsigned)v), hi = __builtin_amdgcn_readfirstlane((unsigned)(v >> 32)); return (const char*)(((unsigned long long)hi << 32) | lo); }

__device__ __forceinline__ void tile_map(int L, int nM, int nN, int& pm, int& pn) {
    const int nwg = nM * nN;
    int wgid = L; { const int q = nwg / NXCD, r = nwg % NXCD, xcd = wgid % NXCD, off = wgid / NXCD; wgid = (xcd < r ? xcd * (q + 1) : r * (q + 1) + (xcd - r) * q) + off; }
    const int nig = WGM * nN, gid = wgid / nig, fm = gid * WGM, gsz = (nM - fm) < WGM ? (nM - fm) : WGM;
    pm = fm + ((wgid % nig) % gsz); pn = (wgid % nig) / gsz;
}

template <class Epi, class Sched, bool GATHER>
__device__ __forceinline__ void gemm_phase(LAS unsigned char* lds, const int K, const Sched& S, const Epi& E) {
    const int tid = threadIdx.x, wid = __builtin_amdgcn_readfirstlane(tid >> 6), lane = tid & 63, wr = wid >> 2, wc = wid & 3, fr = lane & 15, fq = lane >> 4;
    const int nt = K / BK;
    unsigned voffB[2]; unsigned oc[2][2], on[2][2]; int Rr[2]; unsigned Cb[2];
    const size_t kstep = (size_t)(BK * 2);
    const size_t hstep = (size_t)HALF * K * 2;
#pragma unroll
    for (int i = 0; i < 2; ++i) { int R, C; stage_rc(tid * 16 + i * 8192, R, C); const int Rb = (R & ~31) + perm32(R & 31);
        Rr[i] = R; Cb[i] = (unsigned)C * 2u; voffB[i] = (unsigned)(Rb * K + C) * 2u;
        oc[0][i] = (unsigned)(R * K + C) * 2u; oc[1][i] = oc[0][i] + (unsigned)hstep; on[0][i] = oc[0][i]; on[1][i] = oc[1][i]; }
    const unsigned ldsw = (unsigned)wid * 1024u;
    const int aoff = lds_byte(wr * 64 + fr, fq * 8), boff = lds_byte(wc * 32 + fr, fq * 8);
#define PG8_SA(b, h) (((b) * 2 + (h)) * HTB)
#define PG8_SB(b, h) ((4 + (b) * 2 + (h)) * HTB)
#define PG8_STAGE(bufoff, gbase, voff) do { const char* _g = uptr((const char*)(gbase)); _Pragma("unroll") for (int _i = 0; _i < 2; ++_i) \
        __builtin_amdgcn_global_load_lds((const unsigned*)(_g + (voff)[_i]), (LAS unsigned*)(lds + (bufoff) + ldsw + _i * 8192), 16, 0, 0); } while (0)
#define PG8_STAGE_A(bufoff, gbase, h, O) do { const char* _g = uptr((const char*)(gbase) + (GATHER ? (size_t)0 : (size_t)(h) * hstep)); _Pragma("unroll") for (int _i = 0; _i < 2; ++_i) \
        __builtin_amdgcn_global_load_lds((const unsigned*)(_g + (O)[GATHER ? (h) : 0][_i]), (LAS unsigned*)(lds + (bufoff) + ldsw + _i * 8192), 16, 0, 0); } while (0)
#define PG8_LDA(dst, b, h) do { _Pragma("unroll") for (int m = 0; m < 4; ++m) _Pragma("unroll") for (int k = 0; k < 2; ++k) dst[m][k] = *(const LAS bf16x8*)(lds + PG8_SA(b, h) + aoff + m * 2048 + k * 1024); } while (0)
#define PG8_LDB(dst, b, h) do { _Pragma("unroll") for (int n = 0; n < 2; ++n) _Pragma("unroll") for (int k = 0; k < 2; ++k) dst[n][k] = *(const LAS bf16x8*)(lds + PG8_SB(b, h) + boff + n * 2048 + k * 1024); } while (0)
#define PG8_MMA(ai, bj, At, Bt) do { __builtin_amdgcn_s_setprio(1); _Pragma("unroll") for (int m = 0; m < 4; ++m) _Pragma("unroll") for (int n = 0; n < 2; ++n) _Pragma("unroll") for (int k = 0; k < 2; ++k) \
        acc[ai][bj][m][n] = __builtin_amdgcn_mfma_f32_16x16x32_bf16(Bt[n][k], At[m][k], acc[ai][bj][m][n], 0, 0, 0); __builtin_amdgcn_s_setprio(0); } while (0)
#define PG8_WAIT_V(n) asm volatile("s_waitcnt vmcnt(" #n ")" ::: "memory")
#define PG8_WAIT_L(n) asm volatile("s_waitcnt lgkmcnt(" #n ")" ::: "memory")
#define PG8_BAR __builtin_amdgcn_s_barrier()
#define PG8_SCHED __builtin_amdgcn_sched_barrier(0)
#define PG8_LOADOFFS(u, o) do { _Pragma("unroll") for (int _h = 0; _h < 2; ++_h) _Pragma("unroll") for (int _i = 0; _i < 2; ++_i) { \
        int _row = _h * HALF + Rr[_i]; _row = _row < (u).nvalid ? _row : (u).nvalid - 1; const int _tok = (u).tl[_row]; o[_h][_i] = (unsigned)_tok * (unsigned)(K * 2) + Cb[_i]; } } while (0)
#define PG8_KITER(LAST) do { \
            const char* a1 = cA + (size_t)(t + 1) * kstep; \
            const char* a2 = (LAST) ? nA : cA + (size_t)(t + 2) * kstep; const char* b2 = (LAST) ? nB : cB + (size_t)(t + 2) * kstep; \
            const char* a3 = a2 + kstep; const char* b3 = b2 + kstep; \
            unsigned o2[2][2]; \
            _Pragma("unroll") for (int _h = 0; _h < 2; ++_h) _Pragma("unroll") for (int _i = 0; _i < 2; ++_i) o2[_h][_i] = (GATHER && (LAST)) ? on[_h][_i] : oc[_h][_i]; \
            PG8_LDB(B0, 0, 0); PG8_LDB(B1, 0, 1); PG8_SCHED; PG8_LDA(At, 0, 0); PG8_STAGE_A(PG8_SA(1, 1), a1, 1, oc); \
            PG8_WAIT_V(8); PG8_WAIT_L(0); PG8_BAR; PG8_MMA(0, 0, At, B0); PG8_MMA(0, 1, At, B1); PG8_BAR; PG8_SCHED; \
            PG8_LDA(At, 0, 1); PG8_STAGE(PG8_SB(0, 0), b2, voffB); PG8_STAGE(PG8_SB(0, 1), b2 + hstep, voffB); PG8_STAGE_A(PG8_SA(0, 0), a2, 0, o2); \
            PG8_WAIT_V(8); PG8_WAIT_L(0); PG8_BAR; PG8_MMA(1, 0, At, B0); PG8_MMA(1, 1, At, B1); PG8_BAR; PG8_SCHED; \
            PG8_LDB(B0, 1, 0); PG8_LDB(B1, 1, 1); PG8_SCHED; PG8_LDA(At, 1, 0); PG8_STAGE_A(PG8_SA(0, 1), a2, 1, o2); \
            PG8_WAIT_V(8); PG8_WAIT_L(0); PG8_BAR; PG8_MMA(0, 0, At, B0); PG8_MMA(0, 1, At, B1); PG8_BAR; PG8_SCHED; \
            PG8_LDA(At, 1, 1); PG8_STAGE(PG8_SB(1, 0), b3, voffB); PG8_STAGE(PG8_SB(1, 1), b3 + hstep, voffB); PG8_STAGE_A(PG8_SA(1, 0), a3, 0, o2); \
            PG8_WAIT_V(8); PG8_WAIT_L(0); PG8_BAR; PG8_MMA(1, 0, At, B0); PG8_MMA(1, 1, At, B1); PG8_BAR; PG8_SCHED; \
        } while (0)
    Unit cur, nxt; int ui = 0;
    if (!S.next(0, cur)) return;
    f32x4 acc[2][2][4][2];
#pragma unroll
    for (int a = 0; a < 2; ++a)
#pragma unroll
        for (int b = 0; b < 2; ++b)
#pragma unroll
            for (int m = 0; m < 4; ++m)
#pragma unroll
                for (int n = 0; n < 2; ++n) acc[a][b][m][n] = (f32x4){0.f, 0.f, 0.f, 0.f};
    bf16x8 At[4][2], B0[2][2], B1[2][2];
    const char* cA = cur.A; const char* cB = cur.B;
    if constexpr (GATHER) { PG8_LOADOFFS(cur, oc); }
    PG8_STAGE(PG8_SB(0, 0), cB, voffB); PG8_STAGE(PG8_SB(0, 1), cB + hstep, voffB); PG8_STAGE_A(PG8_SA(0, 0), cA, 0, oc); PG8_STAGE_A(PG8_SA(0, 1), cA, 1, oc);
    if (wr == 1) PG8_BAR;
    PG8_WAIT_V(2); PG8_BAR;
    PG8_STAGE(PG8_SB(1, 0), cB + kstep, voffB); PG8_STAGE_A(PG8_SA(1, 0), cA + kstep, 0, oc); PG8_STAGE(PG8_SB(1, 1), cB + hstep + kstep, voffB);
    PG8_WAIT_V(6); PG8_BAR;
    for (;;) {
        const bool has_next = S.next(ui + 1, nxt);
        const char* nA = has_next ? nxt.A : cA; const char* nB = has_next ? nxt.B : cB;
        if constexpr (GATHER) {
            if (has_next) { PG8_LOADOFFS(nxt, on); }
            else {
#pragma unroll
                for (int h = 0; h < 2; ++h)
#pragma unroll
                    for (int i = 0; i < 2; ++i) on[h][i] = oc[h][i];
            }
        }
        int t = 0;
        for (; t < nt - 2; t += 2) PG8_KITER(false);
        PG8_KITER(true);
        if (wr == 0) PG8_BAR;
        int lane_e; asm volatile("v_mbcnt_lo_u32_b32 %0, -1, 0\n\tv_mbcnt_hi_u32_b32 %0, -1, %0" : "=v"(lane_e));
        const bool keep = E(acc, cur, wr, wc, lane_e & 15, lane_e >> 4);
        if (!has_next) break;
        if (!keep) {
#pragma unroll
            for (int a = 0; a < 2; ++a)
#pragma unroll
                for (int b = 0; b < 2; ++b)
#pragma unroll
                    for (int m = 0; m < 4; ++m)
#pragma unroll
                        for (int n = 0; n < 2; ++n) acc[a][b][m][n] = (f32x4){0.f, 0.f, 0.f, 0.f};
        }
        cur = nxt; cA = nA; cB = nB; ++ui;
        if constexpr (GATHER) {
#pragma unroll
            for (int h = 0; h < 2; ++h)
#pragma unroll
                for (int i = 0; i < 2; ++i) oc[h][i] = on[h][i];
        }
        if (wr == 1) PG8_BAR;
    }
    PG8_WAIT_V(0);
    PG8_BAR;
#undef PG8_SA
#undef PG8_SB
#undef PG8_STAGE
#undef PG8_STAGE_A
#undef PG8_LDA
#undef PG8_LDB
#undef PG8_MMA
#undef PG8_WAIT_V
#undef PG8_WAIT_L
#undef PG8_BAR
#undef PG8_SCHED
#undef PG8_LOADOFFS
#undef PG8_KITER
}

struct SchedDense {
    const char* A; const char* B; int nM, nN, G, c; size_t tstep;
    __device__ __forceinline__ bool next(int i, Unit& u) const {
        const long L = (long)i * G + c; if (L >= (long)nM * nN) return false;
        tile_map((int)L, nM, nN, u.pm, u.pn); u.A = A + (size_t)u.pm * tstep; u.B = B + (size_t)u.pn * tstep;
        u.tl = nullptr; u.e = 0; u.kind = 0; u.rowbase = u.pm * BM; u.nvalid = BM; return true; }
};
struct SchedBranch {
    const char* A0; const char* B0; const char* A1; const char* B1; int nM, nN, G, c; size_t tstep;
    __device__ __forceinline__ bool next(int i, Unit& u) const {
        const long L = (long)(i >> 1) * G + c; if (L >= (long)nM * nN) return false;
        tile_map((int)L, nM, nN, u.pm, u.pn); u.kind = i & 1;
        u.A = (u.kind ? A1 : A0) + (size_t)u.pm * tstep; u.B = (u.kind ? B1 : B0) + (size_t)u.pn * tstep;
        u.tl = nullptr; u.e = 0; u.rowbase = u.pm * BM; u.nvalid = BM; return true; }
};
struct SchedMoE {
    const LAS int* tab;
    const char* A; const char* B; size_t bexp; const int* lists; int NT, G, c; size_t tstep; bool gather;
    __device__ __forceinline__ bool next(int i, Unit& u) const {
        const int nwg = tab[32];
        const long L = (long)i * G + c; if (L >= nwg) return false;
        int wgid = (int)L; { const int q = nwg / NXCD, r = nwg % NXCD, xcd = wgid % NXCD, off = wgid / NXCD; wgid = (xcd < r ? xcd * (q + 1) : r * (q + 1) + (xcd - r) * q) + off; }
        int e = 0; while (e < 31 && tab[e + 1] <= wgid) ++e;
        const int local = wgid - tab[e]; u.e = e; u.pm = local / NT; u.pn = local % NT; u.kind = 0;
        u.rowbase = tab[64 + e] + u.pm * BM; int nv = tab[128 + e] - u.pm * BM; u.nvalid = nv > BM ? BM : nv;
        u.B = B + (size_t)e * bexp + (size_t)u.pn * tstep;
        if (gather) { u.A = A; u.tl = lists + (size_t)e * LISTCAP + u.pm * BM; }
        else { u.A = A + (size_t)u.rowbase * (tstep / BM); u.tl = nullptr; }
        return true; }
};

#define EPI_FOR_ROWS  _Pragma("unroll") for (int ai = 0; ai < 2; ++ai) _Pragma("unroll") for (int m = 0; m < 4; ++m)
struct EpiInProj {
    bf16_t* Z; const float* bias;
    __device__ __forceinline__ bool operator()(f32x4 (&acc)[2][2][4][2], const Unit& u, int wr, int wc, int fr, int fq) const {
        const int pn = u.pn, act = pn < 2 ? 0 : (pn == 2 ? 1 : (pn < 7 ? 2 : 3));
        const int col0 = pn * BM + wc * 32 + 8 * fq;
        f32x4 bv[2][2];
#pragma unroll
        for (int bj = 0; bj < 2; ++bj)
#pragma unroll
            for (int n = 0; n < 2; ++n) bv[bj][n] = *(const f32x4*)(bias + col0 + bj * HALF + 4 * n);
        EPI_FOR_ROWS { const int row = u.rowbase + ai * HALF + wr * 64 + m * 16 + fr; bf16_t* rowp = Z + (size_t)row * NZ + col0;
#pragma unroll
            for (int bj = 0; bj < 2; ++bj) { f32x4 v0 = acc[ai][bj][m][0] + bv[bj][0], v1 = acc[ai][bj][m][1] + bv[bj][1];
                if (act == 0) { v0 = v0 * 0.125f; v1 = v1 * 0.125f; }
                else if (act == 2) {
#pragma unroll
                    for (int i = 0; i < 4; ++i) { v0[i] = gelu_tanh(v0[i]); v1[i] = gelu_tanh(v1[i]); } }
                else if (act == 3) {
#pragma unroll
                    for (int i = 0; i < 4; ++i) { v0[i] = sigmoidf_(v0[i]); v1[i] = sigmoidf_(v1[i]); } }
                u32x4 w; w.x = cvt_pk_bf16(v0[0], v0[1]); w.y = cvt_pk_bf16(v0[2], v0[3]); w.z = cvt_pk_bf16(v1[0], v1[1]); w.w = cvt_pk_bf16(v1[2], v1[3]);
                *(u32x4*)(rowp + bj * HALF) = w; } }
        return false;
    }
};
struct EpiBranch {
    const bf16_t* Z; bf16_t* O;
    __device__ __forceinline__ bool operator()(f32x4 (&acc)[2][2][4][2], const Unit& u, int wr, int wc, int fr, int fq) const {
        const int col0 = u.pn * BM + wc * 32 + 8 * fq;
        if (u.kind == 0) {
            EPI_FOR_ROWS { const int row = u.rowbase + ai * HALF + wr * 64 + m * 16 + fr; const bf16_t* zr = Z + (size_t)row * NZ + col0;
#pragma unroll
                for (int bj = 0; bj < 2; ++bj) { float ga[8], gs[8]; unpack8(*(const u32x4*)(zr + ZGA + bj * HALF), ga); unpack8(*(const u32x4*)(zr + ZGS + bj * HALF), gs);
#pragma unroll
                    for (int i = 0; i < 4; ++i) { acc[ai][bj][m][0][i] *= ga[i] / gs[i]; acc[ai][bj][m][1][i] *= ga[4 + i] / gs[4 + i]; } } }
            return true;
        }
        EPI_FOR_ROWS { const int row = u.rowbase + ai * HALF + wr * 64 + m * 16 + fr; const bf16_t* zr = Z + (size_t)row * NZ + col0; bf16_t* op = O + (size_t)row * D + col0;
#pragma unroll
            for (int bj = 0; bj < 2; ++bj) { float gs[8]; unpack8(*(const u32x4*)(zr + ZGS + bj * HALF), gs);
                const f32x4 v0 = acc[ai][bj][m][0], v1 = acc[ai][bj][m][1];
                u32x4 w; w.x = cvt_pk_bf16(v0[0] * gs[0], v0[1] * gs[1]); w.y = cvt_pk_bf16(v0[2] * gs[2], v0[3] * gs[3]); w.z = cvt_pk_bf16(v1[0] * gs[4], v1[1] * gs[5]); w.w = cvt_pk_bf16(v1[2] * gs[6], v1[3] * gs[7]);
                *(u32x4*)(op + bj * HALF) = w; } }
        return false;
    }
};
struct EpiBiasBf16 {
    bf16_t* O; int ldo; const float* bias; int bstride;
    __device__ __forceinline__ bool operator()(f32x4 (&acc)[2][2][4][2], const Unit& u, int wr, int wc, int fr, int fq) const {
        const int col0 = u.pn * BM + wc * 32 + 8 * fq; const float* bp = bias + (size_t)u.e * bstride + col0;
        f32x4 bv[2][2];
#pragma unroll
        for (int bj = 0; bj < 2; ++bj)
#pragma unroll
            for (int n = 0; n < 2; ++n) bv[bj][n] = *(const f32x4*)(bp + bj * HALF + 4 * n);
        EPI_FOR_ROWS { const int row = u.rowbase + ai * HALF + wr * 64 + m * 16 + fr; bf16_t* op = O + (size_t)row * ldo + col0;
#pragma unroll
            for (int bj = 0; bj < 2; ++bj) { const f32x4 v0 = acc[ai][bj][m][0] + bv[bj][0], v1 = acc[ai][bj][m][1] + bv[bj][1];
                u32x4 w; w.x = cvt_pk_bf16(v0[0], v0[1]); w.y = cvt_pk_bf16(v0[2], v0[3]); w.z = cvt_pk_bf16(v1[0], v1[1]); w.w = cvt_pk_bf16(v1[2], v1[3]);
                *(u32x4*)(op + bj * HALF) = w; } }
        return false;
    }
};
struct EpiSwiGLU {
    bf16_t* O; const float* b1;
    __device__ __forceinline__ bool operator()(f32x4 (&acc)[2][2][4][2], const Unit& u, int wr, int wc, int fr, int fq) const {
        const int cl = wc * 32 + 8 * fq, colo = u.pn * HALF + cl; const float* bp = b1 + (size_t)u.e * (2 * DE) + colo;
        f32x4 bg[2], bl[2];
#pragma unroll
        for (int n = 0; n < 2; ++n) { bg[n] = *(const f32x4*)(bp + 4 * n); bl[n] = *(const f32x4*)(bp + DE + 4 * n); }
        EPI_FOR_ROWS { const int row = u.rowbase + ai * HALF + wr * 64 + m * 16 + fr; float r[8];
#pragma unroll
            for (int n = 0; n < 2; ++n) { const f32x4 g4 = acc[ai][0][m][n] + bg[n], l4 = acc[ai][1][m][n] + bl[n];
#pragma unroll
                for (int i = 0; i < 4; ++i) { const float g = fminf(g4[i], 7.f), l = fminf(fmaxf(l4[i], -7.f), 7.f); r[4 * n + i] = g * sigmoidf_(1.702f * g) * (l + 1.f); } }
            u32x4 w; w.x = cvt_pk_bf16(r[0], r[1]); w.y = cvt_pk_bf16(r[2], r[3]); w.z = cvt_pk_bf16(r[4], r[5]); w.w = cvt_pk_bf16(r[6], r[7]);
            *(u32x4*)(O + (size_t)row * DE + colo) = w; }
        return false;
    }
};
}

__device__ __forceinline__ void p0_transpose_item(const float* W, int K, int N, bf16_t* WT, int k0, int n0, int drow0, LAS float* scr, int lane) {
#pragma unroll 8
    for (int i = 0; i < 32; ++i) { const int kk = 2 * i + (lane >> 5); scr[kk * 33 + (lane & 31)] = W[(size_t)(k0 + kk) * N + n0 + (lane & 31)]; }
    asm volatile("s_waitcnt lgkmcnt(0)" ::: "memory");
    const int c = lane & 7;
#pragma unroll
    for (int j = 0; j < 4; ++j) { const int n = (lane >> 3) + 8 * j; const LAS float* s = scr + (8 * c) * 33 + n;
        u32x4 o; o.x = pk2(s[0 * 33], s[1 * 33]); o.y = pk2(s[2 * 33], s[3 * 33]); o.z = pk2(s[4 * 33], s[5 * 33]); o.w = pk2(s[6 * 33], s[7 * 33]);
        *(u32x4*)(WT + (size_t)(drow0 + n) * K + k0 + 8 * c) = o; }
    asm volatile("s_waitcnt lgkmcnt(0)" ::: "memory");
}
__device__ __forceinline__ void transpose_matrix(Frame& F, const float* W, int K, int N, bf16_t* WT, int& itbase, int gw, int NGW, bool w1map) {
    LAS float* scr = (LAS float*)(F.lds + F.wave * 16384);
    const int nblk = N / 32, nitems = (K / 64) * nblk;
    int first = (gw - (itbase % NGW) + NGW) % NGW;
    for (int it = first; it < nitems; it += NGW) {
        const int kb = it / nblk, nb = it % nblk, n0 = nb * 32;
        int drow0 = n0;
        if (w1map) drow0 = (n0 < DE) ? ((n0 >> 7) * 256 + (n0 & 127)) : (((n0 - DE) >> 7) * 256 + 128 + ((n0 - DE) & 127));
        p0_transpose_item(W, K, N, WT, kb * 64, n0, drow0, scr, F.lane);
    }
    itbase += nitems;
}

struct Args { const float* in[25]; float* out; unsigned char* ws; int lo, hi; };

__device__ __forceinline__ void phase0(Frame& F, const Args& a) {
    unsigned char* ws = a.ws;
    {
        const float* c_in = a.in[1]; const float* w_mod = a.in[2]; float* modp = (float*)(ws + WS_MODP);
        LAS float* cact = (LAS float*)F.lds;
        for (int it = blockIdx.x; it < KSPLIT * 12; it += F.G) {
            const int ks = it / 12, nc = it % 12, n = nc * 512 + F.tid, k0 = ks * 64;
            for (int idx = F.tid; idx < 1024; idx += NTHREADS) { const int b = idx & 15, kk = idx >> 4; const float cv = c_in[b * D + k0 + kk]; cact[kk * 16 + b] = cv * sigmoidf_(cv); }
            __syncthreads();
            float acc[16];
#pragma unroll
            for (int b = 0; b < 16; ++b) acc[b] = 0.f;
#pragma unroll 8
            for (int kk = 0; kk < 64; ++kk) { const float w = w_mod[(size_t)(k0 + kk) * 6144 + n];
#pragma unroll
                for (int b4 = 0; b4 < 4; ++b4) { const f32x4 cv = *(const LAS f32x4*)(cact + kk * 16 + 4 * b4);
                    acc[4 * b4 + 0] += cv[0] * w; acc[4 * b4 + 1] += cv[1] * w; acc[4 * b4 + 2] += cv[2] * w; acc[4 * b4 + 3] += cv[3] * w; } }
#pragma unroll
            for (int b = 0; b < 16; ++b) modp[((size_t)ks * 16 + b) * 6144 + n] = acc[b];
            __syncthreads();
        }
    }
    const int gw = blockIdx.x * NWAVES + F.wave, NGW = F.G * NWAVES;
    int itbase = 0;
    transpose_matrix(F, a.in[6], D, NZ, (bf16_t*)(ws + WS_WIN), itbase, gw, NGW, false);
    transpose_matrix(F, a.in[13], 512, D, (bf16_t*)(ws + WS_WBA), itbase, gw, NGW, false);
    transpose_matrix(F, a.in[14], 512, D, (bf16_t*)(ws + WS_WBS), itbase, gw, NGW, false);
    transpose_matrix(F, a.in[15], D, D, (bf16_t*)(ws + WS_WOUT), itbase, gw, NGW, false);
    for (int e = 0; e < NE; ++e) transpose_matrix(F, a.in[21] + (size_t)e * D * 2 * DE, D, 2 * DE, (bf16_t*)(ws + WS_W1) + (size_t)e * 2 * DE * D, itbase, gw, NGW, true);
    for (int e = 0; e < NE; ++e) transpose_matrix(F, a.in[23] + (size_t)e * DE * D, DE, D, (bf16_t*)(ws + WS_W2) + (size_t)e * D * DE, itbase, gw, NGW, false);
}

__device__ __forceinline__ void load_mod(Frame& F, const Args& a, int b, int col0, int n, LAS float* dst) {
    const float* modp = (const float*)(a.ws + WS_MODP); const float* b_mod = a.in[3];
    for (int idx = F.tid; idx < n; idx += NTHREADS) { const int col = col0 + idx; float s = b_mod[col];
#pragma unroll
        for (int ks = 0; ks < KSPLIT; ++ks) s += modp[((size_t)ks * 16 + b) * 6144 + col];
        dst[idx] = s; }
}

__device__ __forceinline__ void phase0b(Frame& F, const Args& a) {
    const float* x = a.in[0]; const float* g = a.in[4]; bf16_t* H = (bf16_t*)(a.ws + WS_H);
    LAS float* mv = (LAS float*)F.lds;
    for (int chunk = blockIdx.x; chunk < T / 128; chunk += F.G) {
        const int b = chunk / 16;
        load_mod(F, a, b, 0, 2048, mv);
        __syncthreads();
        for (int tt = 0; tt < 16; ++tt) {
            const int row = chunk * 128 + F.wave * 16 + tt;
            const f32x4* xr = (const f32x4*)(x + (size_t)row * D) + F.lane;
            f32x4 v[4]; float ss = 0.f;
#pragma unroll
            for (int j = 0; j < 4; ++j) { v[j] = xr[64 * j]; ss += (v[j][0] * v[j][0] + v[j][1] * v[j][1]) + (v[j][2] * v[j][2] + v[j][3] * v[j][3]); }
            const float rstd = rsqrtf(wave_sum(ss) * (1.f / D) + EPS);
            u32x2* o8 = (u32x2*)(H + (size_t)row * D) + F.lane;
#pragma unroll
            for (int j = 0; j < 4; ++j) { const int col = 4 * F.lane + 256 * j; const f32x4 gg = *(const f32x4*)(g + col); float r[4];
#pragma unroll
                for (int i = 0; i < 4; ++i) r[i] = v[j][i] * rstd * gg[i] * (1.f + mv[1024 + col + i]) + mv[col + i];
                u32x2 w; w.x = pk2(r[0], r[1]); w.y = pk2(r[2], r[3]); o8[64 * j] = w; }
        }
        __syncthreads();
    }
}

__device__ __forceinline__ void attn_item(Frame& F, const Args& a, int item) {
    const int hq = item & 7, n = (item >> 3) & 15, b = item >> 7, kvh = hq >> 2;
    const bf16_t* Z = (const bf16_t*)(a.ws + WS_Z); bf16_t* YA = (bf16_t*)(a.ws + WS_YATT);
    LAS bf16_t* Ks = (LAS bf16_t*)F.lds;
    LAS bf16_t* Vs = Ks + 256 * 72;
    const int tok0 = b * SEQ + n * 128;
    for (int c = F.tid; c < 2048; c += NTHREADS) { const int kj = c >> 3, ch = c & 7; const int tk = tok0 - 128 + kj;
        u32x4 kv = (u32x4){0u, 0u, 0u, 0u}, vv = kv;
        if (n > 0 || kj >= 128) { const bf16_t* zr = Z + (size_t)tk * NZ + kvh * 64 + ch * 8; kv = *(const u32x4*)(zr + ZK); vv = *(const u32x4*)(zr + ZV); }
        *(LAS u32x4*)(Ks + kj * 72 + ch * 8) = kv; *(LAS u32x4*)(Vs + kj * 72 + ch * 8) = vv; }
    __syncthreads();
    const int qi = F.tid >> 2, j4 = F.tid & 3;
    float q[64];
    { const bf16_t* qr = Z + (size_t)(tok0 + qi) * NZ + ZQ + hq * 64;
#pragma unroll
      for (int c = 0; c < 8; ++c) unpack8(*(const u32x4*)(qr + c * 8), q + c * 8); }
    const float slope = exp2f(-(float)(hq + 1)), sink = a.in[8][hq];
    float s[32]; float mx = -1e30f;
#pragma unroll
    for (int i = 0; i < 32; ++i) { const int kj = qi + 1 + j4 + 4 * i; const LAS bf16_t* kr = Ks + kj * 72; float dot = 0.f;
#pragma unroll
        for (int c = 0; c < 8; ++c) { float kf[8]; unpack8(*(const LAS u32x4*)(kr + c * 8), kf);
#pragma unroll
            for (int d = 0; d < 8; ++d) dot += q[c * 8 + d] * kf[d]; }
        const float dist = (float)(127 - j4 - 4 * i); const bool valid = (n > 0) || (kj >= 128);
        s[i] = valid ? (dot - slope * dist) : -1e30f; mx = fmaxf(mx, s[i]); }
    mx = fmaxf(mx, __shfl_xor(mx, 1)); mx = fmaxf(mx, __shfl_xor(mx, 2)); mx = fmaxf(mx, sink);
    float l = 0.f;
#pragma unroll
    for (int i = 0; i < 32; ++i) { const float p = __expf(s[i] - mx); s[i] = p; l += p; }
    l += __shfl_xor(l, 1); l += __shfl_xor(l, 2); l += __expf(sink - mx);
    float o[64];
#pragma unroll
    for (int d = 0; d < 64; ++d) o[d] = 0.f;
#pragma unroll 4
    for (int i = 0; i < 32; ++i) { const int kj = qi + 1 + j4 + 4 * i; const LAS bf16_t* vr = Vs + kj * 72; const float p = s[i];
#pragma unroll
        for (int c = 0; c < 8; ++c) { float vf[8]; unpack8(*(const LAS u32x4*)(vr + c * 8), vf);
#pragma unroll
            for (int d = 0; d < 8; ++d) o[c * 8 + d] += p * vf[d]; } }
    const float inv = 1.f / l;
#pragma unroll
    for (int d = 0; d < 64; ++d) { float v = o[d]; v += __shfl_xor(v, 1); v += __shfl_xor(v, 2); o[d] = v * inv; }
    bf16_t* yr = YA + (size_t)(tok0 + qi) * 512 + hq * 64;
#pragma unroll
    for (int jj = 0; jj < 4; ++jj) if (j4 == jj) {
        u32x4 w0, w1; w0.x = pk2(o[16 * jj + 0], o[16 * jj + 1]); w0.y = pk2(o[16 * jj + 2], o[16 * jj + 3]); w0.z = pk2(o[16 * jj + 4], o[16 * jj + 5]); w0.w = pk2(o[16 * jj + 6], o[16 * jj + 7]);
        w1.x = pk2(o[16 * jj + 8], o[16 * jj + 9]); w1.y = pk2(o[16 * jj + 10], o[16 * jj + 11]); w1.z = pk2(o[16 * jj + 12], o[16 * jj + 13]); w1.w = pk2(o[16 * jj + 14], o[16 * jj + 15]);
        *(u32x4*)(yr + 16 * jj) = w0; *(u32x4*)(yr + 16 * jj + 8) = w1; }
    __syncthreads();
}

__device__ __forceinline__ void gmlp_item(Frame& F, const Args& a, int item) {
    const int b = item >> 4, chunk = item & 15;
    const bf16_t* Z = (const bf16_t*)(a.ws + WS_Z); bf16_t* YS = (bf16_t*)(a.ws + WS_YSG);
    const float* ln_g = a.in[9]; const float* ln_b = a.in[10]; const float* sg_w = a.in[11]; const float* sg_b = a.in[12];
    LAS float* Wl = (LAS float*)F.lds;
    LAS float* Vn = Wl + 128 * 129;
    LAS float* st = Vn + 128 * 64;
    const int tok0 = b * SEQ + chunk * 128;
    for (int tt = 0; tt < 16; ++tt) { const int t = F.wave * 16 + tt; float v[8]; unpack8(*(const u32x4*)(Z + (size_t)(tok0 + t) * NZ + ZVS + F.lane * 8), v);
        float s1 = 0.f;
#pragma unroll
        for (int i = 0; i < 8; ++i) s1 += v[i];
        const float mean = wave_sum(s1) * (1.f / 512.f); float s2 = 0.f;
#pragma unroll
        for (int i = 0; i < 8; ++i) { const float d = v[i] - mean; s2 += d * d; }
        const float rstd = rsqrtf(wave_sum(s2) * (1.f / 512.f) + EPS);
        if (F.lane == 0) { st[2 * t] = mean; st[2 * t + 1] = rstd; } }
    __syncthreads();
    for (int g = 0; g < 8; ++g) {
        for (int idx = F.tid; idx < 16384; idx += NTHREADS) { const int t = idx >> 7, s = idx & 127; Wl[t * 129 + s] = (s <= t) ? sg_w[(size_t)g * 16384 + idx] : 0.f; }
        for (int idx = F.tid; idx < 8192; idx += NTHREADS) { const int s = idx >> 6, d = idx & 63; const float gv = bf2f(Z[(size_t)(tok0 + s) * NZ + ZVS + g * 64 + d]);
            Vn[idx] = (gv - st[2 * s]) * st[2 * s + 1] * ln_g[g * 64 + d] + ln_b[g * 64 + d]; }
        __syncthreads();
        const int t = F.tid >> 2, dq = F.tid & 3;
        float acc[16];
#pragma unroll
        for (int i = 0; i < 16; ++i) acc[i] = 0.f;
        for (int s = 0; s <= t; ++s) { const float w = Wl[t * 129 + s]; const LAS f32x4* vp = (const LAS f32x4*)(Vn + s * 64 + dq * 16);
#pragma unroll
            for (int c = 0; c < 4; ++c) { const f32x4 vv = vp[c]; acc[4 * c] += w * vv[0]; acc[4 * c + 1] += w * vv[1]; acc[4 * c + 2] += w * vv[2]; acc[4 * c + 3] += w * vv[3]; } }
        const float bias = sg_b[g * 128 + t];
        const bf16_t* ur = Z + (size_t)(tok0 + t) * NZ + ZU + g * 64 + dq * 16; float gu[16]; unpack8(*(const u32x4*)ur, gu); unpack8(*(const u32x4*)(ur + 8), gu + 8);
        float r[16];
#pragma unroll
        for (int i = 0; i < 16; ++i) r[i] = gu[i] * (acc[i] + bias);
        bf16_t* yr = YS + (size_t)(tok0 + t) * 512 + g * 64 + dq * 16;
        u32x4 w0, w1; w0.x = pk2(r[0], r[1]); w0.y = pk2(r[2], r[3]); w0.z = pk2(r[4], r[5]); w0.w = pk2(r[6], r[7]); w1.x = pk2(r[8], r[9]); w1.y = pk2(r[10], r[11]); w1.z = pk2(r[12], r[13]); w1.w = pk2(r[14], r[15]);
        *(u32x4*)yr = w0; *(u32x4*)(yr + 8) = w1;
        __syncthreads();
    }
}

__device__ __forceinline__ void phase5(Frame& F, const Args& a) {
    const float* x = a.in[0]; const float* g_post = a.in[5]; const float* g_pre = a.in[17]; const float* w_r = a.in[19]; const float* b_r = a.in[20];
    const bf16_t* Y = (const bf16_t*)(a.ws + WS_Y); bf16_t* H2 = (bf16_t*)(a.ws + WS_H2); float* out = a.out;
    unsigned* gcnt = (unsigned*)(a.ws + WS_CTL) + CW_CNT; int* lists = (int*)(a.ws + WS_LISTS); int* tokinfo = (int*)(a.ws + WS_TOKINFO);
    LAS float* h2buf = (LAS float*)F.lds;
    LAS float* part = (LAS float*)(F.lds + 65536);
    LAS float* mv = (LAS float*)(F.lds + 81920);
    LAS int* hist = (LAS int*)(F.lds + 94208);
    LAS int* basep = hist + 32;
    LAS int* asg_e = hist + 64;
    LAS int* asg_l = asg_e + 512;
    LAS float* asg_g = (LAS float*)(asg_l + 512);
    const int e_l = F.lane & 31, kh = F.lane >> 5;
    float wreg[64];
#pragma unroll
    for (int i = 0; i < 64; ++i) wreg[i] = w_r[(size_t)(128 * F.wave + 64 * kh + i) * NE + e_l];
    for (int chunk = blockIdx.x; chunk < T / 128; chunk += F.G) {
        const int b = chunk / 16;
        load_mod(F, a, b, 2048, 3072, mv);
        if (F.tid < 32) hist[F.tid] = 0;
        __syncthreads();
        for (int sb = 0; sb < 8; ++sb) {
#pragma unroll 1
            for (int j = 0; j < 2; ++j) {
                const int tt = 2 * F.wave + j, row = chunk * 128 + sb * 16 + tt;
                const f32x4* xr = (const f32x4*)(x + (size_t)row * D) + F.lane; const u32x2* yr = (const u32x2*)(Y + (size_t)row * D) + F.lane;
                f32x4 xv[4], yv[4]; float ss = 0.f;
#pragma unroll
                for (int jj = 0; jj < 4; ++jj) { xv[jj] = xr[64 * jj]; const u32x2 w = yr[64 * jj];
                    yv[jj][0] = __uint_as_float(w.x << 16); yv[jj][1] = __uint_as_float(w.x & 0xffff0000u); yv[jj][2] = __uint_as_float(w.y << 16); yv[jj][3] = __uint_as_float(w.y & 0xffff0000u);
                    ss += (yv[jj][0] * yv[jj][0] + yv[jj][1] * yv[jj][1]) + (yv[jj][2] * yv[jj][2] + yv[jj][3] * yv[jj][3]); }
                const float rstd = rsqrtf(wave_sum(ss) * (1.f / D) + EPS); float s1 = 0.f;
#pragma unroll
                for (int jj = 0; jj < 4; ++jj) { const int col = 4 * F.lane + 256 * jj; const f32x4 gp = *(const f32x4*)(g_post + col);
#pragma unroll
                    for (int i = 0; i < 4; ++i) { const float v = xv[jj][i] + mv[col + i] * (yv[jj][i] * rstd * gp[i]); xv[jj][i] = v; s1 += v * v; }
                    *((f32x4*)(out + (size_t)row * D) + F.lane + 64 * jj) = xv[jj]; }
                const float rstd1 = rsqrtf(wave_sum(s1) * (1.f / D) + EPS);
                u32x2* o8 = (u32x2*)(H2 + (size_t)row * D) + F.lane;
#pragma unroll
                for (int jj = 0; jj < 4; ++jj) { const int col = 4 * F.lane + 256 * jj; const f32x4 gq = *(const f32x4*)(g_pre + col); f32x4 r;
#pragma unroll
                    for (int i = 0; i < 4; ++i) r[i] = xv[jj][i] * rstd1 * gq[i] * (1.f + mv[2048 + col + i]) + mv[1024 + col + i];
                    u32x2 w; w.x = pk2(r[0], r[1]); w.y = pk2(r[2], r[3]); o8[64 * jj] = w;
                    *(LAS f32x4*)(h2buf + tt * 1024 + col) = r; }
            }
            __syncthreads();
#pragma unroll 1
            for (int t16 = 0; t16 < 16; ++t16) { const LAS f32x4* hp = (const LAS f32x4*)(h2buf + t16 * 1024 + 128 * F.wave + 64 * kh); float acc = 0.f;
#pragma unroll
                for (int i4 = 0; i4 < 16; ++i4) { const f32x4 hv = hp[i4]; acc += hv[0] * wreg[4 * i4] + hv[1] * wreg[4 * i4 + 1] + hv[2] * wreg[4 * i4 + 2] + hv[3] * wreg[4 * i4 + 3]; }
                acc += __shfl_xor(acc, 32);
                if (F.lane < 32) part[(F.wave * 16 + t16) * 32 + F.lane] = acc; }
            __syncthreads();
#pragma unroll 1
            for (int j = 0; j < 2; ++j) {
                const int tt = 2 * F.wave + j, tokidx = sb * 16 + tt;
                float logit = b_r[e_l];
#pragma unroll
                for (int w = 0; w < 8; ++w) logit += part[(w * 16 + tt) * 32 + e_l];
                float val = logit; float tv[4]; int ti[4];
#pragma unroll
                for (int k = 0; k < 4; ++k) { float bv = val; int bi = e_l;
#pragma unroll
                    for (int o = 1; o < 32; o <<= 1) { const float ov = __shfl_xor(bv, o); const int oi = __shfl_xor(bi, o); if (ov > bv || (ov == bv && oi < bi)) { bv = ov; bi = oi; } }
                    tv[k] = bv; ti[k] = bi; if (e_l == bi) val = -3.0e38f; }
                const float p1 = __expf(tv[1] - tv[0]), p2 = __expf(tv[2] - tv[0]), p3 = __expf(tv[3] - tv[0]); const float inv = 1.f / (1.f + p1 + p2 + p3);
                if (F.lane < 4) { const int k = F.lane; const int e = k == 0 ? ti[0] : (k == 1 ? ti[1] : (k == 2 ? ti[2] : ti[3])); const float gt = (k == 0 ? 1.f : (k == 1 ? p1 : (k == 2 ? p2 : p3))) * inv;
                    const int lp = __hip_atomic_fetch_add(hist + e, 1, __ATOMIC_RELAXED, __HIP_MEMORY_SCOPE_WORKGROUP); asg_e[tokidx * 4 + k] = e; asg_l[tokidx * 4 + k] = lp; asg_g[tokidx * 4 + k] = gt; }
            }
        }
        __syncthreads();
        if (F.tid < 32) basep[F.tid] = (int)atomicAdd(gcnt + F.tid, (unsigned)hist[F.tid]);
        __syncthreads();
        { const int aidx = F.tid, tokidx = aidx >> 2, k = aidx & 3, e = asg_e[aidx], pos = basep[e] + asg_l[aidx], token = chunk * 128 + tokidx;
          lists[(size_t)e * LISTCAP + pos] = token;
          int* ti = tokinfo + ((size_t)token * 4 + k) * 4; ti[0] = e; ti[1] = pos; ti[2] = __float_as_int(asg_g[aidx]); ti[3] = 0; }
        __syncthreads();
    }
}

__device__ __forceinline__ void moe_tables(Frame& F, const Args& a, LAS int* tab, int NT) {
    const unsigned* gcnt = (const unsigned*)(a.ws + WS_CTL) + CW_CNT;
    if (F.tid == 0) { int us = 0, ro = 0;
        for (int e = 0; e < NE; ++e) { const int c = (int)__hip_atomic_load(gcnt + e, __ATOMIC_RELAXED, __HIP_MEMORY_SCOPE_AGENT); const int tiles = (c + 255) >> 8; tab[e] = us; tab[64 + e] = ro; tab[128 + e] = c; us += tiles * NT; ro += tiles * 256; }
        tab[32] = us; tab[64 + 32] = ro; }
    __syncthreads();
}

__device__ __forceinline__ void phase9(Frame& F, const Args& a) {
    const float* g_post = a.in[18]; const bf16_t* YS = (const bf16_t*)(a.ws + WS_YS); const int* tokinfo = (const int*)(a.ws + WS_TOKINFO); float* out = a.out;
    LAS int* tab = (LAS int*)(F.lds + MISC_OFF); LAS float* mv = (LAS float*)F.lds;
    moe_tables(F, a, tab, 4);
    for (int chunk = blockIdx.x; chunk < T / 128; chunk += F.G) {
        const int b = chunk / 16;
        load_mod(F, a, b, 5120, 1024, mv);
        __syncthreads();
        for (int tt = 0; tt < 16; ++tt) {
            const int row = chunk * 128 + F.wave * 16 + tt;
            f32x4 yv[4];
#pragma unroll
            for (int jj = 0; jj < 4; ++jj) yv[jj] = (f32x4){0.f, 0.f, 0.f, 0.f};
#pragma unroll
            for (int k = 0; k < 4; ++k) { const int* ti = tokinfo + ((size_t)row * 4 + k) * 4; const int e = ti[0], pos = ti[1]; const float gt = __int_as_float(ti[2]);
                const u32x2* yr = (const u32x2*)(YS + (size_t)(tab[64 + e] + pos) * D) + F.lane;
#pragma unroll
                for (int jj = 0; jj < 4; ++jj) { const u32x2 w = yr[64 * jj];
                    yv[jj][0] += gt * __uint_as_float(w.x << 16); yv[jj][1] += gt * __uint_as_float(w.x & 0xffff0000u); yv[jj][2] += gt * __uint_as_float(w.y << 16); yv[jj][3] += gt * __uint_as_float(w.y & 0xffff0000u); } }
            float ss = 0.f;
#pragma unroll
            for (int jj = 0; jj < 4; ++jj) ss += (yv[jj][0] * yv[jj][0] + yv[jj][1] * yv[jj][1]) + (yv[jj][2] * yv[jj][2] + yv[jj][3] * yv[jj][3]);
            const float rstd = rsqrtf(wave_sum(ss) * (1.f / D) + EPS);
            f32x4* orow = (f32x4*)(out + (size_t)row * D) + F.lane;
#pragma unroll
            for (int jj = 0; jj < 4; ++jj) { const int col = 4 * F.lane + 256 * jj; const f32x4 gp = *(const f32x4*)(g_post + col); f32x4 xv = orow[64 * jj];
#pragma unroll
                for (int i = 0; i < 4; ++i) xv[i] += mv[col + i] * (yv[jj][i] * rstd * gp[i]);
                orow[64 * jj] = xv; }
        }
        __syncthreads();
    }
}

constexpr int NPHASE = 10;
template <int LO, int HI> __global__ void __launch_bounds__(NTHREADS, 2) fwd_kernel(Args a) {
    extern __shared__ __attribute__((aligned(16))) unsigned char lds_raw[];
    Frame F; F.lds = (LAS unsigned char*)lds_raw; F.tid = threadIdx.x; F.lane = F.tid & 63; F.wave = __builtin_amdgcn_readfirstlane(F.tid >> 6); F.G = gridDim.x;
    unsigned char* ws = a.ws;
#define IN(k) (LO <= (k) && (k) < HI)
#define SEAM(k) do { if (IN(k) && IN((k) + 1)) { cg::this_grid().sync(); } } while (0)
    if (IN(0)) { phase0(F, a); } SEAM(0);
    if (IN(1)) { phase0b(F, a); } SEAM(1);
    if (IN(2)) {
        pg8::SchedDense S{(const char*)(ws + WS_H), (const char*)(ws + WS_WIN), T / 256, NZ / 256, F.G, (int)blockIdx.x, (size_t)256 * D * 2};
        pg8::EpiInProj E{(bf16_t*)(ws + WS_Z), a.in[7]};
        pg8::gemm_phase<pg8::EpiInProj, pg8::SchedDense, false>(F.lds, D, S, E);
    } SEAM(2);
    if (IN(3)) {
        for (int it = blockIdx.x; it < 256 + 2048; it += F.G) { if (it < 256) gmlp_item(F, a, it); else attn_item(F, a, it - 256); }
    } SEAM(3);
    if (IN(4)) {
        pg8::SchedBranch S{(const char*)(ws + WS_YATT), (const char*)(ws + WS_WBA), (const char*)(ws + WS_YSG), (const char*)(ws + WS_WBS), T / 256, D / 256, F.G, (int)blockIdx.x, (size_t)256 * 512 * 2};
        pg8::EpiBranch E{(const bf16_t*)(ws + WS_Z), (bf16_t*)(ws + WS_H)};
        pg8::gemm_phase<pg8::EpiBranch, pg8::SchedBranch, false>(F.lds, 512, S, E);
    } SEAM(4);
    if (IN(5)) {
        pg8::SchedDense S{(const char*)(ws + WS_H), (const char*)(ws + WS_WOUT), T / 256, D / 256, F.G, (int)blockIdx.x, (size_t)256 * D * 2};
        pg8::EpiBiasBf16 E{(bf16_t*)(ws + WS_Y), D, a.in[16], 0};
        pg8::gemm_phase<pg8::EpiBiasBf16, pg8::SchedDense, false>(F.lds, D, S, E);
    } SEAM(5);
    if (IN(6)) { phase5(F, a); } SEAM(6);
    if (IN(7)) {
        LAS int* tab = (LAS int*)(F.lds + MISC_OFF); moe_tables(F, a, tab, 8);
        pg8::SchedMoE S{tab, (const char*)(ws + WS_H2), (const char*)(ws + WS_W1), (size_t)2 * DE * D * 2, (const int*)(ws + WS_LISTS), 8, F.G, (int)blockIdx.x, (size_t)256 * D * 2, true};
        pg8::EpiSwiGLU E{(bf16_t*)(ws + WS_ACT), a.in[22]};
        pg8::gemm_phase<pg8::EpiSwiGLU, pg8::SchedMoE, true>(F.lds, D, S, E);
    } SEAM(7);
    if (IN(8)) {
        LAS int* tab = (LAS int*)(F.lds + MISC_OFF); moe_tables(F, a, tab, 4);
        pg8::SchedMoE S{tab, (const char*)(ws + WS_ACT), (const char*)(ws + WS_W2), (size_t)D * DE * 2, nullptr, 4, F.G, (int)blockIdx.x, (size_t)256 * DE * 2, false};
        pg8::EpiBiasBf16 E{(bf16_t*)(ws + WS_YS), D, a.in[24], D};
        pg8::gemm_phase<pg8::EpiBiasBf16, pg8::SchedMoE, false>(F.lds, DE, S, E);
    } SEAM(8);
    if (IN(9)) { phase9(F, a); }
#undef IN
#undef SEAM
}

extern "C" void kernel_launch(void* const* d_in, const int* in_sizes, int n_in, void* d_out, int out_size, void* d_ws, size_t ws_size, hipStream_t stream) {
#if MK_ONE_LAUNCH
    const void* kfn = (const void*)fwd_kernel<0, NPHASE>;
#else
    const void* kfns[NPHASE] = {(const void*)fwd_kernel<0, 1>, (const void*)fwd_kernel<1, 2>, (const void*)fwd_kernel<2, 3>, (const void*)fwd_kernel<3, 4>, (const void*)fwd_kernel<4, 5>,
                                (const void*)fwd_kernel<5, 6>, (const void*)fwd_kernel<6, 7>, (const void*)fwd_kernel<7, 8>, (const void*)fwd_kernel<8, 9>, (const void*)fwd_kernel<9, 10>};
#endif
    static int grid = 0;
    if (grid == 0) {
        if (n_in != 25 || out_size != T * D || ws_size < WS_END) { fprintf(stderr, "kernel_launch: unexpected problem (n_in %d out %d ws %zu)\n", n_in, out_size, ws_size); grid = -1; return; }
        int dev = 0, cus = 0, per_cu = 0;
        (void)hipGetDevice(&dev); (void)hipDeviceGetAttribute(&cus, hipDeviceAttributeMultiprocessorCount, dev);
#if MK_ONE_LAUNCH
        (void)hipFuncSetAttribute(kfn, hipFuncAttributeMaxDynamicSharedMemorySize, LDS_BYTES);
        (void)hipOccupancyMaxActiveBlocksPerMultiprocessor(&per_cu, kfn, NTHREADS, LDS_BYTES);
#else
        per_cu = 1;
        for (int p = 0; p < NPHASE; ++p) { int pc = 0; (void)hipFuncSetAttribute(kfns[p], hipFuncAttributeMaxDynamicSharedMemorySize, LDS_BYTES);
            (void)hipOccupancyMaxActiveBlocksPerMultiprocessor(&pc, kfns[p], NTHREADS, LDS_BYTES); if (pc < per_cu) per_cu = pc; }
#endif
        (void)hipGetLastError();
        if (per_cu < 1) { fprintf(stderr, "kernel_launch: occupancy query says %d blocks per CU\n", per_cu); grid = -1; return; }
        grid = cus;
    }
    if (grid < 0) return;
    (void)hipMemsetAsync((char*)d_ws + WS_CTL, 0, CTL_BYTES, stream);
    Args a{};
    for (int i = 0; i < 25; ++i) a.in[i] = (const float*)d_in[i];
    a.out = (float*)d_out; a.ws = (unsigned char*)d_ws;
#if MK_ONE_LAUNCH
    a.lo = 0; a.hi = NPHASE;
    void* args[] = {&a};
    hipError_t e = hipLaunchCooperativeKernel(kfn, dim3(grid), dim3(NTHREADS), args, LDS_BYTES, stream);
    if (e != hipSuccess) fprintf(stderr, "cooperative launch failed: %s (grid %d)\n", hipGetErrorString(e), grid);
#else
    for (int p = 0; p < NPHASE; ++p) { a.lo = p; a.hi = p + 1; void* args[] = {&a}; (void)hipLaunchKernel(kfns[p], dim3(grid), dim3(NTHREADS), args, LDS_BYTES, stream); }
#endif
}
```

```cpp
#include <hip/hip_runtime.h>
#include <hip/hip_cooperative_groups.h>
#include <cstdio>
#include <cstdint>
namespace cg = cooperative_groups;

#ifndef MK_ONE_LAUNCH
#define MK_ONE_LAUNCH 1
#endif

#define LAS __attribute__((address_space(3)))
typedef unsigned short bf16_t;
typedef short bf16x8 __attribute__((ext_vector_type(8)));
typedef float f32x4 __attribute__((ext_vector_type(4)));
typedef unsigned u32x4 __attribute__((ext_vector_type(4)));
typedef unsigned u32x2 __attribute__((ext_vector_type(2)));

constexpr int D = 1024, BATCH = 16, SEQ = 2048, T = BATCH * SEQ;
constexpr int NZ = 3840;
constexpr int ZQ = 0, ZK = 512, ZV = 640, ZU = 768, ZVS = 1280, ZGA = 1792, ZGS = 2816;
constexpr int NE = 32, TOPK = 4, DE = 1024;
constexpr int KSPLIT = 16;
constexpr float EPS = 1e-6f;
constexpr int LISTCAP = T;
constexpr int APAD = T * TOPK + NE * 256;

constexpr size_t MiB = 1u << 20;
constexpr size_t WS_CTL = 0, CTL_BYTES = 1 * MiB;
constexpr size_t WS_MODP = 1 * MiB;
constexpr size_t WS_WIN = 8 * MiB;
constexpr size_t WS_WBA = 16 * MiB, WS_WBS = 17 * MiB;
constexpr size_t WS_WOUT = 18 * MiB;
constexpr size_t WS_W1 = 24 * MiB;
constexpr size_t WS_W2 = 152 * MiB;
constexpr size_t WS_H2 = 216 * MiB;
constexpr size_t WS_Z = 280 * MiB;
constexpr size_t WS_YATT = 520 * MiB, WS_YSG = 552 * MiB;
constexpr size_t WS_H = 584 * MiB;
constexpr size_t WS_Y = 648 * MiB;
constexpr size_t WS_ACT = 280 * MiB;
constexpr size_t WS_YS = 552 * MiB;
constexpr size_t WS_LISTS = 824 * MiB;
constexpr size_t WS_TOKINFO = 828 * MiB;
constexpr size_t WS_END = 832 * MiB;
constexpr int CW_CNT = 64;

constexpr int RING_BYTES = 131072;
constexpr int MISC_OFF = RING_BYTES;
constexpr int LDS_BYTES = 147456;
constexpr int NWAVES = 8, NTHREADS = 512;

__device__ __forceinline__ float bf2f(unsigned h) { return __uint_as_float(h << 16); }
__device__ __forceinline__ unsigned f2bf(float f) { unsigned u = __float_as_uint(f); return (u + 0x7fffu + ((u >> 16) & 1u)) >> 16; }
__device__ __forceinline__ unsigned pk2(float lo, float hi) { return f2bf(lo) | (f2bf(hi) << 16); }
__device__ __forceinline__ void unpack8(const u32x4 r, float* o) {
    o[0] = __uint_as_float(r.x << 16); o[1] = __uint_as_float(r.x & 0xffff0000u);
    o[2] = __uint_as_float(r.y << 16); o[3] = __uint_as_float(r.y & 0xffff0000u);
    o[4] = __uint_as_float(r.z << 16); o[5] = __uint_as_float(r.z & 0xffff0000u);
    o[6] = __uint_as_float(r.w << 16); o[7] = __uint_as_float(r.w & 0xffff0000u);
}
__device__ __forceinline__ float wave_sum(float v) {
#pragma unroll
    for (int o = 1; o < 64; o <<= 1) v += __shfl_xor(v, o);
    return v;
}
__device__ __forceinline__ float sigmoidf_(float x) { return __builtin_amdgcn_rcpf(1.f + __expf(-x)); }
__device__ __forceinline__ float gelu_tanh(float x) { const float u = 0.7978845608028654f * (x + 0.044715f * x * x * x); return x * __builtin_amdgcn_rcpf(1.f + __expf(-2.f * u)); }

struct Frame { LAS unsigned char* lds; int tid, lane, wave, G; };

namespace pg8 {
constexpr int BM = 256, BK = 64, HALF = 128, HTB = HALF * BK * 2, STAGE_BYTES = 8 * HTB, NXCD = 8, WGM = 8;
__host__ __device__ __forceinline__ int lds_byte(int r, int c) { const int st = (r >> 4) * 2 + (c >> 5), rr = r & 15, cc = c & 31, ob = rr * 64 + cc * 2; return st * 1024 + (ob ^ (((ob >> 9) & 1) << 5)); }
__host__ __device__ __forceinline__ void stage_rc(int b, int& R, int& C) { const int st = b / 1024, sb = b % 1024, swz = sb ^ (((sb >> 9) & 1) << 5); R = (st >> 1) * 16 + swz / 64; C = (st & 1) * 32 + (swz % 64) / 2; }
__host__ __device__ __forceinline__ int perm32(int rho) { const int n = rho >> 4, i = rho & 15; return 8 * (i >> 2) + 4 * n + (i & 3); }
__device__ __forceinline__ unsigned cvt_pk_bf16(float lo, float hi) { unsigned r; asm volatile("v_cvt_pk_bf16_f32 %0, %1, %2" : "=v"(r) : "v"(lo), "v"(hi)); return r; }

struct Unit { const char* A; const char* B; const int* tl; int pm, pn, e, kind, rowbase, nvalid; };
__device__ __forceinline__ const char* uptr(const char* p) { const unsigned long long v = (unsigned long long)p;
    const unsigned lo = __builtin_amdgcn_readfirstlane((unsigned)v), hi = __builtin_amdgcn_readfirstlane((unsigned)(v >> 32)); return (const char*)(((unsigned long long)hi << 32) | lo); }

__device__ __forceinline__ void tile_map(int L, int nM, int nN, int& pm, int& pn) {
    const int nwg = nM * nN;
    int wgid = L; { const int q = nwg / NXCD, r = nwg % NXCD, xcd = wgid % NXCD, off = wgid / NXCD; wgid = (xcd < r ? xcd * (q + 1) : r * (q + 1) + (xcd - r) * q) + off; }
    const int nig = WGM * nN, gid = wgid / nig, fm = gid * WGM, gsz = (nM - fm) < WGM ? (nM - fm) : WGM;
    pm = fm + ((wgid % nig) % gsz); pn = (wgid % nig) / gsz;
}

template <class Epi, class Sched, bool GATHER>
__device__ __forceinline__ void gemm_phase(LAS unsigned char* lds, const int tid, const int K, const Sched& S, const Epi& E) {
    const int wid = __builtin_amdgcn_readfirstlane(tid >> 6), lane = tid & 63, wr = wid >> 2, wc = wid & 3, fr = lane & 15, fq = lane >> 4;
    const int nt = K / BK;
    unsigned voffB[2]; unsigned oc[2][2], on[2][2]; int Rr[2]; unsigned Cb[2];
    const size_t kstep = (size_t)(BK * 2);
    const size_t hstep = (size_t)HALF * K * 2;
#pragma unroll
    for (int i = 0; i < 2; ++i) { int R, C; stage_rc(tid * 16 + i * 8192, R, C); const int Rb = (R & ~31) + perm32(R & 31);
        Rr[i] = R; Cb[i] = (unsigned)C * 2u; voffB[i] = (unsigned)(Rb * K + C) * 2u;
        oc[0][i] = (unsigned)(R * K + C) * 2u; oc[1][i] = oc[0][i] + (unsigned)hstep; on[0][i] = oc[0][i]; on[1][i] = oc[1][i]; }
    const unsigned ldsw = (unsigned)wid * 1024u;
    const int aoff = lds_byte(wr * 64 + fr, fq * 8), boff = lds_byte(wc * 32 + fr, fq * 8);
#define PG8_SA(b, h) (((b) * 2 + (h)) * HTB)
#define PG8_SB(b, h) ((4 + (b) * 2 + (h)) * HTB)
#define PG8_STAGE(bufoff, gbase, voff) do { const char* _g = uptr((const char*)(gbase)); _Pragma("unroll") for (int _i = 0; _i < 2; ++_i) { unsigned _o = (voff)[_i]; asm volatile("" : "+v"(_o)); \
        __builtin_amdgcn_global_load_lds((const unsigned*)(_g + _o), (LAS unsigned*)(lds + (bufoff) + ldsw + _i * 8192), 16, 0, 0); } } while (0)
#define PG8_STAGE_A(bufoff, gbase, h, O) do { const char* _g = uptr((const char*)(gbase) + (GATHER ? (size_t)0 : (size_t)(h) * hstep)); _Pragma("unroll") for (int _i = 0; _i < 2; ++_i) { unsigned _o = (O)[GATHER ? (h) : 0][_i]; asm volatile("" : "+v"(_o)); \
        __builtin_amdgcn_global_load_lds((const unsigned*)(_g + _o), (LAS unsigned*)(lds + (bufoff) + ldsw + _i * 8192), 16, 0, 0); } } while (0)
#define PG8_LDA(dst, b, h) do { _Pragma("unroll") for (int m = 0; m < 4; ++m) _Pragma("unroll") for (int k = 0; k < 2; ++k) dst[m][k] = *(const LAS bf16x8*)(lds + PG8_SA(b, h) + aoff + m * 2048 + k * 1024); } while (0)
#define PG8_LDB(dst, b, h) do { _Pragma("unroll") for (int n = 0; n < 2; ++n) _Pragma("unroll") for (int k = 0; k < 2; ++k) dst[n][k] = *(const LAS bf16x8*)(lds + PG8_SB(b, h) + boff + n * 2048 + k * 1024); } while (0)
#define PG8_MMA(ai, bj, At, Bt) do { __builtin_amdgcn_s_setprio(1); _Pragma("unroll") for (int m = 0; m < 4; ++m) _Pragma("unroll") for (int n = 0; n < 2; ++n) _Pragma("unroll") for (int k = 0; k < 2; ++k) \
        acc[ai][bj][m][n] = __builtin_amdgcn_mfma_f32_16x16x32_bf16(Bt[n][k], At[m][k], acc[ai][bj][m][n], 0, 0, 0); __builtin_amdgcn_s_setprio(0); } while (0)
#define PG8_WAIT_V(n) asm volatile("s_waitcnt vmcnt(" #n ")" ::: "memory")
#define PG8_WAIT_L(n) asm volatile("s_waitcnt lgkmcnt(" #n ")" ::: "memory")
#define PG8_BAR __builtin_amdgcn_s_barrier()
#define PG8_SCHED __builtin_amdgcn_sched_barrier(0)
#define PG8_LOADOFFS(u, o) do { _Pragma("unroll") for (int _h = 0; _h < 2; ++_h) _Pragma("unroll") for (int _i = 0; _i < 2; ++_i) { \
        int _row = _h * HALF + Rr[_i]; _row = _row < (u).nvalid ? _row : (u).nvalid - 1; const int _tok = (u).tl[_row]; o[_h][_i] = (unsigned)_tok * (unsigned)(K * 2) + Cb[_i]; } } while (0)
#define PG8_KITER(LAST) do { \
            const char* a1 = cA + (size_t)(t + 1) * kstep; \
            const char* a2 = (LAST) ? nA : cA + (size_t)(t + 2) * kstep; const char* b2 = (LAST) ? nB : cB + (size_t)(t + 2) * kstep; \
            const char* a3 = a2 + kstep; const char* b3 = b2 + kstep; \
            unsigned o2[2][2]; \
            _Pragma("unroll") for (int _h = 0; _h < 2; ++_h) _Pragma("unroll") for (int _i = 0; _i < 2; ++_i) o2[_h][_i] = (GATHER && (LAST)) ? on[_h][_i] : oc[_h][_i]; \
            PG8_LDB(B0, 0, 0); PG8_LDB(B1, 0, 1); PG8_SCHED; PG8_LDA(At, 0, 0); PG8_STAGE_A(PG8_SA(1, 1), a1, 1, oc); \
            PG8_WAIT_V(8); PG8_WAIT_L(0); PG8_BAR; PG8_MMA(0, 0, At, B0); PG8_MMA(0, 1, At, B1); PG8_BAR; PG8_SCHED; \
            PG8_LDA(At, 0, 1); PG8_STAGE(PG8_SB(0, 0), b2, voffB); PG8_STAGE(PG8_SB(0, 1), b2 + hstep, voffB); PG8_STAGE_A(PG8_SA(0, 0), a2, 0, o2); \
            PG8_WAIT_V(8); PG8_WAIT_L(0); PG8_BAR; PG8_MMA(1, 0, At, B0); PG8_MMA(1, 1, At, B1); PG8_BAR; PG8_SCHED; \
            PG8_LDB(B0, 1, 0); PG8_LDB(B1, 1, 1); PG8_SCHED; PG8_LDA(At, 1, 0); PG8_STAGE_A(PG8_SA(0, 1), a2, 1, o2); \
            PG8_WAIT_V(8); PG8_WAIT_L(0); PG8_BAR; PG8_MMA(0, 0, At, B0); PG8_MMA(0, 1, At, B1); PG8_BAR; PG8_SCHED; \
            PG8_LDA(At, 1, 1); PG8_STAGE(PG8_SB(1, 0), b3, voffB); PG8_STAGE(PG8_SB(1, 1), b3 + hstep, voffB); PG8_STAGE_A(PG8_SA(1, 0), a3, 0, o2); \
            PG8_WAIT_V(8); PG8_WAIT_L(0); PG8_BAR; PG8_MMA(1, 0, At, B0); PG8_MMA(1, 1, At, B1); PG8_BAR; PG8_SCHED; \
        } while (0)
    Unit cur, nxt; int ui = 0;
    if (!S.next(0, cur)) return;
    f32x4 acc[2][2][4][2];
#pragma unroll
    for (int a = 0; a < 2; ++a)
#pragma unroll
        for (int b = 0; b < 2; ++b)
#pragma unroll
            for (int m = 0; m < 4; ++m)
#pragma unroll
                for (int n = 0; n < 2; ++n) acc[a][b][m][n] = (f32x4){0.f, 0.f, 0.f, 0.f};
    bf16x8 At[4][2], B0[2][2], B1[2][2];
    const char* cA = cur.A; const char* cB = cur.B;
    if constexpr (GATHER) { PG8_LOADOFFS(cur, oc); }
    PG8_STAGE(PG8_SB(0, 0), cB, voffB); PG8_STAGE(PG8_SB(0, 1), cB + hstep, voffB); PG8_STAGE_A(PG8_SA(0, 0), cA, 0, oc); PG8_STAGE_A(PG8_SA(0, 1), cA, 1, oc);
    if (wr == 1) PG8_BAR;
    PG8_WAIT_V(2); PG8_BAR;
    PG8_STAGE(PG8_SB(1, 0), cB + kstep, voffB); PG8_STAGE_A(PG8_SA(1, 0), cA + kstep, 0, oc); PG8_STAGE(PG8_SB(1, 1), cB + hstep + kstep, voffB);
    PG8_WAIT_V(6); PG8_BAR;
    for (;;) {
        const bool has_next = S.next(ui + 1, nxt);
        const char* nA = has_next ? nxt.A : cA; const char* nB = has_next ? nxt.B : cB;
        if constexpr (GATHER) {
            if (has_next) { PG8_LOADOFFS(nxt, on); }
            else {
#pragma unroll
                for (int h = 0; h < 2; ++h)
#pragma unroll
                    for (int i = 0; i < 2; ++i) on[h][i] = oc[h][i];
            }
        }
        int t = 0;
        for (; t < nt - 2; t += 2) PG8_KITER(false);
        PG8_KITER(true);
        if (wr == 0) PG8_BAR;
        int lane_e; asm volatile("v_mbcnt_lo_u32_b32 %0, -1, 0\n\tv_mbcnt_hi_u32_b32 %0, -1, %0" : "=v"(lane_e));
        const bool keep = E(acc, cur, wr, wc, lane_e & 15, lane_e >> 4);
        if (!has_next) break;
        if (!keep) {
#pragma unroll
            for (int a = 0; a < 2; ++a)
#pragma unroll
                for (int b = 0; b < 2; ++b)
#pragma unroll
                    for (int m = 0; m < 4; ++m)
#pragma unroll
                        for (int n = 0; n < 2; ++n) acc[a][b][m][n] = (f32x4){0.f, 0.f, 0.f, 0.f};
        }
        cur = nxt; cA = nA; cB = nB; ++ui;
        if constexpr (GATHER) {
#pragma unroll
            for (int h = 0; h < 2; ++h)
#pragma unroll
                for (int i = 0; i < 2; ++i) oc[h][i] = on[h][i];
        }
        if (wr == 1) PG8_BAR;
    }
    PG8_WAIT_V(0);
    PG8_BAR;
#undef PG8_SA
#undef PG8_SB
#undef PG8_STAGE
#undef PG8_STAGE_A
#undef PG8_LDA
#undef PG8_LDB
#undef PG8_MMA
#undef PG8_WAIT_V
#undef PG8_WAIT_L
#undef PG8_BAR
#undef PG8_SCHED
#undef PG8_LOADOFFS
#undef PG8_KITER
}

struct SchedDense {
    const char* A; const char* B; int nM, nN, G, c; size_t tstep;
    __device__ __forceinline__ bool next(int i, Unit& u) const {
        const long L = (long)i * G + c; if (L >= (long)nM * nN) return false;
        tile_map((int)L, nM, nN, u.pm, u.pn); u.A = A + (size_t)u.pm * tstep; u.B = B + (size_t)u.pn * tstep;
        u.tl = nullptr; u.e = 0; u.kind = 0; u.rowbase = u.pm * BM; u.nvalid = BM; return true; }
};
struct SchedBranch {
    const char* A0; const char* B0; const char* A1; const char* B1; int nM, nN, G, c; size_t tstep;
    __device__ __forceinline__ bool next(int i, Unit& u) const {
        const long L = (long)(i >> 1) * G + c; if (L >= (long)nM * nN) return false;
        tile_map((int)L, nM, nN, u.pm, u.pn); u.kind = i & 1;
        u.A = (u.kind ? A1 : A0) + (size_t)u.pm * tstep; u.B = (u.kind ? B1 : B0) + (size_t)u.pn * tstep;
        u.tl = nullptr; u.e = 0; u.rowbase = u.pm * BM; u.nvalid = BM; return true; }
};
struct SchedMoE {
    const LAS int* tab;
    const char* A; const char* B; size_t bexp; const int* lists; int NT, G, c; size_t tstep; bool gather;
    __device__ __forceinline__ bool next(int i, Unit& u) const {
        const int nwg = tab[32];
        const long L = (long)i * G + c; if (L >= nwg) return false;
        int wgid = (int)L; { const int q = nwg / NXCD, r = nwg % NXCD, xcd = wgid % NXCD, off = wgid / NXCD; wgid = (xcd < r ? xcd * (q + 1) : r * (q + 1) + (xcd - r) * q) + off; }
        int e = 0; while (e < 31 && tab[e + 1] <= wgid) ++e;
        const int local = wgid - tab[e]; u.e = e; u.pm = local / NT; u.pn = local % NT; u.kind = 0;
        u.rowbase = tab[64 + e] + u.pm * BM; int nv = tab[128 + e] - u.pm * BM; u.nvalid = nv > BM ? BM : nv;
        u.B = B + (size_t)e * bexp + (size_t)u.pn * tstep;
        if (gather) { u.A = A; u.tl = lists + (size_t)e * LISTCAP + u.pm * BM; }
        else { u.A = A + (size_t)u.rowbase * (tstep / BM); u.tl = nullptr; }
        return true; }
};

#define EPI_FOR_ROWS  _Pragma("unroll") for (int ai = 0; ai < 2; ++ai) _Pragma("unroll") for (int m = 0; m < 4; ++m)
struct EpiInProj {
    bf16_t* Z; const float* bias;
    __device__ __forceinline__ bool operator()(f32x4 (&acc)[2][2][4][2], const Unit& u, int wr, int wc, int fr, int fq) const {
        const int pn = u.pn, act = pn < 2 ? 0 : (pn == 2 ? 1 : (pn < 7 ? 2 : 3));
        const int col0 = pn * BM + wc * 32 + 8 * fq;
        f32x4 bv[2][2];
#pragma unroll
        for (int bj = 0; bj < 2; ++bj)
#pragma unroll
            for (int n = 0; n < 2; ++n) bv[bj][n] = *(const f32x4*)(bias + col0 + bj * HALF + 4 * n);
        EPI_FOR_ROWS { const int row = u.rowbase + ai * HALF + wr * 64 + m * 16 + fr; bf16_t* rowp = Z + (size_t)row * NZ + col0;
#pragma unroll
            for (int bj = 0; bj < 2; ++bj) { f32x4 v0 = acc[ai][bj][m][0] + bv[bj][0], v1 = acc[ai][bj][m][1] + bv[bj][1];
                if (act == 0) { v0 = v0 * 0.125f; v1 = v1 * 0.125f; }
                else if (act == 2) {
#pragma unroll
                    for (int i = 0; i < 4; ++i) { v0[i] = gelu_tanh(v0[i]); v1[i] = gelu_tanh(v1[i]); } }
                else if (act == 3) {
#pragma unroll
                    for (int i = 0; i < 4; ++i) { v0[i] = sigmoidf_(v0[i]); v1[i] = sigmoidf_(v1[i]); } }
                u32x4 w; w.x = cvt_pk_bf16(v0[0], v0[1]); w.y = cvt_pk_bf16(v0[2], v0[3]); w.z = cvt_pk_bf16(v1[0], v1[1]); w.w = cvt_pk_bf16(v1[2], v1[3]);
                *(u32x4*)(rowp + bj * HALF) = w; } }
        return false;
    }
};
struct EpiBranch {
    const bf16_t* Z; bf16_t* O;
    __device__ __forceinline__ bool operator()(f32x4 (&acc)[2][2][4][2], const Unit& u, int wr, int wc, int fr, int fq) const {
        const int col0 = u.pn * BM + wc * 32 + 8 * fq;
        if (u.kind == 0) {
            EPI_FOR_ROWS { const int row = u.rowbase + ai * HALF + wr * 64 + m * 16 + fr; const bf16_t* zr = Z + (size_t)row * NZ + col0;
#pragma unroll
                for (int bj = 0; bj < 2; ++bj) { float ga[8], gs[8]; unpack8(*(const u32x4*)(zr + ZGA + bj * HALF), ga); unpack8(*(const u32x4*)(zr + ZGS + bj * HALF), gs);
#pragma unroll
                    for (int i = 0; i < 4; ++i) { acc[ai][bj][m][0][i] *= ga[i] / gs[i]; acc[ai][bj][m][1][i] *= ga[4 + i] / gs[4 + i]; } } }
            return true;
        }
        EPI_FOR_ROWS { const int row = u.rowbase + ai * HALF + wr * 64 + m * 16 + fr; const bf16_t* zr = Z + (size_t)row * NZ + col0; bf16_t* op = O + (size_t)row * D + col0;
#pragma unroll
            for (int bj = 0; bj < 2; ++bj) { float gs[8]; unpack8(*(const u32x4*)(zr + ZGS + bj * HALF), gs);
                const f32x4 v0 = acc[ai][bj][m][0], v1 = acc[ai][bj][m][1];
                u32x4 w; w.x = cvt_pk_bf16(v0[0] * gs[0], v0[1] * gs[1]); w.y = cvt_pk_bf16(v0[2] * gs[2], v0[3] * gs[3]); w.z = cvt_pk_bf16(v1[0] * gs[4], v1[1] * gs[5]); w.w = cvt_pk_bf16(v1[2] * gs[6], v1[3] * gs[7]);
                *(u32x4*)(op + bj * HALF) = w; } }
        return false;
    }
};
struct EpiBiasBf16 {
    bf16_t* O; int ldo; const float* bias; int bstride;
    __device__ __forceinline__ bool operator()(f32x4 (&acc)[2][2][4][2], const Unit& u, int wr, int wc, int fr, int fq) const {
        const int col0 = u.pn * BM + wc * 32 + 8 * fq; const float* bp = bias + (size_t)u.e * bstride + col0;
        f32x4 bv[2][2];
#pragma unroll
        for (int bj = 0; bj < 2; ++bj)
#pragma unroll
            for (int n = 0; n < 2; ++n) bv[bj][n] = *(const f32x4*)(bp + bj * HALF + 4 * n);
        EPI_FOR_ROWS { const int row = u.rowbase + ai * HALF + wr * 64 + m * 16 + fr; bf16_t* op = O + (size_t)row * ldo + col0;
#pragma unroll
            for (int bj = 0; bj < 2; ++bj) { const f32x4 v0 = acc[ai][bj][m][0] + bv[bj][0], v1 = acc[ai][bj][m][1] + bv[bj][1];
                u32x4 w; w.x = cvt_pk_bf16(v0[0], v0[1]); w.y = cvt_pk_bf16(v0[2], v0[3]); w.z = cvt_pk_bf16(v1[0], v1[1]); w.w = cvt_pk_bf16(v1[2], v1[3]);
                *(u32x4*)(op + bj * HALF) = w; } }
        return false;
    }
};
struct EpiSwiGLU {
    bf16_t* O; const float* b1;
    __device__ __forceinline__ bool operator()(f32x4 (&acc)[2][2][4][2], const Unit& u, int wr, int wc, int fr, int fq) const {
        const int cl = wc * 32 + 8 * fq, colo = u.pn * HALF + cl; const float* bp = b1 + (size_t)u.e * (2 * DE) + colo;
        f32x4 bg[2], bl[2];
#pragma unroll
        for (int n = 0; n < 2; ++n) { bg[n] = *(const f32x4*)(bp + 4 * n); bl[n] = *(const f32x4*)(bp + DE + 4 * n); }
        EPI_FOR_ROWS { const int row = u.rowbase + ai * HALF + wr * 64 + m * 16 + fr; float r[8];
#pragma unroll
            for (int n = 0; n < 2; ++n) { const f32x4 g4 = acc[ai][0][m][n] + bg[n], l4 = acc[ai][1][m][n] + bl[n];
#pragma unroll
                for (int i = 0; i < 4; ++i) { const float g = fminf(g4[i], 7.f), l = fminf(fmaxf(l4[i], -7.f), 7.f); r[4 * n + i] = g * sigmoidf_(1.702f * g) * (l + 1.f); } }
            u32x4 w; w.x = cvt_pk_bf16(r[0], r[1]); w.y = cvt_pk_bf16(r[2], r[3]); w.z = cvt_pk_bf16(r[4], r[5]); w.w = cvt_pk_bf16(r[6], r[7]);
            *(u32x4*)(O + (size_t)row * DE + colo) = w; }
        return false;
    }
};
}

__device__ __forceinline__ void p0_transpose_item(const float* W, int K, int N, bf16_t* WT, int k0, int n0, int drow0, LAS float* scr, int lane) {
#pragma unroll 8
    for (int i = 0; i < 32; ++i) { const int kk = 2 * i + (lane >> 5); scr[kk * 33 + (lane & 31)] = W[(size_t)(k0 + kk) * N + n0 + (lane & 31)]; }
    asm volatile("s_waitcnt lgkmcnt(0)" ::: "memory");
    const int c = lane & 7;
#pragma unroll
    for (int j = 0; j < 4; ++j) { const int n = (lane >> 3) + 8 * j; const LAS float* s = scr + (8 * c) * 33 + n;
        u32x4 o; o.x = pk2(s[0 * 33], s[1 * 33]); o.y = pk2(s[2 * 33], s[3 * 33]); o.z = pk2(s[4 * 33], s[5 * 33]); o.w = pk2(s[6 * 33], s[7 * 33]);
        *(u32x4*)(WT + (size_t)(drow0 + n) * K + k0 + 8 * c) = o; }
    asm volatile("s_waitcnt lgkmcnt(0)" ::: "memory");
}
__device__ __forceinline__ void transpose_matrix(Frame& F, const float* W, int K, int N, bf16_t* WT, int& itbase, int gw, int NGW, bool w1map) {
    LAS float* scr = (LAS float*)(F.lds + F.wave * 16384);
    const int nblk = N / 32, nitems = (K / 64) * nblk;
    int first = (gw - (itbase % NGW) + NGW) % NGW;
    for (int it = first; it < nitems; it += NGW) {
        const int kb = it / nblk, nb = it % nblk, n0 = nb * 32;
        int drow0 = n0;
        if (w1map) drow0 = (n0 < DE) ? ((n0 >> 7) * 256 + (n0 & 127)) : (((n0 - DE) >> 7) * 256 + 128 + ((n0 - DE) & 127));
        p0_transpose_item(W, K, N, WT, kb * 64, n0, drow0, scr, F.lane);
    }
    itbase += nitems;
}

struct Args { const float* in[25]; float* out; unsigned char* ws; int lo, hi; };

__device__ __forceinline__ void phase0(Frame& F, const Args& a) {
    unsigned char* ws = a.ws;
    {
        const float* c_in = a.in[1]; const float* w_mod = a.in[2]; float* modp = (float*)(ws + WS_MODP);
        LAS float* cact = (LAS float*)F.lds;
        for (int it = blockIdx.x; it < KSPLIT * 12; it += F.G) {
            const int ks = it / 12, nc = it % 12, n = nc * 512 + F.tid, k0 = ks * 64;
            for (int idx = F.tid; idx < 1024; idx += NTHREADS) { const int b = idx & 15, kk = idx >> 4; const float cv = c_in[b * D + k0 + kk]; cact[kk * 16 + b] = cv * sigmoidf_(cv); }
            __syncthreads();
            float acc[16];
#pragma unroll
            for (int b = 0; b < 16; ++b) acc[b] = 0.f;
#pragma unroll 8
            for (int kk = 0; kk < 64; ++kk) { const float w = w_mod[(size_t)(k0 + kk) * 6144 + n];
#pragma unroll
                for (int b4 = 0; b4 < 4; ++b4) { const f32x4 cv = *(const LAS f32x4*)(cact + kk * 16 + 4 * b4);
                    acc[4 * b4 + 0] += cv[0] * w; acc[4 * b4 + 1] += cv[1] * w; acc[4 * b4 + 2] += cv[2] * w; acc[4 * b4 + 3] += cv[3] * w; } }
#pragma unroll
            for (int b = 0; b < 16; ++b) modp[((size_t)ks * 16 + b) * 6144 + n] = acc[b];
            __syncthreads();
        }
    }
    const int gw = blockIdx.x * NWAVES + F.wave, NGW = F.G * NWAVES;
    int itbase = 0;
    transpose_matrix(F, a.in[6], D, NZ, (bf16_t*)(ws + WS_WIN), itbase, gw, NGW, false);
    transpose_matrix(F, a.in[13], 512, D, (bf16_t*)(ws + WS_WBA), itbase, gw, NGW, false);
    transpose_matrix(F, a.in[14], 512, D, (bf16_t*)(ws + WS_WBS), itbase, gw, NGW, false);
    transpose_matrix(F, a.in[15], D, D, (bf16_t*)(ws + WS_WOUT), itbase, gw, NGW, false);
    for (int e = 0; e < NE; ++e) transpose_matrix(F, a.in[21] + (size_t)e * D * 2 * DE, D, 2 * DE, (bf16_t*)(ws + WS_W1) + (size_t)e * 2 * DE * D, itbase, gw, NGW, true);
    for (int e = 0; e < NE; ++e) transpose_matrix(F, a.in[23] + (size_t)e * DE * D, DE, D, (bf16_t*)(ws + WS_W2) + (size_t)e * D * DE, itbase, gw, NGW, false);
}

__device__ __forceinline__ void load_mod(Frame& F, const Args& a, int b, int col0, int n, LAS float* dst) {
    const float* modp = (const float*)(a.ws + WS_MODP); const float* b_mod = a.in[3];
    for (int idx = F.tid; idx < n; idx += NTHREADS) { const int col = col0 + idx; float s = b_mod[col];
#pragma unroll
        for (int ks = 0; ks < KSPLIT; ++ks) s += modp[((size_t)ks * 16 + b) * 6144 + col];
        dst[idx] = s; }
}

__device__ __forceinline__ void phase0b(Frame& F, const Args& a) {
    const float* x = a.in[0]; const float* g = a.in[4]; bf16_t* H = (bf16_t*)(a.ws + WS_H);
    LAS float* mv = (LAS float*)F.lds;
    for (int chunk = blockIdx.x; chunk < T / 128; chunk += F.G) {
        const int b = chunk / 16;
        load_mod(F, a, b, 0, 2048, mv);
        __syncthreads();
        for (int tt = 0; tt < 16; ++tt) {
            const int row = chunk * 128 + F.wave * 16 + tt;
            const f32x4* xr = (const f32x4*)(x + (size_t)row * D) + F.lane;
            f32x4 v[4]; float ss = 0.f;
#pragma unroll
            for (int j = 0; j < 4; ++j) { v[j] = xr[64 * j]; ss += (v[j][0] * v[j][0] + v[j][1] * v[j][1]) + (v[j][2] * v[j][2] + v[j][3] * v[j][3]); }
            const float rstd = rsqrtf(wave_sum(ss) * (1.f / D) + EPS);
            u32x2* o8 = (u32x2*)(H + (size_t)row * D) + F.lane;
#pragma unroll
            for (int j = 0; j < 4; ++j) { const int col = 4 * F.lane + 256 * j; const f32x4 gg = *(const f32x4*)(g + col); float r[4];
#pragma unroll
                for (int i = 0; i < 4; ++i) r[i] = v[j][i] * rstd * gg[i] * (1.f + mv[1024 + col + i]) + mv[col + i];
                u32x2 w; w.x = pk2(r[0], r[1]); w.y = pk2(r[2], r[3]); o8[64 * j] = w; }
        }
        __syncthreads();
    }
}

__device__ __forceinline__ void attn_item(Frame& F, const Args& a, int item) {
    const int hq = item & 7, n = (item >> 3) & 15, b = item >> 7, kvh = hq >> 2;
    const bf16_t* Z = (const bf16_t*)(a.ws + WS_Z); bf16_t* YA = (bf16_t*)(a.ws + WS_YATT);
    LAS bf16_t* Ks = (LAS bf16_t*)F.lds;
    LAS bf16_t* Vs = Ks + 256 * 72;
    const int tok0 = b * SEQ + n * 128;
    for (int c = F.tid; c < 2048; c += NTHREADS) { const int kj = c >> 3, ch = c & 7; const int tk = tok0 - 128 + kj;
        u32x4 kv = (u32x4){0u, 0u, 0u, 0u}, vv = kv;
        if (n > 0 || kj >= 128) { const bf16_t* zr = Z + (size_t)tk * NZ + kvh * 64 + ch * 8; kv = *(const u32x4*)(zr + ZK); vv = *(const u32x4*)(zr + ZV); }
        *(LAS u32x4*)(Ks + kj * 72 + ch * 8) = kv; *(LAS u32x4*)(Vs + kj * 72 + ch * 8) = vv; }
    __syncthreads();
    const int qi = F.tid >> 2, j4 = F.tid & 3;
    float q[64];
    { const bf16_t* qr = Z + (size_t)(tok0 + qi) * NZ + ZQ + hq * 64;
#pragma unroll
      for (int c = 0; c < 8; ++c) unpack8(*(const u32x4*)(qr + c * 8), q + c * 8); }
    const float slope = exp2f(-(float)(hq + 1)), sink = a.in[8][hq];
    float s[32]; float mx = -1e30f;
#pragma unroll
    for (int i = 0; i < 32; ++i) { const int kj = qi + 1 + j4 + 4 * i; const LAS bf16_t* kr = Ks + kj * 72; float dot = 0.f;
#pragma unroll
        for (int c = 0; c < 8; ++c) { float kf[8]; unpack8(*(const LAS u32x4*)(kr + c * 8), kf);
#pragma unroll
            for (int d = 0; d < 8; ++d) dot += q[c * 8 + d] * kf[d]; }
        const float dist = (float)(127 - j4 - 4 * i); const bool valid = (n > 0) || (kj >= 128);
        s[i] = valid ? (dot - slope * dist) : -1e30f; mx = fmaxf(mx, s[i]); }
    mx = fmaxf(mx, __shfl_xor(mx, 1)); mx = fmaxf(mx, __shfl_xor(mx, 2)); mx = fmaxf(mx, sink);
    float l = 0.f;
#pragma unroll
    for (int i = 0; i < 32; ++i) { const float p = __expf(s[i] - mx); s[i] = p; l += p; }
    l += __shfl_xor(l, 1); l += __shfl_xor(l, 2); l += __expf(sink - mx);
    float o[64];
#pragma unroll
    for (int d = 0; d < 64; ++d) o[d] = 0.f;
#pragma unroll 4
    for (int i = 0; i < 32; ++i) { const int kj = qi + 1 + j4 + 4 * i; const LAS bf16_t* vr = Vs + kj * 72; const float p = s[i];
#pragma unroll
        for (int c = 0; c < 8; ++c) { float vf[8]; unpack8(*(const LAS u32x4*)(vr + c * 8), vf);
#pragma unroll
            for (int d = 0; d < 8; ++d) o[c * 8 + d] += p * vf[d]; } }
    const float inv = 1.f / l;
#pragma unroll
    for (int d = 0; d < 64; ++d) { float v = o[d]; v += __shfl_xor(v, 1); v += __shfl_xor(v, 2); o[d] = v * inv; }
    bf16_t* yr = YA + (size_t)(tok0 + qi) * 512 + hq * 64;
#pragma unroll
    for (int jj = 0; jj < 4; ++jj) if (j4 == jj) {
        u32x4 w0, w1; w0.x = pk2(o[16 * jj + 0], o[16 * jj + 1]); w0.y = pk2(o[16 * jj + 2], o[16 * jj + 3]); w0.z = pk2(o[16 * jj + 4], o[16 * jj + 5]); w0.w = pk2(o[16 * jj + 6], o[16 * jj + 7]);
        w1.x = pk2(o[16 * jj + 8], o[16 * jj + 9]); w1.y = pk2(o[16 * jj + 10], o[16 * jj + 11]); w1.z = pk2(o[16 * jj + 12], o[16 * jj + 13]); w1.w = pk2(o[16 * jj + 14], o[16 * jj + 15]);
        *(u32x4*)(yr + 16 * jj) = w0; *(u32x4*)(yr + 16 * jj + 8) = w1; }
    __syncthreads();
}

__device__ __forceinline__ void gmlp_item(Frame& F, const Args& a, int item) {
    const int b = item >> 4, chunk = item & 15;
    const bf16_t* Z = (const bf16_t*)(a.ws + WS_Z); bf16_t* YS = (bf16_t*)(a.ws + WS_YSG);
    const float* ln_g = a.in[9]; const float* ln_b = a.in[10]; const float* sg_w = a.in[11]; const float* sg_b = a.in[12];
    LAS float* Wl = (LAS float*)F.lds;
    LAS float* Vn = Wl + 128 * 129;
    LAS float* st = Vn + 128 * 64;
    const int tok0 = b * SEQ + chunk * 128;
    for (int tt = 0; tt < 16; ++tt) { const int t = F.wave * 16 + tt; float v[8]; unpack8(*(const u32x4*)(Z + (size_t)(tok0 + t) * NZ + ZVS + F.lane * 8), v);
        float s1 = 0.f;
#pragma unroll
        for (int i = 0; i < 8; ++i) s1 += v[i];
        const float mean = wave_sum(s1) * (1.f / 512.f); float s2 = 0.f;
#pragma unroll
        for (int i = 0; i < 8; ++i) { const float d = v[i] - mean; s2 += d * d; }
        const float rstd = rsqrtf(wave_sum(s2) * (1.f / 512.f) + EPS);
        if (F.lane == 0) { st[2 * t] = mean; st[2 * t + 1] = rstd; } }
    __syncthreads();
    for (int g = 0; g < 8; ++g) {
        for (int idx = F.tid; idx < 16384; idx += NTHREADS) { const int t = idx >> 7, s = idx & 127; Wl[t * 129 + s] = (s <= t) ? sg_w[(size_t)g * 16384 + idx] : 0.f; }
        for (int idx = F.tid; idx < 8192; idx += NTHREADS) { const int s = idx >> 6, d = idx & 63; const float gv = bf2f(Z[(size_t)(tok0 + s) * NZ + ZVS + g * 64 + d]);
            Vn[idx] = (gv - st[2 * s]) * st[2 * s + 1] * ln_g[g * 64 + d] + ln_b[g * 64 + d]; }
        __syncthreads();
        const int t = F.tid >> 2, dq = F.tid & 3;
        float acc[16];
#pragma unroll
        for (int i = 0; i < 16; ++i) acc[i] = 0.f;
        for (int s = 0; s <= t; ++s) { const float w = Wl[t * 129 + s]; const LAS f32x4* vp = (const LAS f32x4*)(Vn + s * 64 + dq * 16);
#pragma unroll
            for (int c = 0; c < 4; ++c) { const f32x4 vv = vp[c]; acc[4 * c] += w * vv[0]; acc[4 * c + 1] += w * vv[1]; acc[4 * c + 2] += w * vv[2]; acc[4 * c + 3] += w * vv[3]; } }
        const float bias = sg_b[g * 128 + t];
        const bf16_t* ur = Z + (size_t)(tok0 + t) * NZ + ZU + g * 64 + dq * 16; float gu[16]; unpack8(*(const u32x4*)ur, gu); unpack8(*(const u32x4*)(ur + 8), gu + 8);
        float r[16];
#pragma unroll
        for (int i = 0; i < 16; ++i) r[i] = gu[i] * (acc[i] + bias);
        bf16_t* yr = YS + (size_t)(tok0 + t) * 512 + g * 64 + dq * 16;
        u32x4 w0, w1; w0.x = pk2(r[0], r[1]); w0.y = pk2(r[2], r[3]); w0.z = pk2(r[4], r[5]); w0.w = pk2(r[6], r[7]); w1.x = pk2(r[8], r[9]); w1.y = pk2(r[10], r[11]); w1.z = pk2(r[12], r[13]); w1.w = pk2(r[14], r[15]);
        *(u32x4*)yr = w0; *(u32x4*)(yr + 8) = w1;
        __syncthreads();
    }
}

__device__ __forceinline__ void phase5(Frame& F, const Args& a) {
    const float* x = a.in[0]; const float* g_post = a.in[5]; const float* g_pre = a.in[17]; const float* w_r = a.in[19]; const float* b_r = a.in[20];
    const bf16_t* Y = (const bf16_t*)(a.ws + WS_Y); bf16_t* H2 = (bf16_t*)(a.ws + WS_H2); float* out = a.out;
    unsigned* gcnt = (unsigned*)(a.ws + WS_CTL) + CW_CNT; int* lists = (int*)(a.ws + WS_LISTS); int* tokinfo = (int*)(a.ws + WS_TOKINFO);
    LAS float* h2buf = (LAS float*)F.lds;
    LAS float* part = (LAS float*)(F.lds + 65536);
    LAS float* mv = (LAS float*)(F.lds + 81920);
    LAS int* hist = (LAS int*)(F.lds + 94208);
    LAS int* basep = hist + 32;
    LAS int* asg_e = hist + 64;
    LAS int* asg_l = asg_e + 512;
    LAS float* asg_g = (LAS float*)(asg_l + 512);
    const int e_l = F.lane & 31, kh = F.lane >> 5;
    float wreg[64];
#pragma unroll
    for (int i = 0; i < 64; ++i) wreg[i] = w_r[(size_t)(128 * F.wave + 64 * kh + i) * NE + e_l];
    for (int chunk = blockIdx.x; chunk < T / 128; chunk += F.G) {
        const int b = chunk / 16;
        load_mod(F, a, b, 2048, 3072, mv);
        if (F.tid < 32) hist[F.tid] = 0;
        __syncthreads();
        for (int sb = 0; sb < 8; ++sb) {
#pragma unroll 1
            for (int j = 0; j < 2; ++j) {
                const int tt = 2 * F.wave + j, row = chunk * 128 + sb * 16 + tt;
                const f32x4* xr = (const f32x4*)(x + (size_t)row * D) + F.lane; const u32x2* yr = (const u32x2*)(Y + (size_t)row * D) + F.lane;
                f32x4 xv[4], yv[4]; float ss = 0.f;
#pragma unroll
                for (int jj = 0; jj < 4; ++jj) { xv[jj] = xr[64 * jj]; const u32x2 w = yr[64 * jj];
                    yv[jj][0] = __uint_as_float(w.x << 16); yv[jj][1] = __uint_as_float(w.x & 0xffff0000u); yv[jj][2] = __uint_as_float(w.y << 16); yv[jj][3] = __uint_as_float(w.y & 0xffff0000u);
                    ss += (yv[jj][0] * yv[jj][0] + yv[jj][1] * yv[jj][1]) + (yv[jj][2] * yv[jj][2] + yv[jj][3] * yv[jj][3]); }
                const float rstd = rsqrtf(wave_sum(ss) * (1.f / D) + EPS); float s1 = 0.f;
#pragma unroll
                for (int jj = 0; jj < 4; ++jj) { const int col = 4 * F.lane + 256 * jj; const f32x4 gp = *(const f32x4*)(g_post + col);
#pragma unroll
                    for (int i = 0; i < 4; ++i) { const float v = xv[jj][i] + mv[col + i] * (yv[jj][i] * rstd * gp[i]); xv[jj][i] = v; s1 += v * v; }
                    *((f32x4*)(out + (size_t)row * D) + F.lane + 64 * jj) = xv[jj]; }
                const float rstd1 = rsqrtf(wave_sum(s1) * (1.f / D) + EPS);
                u32x2* o8 = (u32x2*)(H2 + (size_t)row * D) + F.lane;
#pragma unroll
                for (int jj = 0; jj < 4; ++jj) { const int col = 4 * F.lane + 256 * jj; const f32x4 gq = *(const f32x4*)(g_pre + col); f32x4 r;
#pragma unroll
                    for (int i = 0; i < 4; ++i) r[i] = xv[jj][i] * rstd1 * gq[i] * (1.f + mv[2048 + col + i]) + mv[1024 + col + i];
                    u32x2 w; w.x = pk2(r[0], r[1]); w.y = pk2(r[2], r[3]); o8[64 * jj] = w;
                    *(LAS f32x4*)(h2buf + tt * 1024 + col) = r; }
            }
            __syncthreads();
#pragma unroll 1
            for (int t16 = 0; t16 < 16; ++t16) { const LAS f32x4* hp = (const LAS f32x4*)(h2buf + t16 * 1024 + 128 * F.wave + 64 * kh); float acc = 0.f;
#pragma unroll
                for (int i4 = 0; i4 < 16; ++i4) { const f32x4 hv = hp[i4]; acc += hv[0] * wreg[4 * i4] + hv[1] * wreg[4 * i4 + 1] + hv[2] * wreg[4 * i4 + 2] + hv[3] * wreg[4 * i4 + 3]; }
                acc += __shfl_xor(acc, 32);
                if (F.lane < 32) part[(F.wave * 16 + t16) * 32 + F.lane] = acc; }
            __syncthreads();
#pragma unroll 1
            for (int j = 0; j < 2; ++j) {
                const int tt = 2 * F.wave + j, tokidx = sb * 16 + tt;
                float logit = b_r[e_l];
#pragma unroll
                for (int w = 0; w < 8; ++w) logit += part[(w * 16 + tt) * 32 + e_l];
                float val = logit; float tv[4]; int ti[4];
#pragma unroll
                for (int k = 0; k < 4; ++k) { float bv = val; int bi = e_l;
#pragma unroll
                    for (int o = 1; o < 32; o <<= 1) { const float ov = __shfl_xor(bv, o); const int oi = __shfl_xor(bi, o); if (ov > bv || (ov == bv && oi < bi)) { bv = ov; bi = oi; } }
                    tv[k] = bv; ti[k] = bi; if (e_l == bi) val = -3.0e38f; }
                const float p1 = __expf(tv[1] - tv[0]), p2 = __expf(tv[2] - tv[0]), p3 = __expf(tv[3] - tv[0]); const float inv = 1.f / (1.f + p1 + p2 + p3);
                if (F.lane < 4) { const int k = F.lane; const int e = k == 0 ? ti[0] : (k == 1 ? ti[1] : (k == 2 ? ti[2] : ti[3])); const float gt = (k == 0 ? 1.f : (k == 1 ? p1 : (k == 2 ? p2 : p3))) * inv;
                    const int lp = __hip_atomic_fetch_add(hist + e, 1, __ATOMIC_RELAXED, __HIP_MEMORY_SCOPE_WORKGROUP); asg_e[tokidx * 4 + k] = e; asg_l[tokidx * 4 + k] = lp; asg_g[tokidx * 4 + k] = gt; }
            }
        }
        __syncthreads();
        if (F.tid < 32) basep[F.tid] = (int)atomicAdd(gcnt + F.tid, (unsigned)hist[F.tid]);
        __syncthreads();
        { const int aidx = F.tid, tokidx = aidx >> 2, k = aidx & 3, e = asg_e[aidx], pos = basep[e] + asg_l[aidx], token = chunk * 128 + tokidx;
          lists[(size_t)e * LISTCAP + pos] = token;
          int* ti = tokinfo + ((size_t)token * 4 + k) * 4; ti[0] = e; ti[1] = pos; ti[2] = __float_as_int(asg_g[aidx]); ti[3] = 0; }
        __syncthreads();
    }
}

__device__ __forceinline__ void moe_tables(Frame& F, const Args& a, LAS int* tab, int NT) {
    const unsigned* gcnt = (const unsigned*)(a.ws + WS_CTL) + CW_CNT;
    if (F.tid == 0) { int us = 0, ro = 0;
        for (int e = 0; e < NE; ++e) { const int c = (int)__hip_atomic_load(gcnt + e, __ATOMIC_RELAXED, __HIP_MEMORY_SCOPE_AGENT); const int tiles = (c + 255) >> 8; tab[e] = us; tab[64 + e] = ro; tab[128 + e] = c; us += tiles * NT; ro += tiles * 256; }
        tab[32] = us; tab[64 + 32] = ro; }
    __syncthreads();
}

__device__ __forceinline__ void phase9(Frame& F, const Args& a) {
    const float* g_post = a.in[18]; const bf16_t* YS = (const bf16_t*)(a.ws + WS_YS); const int* tokinfo = (const int*)(a.ws + WS_TOKINFO); float* out = a.out;
    LAS int* tab = (LAS int*)(F.lds + MISC_OFF); LAS float* mv = (LAS float*)F.lds;
    moe_tables(F, a, tab, 4);
    for (int chunk = blockIdx.x; chunk < T / 128; chunk += F.G) {
        const int b = chunk / 16;
        load_mod(F, a, b, 5120, 1024, mv);
        __syncthreads();
        for (int tt = 0; tt < 16; ++tt) {
            const int row = chunk * 128 + F.wave * 16 + tt;
            f32x4 yv[4];
#pragma unroll
            for (int jj = 0; jj < 4; ++jj) yv[jj] = (f32x4){0.f, 0.f, 0.f, 0.f};
#pragma unroll
            for (int k = 0; k < 4; ++k) { const int* ti = tokinfo + ((size_t)row * 4 + k) * 4; const int e = ti[0], pos = ti[1]; const float gt = __int_as_float(ti[2]);
                const u32x2* yr = (const u32x2*)(YS + (size_t)(tab[64 + e] + pos) * D) + F.lane;
#pragma unroll
                for (int jj = 0; jj < 4; ++jj) { const u32x2 w = yr[64 * jj];
                    yv[jj][0] += gt * __uint_as_float(w.x << 16); yv[jj][1] += gt * __uint_as_float(w.x & 0xffff0000u); yv[jj][2] += gt * __uint_as_float(w.y << 16); yv[jj][3] += gt * __uint_as_float(w.y & 0xffff0000u); } }
            float ss = 0.f;
#pragma unroll
            for (int jj = 0; jj < 4; ++jj) ss += (yv[jj][0] * yv[jj][0] + yv[jj][1] * yv[jj][1]) + (yv[jj][2] * yv[jj][2] + yv[jj][3] * yv[jj][3]);
            const float rstd = rsqrtf(wave_sum(ss) * (1.f / D) + EPS);
            f32x4* orow = (f32x4*)(out + (size_t)row * D) + F.lane;
#pragma unroll
            for (int jj = 0; jj < 4; ++jj) { const int col = 4 * F.lane + 256 * jj; const f32x4 gp = *(const f32x4*)(g_post + col); f32x4 xv = orow[64 * jj];
#pragma unroll
                for (int i = 0; i < 4; ++i) xv[i] += mv[col + i] * (yv[jj][i] * rstd * gp[i]);
                orow[64 * jj] = xv; }
        }
        __syncthreads();
    }
}

constexpr int NPHASE = 10;
template <int LO, int HI> __global__ void __launch_bounds__(NTHREADS, 2) fwd_kernel(Args a) {
    extern __shared__ __attribute__((aligned(16))) unsigned char lds_raw[];
    Frame F; F.lds = (LAS unsigned char*)lds_raw; F.G = gridDim.x;
#define NEWPHASE() do { int _t = threadIdx.x; asm volatile("" : "+v"(_t)); F.tid = _t; F.lane = _t & 63; F.wave = __builtin_amdgcn_readfirstlane(_t >> 6); } while (0)
    NEWPHASE();
    unsigned char* ws = a.ws;
#define IN(k) (LO <= (k) && (k) < HI)
#define SEAM(k) do { if (IN(k) && IN((k) + 1)) { cg::this_grid().sync(); } } while (0)
    if (IN(0)) { NEWPHASE(); phase0(F, a); } SEAM(0);
    if (IN(1)) { NEWPHASE(); phase0b(F, a); } SEAM(1);
    if (IN(2)) { NEWPHASE();
        pg8::SchedDense S{(const char*)(ws + WS_H), (const char*)(ws + WS_WIN), T / 256, NZ / 256, F.G, (int)blockIdx.x, (size_t)256 * D * 2};
        pg8::EpiInProj E{(bf16_t*)(ws + WS_Z), a.in[7]};
        pg8::gemm_phase<pg8::EpiInProj, pg8::SchedDense, false>(F.lds, F.tid, D, S, E);
    } SEAM(2);
    if (IN(3)) { NEWPHASE();
        for (int it = blockIdx.x; it < 256 + 2048; it += F.G) { if (it < 256) gmlp_item(F, a, it); else attn_item(F, a, it - 256); }
    } SEAM(3);
    if (IN(4)) { NEWPHASE();
        pg8::SchedBranch S{(const char*)(ws + WS_YATT), (const char*)(ws + WS_WBA), (const char*)(ws + WS_YSG), (const char*)(ws + WS_WBS), T / 256, D / 256, F.G, (int)blockIdx.x, (size_t)256 * 512 * 2};
        pg8::EpiBranch E{(const bf16_t*)(ws + WS_Z), (bf16_t*)(ws + WS_H)};
        pg8::gemm_phase<pg8::EpiBranch, pg8::SchedBranch, false>(F.lds, F.tid, 512, S, E);
    } SEAM(4);
    if (IN(5)) { NEWPHASE();
        pg8::SchedDense S{(const char*)(ws + WS_H), (const char*)(ws + WS_WOUT), T / 256, D / 256, F.G, (int)blockIdx.x, (size_t)256 * D * 2};
        pg8::EpiBiasBf16 E{(bf16_t*)(ws + WS_Y), D, a.in[16], 0};
        pg8::gemm_phase<pg8::EpiBiasBf16, pg8::SchedDense, false>(F.lds, F.tid, D, S, E);
    } SEAM(5);
    if (IN(6)) { NEWPHASE(); phase5(F, a); } SEAM(6);
    if (IN(7)) { NEWPHASE();
        LAS int* tab = (LAS int*)(F.lds + MISC_OFF); moe_tables(F, a, tab, 8);
        pg8::SchedMoE S{tab, (const char*)(ws + WS_H2), (const char*)(ws + WS_W1), (size_t)2 * DE * D * 2, (const int*)(ws + WS_LISTS), 8, F.G, (int)blockIdx.x, (size_t)256 * D * 2, true};
        pg8::EpiSwiGLU E{(bf16_t*)(ws + WS_ACT), a.in[22]};
        pg8::gemm_phase<pg8::EpiSwiGLU, pg8::SchedMoE, true>(F.lds, F.tid, D, S, E);
    } SEAM(7);
    if (IN(8)) { NEWPHASE();
        LAS int* tab = (LAS int*)(F.lds + MISC_OFF); moe_tables(F, a, tab, 4);
        pg8::SchedMoE S{tab, (const char*)(ws + WS_ACT), (const char*)(ws + WS_W2), (size_t)D * DE * 2, nullptr, 4, F.G, (int)blockIdx.x, (size_t)256 * DE * 2, false};
        pg8::EpiBiasBf16 E{(bf16_t*)(ws + WS_YS), D, a.in[24], D};
        pg8::gemm_phase<pg8::EpiBiasBf16, pg8::SchedMoE, false>(F.lds, F.tid, DE, S, E);
    } SEAM(8);
    if (IN(9)) { NEWPHASE(); phase9(F, a); }
#undef IN
#undef SEAM
}

extern "C" void kernel_launch(void* const* d_in, const int* in_sizes, int n_in, void* d_out, int out_size, void* d_ws, size_t ws_size, hipStream_t stream) {
#if MK_ONE_LAUNCH
    const void* kfn = (const void*)fwd_kernel<0, NPHASE>;
#else
    const void* kfns[NPHASE] = {(const void*)fwd_kernel<0, 1>, (const void*)fwd_kernel<1, 2>, (const void*)fwd_kernel<2, 3>, (const void*)fwd_kernel<3, 4>, (const void*)fwd_kernel<4, 5>,
                                (const void*)fwd_kernel<5, 6>, (const void*)fwd_kernel<6, 7>, (const void*)fwd_kernel<7, 8>, (const void*)fwd_kernel<8, 9>, (const void*)fwd_kernel<9, 10>};
#endif
    static int grid = 0;
    if (grid == 0) {
        if (n_in != 25 || out_size != T * D || ws_size < WS_END) { fprintf(stderr, "kernel_launch: unexpected problem (n_in %d out %d ws %zu)\n", n_in, out_size, ws_size); grid = -1; return; }
        int dev = 0, cus = 0, per_cu = 0;
        (void)hipGetDevice(&dev); (void)hipDeviceGetAttribute(&cus, hipDeviceAttributeMultiprocessorCount, dev);
#if MK_ONE_LAUNCH
        (void)hipFuncSetAttribute(kfn, hipFuncAttributeMaxDynamicSharedMemorySize, LDS_BYTES);
        (void)hipOccupancyMaxActiveBlocksPerMultiprocessor(&per_cu, kfn, NTHREADS, LDS_BYTES);
#else
        per_cu = 1;
        for (int p = 0; p < NPHASE; ++p) { int pc = 0; (void)hipFuncSetAttribute(kfns[p], hipFuncAttributeMaxDynamicSharedMemorySize, LDS_BYTES);
            (void)hipOccupancyMaxActiveBlocksPerMultiprocessor(&pc, kfns[p], NTHREADS, LDS_BYTES); if (pc < per_cu) per_cu = pc; }
#endif
        (void)hipGetLastError();
        if (per_cu < 1) { fprintf(stderr, "kernel_launch: occupancy query says %d blocks per CU\n", per_cu); grid = -1; return; }
        grid = cus;
    }
    if (grid < 0) return;
    (void)hipMemsetAsync((char*)d_ws + WS_CTL, 0, CTL_BYTES, stream);
    Args a{};
    for (int i = 0; i < 25; ++i) a.in[i] = (const float*)d_in[i];
    a.out = (float*)d_out; a.ws = (unsigned char*)d_ws;
#if MK_ONE_LAUNCH
    a.lo = 0; a.hi = NPHASE;
    void* args[] = {&a};
    hipError_t e = hipLaunchCooperativeKernel(kfn, dim3(grid), dim3(NTHREADS), args, LDS_BYTES, stream);
    if (e != hipSuccess) fprintf(stderr, "cooperative launch failed: %s (grid %d)\n", hipGetErrorString(e), grid);
#else
    for (int p = 0; p < NPHASE; ++p) { a.lo = p; a.hi = p + 1; void* args[] = {&a}; (void)hipLaunchKernel(kfns[p], dim3(grid), dim3(NTHREADS), args, LDS_BYTES, stream); }
#endif
}
```

```cpp
#include <hip/hip_runtime.h>
#include <hip/hip_cooperative_groups.h>
#include <cstdio>
#include <cstdint>
namespace cg = cooperative_groups;

#ifndef PHASE_PROGRAM
#define PHASE_PROGRAM {0, 1, 2, 3, 4, 5, 6, 7, 8, 9}
#endif
#ifndef MK_ONE_LAUNCH
#define MK_ONE_LAUNCH 1
#endif

#define LAS __attribute__((address_space(3)))
typedef unsigned short bf16_t;
typedef short bf16x8 __attribute__((ext_vector_type(8)));
typedef float f32x4 __attribute__((ext_vector_type(4)));
typedef unsigned u32x4 __attribute__((ext_vector_type(4)));
typedef unsigned u32x2 __attribute__((ext_vector_type(2)));
typedef float f32x16 __attribute__((ext_vector_type(16)));
typedef float f32x2_t __attribute__((ext_vector_type(2)));
typedef __bf16 bf16x2_t __attribute__((ext_vector_type(2)));

constexpr int D = 1024, BATCH = 16, SEQ = 2048, T = BATCH * SEQ;
constexpr int NZ = 3840;
constexpr int ZQ = 0, ZK = 512, ZV = 640, ZU = 768, ZVS = 1280, ZGA = 1792, ZGS = 2816;
constexpr int NE = 32, TOPK = 4, DE = 1024;
constexpr int KSPLIT = 16;
constexpr float EPS = 1e-6f;
constexpr int LISTCAP = T;
constexpr int APAD = T * TOPK + NE * 256;

constexpr size_t MiB = 1u << 20;
constexpr size_t WS_CTL = 0, CTL_BYTES = 1 * MiB;
constexpr size_t WS_MODP = 1 * MiB;
constexpr size_t WS_WIN = 8 * MiB;
constexpr size_t WS_WBA = 16 * MiB, WS_WBS = 17 * MiB;
constexpr size_t WS_WOUT = 18 * MiB;
constexpr size_t WS_SGW = 20 * MiB;
constexpr size_t WS_W1 = 24 * MiB;
constexpr size_t WS_W2 = 152 * MiB;
constexpr size_t WS_H2 = 216 * MiB;
constexpr size_t WS_Z = 280 * MiB;
constexpr size_t WS_YATT = 520 * MiB, WS_YSG = 552 * MiB;
constexpr size_t WS_H = 584 * MiB;
constexpr size_t WS_Y = 648 * MiB;
constexpr size_t WS_ACT = 280 * MiB;
constexpr size_t WS_YS = 552 * MiB;
constexpr size_t WS_LISTS = 824 * MiB;
constexpr size_t WS_TOKINFO = 828 * MiB;
constexpr size_t WS_X1 = 832 * MiB;
constexpr size_t WS_VT = 960 * MiB;
constexpr size_t WS_GVT = 968 * MiB;
constexpr size_t WS_END = 1000 * MiB;
constexpr int CW_CNT = 64;
constexpr int CW_BAR = 4096;

constexpr int RING_BYTES = 131072;
constexpr int MISC_OFF = RING_BYTES;
constexpr int LDS_BYTES = 147456;
constexpr int NWAVES = 8, NTHREADS = 512;

__device__ __forceinline__ float bf2f(unsigned h) { return __uint_as_float(h << 16); }
__device__ __forceinline__ unsigned f2bf(float f) { unsigned u = __float_as_uint(f); return (u + 0x7fffu + ((u >> 16) & 1u)) >> 16; }
__device__ __forceinline__ unsigned pk2(float lo, float hi) { return f2bf(lo) | (f2bf(hi) << 16); }
__device__ __forceinline__ void unpack8(const u32x4 r, float* o) {
    o[0] = __uint_as_float(r.x << 16); o[1] = __uint_as_float(r.x & 0xffff0000u);
    o[2] = __uint_as_float(r.y << 16); o[3] = __uint_as_float(r.y & 0xffff0000u);
    o[4] = __uint_as_float(r.z << 16); o[5] = __uint_as_float(r.z & 0xffff0000u);
    o[6] = __uint_as_float(r.w << 16); o[7] = __uint_as_float(r.w & 0xffff0000u);
}
__device__ __forceinline__ unsigned cvtpk(float lo, float hi) { const f32x2_t v = {lo, hi}; const bf16x2_t b = __builtin_convertvector(v, bf16x2_t); return __builtin_bit_cast(unsigned, b); }
#define MFMA32(a, b, c) __builtin_amdgcn_mfma_f32_32x32x16_bf16((a), (b), (c), 0, 0, 0)
__device__ __forceinline__ float wave_sum(float v) {
#pragma unroll
    for (int o = 1; o < 64; o <<= 1) v += __shfl_xor(v, o);
    return v;
}
__device__ __forceinline__ float sigmoidf_(float x) { return __builtin_amdgcn_rcpf(1.f + __expf(-x)); }
__device__ __forceinline__ float gelu_tanh(float x) { const float u = 0.7978845608028654f * (x + 0.044715f * x * x * x); return x * __builtin_amdgcn_rcpf(1.f + __expf(-2.f * u)); }

struct Frame { LAS unsigned char* lds; int tid, lane, wave, G; };

namespace pg8 {
constexpr int BM = 256, BK = 64, HALF = 128, HTB = HALF * BK * 2, STAGE_BYTES = 8 * HTB, NXCD = 8, WGM = 8;
__host__ __device__ __forceinline__ int lds_byte(int r, int c) { const int st = (r >> 4) * 2 + (c >> 5), rr = r & 15, cc = c & 31, ob = rr * 64 + cc * 2; return st * 1024 + (ob ^ (((ob >> 9) & 1) << 5)); }
__host__ __device__ __forceinline__ void stage_rc(int b, int& R, int& C) { const int st = b / 1024, sb = b % 1024, swz = sb ^ (((sb >> 9) & 1) << 5); R = (st >> 1) * 16 + swz / 64; C = (st & 1) * 32 + (swz % 64) / 2; }
__host__ __device__ __forceinline__ int perm32(int rho) { const int n = rho >> 4, i = rho & 15; return 8 * (i >> 2) + 4 * n + (i & 3); }
__device__ __forceinline__ unsigned cvt_pk_bf16(float lo, float hi) { unsigned r; asm volatile("v_cvt_pk_bf16_f32 %0, %1, %2" : "=v"(r) : "v"(lo), "v"(hi)); return r; }

struct Unit { const char* A; const char* B; const int* tl; int pm, pn, e, kind, rowbase, nvalid; };
__device__ __forceinline__ const char* uptr(const char* p) { const unsigned long long v = (unsigned long long)p;
    const unsigned lo = __builtin_amdgcn_readfirstlane((unsigned)v), hi = __builtin_amdgcn_readfirstlane((unsigned)(v >> 32)); return (const char*)(((unsigned long long)hi << 32) | lo); }

__device__ __forceinline__ void tile_map(int L, int nM, int nN, int& pm, int& pn) {
    const int nwg = nM * nN;
    int wgid = L; { const int q = nwg / NXCD, r = nwg % NXCD, xcd = wgid % NXCD, off = wgid / NXCD; wgid = (xcd < r ? xcd * (q + 1) : r * (q + 1) + (xcd - r) * q) + off; }
    const int nig = WGM * nN, gid = wgid / nig, fm = gid * WGM, gsz = (nM - fm) < WGM ? (nM - fm) : WGM;
    pm = fm + ((wgid % nig) % gsz); pn = (wgid % nig) / gsz;
}

template <class Epi, class Sched, bool GATHER>
__device__ __forceinline__ void gemm_phase(LAS unsigned char* lds, const int tid, const int K, const Sched& S, const Epi& E) {
    const int wid = __builtin_amdgcn_readfirstlane(tid >> 6), lane = tid & 63, wr = wid >> 2, wc = wid & 3, fr = lane & 15, fq = lane >> 4;
    const int nt = K / BK;
    unsigned voffB[2]; unsigned oc[2][2], on[2][2]; int Rr[2]; unsigned Cb[2];
    const size_t kstep = (size_t)(BK * 2);
    const size_t hstep = (size_t)HALF * K * 2;
#pragma unroll
    for (int i = 0; i < 2; ++i) { int R, C; stage_rc(tid * 16 + i * 8192, R, C); const int Rb = (R & ~31) + perm32(R & 31);
        Rr[i] = R; Cb[i] = (unsigned)C * 2u; voffB[i] = (unsigned)(Rb * K + C) * 2u;
        oc[0][i] = (unsigned)(R * K + C) * 2u; oc[1][i] = oc[0][i] + (unsigned)hstep; on[0][i] = oc[0][i]; on[1][i] = oc[1][i]; }
    const unsigned ldsw = (unsigned)wid * 1024u;
    const int aoff = lds_byte(wr * 64 + fr, fq * 8), boff = lds_byte(wc * 32 + fr, fq * 8);
#define PG8_SA(b, h) (((b) * 2 + (h)) * HTB)
#define PG8_SB(b, h) ((4 + (b) * 2 + (h)) * HTB)
#define PG8_STAGE(bufoff, gbase, voff) do { const char* _g = uptr((const char*)(gbase)); _Pragma("unroll") for (int _i = 0; _i < 2; ++_i) { unsigned _o = (voff)[_i]; asm volatile("" : "+v"(_o)); \
        __builtin_amdgcn_global_load_lds((const unsigned*)(_g + _o), (LAS unsigned*)(lds + (bufoff) + ldsw + _i * 8192), 16, 0, 0); } } while (0)
#define PG8_STAGE_A(bufoff, gbase, h, O) do { const char* _g = uptr((const char*)(gbase) + (GATHER ? (size_t)0 : (size_t)(h) * hstep)); _Pragma("unroll") for (int _i = 0; _i < 2; ++_i) { unsigned _o = (O)[GATHER ? (h) : 0][_i]; asm volatile("" : "+v"(_o)); \
        __builtin_amdgcn_global_load_lds((const unsigned*)(_g + _o), (LAS unsigned*)(lds + (bufoff) + ldsw + _i * 8192), 16, 0, 0); } } while (0)
#define PG8_LDA(dst, b, h) do { _Pragma("unroll") for (int m = 0; m < 4; ++m) _Pragma("unroll") for (int k = 0; k < 2; ++k) dst[m][k] = *(const LAS bf16x8*)(lds + PG8_SA(b, h) + aoff + m * 2048 + k * 1024); } while (0)
#define PG8_LDB(dst, b, h) do { _Pragma("unroll") for (int n = 0; n < 2; ++n) _Pragma("unroll") for (int k = 0; k < 2; ++k) dst[n][k] = *(const LAS bf16x8*)(lds + PG8_SB(b, h) + boff + n * 2048 + k * 1024); } while (0)
#define PG8_MMA(ai, bj, At, Bt) do { __builtin_amdgcn_s_setprio(1); _Pragma("unroll") for (int m = 0; m < 4; ++m) _Pragma("unroll") for (int n = 0; n < 2; ++n) _Pragma("unroll") for (int k = 0; k < 2; ++k) \
        acc[ai][bj][m][n] = __builtin_amdgcn_mfma_f32_16x16x32_bf16(Bt[n][k], At[m][k], acc[ai][bj][m][n], 0, 0, 0); __builtin_amdgcn_s_setprio(0); } while (0)
#define PG8_WAIT_V(n) asm volatile("s_waitcnt vmcnt(" #n ")" ::: "memory")
#define PG8_WAIT_L(n) asm volatile("s_waitcnt lgkmcnt(" #n ")" ::: "memory")
#define PG8_BAR __builtin_amdgcn_s_barrier()
#define PG8_SCHED __builtin_amdgcn_sched_barrier(0)
#define PG8_LOADOFFS(u, o) do { _Pragma("unroll") for (int _h = 0; _h < 2; ++_h) _Pragma("unroll") for (int _i = 0; _i < 2; ++_i) { \
        int _row = _h * HALF + Rr[_i]; _row = _row < (u).nvalid ? _row : (u).nvalid - 1; const int _tok = (u).tl[_row]; o[_h][_i] = (unsigned)_tok * (unsigned)(K * 2) + Cb[_i]; } } while (0)
#define PG8_KITER(LAST) do { \
            const char* a1 = cA + (size_t)(t + 1) * kstep; \
            const char* a2 = (LAST) ? nA : cA + (size_t)(t + 2) * kstep; const char* b2 = (LAST) ? nB : cB + (size_t)(t + 2) * kstep; \
            const char* a3 = a2 + kstep; const char* b3 = b2 + kstep; \
            unsigned o2[2][2]; \
            _Pragma("unroll") for (int _h = 0; _h < 2; ++_h) _Pragma("unroll") for (int _i = 0; _i < 2; ++_i) o2[_h][_i] = (GATHER && (LAST)) ? on[_h][_i] : oc[_h][_i]; \
            PG8_LDB(B0, 0, 0); PG8_LDB(B1, 0, 1); PG8_SCHED; PG8_LDA(At, 0, 0); PG8_STAGE_A(PG8_SA(1, 1), a1, 1, oc); \
            PG8_WAIT_V(8); PG8_WAIT_L(0); PG8_BAR; PG8_MMA(0, 0, At, B0); PG8_MMA(0, 1, At, B1); PG8_BAR; PG8_SCHED; \
            PG8_LDA(At, 0, 1); PG8_STAGE(PG8_SB(0, 0), b2, voffB); PG8_STAGE(PG8_SB(0, 1), b2 + hstep, voffB); PG8_STAGE_A(PG8_SA(0, 0), a2, 0, o2); \
            PG8_WAIT_V(8); PG8_WAIT_L(0); PG8_BAR; PG8_MMA(1, 0, At, B0); PG8_MMA(1, 1, At, B1); PG8_BAR; PG8_SCHED; \
            PG8_LDB(B0, 1, 0); PG8_LDB(B1, 1, 1); PG8_SCHED; PG8_LDA(At, 1, 0); PG8_STAGE_A(PG8_SA(0, 1), a2, 1, o2); \
            PG8_WAIT_V(8); PG8_WAIT_L(0); PG8_BAR; PG8_MMA(0, 0, At, B0); PG8_MMA(0, 1, At, B1); PG8_BAR; PG8_SCHED; \
            PG8_LDA(At, 1, 1); PG8_STAGE(PG8_SB(1, 0), b3, voffB); PG8_STAGE(PG8_SB(1, 1), b3 + hstep, voffB); PG8_STAGE_A(PG8_SA(1, 0), a3, 0, o2); \
            PG8_WAIT_V(8); PG8_WAIT_L(0); PG8_BAR; PG8_MMA(1, 0, At, B0); PG8_MMA(1, 1, At, B1); PG8_BAR; PG8_SCHED; \
        } while (0)
    Unit cur, nxt; int ui = 0;
    if (!S.next(0, cur)) return;
    f32x4 acc[2][2][4][2];
#pragma unroll
    for (int a = 0; a < 2; ++a)
#pragma unroll
        for (int b = 0; b < 2; ++b)
#pragma unroll
            for (int m = 0; m < 4; ++m)
#pragma unroll
                for (int n = 0; n < 2; ++n) acc[a][b][m][n] = (f32x4){0.f, 0.f, 0.f, 0.f};
    bf16x8 At[4][2], B0[2][2], B1[2][2];
    const char* cA = cur.A; const char* cB = cur.B;
    if constexpr (GATHER) { PG8_LOADOFFS(cur, oc); }
    PG8_STAGE(PG8_SB(0, 0), cB, voffB); PG8_STAGE(PG8_SB(0, 1), cB + hstep, voffB); PG8_STAGE_A(PG8_SA(0, 0), cA, 0, oc); PG8_STAGE_A(PG8_SA(0, 1), cA, 1, oc);
    if (wr == 1) PG8_BAR;
    PG8_WAIT_V(2); PG8_BAR;
    PG8_STAGE(PG8_SB(1, 0), cB + kstep, voffB); PG8_STAGE_A(PG8_SA(1, 0), cA + kstep, 0, oc); PG8_STAGE(PG8_SB(1, 1), cB + hstep + kstep, voffB);
    PG8_WAIT_V(6); PG8_BAR;
    for (;;) {
        const bool has_next = S.next(ui + 1, nxt);
        const char* nA = has_next ? nxt.A : cA; const char* nB = has_next ? nxt.B : cB;
        if constexpr (GATHER) {
            if (has_next) { PG8_LOADOFFS(nxt, on); }
            else {
#pragma unroll
                for (int h = 0; h < 2; ++h)
#pragma unroll
                    for (int i = 0; i < 2; ++i) on[h][i] = oc[h][i];
            }
        }
        int t = 0;
        for (; t < nt - 2; t += 2) PG8_KITER(false);
        PG8_KITER(true);
        if (wr == 0) PG8_BAR;
        int lane_e; asm volatile("v_mbcnt_lo_u32_b32 %0, -1, 0\n\tv_mbcnt_hi_u32_b32 %0, -1, %0" : "=v"(lane_e));
        const bool keep = E(acc, cur, wr, wc, lane_e & 15, lane_e >> 4);
        if (!has_next) break;
        if (!keep) {
#pragma unroll
            for (int a = 0; a < 2; ++a)
#pragma unroll
                for (int b = 0; b < 2; ++b)
#pragma unroll
                    for (int m = 0; m < 4; ++m)
#pragma unroll
                        for (int n = 0; n < 2; ++n) acc[a][b][m][n] = (f32x4){0.f, 0.f, 0.f, 0.f};
        }
        cur = nxt; cA = nA; cB = nB; ++ui;
        if constexpr (GATHER) {
#pragma unroll
            for (int h = 0; h < 2; ++h)
#pragma unroll
                for (int i = 0; i < 2; ++i) oc[h][i] = on[h][i];
        }
        if (wr == 1) PG8_BAR;
    }
    PG8_WAIT_V(0);
    PG8_BAR;
#undef PG8_SA
#undef PG8_SB
#undef PG8_STAGE
#undef PG8_STAGE_A
#undef PG8_LDA
#undef PG8_LDB
#undef PG8_MMA
#undef PG8_WAIT_V
#undef PG8_WAIT_L
#undef PG8_BAR
#undef PG8_SCHED
#undef PG8_LOADOFFS
#undef PG8_KITER
}

struct SchedDense {
    const char* A; const char* B; int nM, nN, G, c; size_t tstep;
    __device__ __forceinline__ bool next(int i, Unit& u) const {
        const long L = (long)i * G + c; if (L >= (long)nM * nN) return false;
        tile_map((int)L, nM, nN, u.pm, u.pn); u.A = A + (size_t)u.pm * tstep; u.B = B + (size_t)u.pn * tstep;
        u.tl = nullptr; u.e = 0; u.kind = 0; u.rowbase = u.pm * BM; u.nvalid = BM; return true; }
};
struct SchedBranch {
    const char* A0; const char* B0; const char* A1; const char* B1; int nM, nN, G, c; size_t tstep;
    __device__ __forceinline__ bool next(int i, Unit& u) const {
        const long L = (long)(i >> 1) * G + c; if (L >= (long)nM * nN) return false;
        tile_map((int)L, nM, nN, u.pm, u.pn); u.kind = i & 1;
        u.A = (u.kind ? A1 : A0) + (size_t)u.pm * tstep; u.B = (u.kind ? B1 : B0) + (size_t)u.pn * tstep;
        u.tl = nullptr; u.e = 0; u.rowbase = u.pm * BM; u.nvalid = BM; return true; }
};
struct SchedMoE {
    const LAS int* tab;
    const char* A; const char* B; size_t bexp; const int* lists; int NT, G, c; size_t tstep; bool gather;
    __device__ __forceinline__ bool next(int i, Unit& u) const {
        const int nwg = tab[32];
        const long L = (long)i * G + c; if (L >= nwg) return false;
        int wgid = (int)L; { const int q = nwg / NXCD, r = nwg % NXCD, xcd = wgid % NXCD, off = wgid / NXCD; wgid = (xcd < r ? xcd * (q + 1) : r * (q + 1) + (xcd - r) * q) + off; }
        int e = 0; while (e < 31 && tab[e + 1] <= wgid) ++e;
        const int local = wgid - tab[e]; u.e = e; u.pm = local / NT; u.pn = local % NT; u.kind = 0;
        u.rowbase = tab[64 + e] + u.pm * BM; int nv = tab[128 + e] - u.pm * BM; u.nvalid = nv > BM ? BM : nv;
        u.B = B + (size_t)e * bexp + (size_t)u.pn * tstep;
        if (gather) { u.A = A; u.tl = lists + (size_t)e * LISTCAP + u.pm * BM; }
        else { u.A = A + (size_t)u.rowbase * (tstep / BM); u.tl = nullptr; }
        return true; }
};

#define EPI_FOR_ROWS  _Pragma("unroll") for (int ai = 0; ai < 2; ++ai) _Pragma("unroll") for (int m = 0; m < 4; ++m)
struct EpiInProj {
    bf16_t* Z; const float* bias; bf16_t* VT; bf16_t* GVT;
    __device__ __forceinline__ bool operator()(f32x4 (&acc)[2][2][4][2], const Unit& u, int wr, int wc, int fr, int fq) const {
        const int pn = u.pn, act = pn < 2 ? 0 : (pn == 2 ? 1 : (pn < 7 ? 2 : 3));
        const int col0 = pn * BM + wc * 32 + 8 * fq;
        f32x4 bv[2][2];
#pragma unroll
        for (int bj = 0; bj < 2; ++bj)
#pragma unroll
            for (int n = 0; n < 2; ++n) bv[bj][n] = *(const f32x4*)(bias + col0 + bj * HALF + 4 * n);
        EPI_FOR_ROWS { const int row = u.rowbase + ai * HALF + wr * 64 + m * 16 + fr; bf16_t* rowp = Z + (size_t)row * NZ + col0;
#pragma unroll
            for (int bj = 0; bj < 2; ++bj) { f32x4 v0 = acc[ai][bj][m][0] + bv[bj][0], v1 = acc[ai][bj][m][1] + bv[bj][1];
                if (act == 0) { v0 = v0 * 0.125f; v1 = v1 * 0.125f; }
                else if (act == 2) {
#pragma unroll
                    for (int i = 0; i < 4; ++i) { v0[i] = gelu_tanh(v0[i]); v1[i] = gelu_tanh(v1[i]); } }
                else if (act == 3) {
#pragma unroll
                    for (int i = 0; i < 4; ++i) { v0[i] = sigmoidf_(v0[i]); v1[i] = sigmoidf_(v1[i]); } }
                u32x4 w; w.x = cvt_pk_bf16(v0[0], v0[1]); w.y = cvt_pk_bf16(v0[2], v0[3]); w.z = cvt_pk_bf16(v1[0], v1[1]); w.w = cvt_pk_bf16(v1[2], v1[3]);
                *(u32x4*)(rowp + bj * HALF) = w;
                if ((pn == 2 && bj == 1) || pn == 5 || pn == 6) {
                    const int bt = row >> 11, sq = row & (SEQ - 1);
                    bf16_t* tp = (pn == 2) ? VT + ((size_t)(bt * 128 + wc * 32 + 8 * fq)) * SEQ + sq : GVT + ((size_t)(bt * 512 + (pn - 5) * 256 + bj * HALF + wc * 32 + 8 * fq)) * SEQ + sq;
                    tp[0 * SEQ] = (bf16_t)(w.x & 0xffffu); tp[1 * SEQ] = (bf16_t)(w.x >> 16); tp[2 * SEQ] = (bf16_t)(w.y & 0xffffu); tp[3 * SEQ] = (bf16_t)(w.y >> 16);
                    tp[4 * SEQ] = (bf16_t)(w.z & 0xffffu); tp[5 * SEQ] = (bf16_t)(w.z >> 16); tp[6 * SEQ] = (bf16_t)(w.w & 0xffffu); tp[7 * SEQ] = (bf16_t)(w.w >> 16); } } }
        return false;
    }
};
struct EpiBranch {
    const bf16_t* Z; bf16_t* O;
    __device__ __forceinline__ bool operator()(f32x4 (&acc)[2][2][4][2], const Unit& u, int wr, int wc, int fr, int fq) const {
        const int col0 = u.pn * BM + wc * 32 + 8 * fq;
        if (u.kind == 0) {
            EPI_FOR_ROWS { const int row = u.rowbase + ai * HALF + wr * 64 + m * 16 + fr; const bf16_t* zr = Z + (size_t)row * NZ + col0;
#pragma unroll
                for (int bj = 0; bj < 2; ++bj) { float ga[8], gs[8]; unpack8(*(const u32x4*)(zr + ZGA + bj * HALF), ga); unpack8(*(const u32x4*)(zr + ZGS + bj * HALF), gs);
#pragma unroll
                    for (int i = 0; i < 4; ++i) { acc[ai][bj][m][0][i] *= ga[i] / gs[i]; acc[ai][bj][m][1][i] *= ga[4 + i] / gs[4 + i]; } } }
            return true;
        }
        EPI_FOR_ROWS { const int row = u.rowbase + ai * HALF + wr * 64 + m * 16 + fr; const bf16_t* zr = Z + (size_t)row * NZ + col0; bf16_t* op = O + (size_t)row * D + col0;
#pragma unroll
            for (int bj = 0; bj < 2; ++bj) { float gs[8]; unpack8(*(const u32x4*)(zr + ZGS + bj * HALF), gs);
                const f32x4 v0 = acc[ai][bj][m][0], v1 = acc[ai][bj][m][1];
                u32x4 w; w.x = cvt_pk_bf16(v0[0] * gs[0], v0[1] * gs[1]); w.y = cvt_pk_bf16(v0[2] * gs[2], v0[3] * gs[3]); w.z = cvt_pk_bf16(v1[0] * gs[4], v1[1] * gs[5]); w.w = cvt_pk_bf16(v1[2] * gs[6], v1[3] * gs[7]);
                *(u32x4*)(op + bj * HALF) = w; } }
        return false;
    }
};
struct EpiBiasBf16 {
    bf16_t* O; int ldo; const float* bias; int bstride;
    __device__ __forceinline__ bool operator()(f32x4 (&acc)[2][2][4][2], const Unit& u, int wr, int wc, int fr, int fq) const {
        const int col0 = u.pn * BM + wc * 32 + 8 * fq; const float* bp = bias + (size_t)u.e * bstride + col0;
        f32x4 bv[2][2];
#pragma unroll
        for (int bj = 0; bj < 2; ++bj)
#pragma unroll
            for (int n = 0; n < 2; ++n) bv[bj][n] = *(const f32x4*)(bp + bj * HALF + 4 * n);
        EPI_FOR_ROWS { const int row = u.rowbase + ai * HALF + wr * 64 + m * 16 + fr; bf16_t* op = O + (size_t)row * ldo + col0;
#pragma unroll
            for (int bj = 0; bj < 2; ++bj) { const f32x4 v0 = acc[ai][bj][m][0] + bv[bj][0], v1 = acc[ai][bj][m][1] + bv[bj][1];
                u32x4 w; w.x = cvt_pk_bf16(v0[0], v0[1]); w.y = cvt_pk_bf16(v0[2], v0[3]); w.z = cvt_pk_bf16(v1[0], v1[1]); w.w = cvt_pk_bf16(v1[2], v1[3]);
                *(u32x4*)(op + bj * HALF) = w; } }
        return false;
    }
};
struct EpiSwiGLU {
    bf16_t* O; const float* b1;
    __device__ __forceinline__ bool operator()(f32x4 (&acc)[2][2][4][2], const Unit& u, int wr, int wc, int fr, int fq) const {
        const int cl = wc * 32 + 8 * fq, colo = u.pn * HALF + cl; const float* bp = b1 + (size_t)u.e * (2 * DE) + colo;
        f32x4 bg[2], bl[2];
#pragma unroll
        for (int n = 0; n < 2; ++n) { bg[n] = *(const f32x4*)(bp + 4 * n); bl[n] = *(const f32x4*)(bp + DE + 4 * n); }
        EPI_FOR_ROWS { const int row = u.rowbase + ai * HALF + wr * 64 + m * 16 + fr; float r[8];
#pragma unroll
            for (int n = 0; n < 2; ++n) { const f32x4 g4 = acc[ai][0][m][n] + bg[n], l4 = acc[ai][1][m][n] + bl[n];
#pragma unroll
                for (int i = 0; i < 4; ++i) { const float g = fminf(g4[i], 7.f), l = fminf(fmaxf(l4[i], -7.f), 7.f); r[4 * n + i] = g * sigmoidf_(1.702f * g) * (l + 1.f); } }
            u32x4 w; w.x = cvt_pk_bf16(r[0], r[1]); w.y = cvt_pk_bf16(r[2], r[3]); w.z = cvt_pk_bf16(r[4], r[5]); w.w = cvt_pk_bf16(r[6], r[7]);
            *(u32x4*)(O + (size_t)row * DE + colo) = w; }
        return false;
    }
};
}

__device__ __forceinline__ void p0_transpose_item(const float* W, int K, int N, bf16_t* WT, int k0, int n0, int drow0, LAS float* scr, int lane) {
#pragma unroll 8
    for (int i = 0; i < 32; ++i) { const int kk = 2 * i + (lane >> 5); scr[kk * 33 + (lane & 31)] = W[(size_t)(k0 + kk) * N + n0 + (lane & 31)]; }
    asm volatile("s_waitcnt lgkmcnt(0)" ::: "memory");
    const int c = lane & 7;
#pragma unroll
    for (int j = 0; j < 4; ++j) { const int n = (lane >> 3) + 8 * j; const LAS float* s = scr + (8 * c) * 33 + n;
        u32x4 o; o.x = pk2(s[0 * 33], s[1 * 33]); o.y = pk2(s[2 * 33], s[3 * 33]); o.z = pk2(s[4 * 33], s[5 * 33]); o.w = pk2(s[6 * 33], s[7 * 33]);
        *(u32x4*)(WT + (size_t)(drow0 + n) * K + k0 + 8 * c) = o; }
    asm volatile("s_waitcnt lgkmcnt(0)" ::: "memory");
}
__device__ __forceinline__ void transpose_matrix(Frame& F, const float* W, int K, int N, bf16_t* WT, int& itbase, int gw, int NGW, bool w1map) {
    LAS float* scr = (LAS float*)(F.lds + F.wave * 16384);
    const int nblk = N / 32, nitems = (K / 64) * nblk;
    int first = (gw - (itbase % NGW) + NGW) % NGW;
    for (int it = first; it < nitems; it += NGW) {
        const int kb = it / nblk, nb = it % nblk, n0 = nb * 32;
        int drow0 = n0;
        if (w1map) drow0 = (n0 < DE) ? ((n0 >> 7) * 256 + (n0 & 127)) : (((n0 - DE) >> 7) * 256 + 128 + ((n0 - DE) & 127));
        p0_transpose_item(W, K, N, WT, kb * 64, n0, drow0, scr, F.lane);
    }
    itbase += nitems;
}

struct Args { const float* in[25]; float* out; unsigned char* ws; unsigned long long prog[3]; int nprog, pad; };
typedef const __attribute__((address_space(4))) Args* ArgsP;

__device__ __forceinline__ void phase0(Frame& F, ArgsP a) {
    unsigned char* ws = a->ws;
    {
        const float* c_in = a->in[1]; const float* w_mod = a->in[2]; float* modp = (float*)(ws + WS_MODP);
        LAS float* cact = (LAS float*)F.lds;
        for (int it = blockIdx.x; it < KSPLIT * 12; it += F.G) {
            const int ks = it / 12, nc = it % 12, n = nc * 512 + F.tid, k0 = ks * 64;
            for (int idx = F.tid; idx < 1024; idx += NTHREADS) { const int b = idx & 15, kk = idx >> 4; const float cv = c_in[b * D + k0 + kk]; cact[kk * 16 + b] = cv * sigmoidf_(cv); }
            __syncthreads();
            float acc[16];
#pragma unroll
            for (int b = 0; b < 16; ++b) acc[b] = 0.f;
#pragma unroll 8
            for (int kk = 0; kk < 64; ++kk) { const float w = w_mod[(size_t)(k0 + kk) * 6144 + n];
#pragma unroll
                for (int b4 = 0; b4 < 4; ++b4) { const f32x4 cv = *(const LAS f32x4*)(cact + kk * 16 + 4 * b4);
                    acc[4 * b4 + 0] += cv[0] * w; acc[4 * b4 + 1] += cv[1] * w; acc[4 * b4 + 2] += cv[2] * w; acc[4 * b4 + 3] += cv[3] * w; } }
#pragma unroll
            for (int b = 0; b < 16; ++b) modp[((size_t)ks * 16 + b) * 6144 + n] = acc[b];
            __syncthreads();
        }
    }
    { const float* sg_w = a->in[11]; bf16_t* SGW = (bf16_t*)(ws + WS_SGW);
      for (int idx = blockIdx.x * NTHREADS + F.tid; idx < 8 * 128 * 128 / 2; idx += F.G * NTHREADS) { const int e0 = 2 * idx, t = (e0 >> 7) & 127, sc = e0 & 127;
          const float w0 = sc <= t ? sg_w[e0] : 0.f, w1 = sc + 1 <= t ? sg_w[e0 + 1] : 0.f; ((unsigned*)SGW)[idx] = pk2(w0, w1); } }
    const int gw = blockIdx.x * NWAVES + F.wave, NGW = F.G * NWAVES;
    int itbase = 0;
    transpose_matrix(F, a->in[6], D, NZ, (bf16_t*)(ws + WS_WIN), itbase, gw, NGW, false);
    transpose_matrix(F, a->in[13], 512, D, (bf16_t*)(ws + WS_WBA), itbase, gw, NGW, false);
    transpose_matrix(F, a->in[14], 512, D, (bf16_t*)(ws + WS_WBS), itbase, gw, NGW, false);
    transpose_matrix(F, a->in[15], D, D, (bf16_t*)(ws + WS_WOUT), itbase, gw, NGW, false);
    for (int e = 0; e < NE; ++e) transpose_matrix(F, a->in[21] + (size_t)e * D * 2 * DE, D, 2 * DE, (bf16_t*)(ws + WS_W1) + (size_t)e * 2 * DE * D, itbase, gw, NGW, true);
    for (int e = 0; e < NE; ++e) transpose_matrix(F, a->in[23] + (size_t)e * DE * D, DE, D, (bf16_t*)(ws + WS_W2) + (size_t)e * D * DE, itbase, gw, NGW, false);
}

__device__ __forceinline__ void load_mod(Frame& F, ArgsP a, int b, int col0, int n, LAS float* dst) {
    const float* modp = (const float*)(a->ws + WS_MODP); const float* b_mod = a->in[3];
    for (int idx = F.tid; idx < n; idx += NTHREADS) { const int col = col0 + idx; float s = b_mod[col];
#pragma unroll
        for (int ks = 0; ks < KSPLIT; ++ks) s += modp[((size_t)ks * 16 + b) * 6144 + col];
        dst[idx] = s; }
}

__device__ __forceinline__ void phase0b(Frame& F, ArgsP a) {
    const float* x = a->in[0]; const float* g = a->in[4]; bf16_t* H = (bf16_t*)(a->ws + WS_H);
    LAS float* mv = (LAS float*)F.lds;
    for (int chunk = blockIdx.x; chunk < T / 128; chunk += F.G) {
        const int b = chunk / 16;
        load_mod(F, a, b, 0, 2048, mv);
        __syncthreads();
        for (int tt = 0; tt < 16; ++tt) {
            const int row = chunk * 128 + F.wave * 16 + tt;
            const f32x4* xr = (const f32x4*)(x + (size_t)row * D) + F.lane;
            f32x4 v[4]; float ss = 0.f;
#pragma unroll
            for (int j = 0; j < 4; ++j) { v[j] = xr[64 * j]; ss += (v[j][0] * v[j][0] + v[j][1] * v[j][1]) + (v[j][2] * v[j][2] + v[j][3] * v[j][3]); }
            const float rstd = rsqrtf(wave_sum(ss) * (1.f / D) + EPS);
            u32x2* o8 = (u32x2*)(H + (size_t)row * D) + F.lane;
#pragma unroll
            for (int j = 0; j < 4; ++j) { const int col = 4 * F.lane + 256 * j; const f32x4 gg = *(const f32x4*)(g + col); float r[4];
#pragma unroll
                for (int i = 0; i < 4; ++i) r[i] = v[j][i] * rstd * gg[i] * (1.f + mv[1024 + col + i]) + mv[col + i];
                u32x2 w; w.x = pk2(r[0], r[1]); w.y = pk2(r[2], r[3]); o8[64 * j] = w; }
        }
        __syncthreads();
    }
}

__device__ __forceinline__ void attn_item(Frame& F, ArgsP a, int item) {
    const int hq = item & 7, n = (item >> 3) & 15, b = item >> 7, kvh = hq >> 2;
    const bf16_t* Z = (const bf16_t*)(a->ws + WS_Z); bf16_t* YA = (bf16_t*)(a->ws + WS_YATT);
    LAS bf16_t* Ks = (LAS bf16_t*)F.lds;
    LAS bf16_t* Vs = Ks + 256 * 72;
    const int tok0 = b * SEQ + n * 128;
    for (int c = F.tid; c < 2048; c += NTHREADS) { const int kj = c >> 3, ch = c & 7; const int tk = tok0 - 128 + kj;
        u32x4 kv = (u32x4){0u, 0u, 0u, 0u}, vv = kv;
        if (n > 0 || kj >= 128) { const bf16_t* zr = Z + (size_t)tk * NZ + kvh * 64 + ch * 8; kv = *(const u32x4*)(zr + ZK); vv = *(const u32x4*)(zr + ZV); }
        *(LAS u32x4*)(Ks + kj * 72 + ch * 8) = kv; *(LAS u32x4*)(Vs + kj * 72 + ch * 8) = vv; }
    __syncthreads();
    const int qi = F.tid >> 2, j4 = F.tid & 3;
    float q[64];
    { const bf16_t* qr = Z + (size_t)(tok0 + qi) * NZ + ZQ + hq * 64;
#pragma unroll
      for (int c = 0; c < 8; ++c) unpack8(*(const u32x4*)(qr + c * 8), q + c * 8); }
    const float slope = exp2f(-(float)(hq + 1)), sink = a->in[8][hq];
    float s[32]; float mx = -1e30f;
#pragma unroll
    for (int i = 0; i < 32; ++i) { const int kj = qi + 1 + j4 + 4 * i; const LAS bf16_t* kr = Ks + kj * 72; float dot = 0.f;
#pragma unroll
        for (int c = 0; c < 8; ++c) { float kf[8]; unpack8(*(const LAS u32x4*)(kr + c * 8), kf);
#pragma unroll
            for (int d = 0; d < 8; ++d) dot += q[c * 8 + d] * kf[d]; }
        const float dist = (float)(127 - j4 - 4 * i); const bool valid = (n > 0) || (kj >= 128);
        s[i] = valid ? (dot - slope * dist) : -1e30f; mx = fmaxf(mx, s[i]); }
    mx = fmaxf(mx, __shfl_xor(mx, 1)); mx = fmaxf(mx, __shfl_xor(mx, 2)); mx = fmaxf(mx, sink);
    float l = 0.f;
#pragma unroll
    for (int i = 0; i < 32; ++i) { const float p = __expf(s[i] - mx); s[i] = p; l += p; }
    l += __shfl_xor(l, 1); l += __shfl_xor(l, 2); l += __expf(sink - mx);
    float o[64];
#pragma unroll
    for (int d = 0; d < 64; ++d) o[d] = 0.f;
#pragma unroll 4
    for (int i = 0; i < 32; ++i) { const int kj = qi + 1 + j4 + 4 * i; const LAS bf16_t* vr = Vs + kj * 72; const float p = s[i];
#pragma unroll
        for (int c = 0; c < 8; ++c) { float vf[8]; unpack8(*(const LAS u32x4*)(vr + c * 8), vf);
#pragma unroll
            for (int d = 0; d < 8; ++d) o[c * 8 + d] += p * vf[d]; } }
    const float inv = 1.f / l;
#pragma unroll
    for (int d = 0; d < 64; ++d) { float v = o[d]; v += __shfl_xor(v, 1); v += __shfl_xor(v, 2); o[d] = v * inv; }
    bf16_t* yr = YA + (size_t)(tok0 + qi) * 512 + hq * 64;
#pragma unroll
    for (int jj = 0; jj < 4; ++jj) if (j4 == jj) {
        u32x4 w0, w1; w0.x = pk2(o[16 * jj + 0], o[16 * jj + 1]); w0.y = pk2(o[16 * jj + 2], o[16 * jj + 3]); w0.z = pk2(o[16 * jj + 4], o[16 * jj + 5]); w0.w = pk2(o[16 * jj + 6], o[16 * jj + 7]);
        w1.x = pk2(o[16 * jj + 8], o[16 * jj + 9]); w1.y = pk2(o[16 * jj + 10], o[16 * jj + 11]); w1.z = pk2(o[16 * jj + 12], o[16 * jj + 13]); w1.w = pk2(o[16 * jj + 14], o[16 * jj + 15]);
        *(u32x4*)(yr + 16 * jj) = w0; *(u32x4*)(yr + 16 * jj + 8) = w1; }
    __syncthreads();
}

__device__ __forceinline__ void gmlp_item(Frame& F, ArgsP a, int item) {
    const int b = item >> 4, chunk = item & 15;
    const bf16_t* Z = (const bf16_t*)(a->ws + WS_Z); bf16_t* YS = (bf16_t*)(a->ws + WS_YSG);
    const float* ln_g = a->in[9]; const float* ln_b = a->in[10]; const float* sg_w = a->in[11]; const float* sg_b = a->in[12];
    LAS float* Wl = (LAS float*)F.lds;
    LAS float* Vn = Wl + 128 * 129;
    LAS float* st = Vn + 128 * 64;
    const int tok0 = b * SEQ + chunk * 128;
    for (int tt = 0; tt < 16; ++tt) { const int t = F.wave * 16 + tt; float v[8]; unpack8(*(const u32x4*)(Z + (size_t)(tok0 + t) * NZ + ZVS + F.lane * 8), v);
        float s1 = 0.f;
#pragma unroll
        for (int i = 0; i < 8; ++i) s1 += v[i];
        const float mean = wave_sum(s1) * (1.f / 512.f); float s2 = 0.f;
#pragma unroll
        for (int i = 0; i < 8; ++i) { const float d = v[i] - mean; s2 += d * d; }
        const float rstd = rsqrtf(wave_sum(s2) * (1.f / 512.f) + EPS);
        if (F.lane == 0) { st[2 * t] = mean; st[2 * t + 1] = rstd; } }
    __syncthreads();
    for (int g = 0; g < 8; ++g) {
        for (int idx = F.tid; idx < 16384; idx += NTHREADS) { const int t = idx >> 7, s = idx & 127; Wl[t * 129 + s] = (s <= t) ? sg_w[(size_t)g * 16384 + idx] : 0.f; }
        for (int idx = F.tid; idx < 8192; idx += NTHREADS) { const int s = idx >> 6, d = idx & 63; const float gv = bf2f(Z[(size_t)(tok0 + s) * NZ + ZVS + g * 64 + d]);
            Vn[idx] = (gv - st[2 * s]) * st[2 * s + 1] * ln_g[g * 64 + d] + ln_b[g * 64 + d]; }
        __syncthreads();
        const int t = F.tid >> 2, dq = F.tid & 3;
        float acc[16];
#pragma unroll
        for (int i = 0; i < 16; ++i) acc[i] = 0.f;
        for (int s = 0; s <= t; ++s) { const float w = Wl[t * 129 + s]; const LAS f32x4* vp = (const LAS f32x4*)(Vn + s * 64 + dq * 16);
#pragma unroll
            for (int c = 0; c < 4; ++c) { const f32x4 vv = vp[c]; acc[4 * c] += w * vv[0]; acc[4 * c + 1] += w * vv[1]; acc[4 * c + 2] += w * vv[2]; acc[4 * c + 3] += w * vv[3]; } }
        const float bias = sg_b[g * 128 + t];
        const bf16_t* ur = Z + (size_t)(tok0 + t) * NZ + ZU + g * 64 + dq * 16; float gu[16]; unpack8(*(const u32x4*)ur, gu); unpack8(*(const u32x4*)(ur + 8), gu + 8);
        float r[16];
#pragma unroll
        for (int i = 0; i < 16; ++i) r[i] = gu[i] * (acc[i] + bias);
        bf16_t* yr = YS + (size_t)(tok0 + t) * 512 + g * 64 + dq * 16;
        u32x4 w0, w1; w0.x = pk2(r[0], r[1]); w0.y = pk2(r[2], r[3]); w0.z = pk2(r[4], r[5]); w0.w = pk2(r[6], r[7]); w1.x = pk2(r[8], r[9]); w1.y = pk2(r[10], r[11]); w1.z = pk2(r[12], r[13]); w1.w = pk2(r[14], r[15]);
        *(u32x4*)yr = w0; *(u32x4*)(yr + 8) = w1;
        __syncthreads();
    }
}


__device__ __forceinline__ void attn_item_mfma(Frame& F, ArgsP a, int item) {
    const int kvh = item & 1, n = (item >> 1) & 15, b = item >> 5;
    const bf16_t* Z = (const bf16_t*)(a->ws + WS_Z); const bf16_t* VT = (const bf16_t*)(a->ws + WS_VT); bf16_t* YA = (bf16_t*)(a->ws + WS_YATT);
    LAS bf16_t* Ks = (LAS bf16_t*)F.lds;
    LAS bf16_t* Vs = Ks + 256 * 72;
    const int tok0 = b * SEQ + n * 128;
    for (int c = F.tid; c < 2048; c += NTHREADS) { const int kj = c >> 3, ch = c & 7; u32x4 kv = (u32x4){0u, 0u, 0u, 0u};
        if (n > 0 || kj >= 128) kv = *(const u32x4*)(Z + (size_t)(tok0 - 128 + kj) * NZ + ZK + kvh * 64 + ch * 8);
        *(LAS u32x4*)(Ks + kj * 72 + ch * 8) = kv; }
    for (int c = F.tid; c < 2048; c += NTHREADS) { const int d = c >> 5, ch = c & 31; u32x4 vv = (u32x4){0u, 0u, 0u, 0u};
        if (n > 0 || ch >= 16) vv = *(const u32x4*)(VT + (size_t)(b * 128 + kvh * 64 + d) * SEQ + (n - 1) * 128 + ch * 8);
        *(LAS u32x4*)(Vs + d * 264 + ch * 8) = vv; }
    __syncthreads();
    const int r = F.lane & 31, h = F.lane >> 5;
    const int pr = (r & ~12) | ((r & 4) << 1) | ((r & 8) >> 1);
#pragma unroll 1
    for (int j = 0; j < 2; ++j) {
        const int tk = F.wave * 2 + j, g = tk >> 2, qs = tk & 3, hq = kvh * 4 + g;
        const int qi = 32 * qs + r;
        const bf16_t* qp = Z + (size_t)(tok0 + qi) * NZ + ZQ + hq * 64 + 8 * h;
        bf16x8 qf[4];
#pragma unroll
        for (int ks = 0; ks < 4; ++ks) qf[ks] = *(const bf16x8*)(qp + 16 * ks);
        const float slope = exp2f(-(float)(hq + 1)), sink = a->in[8][hq];
        float mrun = sink, lsum = 0.f;
        f32x16 O[2];
#pragma unroll
        for (int dt = 0; dt < 2; ++dt)
#pragma unroll
            for (int i = 0; i < 16; ++i) O[dt][i] = 0.f;
#pragma unroll
        for (int tt = 0; tt < 5; ++tt) {
            f32x16 S;
#pragma unroll
            for (int i = 0; i < 16; ++i) S[i] = 0.f;
            const LAS bf16_t* kp = Ks + (32 * (qs + tt) + pr) * 72 + 8 * h;
#pragma unroll
            for (int ks = 0; ks < 4; ++ks) { const bf16x8 kf = *(const LAS bf16x8*)(kp + 16 * ks); S = MFMA32(kf, qf[ks], S); }
            float tmax = -1e30f;
#pragma unroll
            for (int i = 0; i < 16; ++i) { const int kj = 32 * (qs + tt) + (i & 3) + 4 * ((i >> 2) & 1) + 8 * h + 16 * (i >> 3); const int dist = qi + 128 - kj;
                const bool valid = (dist >= 0) && (dist < 128) && (n > 0 || kj >= 128);
                const float v = valid ? (S[i] - slope * (float)dist) : -1e30f; S[i] = v; tmax = fmaxf(tmax, v); }
            tmax = fmaxf(tmax, __shfl_xor(tmax, 32));
            const float mnew = fmaxf(mrun, tmax), alpha = __expf(mrun - mnew); mrun = mnew;
            float ps = 0.f;
#pragma unroll
            for (int i = 0; i < 16; ++i) { const float p = __expf(S[i] - mnew); S[i] = p; ps += p; }
            lsum = lsum * alpha + ps;
#pragma unroll
            for (int dt = 0; dt < 2; ++dt)
#pragma unroll
                for (int i = 0; i < 16; ++i) O[dt][i] *= alpha;
#pragma unroll
            for (int sx = 0; sx < 2; ++sx) {
                u32x4 pw; pw.x = cvtpk(S[8 * sx + 0], S[8 * sx + 1]); pw.y = cvtpk(S[8 * sx + 2], S[8 * sx + 3]); pw.z = cvtpk(S[8 * sx + 4], S[8 * sx + 5]); pw.w = cvtpk(S[8 * sx + 6], S[8 * sx + 7]);
                const bf16x8 pb = __builtin_bit_cast(bf16x8, pw);
#pragma unroll
                for (int dt = 0; dt < 2; ++dt) { const bf16x8 vf = *(const LAS bf16x8*)(Vs + (32 * dt + r) * 264 + 32 * (qs + tt) + 16 * sx + 8 * h); O[dt] = MFMA32(vf, pb, O[dt]); }
            }
        }
        const float l = lsum + __shfl_xor(lsum, 32) + __expf(sink - mrun);
        const float inv = 1.f / l;
        bf16_t* yp = YA + (size_t)(tok0 + qi) * 512 + hq * 64;
#pragma unroll
        for (int dt = 0; dt < 2; ++dt)
#pragma unroll
            for (int a4 = 0; a4 < 4; ++a4) { u32x2 w; w.x = cvtpk(O[dt][4 * a4] * inv, O[dt][4 * a4 + 1] * inv); w.y = cvtpk(O[dt][4 * a4 + 2] * inv, O[dt][4 * a4 + 3] * inv);
                *(u32x2*)(yp + 32 * dt + 8 * a4 + 4 * h) = w; }
    }
    __syncthreads();
}

__device__ __forceinline__ void gmlp_item_mfma(Frame& F, ArgsP a, int item) {
    const int b = item >> 4, chunk = item & 15;
    const bf16_t* Z = (const bf16_t*)(a->ws + WS_Z); const bf16_t* GVT = (const bf16_t*)(a->ws + WS_GVT); const bf16_t* SGW = (const bf16_t*)(a->ws + WS_SGW); bf16_t* YS = (bf16_t*)(a->ws + WS_YSG);
    const float* ln_g = a->in[9]; const float* ln_b = a->in[10]; const float* sg_b = a->in[12];
    LAS float* st = (LAS float*)F.lds;
    const int tok0 = b * SEQ + chunk * 128;
    for (int tt = 0; tt < 16; ++tt) { const int t = F.wave * 16 + tt; float v[8]; unpack8(*(const u32x4*)(Z + (size_t)(tok0 + t) * NZ + ZVS + F.lane * 8), v);
        float s1 = 0.f;
#pragma unroll
        for (int i = 0; i < 8; ++i) s1 += v[i];
        const float mean = wave_sum(s1) * (1.f / 512.f); float s2 = 0.f;
#pragma unroll
        for (int i = 0; i < 8; ++i) { const float d = v[i] - mean; s2 += d * d; }
        const float rstd = rsqrtf(wave_sum(s2) * (1.f / 512.f) + EPS);
        if (F.lane == 0) { st[2 * t] = mean; st[2 * t + 1] = rstd; } }
    __syncthreads();
    const int g = F.wave, r = F.lane & 31, h = F.lane >> 5;
    f32x16 acc[2][4];
#pragma unroll
    for (int dt = 0; dt < 2; ++dt)
#pragma unroll
        for (int tt = 0; tt < 4; ++tt)
#pragma unroll
            for (int i = 0; i < 16; ++i) acc[dt][tt][i] = 0.f;
    float gam[2], bet[2];
#pragma unroll
    for (int dt = 0; dt < 2; ++dt) { gam[dt] = ln_g[g * 64 + 32 * dt + r]; bet[dt] = ln_b[g * 64 + 32 * dt + r]; }
#pragma unroll 1
    for (int ks = 0; ks < 8; ++ks) {
        float mu[8], rs[8];
#pragma unroll
        for (int q4 = 0; q4 < 4; ++q4) { const f32x4 sv = *(const LAS f32x4*)(st + 2 * (16 * ks + 8 * h) + 4 * q4); mu[2 * q4] = sv[0]; rs[2 * q4] = sv[1]; mu[2 * q4 + 1] = sv[2]; rs[2 * q4 + 1] = sv[3]; }
        bf16x8 af[2];
#pragma unroll
        for (int dt = 0; dt < 2; ++dt) { float x[8]; unpack8(*(const u32x4*)(GVT + (size_t)(b * 512 + g * 64 + 32 * dt + r) * SEQ + chunk * 128 + 16 * ks + 8 * h), x);
#pragma unroll
            for (int i = 0; i < 8; ++i) x[i] = (x[i] - mu[i]) * rs[i] * gam[dt] + bet[dt];
            u32x4 pw; pw.x = cvtpk(x[0], x[1]); pw.y = cvtpk(x[2], x[3]); pw.z = cvtpk(x[4], x[5]); pw.w = cvtpk(x[6], x[7]); af[dt] = __builtin_bit_cast(bf16x8, pw); }
#pragma unroll
        for (int tt = 0; tt < 4; ++tt) if (16 * ks <= 32 * tt + 31) {
            const bf16x8 wf = *(const bf16x8*)(SGW + ((size_t)g * 128 + 32 * tt + r) * 128 + 16 * ks + 8 * h);
#pragma unroll
            for (int dt = 0; dt < 2; ++dt) acc[dt][tt] = MFMA32(af[dt], wf, acc[dt][tt]); }
    }
#pragma unroll
    for (int tt = 0; tt < 4; ++tt) { const int t = 32 * tt + r; const float bias = sg_b[g * 128 + t];
        const bf16_t* up = Z + (size_t)(tok0 + t) * NZ + ZU + g * 64; bf16_t* yp = YS + (size_t)(tok0 + t) * 512 + g * 64;
#pragma unroll
        for (int dt = 0; dt < 2; ++dt)
#pragma unroll
            for (int a4 = 0; a4 < 4; ++a4) { const int d0 = 32 * dt + 8 * a4 + 4 * h; const u32x2 uw = *(const u32x2*)(up + d0);
                const float u0 = __uint_as_float(uw.x << 16), u1 = __uint_as_float(uw.x & 0xffff0000u), u2 = __uint_as_float(uw.y << 16), u3 = __uint_as_float(uw.y & 0xffff0000u);
                u32x2 w; w.x = cvtpk(u0 * (acc[dt][tt][4 * a4] + bias), u1 * (acc[dt][tt][4 * a4 + 1] + bias)); w.y = cvtpk(u2 * (acc[dt][tt][4 * a4 + 2] + bias), u3 * (acc[dt][tt][4 * a4 + 3] + bias));
                *(u32x2*)(yp + d0) = w; } }
    __syncthreads();
}

__device__ __forceinline__ void phase5(Frame& F, ArgsP a) {
    const float* x = a->in[0]; const float* g_post = a->in[5]; const float* g_pre = a->in[17]; const float* w_r = a->in[19]; const float* b_r = a->in[20];
    const bf16_t* Y = (const bf16_t*)(a->ws + WS_Y); bf16_t* H2 = (bf16_t*)(a->ws + WS_H2); float* out = (float*)(a->ws + WS_X1);
    unsigned* gcnt = (unsigned*)(a->ws + WS_CTL) + CW_CNT; int* lists = (int*)(a->ws + WS_LISTS); int* tokinfo = (int*)(a->ws + WS_TOKINFO);
    LAS float* h2buf = (LAS float*)F.lds;
    LAS float* part = (LAS float*)(F.lds + 65536);
    LAS float* mv = (LAS float*)(F.lds + 81920);
    LAS int* hist = (LAS int*)(F.lds + 94208);
    LAS int* basep = hist + 32;
    LAS int* asg_e = hist + 64;
    LAS int* asg_l = asg_e + 512;
    LAS float* asg_g = (LAS float*)(asg_l + 512);
    const int e_l = F.lane & 31, kh = F.lane >> 5;
    float wreg[64];
#pragma unroll
    for (int i = 0; i < 64; ++i) wreg[i] = w_r[(size_t)(128 * F.wave + 64 * kh + i) * NE + e_l];
    for (int chunk = blockIdx.x; chunk < T / 128; chunk += F.G) {
        const int b = chunk / 16;
        load_mod(F, a, b, 2048, 3072, mv);
        if (F.tid < 32) hist[F.tid] = 0;
        __syncthreads();
        for (int sb = 0; sb < 8; ++sb) {
#pragma unroll 1
            for (int j = 0; j < 2; ++j) {
                const int tt = 2 * F.wave + j, row = chunk * 128 + sb * 16 + tt;
                const f32x4* xr = (const f32x4*)(x + (size_t)row * D) + F.lane; const u32x2* yr = (const u32x2*)(Y + (size_t)row * D) + F.lane;
                f32x4 xv[4], yv[4]; float ss = 0.f;
#pragma unroll
                for (int jj = 0; jj < 4; ++jj) { xv[jj] = xr[64 * jj]; const u32x2 w = yr[64 * jj];
                    yv[jj][0] = __uint_as_float(w.x << 16); yv[jj][1] = __uint_as_float(w.x & 0xffff0000u); yv[jj][2] = __uint_as_float(w.y << 16); yv[jj][3] = __uint_as_float(w.y & 0xffff0000u);
                    ss += (yv[jj][0] * yv[jj][0] + yv[jj][1] * yv[jj][1]) + (yv[jj][2] * yv[jj][2] + yv[jj][3] * yv[jj][3]); }
                const float rstd = rsqrtf(wave_sum(ss) * (1.f / D) + EPS); float s1 = 0.f;
#pragma unroll
                for (int jj = 0; jj < 4; ++jj) { const int col = 4 * F.lane + 256 * jj; const f32x4 gp = *(const f32x4*)(g_post + col);
#pragma unroll
                    for (int i = 0; i < 4; ++i) { const float v = xv[jj][i] + mv[col + i] * (yv[jj][i] * rstd * gp[i]); xv[jj][i] = v; s1 += v * v; }
                    *((f32x4*)(out + (size_t)row * D) + F.lane + 64 * jj) = xv[jj]; }
                const float rstd1 = rsqrtf(wave_sum(s1) * (1.f / D) + EPS);
                u32x2* o8 = (u32x2*)(H2 + (size_t)row * D) + F.lane;
#pragma unroll
                for (int jj = 0; jj < 4; ++jj) { const int col = 4 * F.lane + 256 * jj; const f32x4 gq = *(const f32x4*)(g_pre + col); f32x4 r;
#pragma unroll
                    for (int i = 0; i < 4; ++i) r[i] = xv[jj][i] * rstd1 * gq[i] * (1.f + mv[2048 + col + i]) + mv[1024 + col + i];
                    u32x2 w; w.x = pk2(r[0], r[1]); w.y = pk2(r[2], r[3]); o8[64 * jj] = w;
                    *(LAS f32x4*)(h2buf + tt * 1024 + col) = r; }
            }
            __syncthreads();
#pragma unroll 1
            for (int t16 = 0; t16 < 16; ++t16) { const LAS f32x4* hp = (const LAS f32x4*)(h2buf + t16 * 1024 + 128 * F.wave + 64 * kh); float acc = 0.f;
#pragma unroll
                for (int i4 = 0; i4 < 16; ++i4) { const f32x4 hv = hp[i4]; acc += hv[0] * wreg[4 * i4] + hv[1] * wreg[4 * i4 + 1] + hv[2] * wreg[4 * i4 + 2] + hv[3] * wreg[4 * i4 + 3]; }
                acc += __shfl_xor(acc, 32);
                if (F.lane < 32) part[(F.wave * 16 + t16) * 32 + F.lane] = acc; }
            __syncthreads();
#pragma unroll 1
            for (int j = 0; j < 2; ++j) {
                const int tt = 2 * F.wave + j, tokidx = sb * 16 + tt;
                float logit = b_r[e_l];
#pragma unroll
                for (int w = 0; w < 8; ++w) logit += part[(w * 16 + tt) * 32 + e_l];
                float val = logit; float tv[4]; int ti[4];
#pragma unroll
                for (int k = 0; k < 4; ++k) { float bv = val; int bi = e_l;
#pragma unroll
                    for (int o = 1; o < 32; o <<= 1) { const float ov = __shfl_xor(bv, o); const int oi = __shfl_xor(bi, o); if (ov > bv || (ov == bv && oi < bi)) { bv = ov; bi = oi; } }
                    tv[k] = bv; ti[k] = bi; if (e_l == bi) val = -3.0e38f; }
                const float p1 = __expf(tv[1] - tv[0]), p2 = __expf(tv[2] - tv[0]), p3 = __expf(tv[3] - tv[0]); const float inv = 1.f / (1.f + p1 + p2 + p3);
                if (F.lane < 4) { const int k = F.lane; const int e = k == 0 ? ti[0] : (k == 1 ? ti[1] : (k == 2 ? ti[2] : ti[3])); const float gt = (k == 0 ? 1.f : (k == 1 ? p1 : (k == 2 ? p2 : p3))) * inv;
                    const int lp = __hip_atomic_fetch_add(hist + e, 1, __ATOMIC_RELAXED, __HIP_MEMORY_SCOPE_WORKGROUP); asg_e[tokidx * 4 + k] = e; asg_l[tokidx * 4 + k] = lp; asg_g[tokidx * 4 + k] = gt; }
            }
        }
        __syncthreads();
        if (F.tid < 32) basep[F.tid] = (int)atomicAdd(gcnt + F.tid, (unsigned)hist[F.tid]);
        __syncthreads();
        { const int aidx = F.tid, tokidx = aidx >> 2, k = aidx & 3, e = asg_e[aidx], pos = basep[e] + asg_l[aidx], token = chunk * 128 + tokidx;
          lists[(size_t)e * LISTCAP + pos] = token;
          int* ti = tokinfo + ((size_t)token * 4 + k) * 4; ti[0] = e; ti[1] = pos; ti[2] = __float_as_int(asg_g[aidx]); ti[3] = 0; }
        __syncthreads();
    }
}

__device__ __forceinline__ void moe_tables(Frame& F, ArgsP a, LAS int* tab, int NT) {
    const unsigned* gcnt = (const unsigned*)(a->ws + WS_CTL) + CW_CNT;
    if (F.tid == 0) { int us = 0, ro = 0;
        for (int e = 0; e < NE; ++e) { const int c = (int)__hip_atomic_load(gcnt + e, __ATOMIC_RELAXED, __HIP_MEMORY_SCOPE_AGENT); const int tiles = (c + 255) >> 8; tab[e] = us; tab[64 + e] = ro; tab[128 + e] = c; us += tiles * NT; ro += tiles * 256; }
        tab[32] = us; tab[64 + 32] = ro; }
    __syncthreads();
}

__device__ __forceinline__ void phase9(Frame& F, ArgsP a) {
    const float* g_post = a->in[18]; const bf16_t* YS = (const bf16_t*)(a->ws + WS_YS); const int* tokinfo = (const int*)(a->ws + WS_TOKINFO); float* out = a->out;
    LAS int* tab = (LAS int*)(F.lds + MISC_OFF); LAS float* mv = (LAS float*)F.lds;
    moe_tables(F, a, tab, 4);
    for (int chunk = blockIdx.x; chunk < T / 128; chunk += F.G) {
        const int b = chunk / 16;
        load_mod(F, a, b, 5120, 1024, mv);
        __syncthreads();
        for (int tt = 0; tt < 16; ++tt) {
            const int row = chunk * 128 + F.wave * 16 + tt;
            f32x4 yv[4];
#pragma unroll
            for (int jj = 0; jj < 4; ++jj) yv[jj] = (f32x4){0.f, 0.f, 0.f, 0.f};
#pragma unroll
            for (int k = 0; k < 4; ++k) { const int* ti = tokinfo + ((size_t)row * 4 + k) * 4; const int e = ti[0], pos = ti[1]; const float gt = __int_as_float(ti[2]);
                const u32x2* yr = (const u32x2*)(YS + (size_t)(tab[64 + e] + pos) * D) + F.lane;
#pragma unroll
                for (int jj = 0; jj < 4; ++jj) { const u32x2 w = yr[64 * jj];
                    yv[jj][0] += gt * __uint_as_float(w.x << 16); yv[jj][1] += gt * __uint_as_float(w.x & 0xffff0000u); yv[jj][2] += gt * __uint_as_float(w.y << 16); yv[jj][3] += gt * __uint_as_float(w.y & 0xffff0000u); } }
            float ss = 0.f;
#pragma unroll
            for (int jj = 0; jj < 4; ++jj) ss += (yv[jj][0] * yv[jj][0] + yv[jj][1] * yv[jj][1]) + (yv[jj][2] * yv[jj][2] + yv[jj][3] * yv[jj][3]);
            const float rstd = rsqrtf(wave_sum(ss) * (1.f / D) + EPS);
            f32x4* orow = (f32x4*)(out + (size_t)row * D) + F.lane; const f32x4* xrow = (const f32x4*)((const float*)(a->ws + WS_X1) + (size_t)row * D) + F.lane;
#pragma unroll
            for (int jj = 0; jj < 4; ++jj) { const int col = 4 * F.lane + 256 * jj; const f32x4 gp = *(const f32x4*)(g_post + col); f32x4 xv = xrow[64 * jj];
#pragma unroll
                for (int i = 0; i < 4; ++i) xv[i] += mv[col + i] * (yv[jj][i] * rstd * gp[i]);
                orow[64 * jj] = xv; }
        }
        __syncthreads();
    }
}


#define XB_TMO      128
#define XB_XCNT(j)  (256  + 64 * (j))
#define XB_XSUB(j)  (1280 + 64 * (j))
#define XB_XGEN(j)  (2304 + 64 * (j))
#define XB_TOP      3328
#define XB_TOPGEN   3392
#define XCD_BAR_WORDS 3456
#define XB_SPIN_CAP (1u << 18)
__device__ __forceinline__ unsigned xb_ld(unsigned* p)              { return __hip_atomic_load(p, __ATOMIC_RELAXED, __HIP_MEMORY_SCOPE_AGENT); }
__device__ __forceinline__ unsigned xb_add(unsigned* p, unsigned v) { return __hip_atomic_fetch_add(p, v, __ATOMIC_RELAXED, __HIP_MEMORY_SCOPE_AGENT); }
__device__ __forceinline__ unsigned xb_xcc_id() { return (unsigned)__builtin_amdgcn_s_getreg((3 << 11) | 20) & 0xFu; }
#define XB_SPIN(cond, bar) do { unsigned _sp = 0; while (cond) { __builtin_amdgcn_s_sleep(1); \
    if ((++_sp & 255u) == 0u) { if (xb_ld(&(bar)[XB_TMO])) break; if (_sp > XB_SPIN_CAP) { atomicAdd(&(bar)[XB_TMO], 1u); break; } } } } while (0)
struct XcdBarrier { unsigned* bar; unsigned x; volatile LAS unsigned* st; };
__device__ __forceinline__ XcdBarrier xcd_barrier_post(unsigned* bar, volatile LAS unsigned* st) {
    XcdBarrier b; b.bar = bar; b.x = xb_xcc_id(); b.st = st;
    if (threadIdx.x == 0) (void)xb_add(&bar[XB_XCNT(b.x)], 1u);
    return b;
}
__device__ __forceinline__ void xcd_barrier_complete(unsigned* bar, unsigned x, unsigned& nloc, unsigned& nx) {
    const unsigned G = gridDim.x * gridDim.y * gridDim.z;
    unsigned sum, cnt, mine, sp = 0u;
    for (;;) {
        sum = 0u; cnt = 0u; mine = 0u;
#pragma unroll
        for (unsigned j = 0; j < 16; ++j) { const unsigned c = xb_ld(&bar[XB_XCNT(j)]); sum += c; cnt += (c > 0u) ? 1u : 0u; mine = (j == x) ? c : mine; }
        if (sum == G) break;
        __builtin_amdgcn_s_sleep(1);
        if ((++sp & 255u) == 0u) { if (xb_ld(&bar[XB_TMO])) break; if (sp > XB_SPIN_CAP) { atomicAdd(&bar[XB_TMO], 1u); break; } }
    }
    nloc = mine > 0u ? mine : 1u; nx = cnt > 0u ? cnt : 1u;
}
__device__ __forceinline__ void xcd_barrier(const XcdBarrier& b) {
    asm volatile("s_waitcnt vmcnt(0)" ::: "memory");
    __syncthreads();
    if (threadIdx.x == 0) {
        unsigned* bar = b.bar;
        __builtin_amdgcn_s_waitcnt(0);
        unsigned nloc = b.st[0], nx = b.st[1];
        if (nloc == 0u) { xcd_barrier_complete(bar, b.x, nloc, nx); b.st[0] = nloc; b.st[1] = nx; }
        const unsigned old = xb_add(&bar[XB_XSUB(b.x)], 1u);
        const unsigned gen = old / nloc;
        if (old + 1u == (gen + 1u) * nloc) {
            __builtin_amdgcn_fence(__ATOMIC_RELEASE, "agent");
            asm volatile("s_waitcnt vmcnt(0)" ::: "memory");
            const unsigned og = xb_add(&bar[XB_TOP], 1u);
            const unsigned tg = og / nx;
            if (og + 1u == (tg + 1u) * nx) xb_add(&bar[XB_TOPGEN], 1u);
            else XB_SPIN(xb_ld(&bar[XB_TOPGEN]) == tg, bar);
            __builtin_amdgcn_fence(__ATOMIC_ACQUIRE, "agent");
            xb_add(&bar[XB_XGEN(b.x)], 1u);
            asm volatile("s_waitcnt vmcnt(0)" ::: "memory");
        } else {
            XB_SPIN(xb_ld(&bar[XB_XGEN(b.x)]) == gen, bar);
            __builtin_amdgcn_fence(__ATOMIC_ACQUIRE, "agent");
            asm volatile("s_waitcnt vmcnt(0)" ::: "memory");
        }
    }
    __syncthreads();
}

constexpr int NPHASE = 10;
__global__ void __launch_bounds__(NTHREADS, 2) fwd_kernel(Args a_unused) {
    extern __shared__ __attribute__((aligned(16))) unsigned char lds_raw[];
    Frame F; F.lds = (LAS unsigned char*)lds_raw; F.G = gridDim.x;
    ArgsP a = (ArgsP)__builtin_amdgcn_kernarg_segment_ptr();
    volatile LAS unsigned* bst = (volatile LAS unsigned*)(F.lds + MISC_OFF + 1024);
    XcdBarrier xbar; xbar.bar = (unsigned*)(a->ws + WS_CTL) + CW_BAR; xbar.x = 0; xbar.st = bst;
    const int nprog = a->nprog;
    if (nprog > 1) { if (threadIdx.x == 0) { bst[0] = 0u; bst[1] = 0u; } __syncthreads(); xbar = xcd_barrier_post((unsigned*)(a->ws + WS_CTL) + CW_BAR, bst); if (nprog < 0) cg::this_grid().sync(); }
#pragma nounroll
    for (int pi = 0; pi < nprog; ++pi) {
        { unsigned long long _p = (unsigned long long)__builtin_amdgcn_kernarg_segment_ptr(); asm volatile("" : "+s"(_p)); a = (ArgsP)_p; }
        { int _t = threadIdx.x; asm volatile("" : "+v"(_t)); F.tid = _t; F.lane = _t & 63; F.wave = __builtin_amdgcn_readfirstlane(_t >> 6); }
        { int _g = gridDim.x; asm volatile("" : "+s"(_g)); F.G = _g; }
        int bid = blockIdx.x; asm volatile("" : "+s"(bid));
        unsigned char* ws = a->ws;
        const int ph = (int)((a->prog[pi >> 3] >> ((pi & 7) * 8)) & 0xffull);
        switch (ph) {
        case 0: phase0(F, a); break;
        case 1: phase0b(F, a); break;
        case 2: {
            pg8::SchedDense S{(const char*)(ws + WS_H), (const char*)(ws + WS_WIN), T / 256, NZ / 256, F.G, bid, (size_t)256 * D * 2};
            pg8::EpiInProj E{(bf16_t*)(ws + WS_Z), a->in[7], (bf16_t*)(ws + WS_VT), (bf16_t*)(ws + WS_GVT)};
            pg8::gemm_phase<pg8::EpiInProj, pg8::SchedDense, false>(F.lds, F.tid, D, S, E);
        } break;
        case 3: {
            for (int it = bid; it < 256 + 512; it += F.G) { if (it < 256) gmlp_item_mfma(F, a, it); else attn_item_mfma(F, a, it - 256); }
        } break;
        case 4: {
            pg8::SchedBranch S{(const char*)(ws + WS_YATT), (const char*)(ws + WS_WBA), (const char*)(ws + WS_YSG), (const char*)(ws + WS_WBS), T / 256, D / 256, F.G, bid, (size_t)256 * 512 * 2};
            pg8::EpiBranch E{(const bf16_t*)(ws + WS_Z), (bf16_t*)(ws + WS_H)};
            pg8::gemm_phase<pg8::EpiBranch, pg8::SchedBranch, false>(F.lds, F.tid, 512, S, E);
        } break;
        case 5: {
            pg8::SchedDense S{(const char*)(ws + WS_H), (const char*)(ws + WS_WOUT), T / 256, D / 256, F.G, bid, (size_t)256 * D * 2};
            pg8::EpiBiasBf16 E{(bf16_t*)(ws + WS_Y), D, a->in[16], 0};
            pg8::gemm_phase<pg8::EpiBiasBf16, pg8::SchedDense, false>(F.lds, F.tid, D, S, E);
        } break;
        case 6: phase5(F, a); break;
        case 7: {
            LAS int* tab = (LAS int*)(F.lds + MISC_OFF); moe_tables(F, a, tab, 8);
            pg8::SchedMoE S{tab, (const char*)(ws + WS_H2), (const char*)(ws + WS_W1), (size_t)2 * DE * D * 2, (const int*)(ws + WS_LISTS), 8, F.G, bid, (size_t)256 * D * 2, true};
            pg8::EpiSwiGLU E{(bf16_t*)(ws + WS_ACT), a->in[22]};
            pg8::gemm_phase<pg8::EpiSwiGLU, pg8::SchedMoE, true>(F.lds, F.tid, D, S, E);
        } break;
        case 8: {
            LAS int* tab = (LAS int*)(F.lds + MISC_OFF); moe_tables(F, a, tab, 4);
            pg8::SchedMoE S{tab, (const char*)(ws + WS_ACT), (const char*)(ws + WS_W2), (size_t)D * DE * 2, nullptr, 4, F.G, bid, (size_t)256 * DE * 2, false};
            pg8::EpiBiasBf16 E{(bf16_t*)(ws + WS_YS), D, a->in[24], D};
            pg8::gemm_phase<pg8::EpiBiasBf16, pg8::SchedMoE, false>(F.lds, F.tid, DE, S, E);
        } break;
        case 9: phase9(F, a); break;
        default: if (bid == 0 && F.tid < 32) ((unsigned*)(ws + WS_CTL))[CW_CNT + F.tid] = 0u; break;
        }
        if (pi + 1 < nprog) xcd_barrier(xbar);
    }
}

extern "C" void kernel_launch(void* const* d_in, const int* in_sizes, int n_in, void* d_out, int out_size, void* d_ws, size_t ws_size, hipStream_t stream) {
    const void* kfn = (const void*)fwd_kernel;
    static int grid = 0;
    if (grid == 0) {
        if (n_in != 25 || out_size != T * D || ws_size < WS_END) { fprintf(stderr, "kernel_launch: unexpected problem (n_in %d out %d ws %zu)\n", n_in, out_size, ws_size); grid = -1; return; }
        int dev = 0, cus = 0, per_cu = 0;
        (void)hipGetDevice(&dev); (void)hipDeviceGetAttribute(&cus, hipDeviceAttributeMultiprocessorCount, dev);
        (void)hipFuncSetAttribute(kfn, hipFuncAttributeMaxDynamicSharedMemorySize, LDS_BYTES);
        (void)hipOccupancyMaxActiveBlocksPerMultiprocessor(&per_cu, kfn, NTHREADS, LDS_BYTES);
        (void)hipGetLastError();
        if (per_cu < 1) { fprintf(stderr, "kernel_launch: occupancy query says %d blocks per CU\n", per_cu); grid = -1; return; }
        grid = cus;
    }
    if (grid < 0) return;
    (void)hipMemsetAsync((char*)d_ws + WS_CTL, 0, CTL_BYTES, stream);
    Args a{};
    for (int i = 0; i < 25; ++i) a.in[i] = (const float*)d_in[i];
    a.out = (float*)d_out; a.ws = (unsigned char*)d_ws;
    static const unsigned char program[] = PHASE_PROGRAM;
    const int np = (int)sizeof(program);
#if MK_ONE_LAUNCH
    a.nprog = np; for (int i = 0; i < np; ++i) a.prog[i >> 3] |= (unsigned long long)program[i] << ((i & 7) * 8);
    void* args[] = {&a};
    hipError_t e = hipLaunchCooperativeKernel(kfn, dim3(grid), dim3(NTHREADS), args, LDS_BYTES, stream);
    if (e != hipSuccess) fprintf(stderr, "cooperative launch failed: %s (grid %d)\n", hipGetErrorString(e), grid);
#else
    for (int p = 0; p < np; ++p) { a.nprog = 1; a.prog[0] = program[p]; void* args[] = {&a}; (void)hipLaunchKernel(kfn, dim3(grid), dim3(NTHREADS), args, LDS_BYTES, stream); }
#endif
}
```

```cpp
#include <hip/hip_runtime.h>
#include <hip/hip_cooperative_groups.h>
#include <cstdio>
#include <cstdint>
namespace cg = cooperative_groups;

#ifndef PHASE_PROGRAM
#define PHASE_PROGRAM {0, 1, 2, 3, 4, 5, 6, 7, 8, 9}
#endif
#ifndef MK_ONE_LAUNCH
#define MK_ONE_LAUNCH 1
#endif

#define LAS __attribute__((address_space(3)))
typedef unsigned short bf16_t;
typedef short bf16x8 __attribute__((ext_vector_type(8)));
typedef float f32x4 __attribute__((ext_vector_type(4)));
typedef unsigned u32x4 __attribute__((ext_vector_type(4)));
typedef unsigned u32x2 __attribute__((ext_vector_type(2)));
typedef float f32x16 __attribute__((ext_vector_type(16)));
typedef float f32x2_t __attribute__((ext_vector_type(2)));
typedef __bf16 bf16x2_t __attribute__((ext_vector_type(2)));

constexpr int D = 1024, BATCH = 16, SEQ = 2048, T = BATCH * SEQ;
constexpr int NZ = 3840;
constexpr int ZQ = 0, ZK = 512, ZV = 640, ZU = 768, ZVS = 1280, ZGA = 1792, ZGS = 2816;
constexpr int NE = 32, TOPK = 4, DE = 1024;
constexpr int KSPLIT = 16;
constexpr float EPS = 1e-6f;
constexpr int LISTCAP = T;
constexpr int APAD = T * TOPK + NE * 256;

constexpr size_t MiB = 1u << 20;
constexpr size_t WS_CTL = 0, CTL_BYTES = 1 * MiB;
constexpr size_t WS_MODP = 1 * MiB;
constexpr size_t WS_WIN = 8 * MiB;
constexpr size_t WS_WBA = 16 * MiB, WS_WBS = 17 * MiB;
constexpr size_t WS_WOUT = 18 * MiB;
constexpr size_t WS_SGW = 20 * MiB;
constexpr size_t WS_W1 = 24 * MiB;
constexpr size_t WS_W2 = 152 * MiB;
constexpr size_t WS_H2 = 216 * MiB;
constexpr size_t WS_Z = 280 * MiB;
constexpr size_t WS_YATT = 520 * MiB, WS_YSG = 552 * MiB;
constexpr size_t WS_H = 584 * MiB;
constexpr size_t WS_Y = 648 * MiB;
constexpr size_t WS_ACT = 280 * MiB;
constexpr size_t WS_YS = 552 * MiB;
constexpr size_t WS_LISTS = 824 * MiB;
constexpr size_t WS_TOKINFO = 828 * MiB;
constexpr size_t WS_X1 = 832 * MiB;
constexpr size_t WS_VT = 960 * MiB;
constexpr size_t WS_GVT = 968 * MiB;
constexpr size_t WS_END = 1000 * MiB;
constexpr int CW_CNT = 64;
constexpr int CW_BAR = 4096;

constexpr int RING_BYTES = 131072;
constexpr int MISC_OFF = RING_BYTES;
constexpr int LDS_BYTES = 147456;
constexpr int NWAVES = 8, NTHREADS = 512;

__device__ __forceinline__ float bf2f(unsigned h) { return __uint_as_float(h << 16); }
__device__ __forceinline__ unsigned f2bf(float f) { unsigned u = __float_as_uint(f); return (u + 0x7fffu + ((u >> 16) & 1u)) >> 16; }
__device__ __forceinline__ unsigned pk2(float lo, float hi) { return f2bf(lo) | (f2bf(hi) << 16); }
__device__ __forceinline__ void unpack8(const u32x4 r, float* o) {
    o[0] = __uint_as_float(r.x << 16); o[1] = __uint_as_float(r.x & 0xffff0000u);
    o[2] = __uint_as_float(r.y << 16); o[3] = __uint_as_float(r.y & 0xffff0000u);
    o[4] = __uint_as_float(r.z << 16); o[5] = __uint_as_float(r.z & 0xffff0000u);
    o[6] = __uint_as_float(r.w << 16); o[7] = __uint_as_float(r.w & 0xffff0000u);
}
__device__ __forceinline__ unsigned cvtpk(float lo, float hi) { const f32x2_t v = {lo, hi}; const bf16x2_t b = __builtin_convertvector(v, bf16x2_t); return __builtin_bit_cast(unsigned, b); }
#define MFMA32(a, b, c) __builtin_amdgcn_mfma_f32_32x32x16_bf16((a), (b), (c), 0, 0, 0)
__device__ __forceinline__ float wave_sum(float v) {
#pragma unroll
    for (int o = 1; o < 64; o <<= 1) v += __shfl_xor(v, o);
    return v;
}
__device__ __forceinline__ float sigmoidf_(float x) { return __builtin_amdgcn_rcpf(1.f + __expf(-x)); }
__device__ __forceinline__ float gelu_tanh(float x) { const float u = 0.7978845608028654f * (x + 0.044715f * x * x * x); return x * __builtin_amdgcn_rcpf(1.f + __expf(-2.f * u)); }

struct Frame { LAS unsigned char* lds; int tid, lane, wave, G; };

namespace pg8 {
constexpr int BM = 256, BK = 64, HALF = 128, HTB = HALF * BK * 2, STAGE_BYTES = 8 * HTB, NXCD = 8, WGM = 8;
__host__ __device__ __forceinline__ int lds_byte(int r, int c) { const int st = (r >> 4) * 2 + (c >> 5), rr = r & 15, cc = c & 31, ob = rr * 64 + cc * 2; return st * 1024 + (ob ^ (((ob >> 9) & 1) << 5)); }
__host__ __device__ __forceinline__ void stage_rc(int b, int& R, int& C) { const int st = b / 1024, sb = b % 1024, swz = sb ^ (((sb >> 9) & 1) << 5); R = (st >> 1) * 16 + swz / 64; C = (st & 1) * 32 + (swz % 64) / 2; }
__host__ __device__ __forceinline__ int perm32(int rho) { const int n = rho >> 4, i = rho & 15; return 8 * (i >> 2) + 4 * n + (i & 3); }
__device__ __forceinline__ unsigned cvt_pk_bf16(float lo, float hi) { unsigned r; asm volatile("v_cvt_pk_bf16_f32 %0, %1, %2" : "=v"(r) : "v"(lo), "v"(hi)); return r; }

struct Unit { const char* A; const char* B; const int* tl; int pm, pn, e, kind, rowbase, nvalid; };
__device__ __forceinline__ const char* uptr(const char* p) { const unsigned long long v = (unsigned long long)p;
    const unsigned lo = __builtin_amdgcn_readfirstlane((unsigned)v), hi = __builtin_amdgcn_readfirstlane((unsigned)(v >> 32)); return (const char*)(((unsigned long long)hi << 32) | lo); }

__device__ __forceinline__ void tile_map(int L, int nM, int nN, int& pm, int& pn) {
    const int nwg = nM * nN;
    int wgid = L; { const int q = nwg / NXCD, r = nwg % NXCD, xcd = wgid % NXCD, off = wgid / NXCD; wgid = (xcd < r ? xcd * (q + 1) : r * (q + 1) + (xcd - r) * q) + off; }
    const int nig = WGM * nN, gid = wgid / nig, fm = gid * WGM, gsz = (nM - fm) < WGM ? (nM - fm) : WGM;
    pm = fm + ((wgid % nig) % gsz); pn = (wgid % nig) / gsz;
}

template <class Epi, class Sched, bool GATHER>
__device__ __forceinline__ void gemm_phase(LAS unsigned char* lds, const int tid, const int K, const Sched& S, const Epi& E) {
    const int wid = __builtin_amdgcn_readfirstlane(tid >> 6), lane = tid & 63, wr = wid >> 2, wc = wid & 3, fr = lane & 15, fq = lane >> 4;
    const int nt = K / BK;
    unsigned voffB[2]; unsigned oc[2][2], on[2][2]; int Rr[2]; unsigned Cb[2];
    const size_t kstep = (size_t)(BK * 2);
    const size_t hstep = (size_t)HALF * K * 2;
#pragma unroll
    for (int i = 0; i < 2; ++i) { int R, C; stage_rc(tid * 16 + i * 8192, R, C); const int Rb = (R & ~31) + perm32(R & 31);
        Rr[i] = R; Cb[i] = (unsigned)C * 2u; voffB[i] = (unsigned)(Rb * K + C) * 2u;
        oc[0][i] = (unsigned)(R * K + C) * 2u; oc[1][i] = oc[0][i] + (unsigned)hstep; on[0][i] = oc[0][i]; on[1][i] = oc[1][i]; }
    const unsigned ldsw = (unsigned)wid * 1024u;
    const int aoff = lds_byte(wr * 64 + fr, fq * 8), boff = lds_byte(wc * 32 + fr, fq * 8);
#define PG8_SA(b, h) (((b) * 2 + (h)) * HTB)
#define PG8_SB(b, h) ((4 + (b) * 2 + (h)) * HTB)
#define PG8_STAGE(bufoff, gbase, voff) do { const char* _g = uptr((const char*)(gbase)); _Pragma("unroll") for (int _i = 0; _i < 2; ++_i) { unsigned _o = (voff)[_i]; asm volatile("" : "+v"(_o)); \
        __builtin_amdgcn_global_load_lds((const unsigned*)(_g + _o), (LAS unsigned*)(lds + (bufoff) + ldsw + _i * 8192), 16, 0, 0); } } while (0)
#define PG8_STAGE_A(bufoff, gbase, h, O) do { const char* _g = uptr((const char*)(gbase) + (GATHER ? (size_t)0 : (size_t)(h) * hstep)); _Pragma("unroll") for (int _i = 0; _i < 2; ++_i) { unsigned _o = (O)[GATHER ? (h) : 0][_i]; asm volatile("" : "+v"(_o)); \
        __builtin_amdgcn_global_load_lds((const unsigned*)(_g + _o), (LAS unsigned*)(lds + (bufoff) + ldsw + _i * 8192), 16, 0, 0); } } while (0)
#define PG8_LDA(dst, b, h) do { _Pragma("unroll") for (int m = 0; m < 4; ++m) _Pragma("unroll") for (int k = 0; k < 2; ++k) dst[m][k] = *(const LAS bf16x8*)(lds + PG8_SA(b, h) + aoff + m * 2048 + k * 1024); } while (0)
#define PG8_LDB(dst, b, h) do { _Pragma("unroll") for (int n = 0; n < 2; ++n) _Pragma("unroll") for (int k = 0; k < 2; ++k) dst[n][k] = *(const LAS bf16x8*)(lds + PG8_SB(b, h) + boff + n * 2048 + k * 1024); } while (0)
#define PG8_MMA(ai, bj, At, Bt) do { __builtin_amdgcn_s_setprio(1); _Pragma("unroll") for (int m = 0; m < 4; ++m) _Pragma("unroll") for (int n = 0; n < 2; ++n) _Pragma("unroll") for (int k = 0; k < 2; ++k) \
        acc[ai][bj][m][n] = __builtin_amdgcn_mfma_f32_16x16x32_bf16(Bt[n][k], At[m][k], acc[ai][bj][m][n], 0, 0, 0); __builtin_amdgcn_s_setprio(0); } while (0)
#define PG8_WAIT_V(n) asm volatile("s_waitcnt vmcnt(" #n ")" ::: "memory")
#define PG8_WAIT_L(n) asm volatile("s_waitcnt lgkmcnt(" #n ")" ::: "memory")
#define PG8_BAR __builtin_amdgcn_s_barrier()
#define PG8_SCHED __builtin_amdgcn_sched_barrier(0)
#define PG8_LOADOFFS(u, o) do { _Pragma("unroll") for (int _h = 0; _h < 2; ++_h) _Pragma("unroll") for (int _i = 0; _i < 2; ++_i) { \
        int _row = _h * HALF + Rr[_i]; _row = _row < (u).nvalid ? _row : (u).nvalid - 1; const int _tok = (u).tl[_row]; o[_h][_i] = (unsigned)_tok * (unsigned)(K * 2) + Cb[_i]; } } while (0)
#define PG8_KITER(LAST) do { \
            const char* a1 = cA + (size_t)(t + 1) * kstep; \
            const char* a2 = (LAST) ? nA : cA + (size_t)(t + 2) * kstep; const char* b2 = (LAST) ? nB : cB + (size_t)(t + 2) * kstep; \
            const char* a3 = a2 + kstep; const char* b3 = b2 + kstep; \
            unsigned o2[2][2]; \
            _Pragma("unroll") for (int _h = 0; _h < 2; ++_h) _Pragma("unroll") for (int _i = 0; _i < 2; ++_i) o2[_h][_i] = (GATHER && (LAST)) ? on[_h][_i] : oc[_h][_i]; \
            PG8_LDB(B0, 0, 0); PG8_LDB(B1, 0, 1); PG8_SCHED; PG8_LDA(At, 0, 0); PG8_STAGE_A(PG8_SA(1, 1), a1, 1, oc); \
            PG8_WAIT_V(8); PG8_WAIT_L(0); PG8_BAR; PG8_MMA(0, 0, At, B0); PG8_MMA(0, 1, At, B1); PG8_BAR; PG8_SCHED; \
            PG8_LDA(At, 0, 1); PG8_STAGE(PG8_SB(0, 0), b2, voffB); PG8_STAGE(PG8_SB(0, 1), b2 + hstep, voffB); PG8_STAGE_A(PG8_SA(0, 0), a2, 0, o2); \
            PG8_WAIT_V(8); PG8_WAIT_L(0); PG8_BAR; PG8_MMA(1, 0, At, B0); PG8_MMA(1, 1, At, B1); PG8_BAR; PG8_SCHED; \
            PG8_LDB(B0, 1, 0); PG8_LDB(B1, 1, 1); PG8_SCHED; PG8_LDA(At, 1, 0); PG8_STAGE_A(PG8_SA(0, 1), a2, 1, o2); \
            PG8_WAIT_V(8); PG8_WAIT_L(0); PG8_BAR; PG8_MMA(0, 0, At, B0); PG8_MMA(0, 1, At, B1); PG8_BAR; PG8_SCHED; \
            PG8_LDA(At, 1, 1); PG8_STAGE(PG8_SB(1, 0), b3, voffB); PG8_STAGE(PG8_SB(1, 1), b3 + hstep, voffB); PG8_STAGE_A(PG8_SA(1, 0), a3, 0, o2); \
            PG8_WAIT_V(8); PG8_WAIT_L(0); PG8_BAR; PG8_MMA(1, 0, At, B0); PG8_MMA(1, 1, At, B1); PG8_BAR; PG8_SCHED; \
        } while (0)
    Unit cur, nxt; int ui = 0;
    if (!S.next(0, cur)) return;
    f32x4 acc[2][2][4][2];
#pragma unroll
    for (int a = 0; a < 2; ++a)
#pragma unroll
        for (int b = 0; b < 2; ++b)
#pragma unroll
            for (int m = 0; m < 4; ++m)
#pragma unroll
                for (int n = 0; n < 2; ++n) acc[a][b][m][n] = (f32x4){0.f, 0.f, 0.f, 0.f};
    bf16x8 At[4][2], B0[2][2], B1[2][2];
    const char* cA = cur.A; const char* cB = cur.B;
    if constexpr (GATHER) { PG8_LOADOFFS(cur, oc); }
    PG8_STAGE(PG8_SB(0, 0), cB, voffB); PG8_STAGE(PG8_SB(0, 1), cB + hstep, voffB); PG8_STAGE_A(PG8_SA(0, 0), cA, 0, oc); PG8_STAGE_A(PG8_SA(0, 1), cA, 1, oc);
    if (wr == 1) PG8_BAR;
    PG8_WAIT_V(2); PG8_BAR;
    PG8_STAGE(PG8_SB(1, 0), cB + kstep, voffB); PG8_STAGE_A(PG8_SA(1, 0), cA + kstep, 0, oc); PG8_STAGE(PG8_SB(1, 1), cB + hstep + kstep, voffB);
    PG8_WAIT_V(6); PG8_BAR;
    for (;;) {
        const bool has_next = S.next(ui + 1, nxt);
        const char* nA = has_next ? nxt.A : cA; const char* nB = has_next ? nxt.B : cB;
        if constexpr (GATHER) {
            if (has_next) { PG8_LOADOFFS(nxt, on); }
            else {
#pragma unroll
                for (int h = 0; h < 2; ++h)
#pragma unroll
                    for (int i = 0; i < 2; ++i) on[h][i] = oc[h][i];
            }
        }
        int t = 0;
        for (; t < nt - 2; t += 2) PG8_KITER(false);
        PG8_KITER(true);
        if (wr == 0) PG8_BAR;
        int lane_e; asm volatile("v_mbcnt_lo_u32_b32 %0, -1, 0\n\tv_mbcnt_hi_u32_b32 %0, -1, %0" : "=v"(lane_e));
        const bool keep = E(acc, cur, wr, wc, lane_e & 15, lane_e >> 4);
        if (!has_next) break;
        if (!keep) {
#pragma unroll
            for (int a = 0; a < 2; ++a)
#pragma unroll
                for (int b = 0; b < 2; ++b)
#pragma unroll
                    for (int m = 0; m < 4; ++m)
#pragma unroll
                        for (int n = 0; n < 2; ++n) acc[a][b][m][n] = (f32x4){0.f, 0.f, 0.f, 0.f};
        }
        cur = nxt; cA = nA; cB = nB; ++ui;
        if constexpr (GATHER) {
#pragma unroll
            for (int h = 0; h < 2; ++h)
#pragma unroll
                for (int i = 0; i < 2; ++i) oc[h][i] = on[h][i];
        }
        if (wr == 1) PG8_BAR;
    }
    PG8_WAIT_V(0);
    PG8_BAR;
#undef PG8_SA
#undef PG8_SB
#undef PG8_STAGE
#undef PG8_STAGE_A
#undef PG8_LDA
#undef PG8_LDB
#undef PG8_MMA
#undef PG8_WAIT_V
#undef PG8_WAIT_L
#undef PG8_BAR
#undef PG8_SCHED
#undef PG8_LOADOFFS
#undef PG8_KITER
}

struct SchedDense {
    const char* A; const char* B; int nM, nN, G, c; size_t tstep;
    __device__ __forceinline__ bool next(int i, Unit& u) const {
        const long L = (long)i * G + c; if (L >= (long)nM * nN) return false;
        tile_map((int)L, nM, nN, u.pm, u.pn); u.A = A + (size_t)u.pm * tstep; u.B = B + (size_t)u.pn * tstep;
        u.tl = nullptr; u.e = 0; u.kind = 0; u.rowbase = u.pm * BM; u.nvalid = BM; return true; }
};
struct SchedBranch {
    const char* A0; const char* B0; const char* A1; const char* B1; int nM, nN, G, c; size_t tstep;
    __device__ __forceinline__ bool next(int i, Unit& u) const {
        const long L = (long)(i >> 1) * G + c; if (L >= (long)nM * nN) return false;
        tile_map((int)L, nM, nN, u.pm, u.pn); u.kind = i & 1;
        u.A = (u.kind ? A1 : A0) + (size_t)u.pm * tstep; u.B = (u.kind ? B1 : B0) + (size_t)u.pn * tstep;
        u.tl = nullptr; u.e = 0; u.rowbase = u.pm * BM; u.nvalid = BM; return true; }
};
struct SchedMoE {
    const LAS int* tab;
    const char* A; const char* B; size_t bexp; const int* lists; int NT, G, c; size_t tstep; bool gather;
    __device__ __forceinline__ bool next(int i, Unit& u) const {
        const int nwg = tab[32];
        const long L = (long)i * G + c; if (L >= nwg) return false;
        int wgid = (int)L; { const int q = nwg / NXCD, r = nwg % NXCD, xcd = wgid % NXCD, off = wgid / NXCD; wgid = (xcd < r ? xcd * (q + 1) : r * (q + 1) + (xcd - r) * q) + off; }
        int e = 0; while (e < 31 && tab[e + 1] <= wgid) ++e;
        const int local = wgid - tab[e]; u.e = e; u.pm = local / NT; u.pn = local % NT; u.kind = 0;
        u.rowbase = tab[64 + e] + u.pm * BM; int nv = tab[128 + e] - u.pm * BM; u.nvalid = nv > BM ? BM : nv;
        u.B = B + (size_t)e * bexp + (size_t)u.pn * tstep;
        if (gather) { u.A = A; u.tl = lists + (size_t)e * LISTCAP + u.pm * BM; }
        else { u.A = A + (size_t)u.rowbase * (tstep / BM); u.tl = nullptr; }
        return true; }
};

#define EPI_FOR_ROWS  _Pragma("unroll") for (int ai = 0; ai < 2; ++ai) _Pragma("unroll") for (int m = 0; m < 4; ++m)
struct EpiInProj {
    bf16_t* Z; const float* bias; bf16_t* VT; bf16_t* GVT;
    __device__ __forceinline__ bool operator()(f32x4 (&acc)[2][2][4][2], const Unit& u, int wr, int wc, int fr, int fq) const {
        const int pn = u.pn, act = pn < 2 ? 0 : (pn == 2 ? 1 : (pn < 7 ? 2 : 3));
        const int col0 = pn * BM + wc * 32 + 8 * fq;
        f32x4 bv[2][2];
#pragma unroll
        for (int bj = 0; bj < 2; ++bj)
#pragma unroll
            for (int n = 0; n < 2; ++n) bv[bj][n] = *(const f32x4*)(bias + col0 + bj * HALF + 4 * n);
        EPI_FOR_ROWS { const int row = u.rowbase + ai * HALF + wr * 64 + m * 16 + fr; bf16_t* rowp = Z + (size_t)row * NZ + col0;
#pragma unroll
            for (int bj = 0; bj < 2; ++bj) { f32x4 v0 = acc[ai][bj][m][0] + bv[bj][0], v1 = acc[ai][bj][m][1] + bv[bj][1];
                if (act == 0) { v0 = v0 * 0.125f; v1 = v1 * 0.125f; }
                else if (act == 2) {
#pragma unroll
                    for (int i = 0; i < 4; ++i) { v0[i] = gelu_tanh(v0[i]); v1[i] = gelu_tanh(v1[i]); } }
                else if (act == 3) {
#pragma unroll
                    for (int i = 0; i < 4; ++i) { v0[i] = sigmoidf_(v0[i]); v1[i] = sigmoidf_(v1[i]); } }
                u32x4 w; w.x = cvt_pk_bf16(v0[0], v0[1]); w.y = cvt_pk_bf16(v0[2], v0[3]); w.z = cvt_pk_bf16(v1[0], v1[1]); w.w = cvt_pk_bf16(v1[2], v1[3]);
                *(u32x4*)(rowp + bj * HALF) = w;
                if ((pn == 2 && bj == 1) || pn == 5 || pn == 6) {
                    const int bt = row >> 11, sq = row & (SEQ - 1);
                    bf16_t* tp = (pn == 2) ? VT + ((size_t)(bt * 128 + wc * 32 + 8 * fq)) * SEQ + sq : GVT + ((size_t)(bt * 512 + (pn - 5) * 256 + bj * HALF + wc * 32 + 8 * fq)) * SEQ + sq;
                    tp[0 * SEQ] = (bf16_t)(w.x & 0xffffu); tp[1 * SEQ] = (bf16_t)(w.x >> 16); tp[2 * SEQ] = (bf16_t)(w.y & 0xffffu); tp[3 * SEQ] = (bf16_t)(w.y >> 16);
                    tp[4 * SEQ] = (bf16_t)(w.z & 0xffffu); tp[5 * SEQ] = (bf16_t)(w.z >> 16); tp[6 * SEQ] = (bf16_t)(w.w & 0xffffu); tp[7 * SEQ] = (bf16_t)(w.w >> 16); } } }
        return false;
    }
};
struct EpiBranch {
    const bf16_t* Z; bf16_t* O;
    __device__ __forceinline__ bool operator()(f32x4 (&acc)[2][2][4][2], const Unit& u, int wr, int wc, int fr, int fq) const {
        const int col0 = u.pn * BM + wc * 32 + 8 * fq;
        if (u.kind == 0) {
            EPI_FOR_ROWS { const int row = u.rowbase + ai * HALF + wr * 64 + m * 16 + fr; const bf16_t* zr = Z + (size_t)row * NZ + col0;
#pragma unroll
                for (int bj = 0; bj < 2; ++bj) { float ga[8], gs[8]; unpack8(*(const u32x4*)(zr + ZGA + bj * HALF), ga); unpack8(*(const u32x4*)(zr + ZGS + bj * HALF), gs);
#pragma unroll
                    for (int i = 0; i < 4; ++i) { acc[ai][bj][m][0][i] *= ga[i] / gs[i]; acc[ai][bj][m][1][i] *= ga[4 + i] / gs[4 + i]; } } }
            return true;
        }
        EPI_FOR_ROWS { const int row = u.rowbase + ai * HALF + wr * 64 + m * 16 + fr; const bf16_t* zr = Z + (size_t)row * NZ + col0; bf16_t* op = O + (size_t)row * D + col0;
#pragma unroll
            for (int bj = 0; bj < 2; ++bj) { float gs[8]; unpack8(*(const u32x4*)(zr + ZGS + bj * HALF), gs);
                const f32x4 v0 = acc[ai][bj][m][0], v1 = acc[ai][bj][m][1];
                u32x4 w; w.x = cvt_pk_bf16(v0[0] * gs[0], v0[1] * gs[1]); w.y = cvt_pk_bf16(v0[2] * gs[2], v0[3] * gs[3]); w.z = cvt_pk_bf16(v1[0] * gs[4], v1[1] * gs[5]); w.w = cvt_pk_bf16(v1[2] * gs[6], v1[3] * gs[7]);
                *(u32x4*)(op + bj * HALF) = w; } }
        return false;
    }
};
struct EpiBiasBf16 {
    bf16_t* O; int ldo; const float* bias; int bstride;
    __device__ __forceinline__ bool operator()(f32x4 (&acc)[2][2][4][2], const Unit& u, int wr, int wc, int fr, int fq) const {
        const int col0 = u.pn * BM + wc * 32 + 8 * fq; const float* bp = bias + (size_t)u.e * bstride + col0;
        f32x4 bv[2][2];
#pragma unroll
        for (int bj = 0; bj < 2; ++bj)
#pragma unroll
            for (int n = 0; n < 2; ++n) bv[bj][n] = *(const f32x4*)(bp + bj * HALF + 4 * n);
        EPI_FOR_ROWS { const int row = u.rowbase + ai * HALF + wr * 64 + m * 16 + fr; bf16_t* op = O + (size_t)row * ldo + col0;
#pragma unroll
            for (int bj = 0; bj < 2; ++bj) { const f32x4 v0 = acc[ai][bj][m][0] + bv[bj][0], v1 = acc[ai][bj][m][1] + bv[bj][1];
                u32x4 w; w.x = cvt_pk_bf16(v0[0], v0[1]); w.y = cvt_pk_bf16(v0[2], v0[3]); w.z = cvt_pk_bf16(v1[0], v1[1]); w.w = cvt_pk_bf16(v1[2], v1[3]);
                *(u32x4*)(op + bj * HALF) = w; } }
        return false;
    }
};
struct EpiSwiGLU {
    bf16_t* O; const float* b1;
    __device__ __forceinline__ bool operator()(f32x4 (&acc)[2][2][4][2], const Unit& u, int wr, int wc, int fr, int fq) const {
        const int cl = wc * 32 + 8 * fq, colo = u.pn * HALF + cl; const float* bp = b1 + (size_t)u.e * (2 * DE) + colo;
        f32x4 bg[2], bl[2];
#pragma unroll
        for (int n = 0; n < 2; ++n) { bg[n] = *(const f32x4*)(bp + 4 * n); bl[n] = *(const f32x4*)(bp + DE + 4 * n); }
        EPI_FOR_ROWS { const int row = u.rowbase + ai * HALF + wr * 64 + m * 16 + fr; float r[8];
#pragma unroll
            for (int n = 0; n < 2; ++n) { const f32x4 g4 = acc[ai][0][m][n] + bg[n], l4 = acc[ai][1][m][n] + bl[n];
#pragma unroll
                for (int i = 0; i < 4; ++i) { const float g = fminf(g4[i], 7.f), l = fminf(fmaxf(l4[i], -7.f), 7.f); r[4 * n + i] = g * sigmoidf_(1.702f * g) * (l + 1.f); } }
            u32x4 w; w.x = cvt_pk_bf16(r[0], r[1]); w.y = cvt_pk_bf16(r[2], r[3]); w.z = cvt_pk_bf16(r[4], r[5]); w.w = cvt_pk_bf16(r[6], r[7]);
            *(u32x4*)(O + (size_t)row * DE + colo) = w; }
        return false;
    }
};
}

__device__ __forceinline__ void p0_transpose_item(const float* W, int K, int N, bf16_t* WT, int k0, int n0, int drow0, LAS float* scr, int lane) {
#pragma unroll 8
    for (int i = 0; i < 32; ++i) { const int kk = 2 * i + (lane >> 5); scr[kk * 33 + (lane & 31)] = W[(size_t)(k0 + kk) * N + n0 + (lane & 31)]; }
    asm volatile("s_waitcnt lgkmcnt(0)" ::: "memory");
    const int c = lane & 7;
#pragma unroll
    for (int j = 0; j < 4; ++j) { const int n = (lane >> 3) + 8 * j; const LAS float* s = scr + (8 * c) * 33 + n;
        u32x4 o; o.x = pk2(s[0 * 33], s[1 * 33]); o.y = pk2(s[2 * 33], s[3 * 33]); o.z = pk2(s[4 * 33], s[5 * 33]); o.w = pk2(s[6 * 33], s[7 * 33]);
        *(u32x4*)(WT + (size_t)(drow0 + n) * K + k0 + 8 * c) = o; }
    asm volatile("s_waitcnt lgkmcnt(0)" ::: "memory");
}
__device__ __forceinline__ void transpose_matrix(Frame& F, const float* W, int K, int N, bf16_t* WT, int& itbase, int gw, int NGW, bool w1map) {
    LAS float* scr = (LAS float*)(F.lds + F.wave * 16384);
    const int nblk = N / 32, nitems = (K / 64) * nblk;
    int first = (gw - (itbase % NGW) + NGW) % NGW;
    for (int it = first; it < nitems; it += NGW) {
        const int kb = it / nblk, nb = it % nblk, n0 = nb * 32;
        int drow0 = n0;
        if (w1map) drow0 = (n0 < DE) ? ((n0 >> 7) * 256 + (n0 & 127)) : (((n0 - DE) >> 7) * 256 + 128 + ((n0 - DE) & 127));
        p0_transpose_item(W, K, N, WT, kb * 64, n0, drow0, scr, F.lane);
    }
    itbase += nitems;
}

struct Args { const float* in[25]; float* out; unsigned char* ws; unsigned long long prog[3]; int nprog, pad; };
typedef const __attribute__((address_space(4))) Args* ArgsP;

__device__ __forceinline__ void phase0(Frame& F, ArgsP a) {
    unsigned char* ws = a->ws;
    {
        const float* c_in = a->in[1]; const float* w_mod = a->in[2]; float* modp = (float*)(ws + WS_MODP);
        LAS float* cact = (LAS float*)F.lds;
        for (int it = blockIdx.x; it < KSPLIT * 12; it += F.G) {
            const int ks = it / 12, nc = it % 12, n = nc * 512 + F.tid, k0 = ks * 64;
            for (int idx = F.tid; idx < 1024; idx += NTHREADS) { const int b = idx & 15, kk = idx >> 4; const float cv = c_in[b * D + k0 + kk]; cact[kk * 16 + b] = cv * sigmoidf_(cv); }
            __syncthreads();
            float acc[16];
#pragma unroll
            for (int b = 0; b < 16; ++b) acc[b] = 0.f;
#pragma unroll 8
            for (int kk = 0; kk < 64; ++kk) { const float w = w_mod[(size_t)(k0 + kk) * 6144 + n];
#pragma unroll
                for (int b4 = 0; b4 < 4; ++b4) { const f32x4 cv = *(const LAS f32x4*)(cact + kk * 16 + 4 * b4);
                    acc[4 * b4 + 0] += cv[0] * w; acc[4 * b4 + 1] += cv[1] * w; acc[4 * b4 + 2] += cv[2] * w; acc[4 * b4 + 3] += cv[3] * w; } }
#pragma unroll
            for (int b = 0; b < 16; ++b) modp[((size_t)ks * 16 + b) * 6144 + n] = acc[b];
            __syncthreads();
        }
    }
    { const float* sg_w = a->in[11]; bf16_t* SGW = (bf16_t*)(ws + WS_SGW);
      for (int idx = blockIdx.x * NTHREADS + F.tid; idx < 8 * 128 * 128 / 2; idx += F.G * NTHREADS) { const int e0 = 2 * idx, t = (e0 >> 7) & 127, sc = e0 & 127;
          const float w0 = sc <= t ? sg_w[e0] : 0.f, w1 = sc + 1 <= t ? sg_w[e0 + 1] : 0.f; ((unsigned*)SGW)[idx] = pk2(w0, w1); } }
    const int gw = blockIdx.x * NWAVES + F.wave, NGW = F.G * NWAVES;
    int itbase = 0;
    transpose_matrix(F, a->in[6], D, NZ, (bf16_t*)(ws + WS_WIN), itbase, gw, NGW, false);
    transpose_matrix(F, a->in[13], 512, D, (bf16_t*)(ws + WS_WBA), itbase, gw, NGW, false);
    transpose_matrix(F, a->in[14], 512, D, (bf16_t*)(ws + WS_WBS), itbase, gw, NGW, false);
    transpose_matrix(F, a->in[15], D, D, (bf16_t*)(ws + WS_WOUT), itbase, gw, NGW, false);
    for (int e = 0; e < NE; ++e) transpose_matrix(F, a->in[21] + (size_t)e * D * 2 * DE, D, 2 * DE, (bf16_t*)(ws + WS_W1) + (size_t)e * 2 * DE * D, itbase, gw, NGW, true);
    for (int e = 0; e < NE; ++e) transpose_matrix(F, a->in[23] + (size_t)e * DE * D, DE, D, (bf16_t*)(ws + WS_W2) + (size_t)e * D * DE, itbase, gw, NGW, false);
}

__device__ __forceinline__ void load_mod(Frame& F, ArgsP a, int b, int col0, int n, LAS float* dst) {
    const float* modp = (const float*)(a->ws + WS_MODP); const float* b_mod = a->in[3];
    for (int idx = F.tid; idx < n; idx += NTHREADS) { const int col = col0 + idx; float s = b_mod[col];
#pragma unroll
        for (int ks = 0; ks < KSPLIT; ++ks) s += modp[((size_t)ks * 16 + b) * 6144 + col];
        dst[idx] = s; }
}

__device__ __forceinline__ void phase0b(Frame& F, ArgsP a) {
    const float* x = a->in[0]; const float* g = a->in[4]; bf16_t* H = (bf16_t*)(a->ws + WS_H);
    LAS float* mv = (LAS float*)F.lds;
    for (int chunk = blockIdx.x; chunk < T / 128; chunk += F.G) {
        const int b = chunk / 16;
        load_mod(F, a, b, 0, 2048, mv);
        __syncthreads();
        for (int tt = 0; tt < 16; ++tt) {
            const int row = chunk * 128 + F.wave * 16 + tt;
            const f32x4* xr = (const f32x4*)(x + (size_t)row * D) + F.lane;
            f32x4 v[4]; float ss = 0.f;
#pragma unroll
            for (int j = 0; j < 4; ++j) { v[j] = xr[64 * j]; ss += (v[j][0] * v[j][0] + v[j][1] * v[j][1]) + (v[j][2] * v[j][2] + v[j][3] * v[j][3]); }
            const float rstd = rsqrtf(wave_sum(ss) * (1.f / D) + EPS);
            u32x2* o8 = (u32x2*)(H + (size_t)row * D) + F.lane;
#pragma unroll
            for (int j = 0; j < 4; ++j) { const int col = 4 * F.lane + 256 * j; const f32x4 gg = *(const f32x4*)(g + col); float r[4];
#pragma unroll
                for (int i = 0; i < 4; ++i) r[i] = v[j][i] * rstd * gg[i] * (1.f + mv[1024 + col + i]) + mv[col + i];
                u32x2 w; w.x = pk2(r[0], r[1]); w.y = pk2(r[2], r[3]); o8[64 * j] = w; }
        }
        __syncthreads();
    }
}

__device__ __forceinline__ void attn_item(Frame& F, ArgsP a, int item) {
    const int hq = item & 7, n = (item >> 3) & 15, b = item >> 7, kvh = hq >> 2;
    const bf16_t* Z = (const bf16_t*)(a->ws + WS_Z); bf16_t* YA = (bf16_t*)(a->ws + WS_YATT);
    LAS bf16_t* Ks = (LAS bf16_t*)F.lds;
    LAS bf16_t* Vs = Ks + 256 * 72;
    const int tok0 = b * SEQ + n * 128;
    for (int c = F.tid; c < 2048; c += NTHREADS) { const int kj = c >> 3, ch = c & 7; const int tk = tok0 - 128 + kj;
        u32x4 kv = (u32x4){0u, 0u, 0u, 0u}, vv = kv;
        if (n > 0 || kj >= 128) { const bf16_t* zr = Z + (size_t)tk * NZ + kvh * 64 + ch * 8; kv = *(const u32x4*)(zr + ZK); vv = *(const u32x4*)(zr + ZV); }
        *(LAS u32x4*)(Ks + kj * 72 + ch * 8) = kv; *(LAS u32x4*)(Vs + kj * 72 + ch * 8) = vv; }
    __syncthreads();
    const int qi = F.tid >> 2, j4 = F.tid & 3;
    float q[64];
    { const bf16_t* qr = Z + (size_t)(tok0 + qi) * NZ + ZQ + hq * 64;
#pragma unroll
      for (int c = 0; c < 8; ++c) unpack8(*(const u32x4*)(qr + c * 8), q + c * 8); }
    const float slope = exp2f(-(float)(hq + 1)), sink = a->in[8][hq];
    float s[32]; float mx = -1e30f;
#pragma unroll
    for (int i = 0; i < 32; ++i) { const int kj = qi + 1 + j4 + 4 * i; const LAS bf16_t* kr = Ks + kj * 72; float dot = 0.f;
#pragma unroll
        for (int c = 0; c < 8; ++c) { float kf[8]; unpack8(*(const LAS u32x4*)(kr + c * 8), kf);
#pragma unroll
            for (int d = 0; d < 8; ++d) dot += q[c * 8 + d] * kf[d]; }
        const float dist = (float)(127 - j4 - 4 * i); const bool valid = (n > 0) || (kj >= 128);
        s[i] = valid ? (dot - slope * dist) : -1e30f; mx = fmaxf(mx, s[i]); }
    mx = fmaxf(mx, __shfl_xor(mx, 1)); mx = fmaxf(mx, __shfl_xor(mx, 2)); mx = fmaxf(mx, sink);
    float l = 0.f;
#pragma unroll
    for (int i = 0; i < 32; ++i) { const float p = __expf(s[i] - mx); s[i] = p; l += p; }
    l += __shfl_xor(l, 1); l += __shfl_xor(l, 2); l += __expf(sink - mx);
    float o[64];
#pragma unroll
    for (int d = 0; d < 64; ++d) o[d] = 0.f;
#pragma unroll 4
    for (int i = 0; i < 32; ++i) { const int kj = qi + 1 + j4 + 4 * i; const LAS bf16_t* vr = Vs + kj * 72; const float p = s[i];
#pragma unroll
        for (int c = 0; c < 8; ++c) { float vf[8]; unpack8(*(const LAS u32x4*)(vr + c * 8), vf);
#pragma unroll
            for (int d = 0; d < 8; ++d) o[c * 8 + d] += p * vf[d]; } }
    const float inv = 1.f / l;
#pragma unroll
    for (int d = 0; d < 64; ++d) { float v = o[d]; v += __shfl_xor(v, 1); v += __shfl_xor(v, 2); o[d] = v * inv; }
    bf16_t* yr = YA + (size_t)(tok0 + qi) * 512 + hq * 64;
#pragma unroll
    for (int jj = 0; jj < 4; ++jj) if (j4 == jj) {
        u32x4 w0, w1; w0.x = pk2(o[16 * jj + 0], o[16 * jj + 1]); w0.y = pk2(o[16 * jj + 2], o[16 * jj + 3]); w0.z = pk2(o[16 * jj + 4], o[16 * jj + 5]); w0.w = pk2(o[16 * jj + 6], o[16 * jj + 7]);
        w1.x = pk2(o[16 * jj + 8], o[16 * jj + 9]); w1.y = pk2(o[16 * jj + 10], o[16 * jj + 11]); w1.z = pk2(o[16 * jj + 12], o[16 * jj + 13]); w1.w = pk2(o[16 * jj + 14], o[16 * jj + 15]);
        *(u32x4*)(yr + 16 * jj) = w0; *(u32x4*)(yr + 16 * jj + 8) = w1; }
    __syncthreads();
}

__device__ __forceinline__ void gmlp_item(Frame& F, ArgsP a, int item) {
    const int b = item >> 4, chunk = item & 15;
    const bf16_t* Z = (const bf16_t*)(a->ws + WS_Z); bf16_t* YS = (bf16_t*)(a->ws + WS_YSG);
    const float* ln_g = a->in[9]; const float* ln_b = a->in[10]; const float* sg_w = a->in[11]; const float* sg_b = a->in[12];
    LAS float* Wl = (LAS float*)F.lds;
    LAS float* Vn = Wl + 128 * 129;
    LAS float* st = Vn + 128 * 64;
    const int tok0 = b * SEQ + chunk * 128;
    for (int tt = 0; tt < 16; ++tt) { const int t = F.wave * 16 + tt; float v[8]; unpack8(*(const u32x4*)(Z + (size_t)(tok0 + t) * NZ + ZVS + F.lane * 8), v);
        float s1 = 0.f;
#pragma unroll
        for (int i = 0; i < 8; ++i) s1 += v[i];
        const float mean = wave_sum(s1) * (1.f / 512.f); float s2 = 0.f;
#pragma unroll
        for (int i = 0; i < 8; ++i) { const float d = v[i] - mean; s2 += d * d; }
        const float rstd = rsqrtf(wave_sum(s2) * (1.f / 512.f) + EPS);
        if (F.lane == 0) { st[2 * t] = mean; st[2 * t + 1] = rstd; } }
    __syncthreads();
    for (int g = 0; g < 8; ++g) {
        for (int idx = F.tid; idx < 16384; idx += NTHREADS) { const int t = idx >> 7, s = idx & 127; Wl[t * 129 + s] = (s <= t) ? sg_w[(size_t)g * 16384 + idx] : 0.f; }
        for (int idx = F.tid; idx < 8192; idx += NTHREADS) { const int s = idx >> 6, d = idx & 63; const float gv = bf2f(Z[(size_t)(tok0 + s) * NZ + ZVS + g * 64 + d]);
            Vn[idx] = (gv - st[2 * s]) * st[2 * s + 1] * ln_g[g * 64 + d] + ln_b[g * 64 + d]; }
        __syncthreads();
        const int t = F.tid >> 2, dq = F.tid & 3;
        float acc[16];
#pragma unroll
        for (int i = 0; i < 16; ++i) acc[i] = 0.f;
        for (int s = 0; s <= t; ++s) { const float w = Wl[t * 129 + s]; const LAS f32x4* vp = (const LAS f32x4*)(Vn + s * 64 + dq * 16);
#pragma unroll
            for (int c = 0; c < 4; ++c) { const f32x4 vv = vp[c]; acc[4 * c] += w * vv[0]; acc[4 * c + 1] += w * vv[1]; acc[4 * c + 2] += w * vv[2]; acc[4 * c + 3] += w * vv[3]; } }
        const float bias = sg_b[g * 128 + t];
        const bf16_t* ur = Z + (size_t)(tok0 + t) * NZ + ZU + g * 64 + dq * 16; float gu[16]; unpack8(*(const u32x4*)ur, gu); unpack8(*(const u32x4*)(ur + 8), gu + 8);
        float r[16];
#pragma unroll
        for (int i = 0; i < 16; ++i) r[i] = gu[i] * (acc[i] + bias);
        bf16_t* yr = YS + (size_t)(tok0 + t) * 512 + g * 64 + dq * 16;
        u32x4 w0, w1; w0.x = pk2(r[0], r[1]); w0.y = pk2(r[2], r[3]); w0.z = pk2(r[4], r[5]); w0.w = pk2(r[6], r[7]); w1.x = pk2(r[8], r[9]); w1.y = pk2(r[10], r[11]); w1.z = pk2(r[12], r[13]); w1.w = pk2(r[14], r[15]);
        *(u32x4*)yr = w0; *(u32x4*)(yr + 8) = w1;
        __syncthreads();
    }
}


__device__ __forceinline__ void attn_item_mfma(Frame& F, ArgsP a, int item) {
    const int kvh = item & 1, n = (item >> 1) & 15, b = item >> 5;
    const bf16_t* Z = (const bf16_t*)(a->ws + WS_Z); const bf16_t* VT = (const bf16_t*)(a->ws + WS_VT); bf16_t* YA = (bf16_t*)(a->ws + WS_YATT);
    LAS bf16_t* Ks = (LAS bf16_t*)F.lds;
    LAS bf16_t* Vs = Ks + 256 * 72;
    const int tok0 = b * SEQ + n * 128;
    for (int c = F.tid; c < 2048; c += NTHREADS) { const int kj = c >> 3, ch = c & 7; u32x4 kv = (u32x4){0u, 0u, 0u, 0u};
        if (n > 0 || kj >= 128) kv = *(const u32x4*)(Z + (size_t)(tok0 - 128 + kj) * NZ + ZK + kvh * 64 + ch * 8);
        *(LAS u32x4*)(Ks + kj * 72 + ch * 8) = kv; }
    for (int c = F.tid; c < 2048; c += NTHREADS) { const int d = c >> 5, ch = c & 31; u32x4 vv = (u32x4){0u, 0u, 0u, 0u};
        if (n > 0 || ch >= 16) vv = *(const u32x4*)(VT + (size_t)(b * 128 + kvh * 64 + d) * SEQ + (n - 1) * 128 + ch * 8);
        *(LAS u32x4*)(Vs + d * 264 + ch * 8) = vv; }
    __syncthreads();
    const int r = F.lane & 31, h = F.lane >> 5;
    const int pr = (r & ~12) | ((r & 4) << 1) | ((r & 8) >> 1);
#pragma unroll 1
    for (int j = 0; j < 2; ++j) {
        const int tk = F.wave * 2 + j, g = tk >> 2, qs = tk & 3, hq = kvh * 4 + g;
        const int qi = 32 * qs + r;
        const bf16_t* qp = Z + (size_t)(tok0 + qi) * NZ + ZQ + hq * 64 + 8 * h;
        bf16x8 qf[4];
#pragma unroll
        for (int ks = 0; ks < 4; ++ks) qf[ks] = *(const bf16x8*)(qp + 16 * ks);
        const float slope = exp2f(-(float)(hq + 1)), sink = a->in[8][hq];
        float mrun = sink, lsum = 0.f;
        f32x16 O[2];
#pragma unroll
        for (int dt = 0; dt < 2; ++dt)
#pragma unroll
            for (int i = 0; i < 16; ++i) O[dt][i] = 0.f;
#pragma unroll
        for (int tt = 0; tt < 5; ++tt) {
            f32x16 S;
#pragma unroll
            for (int i = 0; i < 16; ++i) S[i] = 0.f;
            const LAS bf16_t* kp = Ks + (32 * (qs + tt) + pr) * 72 + 8 * h;
#pragma unroll
            for (int ks = 0; ks < 4; ++ks) { const bf16x8 kf = *(const LAS bf16x8*)(kp + 16 * ks); S = MFMA32(kf, qf[ks], S); }
            float tmax = -1e30f;
#pragma unroll
            for (int i = 0; i < 16; ++i) { const int kj = 32 * (qs + tt) + (i & 3) + 4 * ((i >> 2) & 1) + 8 * h + 16 * (i >> 3); const int dist = qi + 128 - kj;
                const bool valid = (dist >= 0) && (dist < 128) && (n > 0 || kj >= 128);
                const float v = valid ? (S[i] - slope * (float)dist) : -1e30f; S[i] = v; tmax = fmaxf(tmax, v); }
            tmax = fmaxf(tmax, __shfl_xor(tmax, 32));
            const float mnew = fmaxf(mrun, tmax), alpha = __expf(mrun - mnew); mrun = mnew;
            float ps = 0.f;
#pragma unroll
            for (int i = 0; i < 16; ++i) { const float p = __expf(S[i] - mnew); S[i] = p; ps += p; }
            lsum = lsum * alpha + ps;
#pragma unroll
            for (int dt = 0; dt < 2; ++dt)
#pragma unroll
                for (int i = 0; i < 16; ++i) O[dt][i] *= alpha;
#pragma unroll
            for (int sx = 0; sx < 2; ++sx) {
                u32x4 pw; pw.x = cvtpk(S[8 * sx + 0], S[8 * sx + 1]); pw.y = cvtpk(S[8 * sx + 2], S[8 * sx + 3]); pw.z = cvtpk(S[8 * sx + 4], S[8 * sx + 5]); pw.w = cvtpk(S[8 * sx + 6], S[8 * sx + 7]);
                const bf16x8 pb = __builtin_bit_cast(bf16x8, pw);
#pragma unroll
                for (int dt = 0; dt < 2; ++dt) { const bf16x8 vf = *(const LAS bf16x8*)(Vs + (32 * dt + r) * 264 + 32 * (qs + tt) + 16 * sx + 8 * h); O[dt] = MFMA32(vf, pb, O[dt]); }
            }
        }
        const float l = lsum + __shfl_xor(lsum, 32) + __expf(sink - mrun);
        const float inv = 1.f / l;
        bf16_t* yp = YA + (size_t)(tok0 + qi) * 512 + hq * 64;
#pragma unroll
        for (int dt = 0; dt < 2; ++dt)
#pragma unroll
            for (int a4 = 0; a4 < 4; ++a4) { u32x2 w; w.x = cvtpk(O[dt][4 * a4] * inv, O[dt][4 * a4 + 1] * inv); w.y = cvtpk(O[dt][4 * a4 + 2] * inv, O[dt][4 * a4 + 3] * inv);
                *(u32x2*)(yp + 32 * dt + 8 * a4 + 4 * h) = w; }
    }
    __syncthreads();
}

__device__ __forceinline__ void gmlp_item_mfma(Frame& F, ArgsP a, int item) {
    const int b = item >> 4, chunk = item & 15;
    const bf16_t* Z = (const bf16_t*)(a->ws + WS_Z); const bf16_t* GVT = (const bf16_t*)(a->ws + WS_GVT); const bf16_t* SGW = (const bf16_t*)(a->ws + WS_SGW); bf16_t* YS = (bf16_t*)(a->ws + WS_YSG);
    const float* ln_g = a->in[9]; const float* ln_b = a->in[10]; const float* sg_b = a->in[12];
    LAS float* st = (LAS float*)F.lds;
    const int tok0 = b * SEQ + chunk * 128;
    for (int tt = 0; tt < 16; ++tt) { const int t = F.wave * 16 + tt; float v[8]; unpack8(*(const u32x4*)(Z + (size_t)(tok0 + t) * NZ + ZVS + F.lane * 8), v);
        float s1 = 0.f;
#pragma unroll
        for (int i = 0; i < 8; ++i) s1 += v[i];
        const float mean = wave_sum(s1) * (1.f / 512.f); float s2 = 0.f;
#pragma unroll
        for (int i = 0; i < 8; ++i) { const float d = v[i] - mean; s2 += d * d; }
        const float rstd = rsqrtf(wave_sum(s2) * (1.f / 512.f) + EPS);
        if (F.lane == 0) { st[2 * t] = mean; st[2 * t + 1] = rstd; } }
    __syncthreads();
    const int g = F.wave, r = F.lane & 31, h = F.lane >> 5;
    f32x16 acc[2][4];
#pragma unroll
    for (int dt = 0; dt < 2; ++dt)
#pragma unroll
        for (int tt = 0; tt < 4; ++tt)
#pragma unroll
            for (int i = 0; i < 16; ++i) acc[dt][tt][i] = 0.f;
    float gam[2], bet[2];
#pragma unroll
    for (int dt = 0; dt < 2; ++dt) { gam[dt] = ln_g[g * 64 + 32 * dt + r]; bet[dt] = ln_b[g * 64 + 32 * dt + r]; }
#pragma unroll 1
    for (int ks = 0; ks < 8; ++ks) {
        float mu[8], rs[8];
#pragma unroll
        for (int q4 = 0; q4 < 4; ++q4) { const f32x4 sv = *(const LAS f32x4*)(st + 2 * (16 * ks + 8 * h) + 4 * q4); mu[2 * q4] = sv[0]; rs[2 * q4] = sv[1]; mu[2 * q4 + 1] = sv[2]; rs[2 * q4 + 1] = sv[3]; }
        bf16x8 af[2];
#pragma unroll
        for (int dt = 0; dt < 2; ++dt) { float x[8]; unpack8(*(const u32x4*)(GVT + (size_t)(b * 512 + g * 64 + 32 * dt + r) * SEQ + chunk * 128 + 16 * ks + 8 * h), x);
#pragma unroll
            for (int i = 0; i < 8; ++i) x[i] = (x[i] - mu[i]) * rs[i] * gam[dt] + bet[dt];
            u32x4 pw; pw.x = cvtpk(x[0], x[1]); pw.y = cvtpk(x[2], x[3]); pw.z = cvtpk(x[4], x[5]); pw.w = cvtpk(x[6], x[7]); af[dt] = __builtin_bit_cast(bf16x8, pw); }
#pragma unroll
        for (int tt = 0; tt < 4; ++tt) if (16 * ks <= 32 * tt + 31) {
            const bf16x8 wf = *(const bf16x8*)(SGW + ((size_t)g * 128 + 32 * tt + r) * 128 + 16 * ks + 8 * h);
#pragma unroll
            for (int dt = 0; dt < 2; ++dt) acc[dt][tt] = MFMA32(af[dt], wf, acc[dt][tt]); }
    }
#pragma unroll
    for (int tt = 0; tt < 4; ++tt) { const int t = 32 * tt + r; const float bias = sg_b[g * 128 + t];
        const bf16_t* up = Z + (size_t)(tok0 + t) * NZ + ZU + g * 64; bf16_t* yp = YS + (size_t)(tok0 + t) * 512 + g * 64;
#pragma unroll
        for (int dt = 0; dt < 2; ++dt)
#pragma unroll
            for (int a4 = 0; a4 < 4; ++a4) { const int d0 = 32 * dt + 8 * a4 + 4 * h; const u32x2 uw = *(const u32x2*)(up + d0);
                const float u0 = __uint_as_float(uw.x << 16), u1 = __uint_as_float(uw.x & 0xffff0000u), u2 = __uint_as_float(uw.y << 16), u3 = __uint_as_float(uw.y & 0xffff0000u);
                u32x2 w; w.x = cvtpk(u0 * (acc[dt][tt][4 * a4] + bias), u1 * (acc[dt][tt][4 * a4 + 1] + bias)); w.y = cvtpk(u2 * (acc[dt][tt][4 * a4 + 2] + bias), u3 * (acc[dt][tt][4 * a4 + 3] + bias));
                *(u32x2*)(yp + d0) = w; } }
    __syncthreads();
}

__device__ __forceinline__ void phase5(Frame& F, ArgsP a) {
    const float* x = a->in[0]; const float* g_post = a->in[5]; const float* g_pre = a->in[17]; const float* w_r = a->in[19]; const float* b_r = a->in[20];
    const bf16_t* Y = (const bf16_t*)(a->ws + WS_Y); bf16_t* H2 = (bf16_t*)(a->ws + WS_H2); float* out = (float*)(a->ws + WS_X1);
    unsigned* gcnt = (unsigned*)(a->ws + WS_CTL) + CW_CNT; int* lists = (int*)(a->ws + WS_LISTS); int* tokinfo = (int*)(a->ws + WS_TOKINFO);
    LAS float* h2buf = (LAS float*)F.lds;
    LAS float* part = (LAS float*)(F.lds + 65536);
    LAS float* mv = (LAS float*)(F.lds + 81920);
    LAS int* hist = (LAS int*)(F.lds + 94208);
    LAS int* basep = hist + 32;
    LAS int* asg_e = hist + 64;
    LAS int* asg_l = asg_e + 512;
    LAS float* asg_g = (LAS float*)(asg_l + 512);
    const int e_l = F.lane & 31, kh = F.lane >> 5;
    float wreg[64];
#pragma unroll
    for (int i = 0; i < 64; ++i) wreg[i] = w_r[(size_t)(128 * F.wave + 64 * kh + i) * NE + e_l];
    for (int chunk = blockIdx.x; chunk < T / 128; chunk += F.G) {
        const int b = chunk / 16;
        load_mod(F, a, b, 2048, 3072, mv);
        if (F.tid < 32) hist[F.tid] = 0;
        __syncthreads();
#define P5_LOADROWS(SB, XR, YR) do { _Pragma("unroll") for (int _j = 0; _j < 2; ++_j) { const int _row = chunk * 128 + (SB) * 16 + 2 * F.wave + _j; \
            const f32x4* _xr = (const f32x4*)(x + (size_t)_row * D) + F.lane; const u32x2* _yr = (const u32x2*)(Y + (size_t)_row * D) + F.lane; \
            _Pragma("unroll") for (int _jj = 0; _jj < 4; ++_jj) { XR[_j][_jj] = _xr[64 * _jj]; YR[_j][_jj] = _yr[64 * _jj]; } } } while (0)
        f32x4 xc[2][4]; u32x2 yc[2][4];
        P5_LOADROWS(0, xc, yc);
        for (int sb = 0; sb < 8; ++sb) {
#pragma unroll
            for (int j = 0; j < 2; ++j) {
                const int tt = 2 * F.wave + j, row = chunk * 128 + sb * 16 + tt;
                f32x4 xv[4], yv[4]; float ss = 0.f;
#pragma unroll
                for (int jj = 0; jj < 4; ++jj) { xv[jj] = xc[j][jj]; const u32x2 w = yc[j][jj];
                    yv[jj][0] = __uint_as_float(w.x << 16); yv[jj][1] = __uint_as_float(w.x & 0xffff0000u); yv[jj][2] = __uint_as_float(w.y << 16); yv[jj][3] = __uint_as_float(w.y & 0xffff0000u);
                    ss += (yv[jj][0] * yv[jj][0] + yv[jj][1] * yv[jj][1]) + (yv[jj][2] * yv[jj][2] + yv[jj][3] * yv[jj][3]); }
                const float rstd = rsqrtf(wave_sum(ss) * (1.f / D) + EPS); float s1 = 0.f;
#pragma unroll
                for (int jj = 0; jj < 4; ++jj) { const int col = 4 * F.lane + 256 * jj; const f32x4 gp = *(const f32x4*)(g_post + col);
#pragma unroll
                    for (int i = 0; i < 4; ++i) { const float v = xv[jj][i] + mv[col + i] * (yv[jj][i] * rstd * gp[i]); xv[jj][i] = v; s1 += v * v; }
                    *((f32x4*)(out + (size_t)row * D) + F.lane + 64 * jj) = xv[jj]; }
                const float rstd1 = rsqrtf(wave_sum(s1) * (1.f / D) + EPS);
                u32x2* o8 = (u32x2*)(H2 + (size_t)row * D) + F.lane;
#pragma unroll
                for (int jj = 0; jj < 4; ++jj) { const int col = 4 * F.lane + 256 * jj; const f32x4 gq = *(const f32x4*)(g_pre + col); f32x4 r;
#pragma unroll
                    for (int i = 0; i < 4; ++i) r[i] = xv[jj][i] * rstd1 * gq[i] * (1.f + mv[2048 + col + i]) + mv[1024 + col + i];
                    u32x2 w; w.x = pk2(r[0], r[1]); w.y = pk2(r[2], r[3]); o8[64 * jj] = w;
                    *(LAS f32x4*)(h2buf + tt * 1024 + col) = r; }
            }
            { const int sbn = sb < 7 ? sb + 1 : 7; P5_LOADROWS(sbn, xc, yc); }
            __syncthreads();
#pragma unroll 1
            for (int t16 = 0; t16 < 16; ++t16) { const LAS f32x4* hp = (const LAS f32x4*)(h2buf + t16 * 1024 + 128 * F.wave + 64 * kh); float acc = 0.f;
#pragma unroll
                for (int i4 = 0; i4 < 16; ++i4) { const f32x4 hv = hp[i4]; acc += hv[0] * wreg[4 * i4] + hv[1] * wreg[4 * i4 + 1] + hv[2] * wreg[4 * i4 + 2] + hv[3] * wreg[4 * i4 + 3]; }
                acc += __shfl_xor(acc, 32);
                if (F.lane < 32) part[(F.wave * 16 + t16) * 32 + F.lane] = acc; }
            __syncthreads();
#pragma unroll 1
            for (int j = 0; j < 2; ++j) {
                const int tt = 2 * F.wave + j, tokidx = sb * 16 + tt;
                float logit = b_r[e_l];
#pragma unroll
                for (int w = 0; w < 8; ++w) logit += part[(w * 16 + tt) * 32 + e_l];
                float val = logit; float tv[4]; int ti[4];
#pragma unroll
                for (int k = 0; k < 4; ++k) { float bv = val; int bi = e_l;
#pragma unroll
                    for (int o = 1; o < 32; o <<= 1) { const float ov = __shfl_xor(bv, o); const int oi = __shfl_xor(bi, o); if (ov > bv || (ov == bv && oi < bi)) { bv = ov; bi = oi; } }
                    tv[k] = bv; ti[k] = bi; if (e_l == bi) val = -3.0e38f; }
                const float p1 = __expf(tv[1] - tv[0]), p2 = __expf(tv[2] - tv[0]), p3 = __expf(tv[3] - tv[0]); const float inv = 1.f / (1.f + p1 + p2 + p3);
                if (F.lane < 4) { const int k = F.lane; const int e = k == 0 ? ti[0] : (k == 1 ? ti[1] : (k == 2 ? ti[2] : ti[3])); const float gt = (k == 0 ? 1.f : (k == 1 ? p1 : (k == 2 ? p2 : p3))) * inv;
                    const int lp = __hip_atomic_fetch_add(hist + e, 1, __ATOMIC_RELAXED, __HIP_MEMORY_SCOPE_WORKGROUP); asg_e[tokidx * 4 + k] = e; asg_l[tokidx * 4 + k] = lp; asg_g[tokidx * 4 + k] = gt; }
            }
        }
        __syncthreads();
        if (F.tid < 32) basep[F.tid] = (int)atomicAdd(gcnt + F.tid, (unsigned)hist[F.tid]);
        __syncthreads();
        { const int aidx = F.tid, tokidx = aidx >> 2, k = aidx & 3, e = asg_e[aidx], pos = basep[e] + asg_l[aidx], token = chunk * 128 + tokidx;
          lists[(size_t)e * LISTCAP + pos] = token;
          int* ti = tokinfo + ((size_t)token * 4 + k) * 4; ti[0] = e; ti[1] = pos; ti[2] = __float_as_int(asg_g[aidx]); ti[3] = 0; }
        __syncthreads();
    }
}

__device__ __forceinline__ void moe_tables(Frame& F, ArgsP a, LAS int* tab, int NT) {
    const unsigned* gcnt = (const unsigned*)(a->ws + WS_CTL) + CW_CNT;
    if (F.tid == 0) { int us = 0, ro = 0;
        for (int e = 0; e < NE; ++e) { const int c = (int)__hip_atomic_load(gcnt + e, __ATOMIC_RELAXED, __HIP_MEMORY_SCOPE_AGENT); const int tiles = (c + 255) >> 8; tab[e] = us; tab[64 + e] = ro; tab[128 + e] = c; us += tiles * NT; ro += tiles * 256; }
        tab[32] = us; tab[64 + 32] = ro; }
    __syncthreads();
}

__device__ __forceinline__ void phase9(Frame& F, ArgsP a) {
    const float* g_post = a->in[18]; const bf16_t* YS = (const bf16_t*)(a->ws + WS_YS); const int* tokinfo = (const int*)(a->ws + WS_TOKINFO); float* out = a->out;
    const float* X1 = (const float*)(a->ws + WS_X1);
    LAS int* tab = (LAS int*)(F.lds + MISC_OFF); LAS float* mv = (LAS float*)F.lds;
    moe_tables(F, a, tab, 4);
    for (int chunk = blockIdx.x; chunk < T / 128; chunk += F.G) {
        const int b = chunk / 16;
        load_mod(F, a, b, 5120, 1024, mv);
        __syncthreads();
        const int row0 = chunk * 128 + F.wave * 16;
        const u32x4 tinf = *(const u32x4*)(tokinfo + ((size_t)(row0 + (F.lane >> 2)) * 4 + (F.lane & 3)) * 4);
        const int srow = tab[64 + (int)tinf.x] + (int)tinf.y; const float sgate = __uint_as_float(tinf.z);
#define P9_LOAD(I, YR, XR) do { _Pragma("unroll") for (int _k = 0; _k < 4; ++_k) { const int _r = __shfl(srow, 4 * (I) + _k); const u32x2* _yr = (const u32x2*)(YS + (size_t)_r * D) + F.lane; \
            _Pragma("unroll") for (int _jj = 0; _jj < 4; ++_jj) YR[_k][_jj] = _yr[64 * _jj]; } \
            const f32x4* _xr = (const f32x4*)(X1 + (size_t)(row0 + (I)) * D) + F.lane; _Pragma("unroll") for (int _jj = 0; _jj < 4; ++_jj) XR[_jj] = _xr[64 * _jj]; } while (0)
        u32x2 yc[4][4], yn[4][4]; f32x4 xc[4], xn[4];
        P9_LOAD(0, yc, xc);
#pragma unroll 1
        for (int i = 0; i < 16; ++i) {
            { const int in_ = i < 15 ? i + 1 : 15; P9_LOAD(in_, yn, xn); }
            f32x4 yv[4];
#pragma unroll
            for (int jj = 0; jj < 4; ++jj) yv[jj] = (f32x4){0.f, 0.f, 0.f, 0.f};
#pragma unroll
            for (int k = 0; k < 4; ++k) { const float gt = __shfl(sgate, 4 * i + k);
#pragma unroll
                for (int jj = 0; jj < 4; ++jj) { const u32x2 w = yc[k][jj];
                    yv[jj][0] += gt * __uint_as_float(w.x << 16); yv[jj][1] += gt * __uint_as_float(w.x & 0xffff0000u); yv[jj][2] += gt * __uint_as_float(w.y << 16); yv[jj][3] += gt * __uint_as_float(w.y & 0xffff0000u); } }
            float ss = 0.f;
#pragma unroll
            for (int jj = 0; jj < 4; ++jj) ss += (yv[jj][0] * yv[jj][0] + yv[jj][1] * yv[jj][1]) + (yv[jj][2] * yv[jj][2] + yv[jj][3] * yv[jj][3]);
            const float rstd = rsqrtf(wave_sum(ss) * (1.f / D) + EPS);
            f32x4* orow = (f32x4*)(out + (size_t)(row0 + i) * D) + F.lane;
#pragma unroll
            for (int jj = 0; jj < 4; ++jj) { const int col = 4 * F.lane + 256 * jj; const f32x4 gp = *(const f32x4*)(g_post + col); f32x4 xv = xc[jj];
#pragma unroll
                for (int ii = 0; ii < 4; ++ii) xv[ii] += mv[col + ii] * (yv[jj][ii] * rstd * gp[ii]);
                orow[64 * jj] = xv; }
#pragma unroll
            for (int k = 0; k < 4; ++k)
#pragma unroll
                for (int jj = 0; jj < 4; ++jj) yc[k][jj] = yn[k][jj];
#pragma unroll
            for (int jj = 0; jj < 4; ++jj) xc[jj] = xn[jj];
        }
        __syncthreads();
    }
}

#define XB_TMO      128
#define XB_XCNT(j)  (256  + 64 * (j))
#define XB_XSUB(j)  (1280 + 64 * (j))
#define XB_XGEN(j)  (2304 + 64 * (j))
#define XB_TOP      3328
#define XB_TOPGEN   3392
#define XCD_BAR_WORDS 3456
#define XB_SPIN_CAP (1u << 18)
__device__ __forceinline__ unsigned xb_ld(unsigned* p)              { return __hip_atomic_load(p, __ATOMIC_RELAXED, __HIP_MEMORY_SCOPE_AGENT); }
__device__ __forceinline__ unsigned xb_add(unsigned* p, unsigned v) { return __hip_atomic_fetch_add(p, v, __ATOMIC_RELAXED, __HIP_MEMORY_SCOPE_AGENT); }
__device__ __forceinline__ unsigned xb_xcc_id() { return (unsigned)__builtin_amdgcn_s_getreg((3 << 11) | 20) & 0xFu; }
#define XB_SPIN(cond, bar) do { unsigned _sp = 0; while (cond) { __builtin_amdgcn_s_sleep(1); \
    if ((++_sp & 255u) == 0u) { if (xb_ld(&(bar)[XB_TMO])) break; if (_sp > XB_SPIN_CAP) { atomicAdd(&(bar)[XB_TMO], 1u); break; } } } } while (0)
struct XcdBarrier { unsigned* bar; unsigned x; volatile LAS unsigned* st; };
__device__ __forceinline__ XcdBarrier xcd_barrier_post(unsigned* bar, volatile LAS unsigned* st) {
    XcdBarrier b; b.bar = bar; b.x = xb_xcc_id(); b.st = st;
    if (threadIdx.x == 0) (void)xb_add(&bar[XB_XCNT(b.x)], 1u);
    return b;
}
__device__ __forceinline__ void xcd_barrier_complete(unsigned* bar, unsigned x, unsigned& nloc, unsigned& nx) {
    const unsigned G = gridDim.x * gridDim.y * gridDim.z;
    unsigned sum, cnt, mine, sp = 0u;
    for (;;) {
        sum = 0u; cnt = 0u; mine = 0u;
#pragma unroll
        for (unsigned j = 0; j < 16; ++j) { const unsigned c = xb_ld(&bar[XB_XCNT(j)]); sum += c; cnt += (c > 0u) ? 1u : 0u; mine = (j == x) ? c : mine; }
        if (sum == G) break;
        __builtin_amdgcn_s_sleep(1);
        if ((++sp & 255u) == 0u) { if (xb_ld(&bar[XB_TMO])) break; if (sp > XB_SPIN_CAP) { atomicAdd(&bar[XB_TMO], 1u); break; } }
    }
    nloc = mine > 0u ? mine : 1u; nx = cnt > 0u ? cnt : 1u;
}
__device__ __forceinline__ void xcd_barrier(const XcdBarrier& b) {
    asm volatile("s_waitcnt vmcnt(0)" ::: "memory");
    __syncthreads();
    if (threadIdx.x == 0) {
        unsigned* bar = b.bar;
        __builtin_amdgcn_s_waitcnt(0);
        unsigned nloc = b.st[0], nx = b.st[1];
        if (nloc == 0u) { xcd_barrier_complete(bar, b.x, nloc, nx); b.st[0] = nloc; b.st[1] = nx; }
        const unsigned old = xb_add(&bar[XB_XSUB(b.x)], 1u);
        const unsigned gen = old / nloc;
        if (old + 1u == (gen + 1u) * nloc) {
            __builtin_amdgcn_fence(__ATOMIC_RELEASE, "agent");
            asm volatile("s_waitcnt vmcnt(0)" ::: "memory");
            const unsigned og = xb_add(&bar[XB_TOP], 1u);
            const unsigned tg = og / nx;
            if (og + 1u == (tg + 1u) * nx) xb_add(&bar[XB_TOPGEN], 1u);
            else XB_SPIN(xb_ld(&bar[XB_TOPGEN]) == tg, bar);
            __builtin_amdgcn_fence(__ATOMIC_ACQUIRE, "agent");
            xb_add(&bar[XB_XGEN(b.x)], 1u);
            asm volatile("s_waitcnt vmcnt(0)" ::: "memory");
        } else {
            XB_SPIN(xb_ld(&bar[XB_XGEN(b.x)]) == gen, bar);
            __builtin_amdgcn_fence(__ATOMIC_ACQUIRE, "agent");
            asm volatile("s_waitcnt vmcnt(0)" ::: "memory");
        }
    }
    __syncthreads();
}

constexpr int NPHASE = 10;
__global__ void __launch_bounds__(NTHREADS, 2) fwd_kernel(Args a_unused) {
    extern __shared__ __attribute__((aligned(16))) unsigned char lds_raw[];
    Frame F; F.lds = (LAS unsigned char*)lds_raw; F.G = gridDim.x;
    ArgsP a = (ArgsP)__builtin_amdgcn_kernarg_segment_ptr();
    volatile LAS unsigned* bst = (volatile LAS unsigned*)(F.lds + MISC_OFF + 1024);
    XcdBarrier xbar; xbar.bar = (unsigned*)(a->ws + WS_CTL) + CW_BAR; xbar.x = 0; xbar.st = bst;
    const int nprog = a->nprog;
    if (nprog > 1) { if (threadIdx.x == 0) { bst[0] = 0u; bst[1] = 0u; } __syncthreads(); xbar = xcd_barrier_post((unsigned*)(a->ws + WS_CTL) + CW_BAR, bst); if (nprog < 0) cg::this_grid().sync(); }
#pragma nounroll
    for (int pi = 0; pi < nprog; ++pi) {
        { unsigned long long _p = (unsigned long long)__builtin_amdgcn_kernarg_segment_ptr(); asm volatile("" : "+s"(_p)); a = (ArgsP)_p; }
        { int _t = threadIdx.x; asm volatile("" : "+v"(_t)); F.tid = _t; F.lane = _t & 63; F.wave = __builtin_amdgcn_readfirstlane(_t >> 6); }
        { int _g = gridDim.x; asm volatile("" : "+s"(_g)); F.G = _g; }
        int bid = blockIdx.x; asm volatile("" : "+s"(bid));
        unsigned char* ws = a->ws;
        const int ph = (int)((a->prog[pi >> 3] >> ((pi & 7) * 8)) & 0xffull);
        switch (ph) {
        case 0: phase0(F, a); break;
        case 1: phase0b(F, a); break;
        case 2: {
            pg8::SchedDense S{(const char*)(ws + WS_H), (const char*)(ws + WS_WIN), T / 256, NZ / 256, F.G, bid, (size_t)256 * D * 2};
            pg8::EpiInProj E{(bf16_t*)(ws + WS_Z), a->in[7], (bf16_t*)(ws + WS_VT), (bf16_t*)(ws + WS_GVT)};
            pg8::gemm_phase<pg8::EpiInProj, pg8::SchedDense, false>(F.lds, F.tid, D, S, E);
        } break;
        case 3: {
            for (int it = bid; it < 256 + 512; it += F.G) { if (it < 256) gmlp_item_mfma(F, a, it); else attn_item_mfma(F, a, it - 256); }
        } break;
        case 4: {
            pg8::SchedBranch S{(const char*)(ws + WS_YATT), (const char*)(ws + WS_WBA), (const char*)(ws + WS_YSG), (const char*)(ws + WS_WBS), T / 256, D / 256, F.G, bid, (size_t)256 * 512 * 2};
            pg8::EpiBranch E{(const bf16_t*)(ws + WS_Z), (bf16_t*)(ws + WS_H)};
            pg8::gemm_phase<pg8::EpiBranch, pg8::SchedBranch, false>(F.lds, F.tid, 512, S, E);
        } break;
        case 5: {
            pg8::SchedDense S{(const char*)(ws + WS_H), (const char*)(ws + WS_WOUT), T / 256, D / 256, F.G, bid, (size_t)256 * D * 2};
            pg8::EpiBiasBf16 E{(bf16_t*)(ws + WS_Y), D, a->in[16], 0};
            pg8::gemm_phase<pg8::EpiBiasBf16, pg8::SchedDense, false>(F.lds, F.tid, D, S, E);
        } break;
        case 6: phase5(F, a); break;
        case 7: {
            LAS int* tab = (LAS int*)(F.lds + MISC_OFF); moe_tables(F, a, tab, 8);
            pg8::SchedMoE S{tab, (const char*)(ws + WS_H2), (const char*)(ws + WS_W1), (size_t)2 * DE * D * 2, (const int*)(ws + WS_LISTS), 8, F.G, bid, (size_t)256 * D * 2, true};
            pg8::EpiSwiGLU E{(bf16_t*)(ws + WS_ACT), a->in[22]};
            pg8::gemm_phase<pg8::EpiSwiGLU, pg8::SchedMoE, true>(F.lds, F.tid, D, S, E);
        } break;
        case 8: {
            LAS int* tab = (LAS int*)(F.lds + MISC_OFF); moe_tables(F, a, tab, 4);
            pg8::SchedMoE S{tab, (const char*)(ws + WS_ACT), (const char*)(ws + WS_W2), (size_t)D * DE * 2, nullptr, 4, F.G, bid, (size_t)256 * DE * 2, false};
            pg8::EpiBiasBf16 E{(bf16_t*)(ws + WS_YS), D, a->in[24], D};
            pg8::gemm_phase<pg8::EpiBiasBf16, pg8::SchedMoE, false>(F.lds, F.tid, DE, S, E);
        } break;
        case 9: phase9(F, a); break;
        default: if (bid == 0 && F.tid < 32) ((unsigned*)(ws + WS_CTL))[CW_CNT + F.tid] = 0u; break;
        }
        if (pi + 1 < nprog) xcd_barrier(xbar);
    }
}

extern "C" void kernel_launch(void* const* d_in, const int* in_sizes, int n_in, void* d_out, int out_size, void* d_ws, size_t ws_size, hipStream_t stream) {
    const void* kfn = (const void*)fwd_kernel;
    static int grid = 0;
    if (grid == 0) {
        if (n_in != 25 || out_size != T * D || ws_size < WS_END) { fprintf(stderr, "kernel_launch: unexpected problem (n_in %d out %d ws %zu)\n", n_in, out_size, ws_size); grid = -1; return; }
        int dev = 0, cus = 0, per_cu = 0;
        (void)hipGetDevice(&dev); (void)hipDeviceGetAttribute(&cus, hipDeviceAttributeMultiprocessorCount, dev);
        (void)hipFuncSetAttribute(kfn, hipFuncAttributeMaxDynamicSharedMemorySize, LDS_BYTES);
        (void)hipOccupancyMaxActiveBlocksPerMultiprocessor(&per_cu, kfn, NTHREADS, LDS_BYTES);
        (void)hipGetLastError();
        if (per_cu < 1) { fprintf(stderr, "kernel_launch: occupancy query says %d blocks per CU\n", per_cu); grid = -1; return; }
        grid = cus;
    }
    if (grid < 0) return;
    (void)hipMemsetAsync((char*)d_ws + WS_CTL, 0, CTL_BYTES, stream);
    Args a{};
    for (int i = 0; i < 25; ++i) a.in[i] = (const float*)d_in[i];
    a.out = (float*)d_out; a.ws = (unsigned char*)d_ws;
    static const unsigned char program[] = PHASE_PROGRAM;
    const int np = (int)sizeof(program);
#if MK_ONE_LAUNCH
    a.nprog = np; for (int i = 0; i < np; ++i) a.prog[i >> 3] |= (unsigned long long)program[i] << ((i & 7) * 8);
    void* args[] = {&a};
    hipError_t e = hipLaunchCooperativeKernel(kfn, dim3(grid), dim3(NTHREADS), args, LDS_BYTES, stream);
    if (e != hipSuccess) fprintf(stderr, "cooperative launch failed: %s (grid %d)\n", hipGetErrorString(e), grid);
#else
    for (int p = 0; p < np; ++p) { a.nprog = 1; a.prog[0] = program[p]; void* args[] = {&a}; (void)hipLaunchKernel(kfn, dim3(grid), dim3(NTHREADS), args, LDS_BYTES, stream); }
#endif
}
```

```cpp
#include <hip/hip_runtime.h>
#include <hip/hip_cooperative_groups.h>
#include <cstdio>
#include <cstdint>
namespace cg = cooperative_groups;

#ifndef PHASE_PROGRAM
#define PHASE_PROGRAM {0, 1, 2, 3, 4, 5, 6, 7, 8, 9}
#endif
#ifndef MK_ONE_LAUNCH
#define MK_ONE_LAUNCH 1
#endif

#define LAS __attribute__((address_space(3)))
typedef unsigned short bf16_t;
typedef short bf16x8 __attribute__((ext_vector_type(8)));
typedef float f32x4 __attribute__((ext_vector_type(4)));
typedef unsigned u32x4 __attribute__((ext_vector_type(4)));
typedef unsigned u32x2 __attribute__((ext_vector_type(2)));
typedef float f32x16 __attribute__((ext_vector_type(16)));
typedef float f32x2_t __attribute__((ext_vector_type(2)));
typedef __bf16 bf16x2_t __attribute__((ext_vector_type(2)));
typedef int i32x4 __attribute__((ext_vector_type(4)));
typedef int i32x8 __attribute__((ext_vector_type(8)));

constexpr int D = 1024, BATCH = 16, SEQ = 2048, T = BATCH * SEQ;
constexpr int NZ = 3840;
constexpr int ZQ = 0, ZK = 512, ZV = 640, ZU = 768, ZVS = 1280, ZGA = 1792, ZGS = 2816;
constexpr int NE = 32, TOPK = 4, DE = 1024;
constexpr int KSPLIT = 16;
constexpr float EPS = 1e-6f;
constexpr int LISTCAP = T;
constexpr int APAD = T * TOPK + NE * 256;

constexpr size_t MiB = 1u << 20;
constexpr size_t WS_CTL = 0, CTL_BYTES = 1 * MiB;
constexpr size_t WS_MODP = 1 * MiB;
constexpr size_t WS_WIN = 8 * MiB;
constexpr size_t WS_WBA = 16 * MiB, WS_WBS = 17 * MiB;
constexpr size_t WS_WOUT = 18 * MiB;
constexpr size_t WS_SGW = 20 * MiB;
constexpr size_t WS_W1 = 24 * MiB;
constexpr size_t WS_W2 = 152 * MiB;
constexpr size_t WS_H2 = 216 * MiB;
constexpr size_t WS_Z = 280 * MiB;
constexpr size_t WS_YATT = 520 * MiB, WS_YSG = 552 * MiB;
constexpr size_t WS_H = 584 * MiB;
constexpr size_t WS_Y = 648 * MiB;
constexpr size_t WS_ACT = 280 * MiB;
constexpr size_t WS_YS = 552 * MiB;
constexpr size_t WS_LISTS = 824 * MiB;
constexpr size_t WS_TOKINFO = 828 * MiB;
constexpr size_t WS_X1 = 832 * MiB;
constexpr size_t WS_VT = 960 * MiB;
constexpr size_t WS_GVT = 968 * MiB;
constexpr size_t WS_END = 1000 * MiB;
constexpr int CW_CNT = 64;
constexpr int CW_BAR = 4096;

constexpr int RING_BYTES = 131072;
constexpr int MISC_OFF = RING_BYTES;
constexpr int LDS_BYTES = 147456;
constexpr int NWAVES = 8, NTHREADS = 512;

__device__ __forceinline__ float bf2f(unsigned h) { return __uint_as_float(h << 16); }
__device__ __forceinline__ unsigned f2bf(float f) { unsigned u = __float_as_uint(f); return (u + 0x7fffu + ((u >> 16) & 1u)) >> 16; }
__device__ __forceinline__ unsigned pk2(float lo, float hi) { return f2bf(lo) | (f2bf(hi) << 16); }
__device__ __forceinline__ void unpack8(const u32x4 r, float* o) {
    o[0] = __uint_as_float(r.x << 16); o[1] = __uint_as_float(r.x & 0xffff0000u);
    o[2] = __uint_as_float(r.y << 16); o[3] = __uint_as_float(r.y & 0xffff0000u);
    o[4] = __uint_as_float(r.z << 16); o[5] = __uint_as_float(r.z & 0xffff0000u);
    o[6] = __uint_as_float(r.w << 16); o[7] = __uint_as_float(r.w & 0xffff0000u);
}
__device__ __forceinline__ unsigned cvtpk(float lo, float hi) { const f32x2_t v = {lo, hi}; const bf16x2_t b = __builtin_convertvector(v, bf16x2_t); return __builtin_bit_cast(unsigned, b); }
constexpr float FP8_SW = 64.f, FP8_SH = 4.f, FP8_SA = 4.f;
__device__ __forceinline__ float fp8_clamp(float v) { return fminf(fmaxf(v, -448.f), 448.f); }
__device__ __forceinline__ unsigned cvt4_fp8(float a, float b, float c, float d, float sc) {
    unsigned w = 0; w = __builtin_amdgcn_cvt_pk_fp8_f32(fp8_clamp(a * sc), fp8_clamp(b * sc), w, false); w = __builtin_amdgcn_cvt_pk_fp8_f32(fp8_clamp(c * sc), fp8_clamp(d * sc), w, true); return w; }
#define MFMA32(a, b, c) __builtin_amdgcn_mfma_f32_32x32x16_bf16((a), (b), (c), 0, 0, 0)
__device__ __forceinline__ float wave_sum(float v) {
#pragma unroll
    for (int o = 1; o < 64; o <<= 1) v += __shfl_xor(v, o);
    return v;
}
__device__ __forceinline__ float sigmoidf_(float x) { return __builtin_amdgcn_rcpf(1.f + __expf(-x)); }
__device__ __forceinline__ float gelu_tanh(float x) { const float u = 0.7978845608028654f * (x + 0.044715f * x * x * x); return x * __builtin_amdgcn_rcpf(1.f + __expf(-2.f * u)); }

struct Frame { LAS unsigned char* lds; int tid, lane, wave, G; };

namespace pg8 {
constexpr int BM = 256, BK = 64, HALF = 128, HTB = HALF * BK * 2, STAGE_BYTES = 8 * HTB, NXCD = 8, WGM = 8;
__host__ __device__ __forceinline__ int lds_byte(int r, int c) { const int st = (r >> 4) * 2 + (c >> 5), rr = r & 15, cc = c & 31, ob = rr * 64 + cc * 2; return st * 1024 + (ob ^ (((ob >> 9) & 1) << 5)); }
__host__ __device__ __forceinline__ void stage_rc(int b, int& R, int& C) { const int st = b / 1024, sb = b % 1024, swz = sb ^ (((sb >> 9) & 1) << 5); R = (st >> 1) * 16 + swz / 64; C = (st & 1) * 32 + (swz % 64) / 2; }
__host__ __device__ __forceinline__ int perm32(int rho) { const int n = rho >> 4, i = rho & 15; return 8 * (i >> 2) + 4 * n + (i & 3); }
__device__ __forceinline__ unsigned cvt_pk_bf16(float lo, float hi) { unsigned r; asm volatile("v_cvt_pk_bf16_f32 %0, %1, %2" : "=v"(r) : "v"(lo), "v"(hi)); return r; }

struct Unit { const char* A; const char* B; const int* tl; int pm, pn, e, kind, rowbase, nvalid; };
__device__ __forceinline__ const char* uptr(const char* p) { const unsigned long long v = (unsigned long long)p;
    const unsigned lo = __builtin_amdgcn_readfirstlane((unsigned)v), hi = __builtin_amdgcn_readfirstlane((unsigned)(v >> 32)); return (const char*)(((unsigned long long)hi << 32) | lo); }

__device__ __forceinline__ void tile_map(int L, int nM, int nN, int& pm, int& pn) {
    const int nwg = nM * nN;
    int wgid = L; { const int q = nwg / NXCD, r = nwg % NXCD, xcd = wgid % NXCD, off = wgid / NXCD; wgid = (xcd < r ? xcd * (q + 1) : r * (q + 1) + (xcd - r) * q) + off; }
    const int nig = WGM * nN, gid = wgid / nig, fm = gid * WGM, gsz = (nM - fm) < WGM ? (nM - fm) : WGM;
    pm = fm + ((wgid % nig) % gsz); pn = (wgid % nig) / gsz;
}

template <class Epi, class Sched, bool GATHER, bool FP8 = false>
__device__ __forceinline__ void gemm_phase(LAS unsigned char* lds, const int tid, const int Kb, const Sched& S, const Epi& E) {
    const int wid = __builtin_amdgcn_readfirstlane(tid >> 6), lane = tid & 63, wr = wid >> 2, wc = wid & 3, fr = lane & 15, fq = lane >> 4;
    const int nt = Kb / 128;
    unsigned voffB[2]; unsigned oc[2][2], o2[2][2];
    LAS u32x4* onl = (LAS u32x4*)(lds + MISC_OFF + 2048) + tid;
    const size_t kstep = (size_t)(BK * 2);
    const size_t hstep = (size_t)HALF * Kb;
#pragma unroll
    for (int i = 0; i < 2; ++i) { int R, C; stage_rc(tid * 16 + i * 8192, R, C); const int Rb = (R & ~31) + perm32(R & 31);
        voffB[i] = (unsigned)(Rb * Kb) + (unsigned)C * 2u;
        oc[0][i] = (unsigned)(R * Kb) + (unsigned)C * 2u; oc[1][i] = oc[0][i] + (unsigned)hstep; o2[0][i] = oc[0][i]; o2[1][i] = oc[1][i]; }
    const unsigned ldsw = (unsigned)wid * 1024u;
    const int aoff = lds_byte(wr * 64 + fr, fq * 8), boff = lds_byte(wc * 32 + fr, fq * 8);
#define PG8_SA(b, h) (((b) * 2 + (h)) * HTB)
#define PG8_SB(b, h) ((4 + (b) * 2 + (h)) * HTB)
#define PG8_STAGE(bufoff, gbase, voff) do { const char* _g = uptr((const char*)(gbase)); _Pragma("unroll") for (int _i = 0; _i < 2; ++_i) { unsigned _o = (voff)[_i]; asm volatile("" : "+v"(_o)); \
        __builtin_amdgcn_global_load_lds((const unsigned*)(_g + _o), (LAS unsigned*)(lds + (bufoff) + ldsw + _i * 8192), 16, 0, 0); } } while (0)
#define PG8_STAGE_A(bufoff, gbase, h, O) do { const char* _g = uptr((const char*)(gbase) + (GATHER ? (size_t)0 : (size_t)(h) * hstep)); _Pragma("unroll") for (int _i = 0; _i < 2; ++_i) { unsigned _o = (O)[GATHER ? (h) : 0][_i]; asm volatile("" : "+v"(_o)); \
        __builtin_amdgcn_global_load_lds((const unsigned*)(_g + _o), (LAS unsigned*)(lds + (bufoff) + ldsw + _i * 8192), 16, 0, 0); } } while (0)
#define PG8_CAT2(x, y) __builtin_shufflevector(__builtin_bit_cast(i32x4, (x)), __builtin_bit_cast(i32x4, (y)), 0, 1, 2, 3, 4, 5, 6, 7)
#define PG8_RDA(b, h, m, k) (*(const LAS bf16x8*)(lds + PG8_SA(b, h) + aoff + (m) * 2048 + (k) * 1024))
#define PG8_RDB(b, h, n, k) (*(const LAS bf16x8*)(lds + PG8_SB(b, h) + boff + (n) * 2048 + (k) * 1024))
#define PG8_LDA(dst, b, h) do { _Pragma("unroll") for (int m = 0; m < 4; ++m) { \
        if constexpr (FP8) { dst##8[m] = PG8_CAT2(PG8_RDA(b, h, m, 0), PG8_RDA(b, h, m, 1)); } else { dst[m][0] = PG8_RDA(b, h, m, 0); dst[m][1] = PG8_RDA(b, h, m, 1); } } } while (0)
#define PG8_LDB(dst, b, h) do { _Pragma("unroll") for (int n = 0; n < 2; ++n) { \
        if constexpr (FP8) { dst##8[n] = PG8_CAT2(PG8_RDB(b, h, n, 0), PG8_RDB(b, h, n, 1)); } else { dst[n][0] = PG8_RDB(b, h, n, 0); dst[n][1] = PG8_RDB(b, h, n, 1); } } } while (0)
#define PG8_MMA(ai, bj, At, Bt) do { __builtin_amdgcn_s_setprio(1); \
        if constexpr (FP8) { _Pragma("unroll") for (int m = 0; m < 4; ++m) _Pragma("unroll") for (int n = 0; n < 2; ++n) \
            asm volatile("v_mfma_f32_16x16x128_f8f6f4 %0, %1, %2, %0" : "+v"(acc[ai][bj][m][n]) : "v"(Bt##8[n]), "v"(At##8[m])); } \
        else { _Pragma("unroll") for (int m = 0; m < 4; ++m) _Pragma("unroll") for (int n = 0; n < 2; ++n) _Pragma("unroll") for (int k = 0; k < 2; ++k) \
            acc[ai][bj][m][n] = __builtin_amdgcn_mfma_f32_16x16x32_bf16(Bt[n][k], At[m][k], acc[ai][bj][m][n], 0, 0, 0); } \
        __builtin_amdgcn_s_setprio(0); } while (0)
#define PG8_WAIT_V(n) asm volatile("s_waitcnt vmcnt(" #n ")" ::: "memory")
#define PG8_WAIT_L(n) asm volatile("s_waitcnt lgkmcnt(" #n ")" ::: "memory")
#define PG8_BAR __builtin_amdgcn_s_barrier()
#define PG8_SCHED __builtin_amdgcn_sched_barrier(0)
#define PG8_LOADOFFS(u, o) do { int _t = tid; asm volatile("" : "+v"(_t)); _Pragma("unroll") for (int _i = 0; _i < 2; ++_i) { int _R, _C; stage_rc(_t * 16 + _i * 8192, _R, _C); \
        _Pragma("unroll") for (int _h = 0; _h < 2; ++_h) { int _row = _h * HALF + _R; _row = _row < (u).nvalid ? _row : (u).nvalid - 1; const int _tok = (u).tl[_row]; o[_h][_i] = (unsigned)_tok * (unsigned)Kb + (unsigned)_C * 2u; } } } while (0)
#define PG8_KITER(LAST) do { \
            const char* a1 = cA + (size_t)(t + 1) * kstep; \
            const char* a2 = (LAST) ? nA : cA + (size_t)(t + 2) * kstep; const char* b2 = (LAST) ? nB : cB + (size_t)(t + 2) * kstep; \
            const char* a3 = a2 + kstep; const char* b3 = b2 + kstep; \
            PG8_LDB(B0, 0, 0); PG8_LDB(B1, 0, 1); PG8_SCHED; PG8_LDA(At, 0, 0); PG8_STAGE_A(PG8_SA(1, 1), a1, 1, oc); \
            if constexpr (GATHER && (LAST)) { const u32x4 _n = *onl; o2[0][0] = _n.x; o2[0][1] = _n.y; o2[1][0] = _n.z; o2[1][1] = _n.w; } \
            else { _Pragma("unroll") for (int _h = 0; _h < 2; ++_h) _Pragma("unroll") for (int _i = 0; _i < 2; ++_i) o2[_h][_i] = oc[_h][_i]; } \
            PG8_WAIT_V(8); PG8_WAIT_L(0); PG8_BAR; PG8_MMA(0, 0, At, B0); PG8_MMA(0, 1, At, B1); PG8_BAR; PG8_SCHED; \
            PG8_LDA(At, 0, 1); PG8_STAGE(PG8_SB(0, 0), b2, voffB); PG8_STAGE(PG8_SB(0, 1), b2 + hstep, voffB); PG8_STAGE_A(PG8_SA(0, 0), a2, 0, o2); \
            PG8_WAIT_V(8); PG8_WAIT_L(0); PG8_BAR; PG8_MMA(1, 0, At, B0); PG8_MMA(1, 1, At, B1); PG8_BAR; PG8_SCHED; \
            PG8_LDB(B0, 1, 0); PG8_LDB(B1, 1, 1); PG8_SCHED; PG8_LDA(At, 1, 0); PG8_STAGE_A(PG8_SA(0, 1), a2, 1, o2); \
            PG8_WAIT_V(8); PG8_WAIT_L(0); PG8_BAR; PG8_MMA(0, 0, At, B0); PG8_MMA(0, 1, At, B1); PG8_BAR; PG8_SCHED; \
            PG8_LDA(At, 1, 1); PG8_STAGE(PG8_SB(1, 0), b3, voffB); PG8_STAGE(PG8_SB(1, 1), b3 + hstep, voffB); PG8_STAGE_A(PG8_SA(1, 0), a3, 0, o2); \
            PG8_WAIT_V(8); PG8_WAIT_L(0); PG8_BAR; PG8_MMA(1, 0, At, B0); PG8_MMA(1, 1, At, B1); PG8_BAR; PG8_SCHED; \
        } while (0)
    Unit cur, nxt; int ui = 0;
    if (!S.next(0, cur)) return;
    f32x4 acc[2][2][4][2];
#pragma unroll
    for (int a = 0; a < 2; ++a)
#pragma unroll
        for (int b = 0; b < 2; ++b)
#pragma unroll
            for (int m = 0; m < 4; ++m)
#pragma unroll
                for (int n = 0; n < 2; ++n) acc[a][b][m][n] = (f32x4){0.f, 0.f, 0.f, 0.f};
    bf16x8 At[4][2], B0[2][2], B1[2][2]; i32x8 At8[4], B08[2], B18[2];
    const char* cA = cur.A; const char* cB = cur.B;
    if constexpr (GATHER) { PG8_LOADOFFS(cur, oc); }
    PG8_STAGE(PG8_SB(0, 0), cB, voffB); PG8_STAGE(PG8_SB(0, 1), cB + hstep, voffB); PG8_STAGE_A(PG8_SA(0, 0), cA, 0, oc); PG8_STAGE_A(PG8_SA(0, 1), cA, 1, oc);
    if (wr == 1) PG8_BAR;
    PG8_WAIT_V(2); PG8_BAR;
    PG8_STAGE(PG8_SB(1, 0), cB + kstep, voffB); PG8_STAGE_A(PG8_SA(1, 0), cA + kstep, 0, oc); PG8_STAGE(PG8_SB(1, 1), cB + hstep + kstep, voffB);
    PG8_WAIT_V(6); PG8_BAR;
    for (;;) {
        const bool has_next = S.next(ui + 1, nxt);
        const char* nA = has_next ? nxt.A : cA; const char* nB = has_next ? nxt.B : cB;
        if constexpr (GATHER) {
            unsigned onx[2][2];
            if (has_next) { PG8_LOADOFFS(nxt, onx); }
            else {
#pragma unroll
                for (int h = 0; h < 2; ++h)
#pragma unroll
                    for (int i = 0; i < 2; ++i) onx[h][i] = oc[h][i];
            }
            *onl = (u32x4){onx[0][0], onx[0][1], onx[1][0], onx[1][1]};
        }
        int t = 0;
#pragma nounroll
        for (; t < nt - 2; t += 2) PG8_KITER(false);
        PG8_KITER(true);
        if (wr == 0) PG8_BAR;
        if constexpr (FP8) asm volatile("s_nop 15\n\ts_nop 15" ::: "memory");
        int lane_e; asm volatile("v_mbcnt_lo_u32_b32 %0, -1, 0\n\tv_mbcnt_hi_u32_b32 %0, -1, %0" : "=v"(lane_e));
        const bool keep = E(acc, cur, wr, wc, lane_e & 15, lane_e >> 4);
        if (!has_next) break;
        if (!keep) {
#pragma unroll
            for (int a = 0; a < 2; ++a)
#pragma unroll
                for (int b = 0; b < 2; ++b)
#pragma unroll
                    for (int m = 0; m < 4; ++m)
#pragma unroll
                        for (int n = 0; n < 2; ++n) acc[a][b][m][n] = (f32x4){0.f, 0.f, 0.f, 0.f};
        }
        cur = nxt; cA = nA; cB = nB; ++ui;
        if constexpr (GATHER) {
#pragma unroll
            for (int h = 0; h < 2; ++h)
#pragma unroll
                for (int i = 0; i < 2; ++i) oc[h][i] = o2[h][i];
        }
        if (wr == 1) PG8_BAR;
    }
    PG8_WAIT_V(0);
    PG8_BAR;
#undef PG8_SA
#undef PG8_SB
#undef PG8_STAGE
#undef PG8_STAGE_A
#undef PG8_LDA
#undef PG8_LDB
#undef PG8_MMA
#undef PG8_CAT2
#undef PG8_RDA
#undef PG8_RDB
#undef PG8_WAIT_V
#undef PG8_WAIT_L
#undef PG8_BAR
#undef PG8_SCHED
#undef PG8_LOADOFFS
#undef PG8_KITER
}

struct SchedDense {
    const char* A; const char* B; int nM, nN, G, c; size_t tstep;
    __device__ __forceinline__ bool next(int i, Unit& u) const {
        const long L = (long)i * G + c; if (L >= (long)nM * nN) return false;
        tile_map((int)L, nM, nN, u.pm, u.pn); u.A = A + (size_t)u.pm * tstep; u.B = B + (size_t)u.pn * tstep;
        u.tl = nullptr; u.e = 0; u.kind = 0; u.rowbase = u.pm * BM; u.nvalid = BM; return true; }
};
struct SchedBranch {
    const char* A0; const char* B0; const char* A1; const char* B1; int nM, nN, G, c; size_t tstep;
    __device__ __forceinline__ bool next(int i, Unit& u) const {
        const long L = (long)(i >> 1) * G + c; if (L >= (long)nM * nN) return false;
        tile_map((int)L, nM, nN, u.pm, u.pn); u.kind = i & 1;
        u.A = (u.kind ? A1 : A0) + (size_t)u.pm * tstep; u.B = (u.kind ? B1 : B0) + (size_t)u.pn * tstep;
        u.tl = nullptr; u.e = 0; u.rowbase = u.pm * BM; u.nvalid = BM; return true; }
};
struct SchedMoE {
    const LAS int* tab;
    const char* A; const char* B; size_t bexp; const int* lists; int NT, G, c; size_t tstep; bool gather;
    __device__ __forceinline__ bool next(int i, Unit& u) const {
        const int nwg = __builtin_amdgcn_readfirstlane(tab[32]);
        const long L = (long)i * G + c; if (L >= nwg) return false;
        int wgid = (int)L; { const int q = nwg / NXCD, r = nwg % NXCD, xcd = wgid % NXCD, off = wgid / NXCD; wgid = (xcd < r ? xcd * (q + 1) : r * (q + 1) + (xcd - r) * q) + off; }
        const int ln = (int)__builtin_amdgcn_mbcnt_hi(~0u, __builtin_amdgcn_mbcnt_lo(~0u, 0u)), le = ln < 32 ? ln : 31;
        const int ulo = tab[le], uhi = tab[le + 1];
        const unsigned long long mm = __ballot(ln < 32 && ulo <= wgid && wgid < uhi);
        const int e = __builtin_amdgcn_readfirstlane((int)__builtin_ctzll(mm | (1ull << 31)));
        const int local = wgid - __builtin_amdgcn_readfirstlane(tab[e]); u.e = e; u.pm = local / NT; u.pn = local % NT; u.kind = 0;
        u.rowbase = __builtin_amdgcn_readfirstlane(tab[64 + e]) + u.pm * BM; int nv = __builtin_amdgcn_readfirstlane(tab[128 + e]) - u.pm * BM; u.nvalid = nv > BM ? BM : nv;
        u.B = B + (size_t)e * bexp + (size_t)u.pn * tstep;
        if (gather) { u.A = A; u.tl = lists + (size_t)e * LISTCAP + u.pm * BM; }
        else { u.A = A + (size_t)u.rowbase * (tstep / BM); u.tl = nullptr; }
        return true; }
};

#define EPI_FOR_ROWS  _Pragma("unroll") for (int ai = 0; ai < 2; ++ai) _Pragma("unroll") for (int m = 0; m < 4; ++m)
struct EpiInProj {
    bf16_t* Z; const float* bias; bf16_t* VT; bf16_t* GVT;
    __device__ __forceinline__ bool operator()(f32x4 (&acc)[2][2][4][2], const Unit& u, int wr, int wc, int fr, int fq) const {
        const int pn = u.pn, act = pn < 2 ? 0 : (pn == 2 ? 1 : (pn < 7 ? 2 : 3));
        const int col0 = pn * BM + wc * 32 + 8 * fq;
        f32x4 bv[2][2];
#pragma unroll
        for (int bj = 0; bj < 2; ++bj)
#pragma unroll
            for (int n = 0; n < 2; ++n) bv[bj][n] = *(const f32x4*)(bias + col0 + bj * HALF + 4 * n);
        EPI_FOR_ROWS { const int row = u.rowbase + ai * HALF + wr * 64 + m * 16 + fr; bf16_t* rowp = Z + (size_t)row * NZ + col0;
#pragma unroll
            for (int bj = 0; bj < 2; ++bj) { f32x4 v0 = acc[ai][bj][m][0] + bv[bj][0], v1 = acc[ai][bj][m][1] + bv[bj][1];
                if (act == 0) { v0 = v0 * 0.125f; v1 = v1 * 0.125f; }
                else if (act == 2) {
#pragma unroll
                    for (int i = 0; i < 4; ++i) { v0[i] = gelu_tanh(v0[i]); v1[i] = gelu_tanh(v1[i]); } }
                else if (act == 3) {
#pragma unroll
                    for (int i = 0; i < 4; ++i) { v0[i] = sigmoidf_(v0[i]); v1[i] = sigmoidf_(v1[i]); } }
                u32x4 w; w.x = cvt_pk_bf16(v0[0], v0[1]); w.y = cvt_pk_bf16(v0[2], v0[3]); w.z = cvt_pk_bf16(v1[0], v1[1]); w.w = cvt_pk_bf16(v1[2], v1[3]);
                *(u32x4*)(rowp + bj * HALF) = w;
                if ((pn == 2 && bj == 1) || pn == 5 || pn == 6) {
                    const int bt = row >> 11, sq = row & (SEQ - 1);
                    bf16_t* tp = (pn == 2) ? VT + ((size_t)(bt * 128 + wc * 32 + 8 * fq)) * SEQ + sq : GVT + ((size_t)(bt * 512 + (pn - 5) * 256 + bj * HALF + wc * 32 + 8 * fq)) * SEQ + sq;
                    tp[0 * SEQ] = (bf16_t)(w.x & 0xffffu); tp[1 * SEQ] = (bf16_t)(w.x >> 16); tp[2 * SEQ] = (bf16_t)(w.y & 0xffffu); tp[3 * SEQ] = (bf16_t)(w.y >> 16);
                    tp[4 * SEQ] = (bf16_t)(w.z & 0xffffu); tp[5 * SEQ] = (bf16_t)(w.z >> 16); tp[6 * SEQ] = (bf16_t)(w.w & 0xffffu); tp[7 * SEQ] = (bf16_t)(w.w >> 16); } } }
        return false;
    }
};
struct EpiBranch {
    const bf16_t* Z; bf16_t* O;
    __device__ __forceinline__ bool operator()(f32x4 (&acc)[2][2][4][2], const Unit& u, int wr, int wc, int fr, int fq) const {
        const int col0 = u.pn * BM + wc * 32 + 8 * fq;
        if (u.kind == 0) {
            EPI_FOR_ROWS { const int row = u.rowbase + ai * HALF + wr * 64 + m * 16 + fr; const bf16_t* zr = Z + (size_t)row * NZ + col0;
#pragma unroll
                for (int bj = 0; bj < 2; ++bj) { float ga[8], gs[8]; unpack8(*(const u32x4*)(zr + ZGA + bj * HALF), ga); unpack8(*(const u32x4*)(zr + ZGS + bj * HALF), gs);
#pragma unroll
                    for (int i = 0; i < 4; ++i) { acc[ai][bj][m][0][i] *= ga[i] / gs[i]; acc[ai][bj][m][1][i] *= ga[4 + i] / gs[4 + i]; } } }
            return true;
        }
        EPI_FOR_ROWS { const int row = u.rowbase + ai * HALF + wr * 64 + m * 16 + fr; const bf16_t* zr = Z + (size_t)row * NZ + col0; bf16_t* op = O + (size_t)row * D + col0;
#pragma unroll
            for (int bj = 0; bj < 2; ++bj) { float gs[8]; unpack8(*(const u32x4*)(zr + ZGS + bj * HALF), gs);
                const f32x4 v0 = acc[ai][bj][m][0], v1 = acc[ai][bj][m][1];
                u32x4 w; w.x = cvt_pk_bf16(v0[0] * gs[0], v0[1] * gs[1]); w.y = cvt_pk_bf16(v0[2] * gs[2], v0[3] * gs[3]); w.z = cvt_pk_bf16(v1[0] * gs[4], v1[1] * gs[5]); w.w = cvt_pk_bf16(v1[2] * gs[6], v1[3] * gs[7]);
                *(u32x4*)(op + bj * HALF) = w; } }
        return false;
    }
};
struct EpiBiasBf16 {
    bf16_t* O; int ldo; const float* bias; int bstride; float sc;
    __device__ __forceinline__ bool operator()(f32x4 (&acc)[2][2][4][2], const Unit& u, int wr, int wc, int fr, int fq) const {
        const int col0 = u.pn * BM + wc * 32 + 8 * fq; const float* bp = bias + (size_t)u.e * bstride + col0;
        f32x4 bv[2][2];
#pragma unroll
        for (int bj = 0; bj < 2; ++bj)
#pragma unroll
            for (int n = 0; n < 2; ++n) bv[bj][n] = *(const f32x4*)(bp + bj * HALF + 4 * n);
        EPI_FOR_ROWS { const int row = u.rowbase + ai * HALF + wr * 64 + m * 16 + fr; bf16_t* op = O + (size_t)row * ldo + col0;
#pragma unroll
            for (int bj = 0; bj < 2; ++bj) { const f32x4 v0 = acc[ai][bj][m][0] * sc + bv[bj][0], v1 = acc[ai][bj][m][1] * sc + bv[bj][1];
                u32x4 w; w.x = cvt_pk_bf16(v0[0], v0[1]); w.y = cvt_pk_bf16(v0[2], v0[3]); w.z = cvt_pk_bf16(v1[0], v1[1]); w.w = cvt_pk_bf16(v1[2], v1[3]);
                *(u32x4*)(op + bj * HALF) = w; } }
        return false;
    }
};
struct EpiSwiGLU {
    unsigned char* O; const float* b1;
    __device__ __forceinline__ bool operator()(f32x4 (&acc)[2][2][4][2], const Unit& u, int wr, int wc, int fr, int fq) const {
        const int cl = wc * 32 + 8 * fq, colo = u.pn * HALF + cl; const float* bp = b1 + (size_t)u.e * (2 * DE) + colo;
        const float isc = 1.f / (FP8_SH * FP8_SW);
        f32x4 bg[2], bl[2];
#pragma unroll
        for (int n = 0; n < 2; ++n) { bg[n] = *(const f32x4*)(bp + 4 * n); bl[n] = *(const f32x4*)(bp + DE + 4 * n); }
        EPI_FOR_ROWS { const int row = u.rowbase + ai * HALF + wr * 64 + m * 16 + fr; float r[8];
#pragma unroll
            for (int n = 0; n < 2; ++n) { const f32x4 g4 = acc[ai][0][m][n] * isc + bg[n], l4 = acc[ai][1][m][n] * isc + bl[n];
#pragma unroll
                for (int i = 0; i < 4; ++i) { const float g = fminf(g4[i], 7.f), l = fminf(fmaxf(l4[i], -7.f), 7.f); r[4 * n + i] = g * sigmoidf_(1.702f * g) * (l + 1.f); } }
            u32x2 w; w.x = cvt4_fp8(r[0], r[1], r[2], r[3], FP8_SA); w.y = cvt4_fp8(r[4], r[5], r[6], r[7], FP8_SA);
            *(u32x2*)(O + (size_t)row * DE + colo) = w; }
        return false;
    }
};
}

__device__ __forceinline__ void p0_transpose_item(const float* W, int K, int N, bf16_t* WT, int k0, int n0, int drow0, LAS float* scr, int lane) {
#pragma unroll 8
    for (int i = 0; i < 32; ++i) { const int kk = 2 * i + (lane >> 5); scr[kk * 33 + (lane & 31)] = W[(size_t)(k0 + kk) * N + n0 + (lane & 31)]; }
    asm volatile("s_waitcnt lgkmcnt(0)" ::: "memory");
    const int c = lane & 7;
#pragma unroll
    for (int j = 0; j < 4; ++j) { const int n = (lane >> 3) + 8 * j; const LAS float* s = scr + (8 * c) * 33 + n;
        u32x4 o; o.x = pk2(s[0 * 33], s[1 * 33]); o.y = pk2(s[2 * 33], s[3 * 33]); o.z = pk2(s[4 * 33], s[5 * 33]); o.w = pk2(s[6 * 33], s[7 * 33]);
        *(u32x4*)(WT + (size_t)(drow0 + n) * K + k0 + 8 * c) = o; }
    asm volatile("s_waitcnt lgkmcnt(0)" ::: "memory");
}
__device__ __forceinline__ void p0_transpose_item_fp8(const float* W, int K, int N, unsigned char* WT, int k0, int n0, int drow0, LAS float* scr, int lane, float sc) {
#pragma unroll 8
    for (int i = 0; i < 32; ++i) { const int kk = 2 * i + (lane >> 5); scr[kk * 33 + (lane & 31)] = W[(size_t)(k0 + kk) * N + n0 + (lane & 31)]; }
    asm volatile("s_waitcnt lgkmcnt(0)" ::: "memory");
    const int c = lane & 7;
#pragma unroll
    for (int j = 0; j < 4; ++j) { const int n = (lane >> 3) + 8 * j; const LAS float* s = scr + (8 * c) * 33 + n;
        u32x2 o; o.x = cvt4_fp8(s[0 * 33], s[1 * 33], s[2 * 33], s[3 * 33], sc); o.y = cvt4_fp8(s[4 * 33], s[5 * 33], s[6 * 33], s[7 * 33], sc);
        *(u32x2*)(WT + (size_t)(drow0 + n) * K + k0 + 8 * c) = o; }
    asm volatile("s_waitcnt lgkmcnt(0)" ::: "memory");
}
template <bool FP8W>
__device__ __forceinline__ void transpose_matrix(Frame& F, const float* W, int K, int N, void* WT, int& itbase, int gw, int NGW, bool w1map) {
    LAS float* scr = (LAS float*)(F.lds + F.wave * 16384);
    const int nblk = N / 32, nitems = (K / 64) * nblk;
    int first = (gw - (itbase % NGW) + NGW) % NGW;
    for (int it = first; it < nitems; it += NGW) {
        const int kb = it / nblk, nb = it % nblk, n0 = nb * 32;
        int drow0 = n0;
        if (w1map) drow0 = (n0 < DE) ? ((n0 >> 7) * 256 + (n0 & 127)) : (((n0 - DE) >> 7) * 256 + 128 + ((n0 - DE) & 127));
        if constexpr (FP8W) p0_transpose_item_fp8(W, K, N, (unsigned char*)WT, kb * 64, n0, drow0, scr, F.lane, FP8_SW);
        else p0_transpose_item(W, K, N, (bf16_t*)WT, kb * 64, n0, drow0, scr, F.lane);
    }
    itbase += nitems;
}

struct Args { const float* in[25]; float* out; unsigned char* ws; unsigned long long prog[3]; int nprog, pad; };
typedef const __attribute__((address_space(4))) Args* ArgsP;

__device__ __forceinline__ void phase0(Frame& F, ArgsP a) {
    unsigned char* ws = a->ws;
    {
        const float* c_in = a->in[1]; const float* w_mod = a->in[2]; float* modp = (float*)(ws + WS_MODP);
        LAS float* cact = (LAS float*)F.lds;
        for (int it = blockIdx.x; it < KSPLIT * 12; it += F.G) {
            const int ks = it / 12, nc = it % 12, n = nc * 512 + F.tid, k0 = ks * 64;
            for (int idx = F.tid; idx < 1024; idx += NTHREADS) { const int b = idx & 15, kk = idx >> 4; const float cv = c_in[b * D + k0 + kk]; cact[kk * 16 + b] = cv * sigmoidf_(cv); }
            __syncthreads();
            float acc[16];
#pragma unroll
            for (int b = 0; b < 16; ++b) acc[b] = 0.f;
#pragma unroll 8
            for (int kk = 0; kk < 64; ++kk) { const float w = w_mod[(size_t)(k0 + kk) * 6144 + n];
#pragma unroll
                for (int b4 = 0; b4 < 4; ++b4) { const f32x4 cv = *(const LAS f32x4*)(cact + kk * 16 + 4 * b4);
                    acc[4 * b4 + 0] += cv[0] * w; acc[4 * b4 + 1] += cv[1] * w; acc[4 * b4 + 2] += cv[2] * w; acc[4 * b4 + 3] += cv[3] * w; } }
#pragma unroll
            for (int b = 0; b < 16; ++b) modp[((size_t)ks * 16 + b) * 6144 + n] = acc[b];
            __syncthreads();
        }
    }
    { const float* sg_w = a->in[11]; bf16_t* SGW = (bf16_t*)(ws + WS_SGW);
      for (int idx = blockIdx.x * NTHREADS + F.tid; idx < 8 * 128 * 128 / 2; idx += F.G * NTHREADS) { const int e0 = 2 * idx, t = (e0 >> 7) & 127, sc = e0 & 127;
          const float w0 = sc <= t ? sg_w[e0] : 0.f, w1 = sc + 1 <= t ? sg_w[e0 + 1] : 0.f; ((unsigned*)SGW)[idx] = pk2(w0, w1); } }
    const int gw = blockIdx.x * NWAVES + F.wave, NGW = F.G * NWAVES;
    int itbase = 0;
    transpose_matrix<false>(F, a->in[6], D, NZ, (bf16_t*)(ws + WS_WIN), itbase, gw, NGW, false);
    transpose_matrix<false>(F, a->in[13], 512, D, (bf16_t*)(ws + WS_WBA), itbase, gw, NGW, false);
    transpose_matrix<false>(F, a->in[14], 512, D, (bf16_t*)(ws + WS_WBS), itbase, gw, NGW, false);
    transpose_matrix<false>(F, a->in[15], D, D, (bf16_t*)(ws + WS_WOUT), itbase, gw, NGW, false);
    for (int e = 0; e < NE; ++e) transpose_matrix<true>(F, a->in[21] + (size_t)e * D * 2 * DE, D, 2 * DE, (unsigned char*)(ws + WS_W1) + (size_t)e * 2 * DE * D, itbase, gw, NGW, true);
    for (int e = 0; e < NE; ++e) transpose_matrix<true>(F, a->in[23] + (size_t)e * DE * D, DE, D, (unsigned char*)(ws + WS_W2) + (size_t)e * D * DE, itbase, gw, NGW, false);
}

__device__ __forceinline__ void load_mod(Frame& F, ArgsP a, int b, int col0, int n, LAS float* dst) {
    const float* modp = (const float*)(a->ws + WS_MODP); const float* b_mod = a->in[3];
    for (int idx = F.tid; idx < n; idx += NTHREADS) { const int col = col0 + idx; float s = b_mod[col];
#pragma unroll
        for (int ks = 0; ks < KSPLIT; ++ks) s += modp[((size_t)ks * 16 + b) * 6144 + col];
        dst[idx] = s; }
}

__device__ __forceinline__ void phase0b(Frame& F, ArgsP a) {
    const float* x = a->in[0]; const float* g = a->in[4]; bf16_t* H = (bf16_t*)(a->ws + WS_H);
    LAS float* mv = (LAS float*)F.lds;
    for (int chunk = blockIdx.x; chunk < T / 128; chunk += F.G) {
        const int b = chunk / 16;
        load_mod(F, a, b, 0, 2048, mv);
        __syncthreads();
        for (int tt = 0; tt < 16; ++tt) {
            const int row = chunk * 128 + F.wave * 16 + tt;
            const f32x4* xr = (const f32x4*)(x + (size_t)row * D) + F.lane;
            f32x4 v[4]; float ss = 0.f;
#pragma unroll
            for (int j = 0; j < 4; ++j) { v[j] = xr[64 * j]; ss += (v[j][0] * v[j][0] + v[j][1] * v[j][1]) + (v[j][2] * v[j][2] + v[j][3] * v[j][3]); }
            const float rstd = rsqrtf(wave_sum(ss) * (1.f / D) + EPS);
            u32x2* o8 = (u32x2*)(H + (size_t)row * D) + F.lane;
#pragma unroll
            for (int j = 0; j < 4; ++j) { const int col = 4 * F.lane + 256 * j; const f32x4 gg = *(const f32x4*)(g + col); float r[4];
#pragma unroll
                for (int i = 0; i < 4; ++i) r[i] = v[j][i] * rstd * gg[i] * (1.f + mv[1024 + col + i]) + mv[col + i];
                u32x2 w; w.x = pk2(r[0], r[1]); w.y = pk2(r[2], r[3]); o8[64 * j] = w; }
        }
        __syncthreads();
    }
}

__device__ __forceinline__ void attn_item(Frame& F, ArgsP a, int item) {
    const int hq = item & 7, n = (item >> 3) & 15, b = item >> 7, kvh = hq >> 2;
    const bf16_t* Z = (const bf16_t*)(a->ws + WS_Z); bf16_t* YA = (bf16_t*)(a->ws + WS_YATT);
    LAS bf16_t* Ks = (LAS bf16_t*)F.lds;
    LAS bf16_t* Vs = Ks + 256 * 72;
    const int tok0 = b * SEQ + n * 128;
    for (int c = F.tid; c < 2048; c += NTHREADS) { const int kj = c >> 3, ch = c & 7; const int tk = tok0 - 128 + kj;
        u32x4 kv = (u32x4){0u, 0u, 0u, 0u}, vv = kv;
        if (n > 0 || kj >= 128) { const bf16_t* zr = Z + (size_t)tk * NZ + kvh * 64 + ch * 8; kv = *(const u32x4*)(zr + ZK); vv = *(const u32x4*)(zr + ZV); }
        *(LAS u32x4*)(Ks + kj * 72 + ch * 8) = kv; *(LAS u32x4*)(Vs + kj * 72 + ch * 8) = vv; }
    __syncthreads();
    const int qi = F.tid >> 2, j4 = F.tid & 3;
    float q[64];
    { const bf16_t* qr = Z + (size_t)(tok0 + qi) * NZ + ZQ + hq * 64;
#pragma unroll
      for (int c = 0; c < 8; ++c) unpack8(*(const u32x4*)(qr + c * 8), q + c * 8); }
    const float slope = exp2f(-(float)(hq + 1)), sink = a->in[8][hq];
    float s[32]; float mx = -1e30f;
#pragma unroll
    for (int i = 0; i < 32; ++i) { const int kj = qi + 1 + j4 + 4 * i; const LAS bf16_t* kr = Ks + kj * 72; float dot = 0.f;
#pragma unroll
        for (int c = 0; c < 8; ++c) { float kf[8]; unpack8(*(const LAS u32x4*)(kr + c * 8), kf);
#pragma unroll
            for (int d = 0; d < 8; ++d) dot += q[c * 8 + d] * kf[d]; }
        const float dist = (float)(127 - j4 - 4 * i); const bool valid = (n > 0) || (kj >= 128);
        s[i] = valid ? (dot - slope * dist) : -1e30f; mx = fmaxf(mx, s[i]); }
    mx = fmaxf(mx, __shfl_xor(mx, 1)); mx = fmaxf(mx, __shfl_xor(mx, 2)); mx = fmaxf(mx, sink);
    float l = 0.f;
#pragma unroll
    for (int i = 0; i < 32; ++i) { const float p = __expf(s[i] - mx); s[i] = p; l += p; }
    l += __shfl_xor(l, 1); l += __shfl_xor(l, 2); l += __expf(sink - mx);
    float o[64];
#pragma unroll
    for (int d = 0; d < 64; ++d) o[d] = 0.f;
#pragma unroll 4
    for (int i = 0; i < 32; ++i) { const int kj = qi + 1 + j4 + 4 * i; const LAS bf16_t* vr = Vs + kj * 72; const float p = s[i];
#pragma unroll
        for (int c = 0; c < 8; ++c) { float vf[8]; unpack8(*(const LAS u32x4*)(vr + c * 8), vf);
#pragma unroll
            for (int d = 0; d < 8; ++d) o[c * 8 + d] += p * vf[d]; } }
    const float inv = 1.f / l;
#pragma unroll
    for (int d = 0; d < 64; ++d) { float v = o[d]; v += __shfl_xor(v, 1); v += __shfl_xor(v, 2); o[d] = v * inv; }
    bf16_t* yr = YA + (size_t)(tok0 + qi) * 512 + hq * 64;
#pragma unroll
    for (int jj = 0; jj < 4; ++jj) if (j4 == jj) {
        u32x4 w0, w1; w0.x = pk2(o[16 * jj + 0], o[16 * jj + 1]); w0.y = pk2(o[16 * jj + 2], o[16 * jj + 3]); w0.z = pk2(o[16 * jj + 4], o[16 * jj + 5]); w0.w = pk2(o[16 * jj + 6], o[16 * jj + 7]);
        w1.x = pk2(o[16 * jj + 8], o[16 * jj + 9]); w1.y = pk2(o[16 * jj + 10], o[16 * jj + 11]); w1.z = pk2(o[16 * jj + 12], o[16 * jj + 13]); w1.w = pk2(o[16 * jj + 14], o[16 * jj + 15]);
        *(u32x4*)(yr + 16 * jj) = w0; *(u32x4*)(yr + 16 * jj + 8) = w1; }
    __syncthreads();
}

__device__ __forceinline__ void gmlp_item(Frame& F, ArgsP a, int item) {
    const int b = item >> 4, chunk = item & 15;
    const bf16_t* Z = (const bf16_t*)(a->ws + WS_Z); bf16_t* YS = (bf16_t*)(a->ws + WS_YSG);
    const float* ln_g = a->in[9]; const float* ln_b = a->in[10]; const float* sg_w = a->in[11]; const float* sg_b = a->in[12];
    LAS float* Wl = (LAS float*)F.lds;
    LAS float* Vn = Wl + 128 * 129;
    LAS float* st = Vn + 128 * 64;
    const int tok0 = b * SEQ + chunk * 128;
    for (int tt = 0; tt < 16; ++tt) { const int t = F.wave * 16 + tt; float v[8]; unpack8(*(const u32x4*)(Z + (size_t)(tok0 + t) * NZ + ZVS + F.lane * 8), v);
        float s1 = 0.f;
#pragma unroll
        for (int i = 0; i < 8; ++i) s1 += v[i];
        const float mean = wave_sum(s1) * (1.f / 512.f); float s2 = 0.f;
#pragma unroll
        for (int i = 0; i < 8; ++i) { const float d = v[i] - mean; s2 += d * d; }
        const float rstd = rsqrtf(wave_sum(s2) * (1.f / 512.f) + EPS);
        if (F.lane == 0) { st[2 * t] = mean; st[2 * t + 1] = rstd; } }
    __syncthreads();
    for (int g = 0; g < 8; ++g) {
        for (int idx = F.tid; idx < 16384; idx += NTHREADS) { const int t = idx >> 7, s = idx & 127; Wl[t * 129 + s] = (s <= t) ? sg_w[(size_t)g * 16384 + idx] : 0.f; }
        for (int idx = F.tid; idx < 8192; idx += NTHREADS) { const int s = idx >> 6, d = idx & 63; const float gv = bf2f(Z[(size_t)(tok0 + s) * NZ + ZVS + g * 64 + d]);
            Vn[idx] = (gv - st[2 * s]) * st[2 * s + 1] * ln_g[g * 64 + d] + ln_b[g * 64 + d]; }
        __syncthreads();
        const int t = F.tid >> 2, dq = F.tid & 3;
        float acc[16];
#pragma unroll
        for (int i = 0; i < 16; ++i) acc[i] = 0.f;
        for (int s = 0; s <= t; ++s) { const float w = Wl[t * 129 + s]; const LAS f32x4* vp = (const LAS f32x4*)(Vn + s * 64 + dq * 16);
#pragma unroll
            for (int c = 0; c < 4; ++c) { const f32x4 vv = vp[c]; acc[4 * c] += w * vv[0]; acc[4 * c + 1] += w * vv[1]; acc[4 * c + 2] += w * vv[2]; acc[4 * c + 3] += w * vv[3]; } }
        const float bias = sg_b[g * 128 + t];
        const bf16_t* ur = Z + (size_t)(tok0 + t) * NZ + ZU + g * 64 + dq * 16; float gu[16]; unpack8(*(const u32x4*)ur, gu); unpack8(*(const u32x4*)(ur + 8), gu + 8);
        float r[16];
#pragma unroll
        for (int i = 0; i < 16; ++i) r[i] = gu[i] * (acc[i] + bias);
        bf16_t* yr = YS + (size_t)(tok0 + t) * 512 + g * 64 + dq * 16;
        u32x4 w0, w1; w0.x = pk2(r[0], r[1]); w0.y = pk2(r[2], r[3]); w0.z = pk2(r[4], r[5]); w0.w = pk2(r[6], r[7]); w1.x = pk2(r[8], r[9]); w1.y = pk2(r[10], r[11]); w1.z = pk2(r[12], r[13]); w1.w = pk2(r[14], r[15]);
        *(u32x4*)yr = w0; *(u32x4*)(yr + 8) = w1;
        __syncthreads();
    }
}


__device__ __forceinline__ void attn_item_mfma(Frame& F, ArgsP a, int item) {
    const int kvh = item & 1, n = (item >> 1) & 15, b = item >> 5;
    const bf16_t* Z = (const bf16_t*)(a->ws + WS_Z); const bf16_t* VT = (const bf16_t*)(a->ws + WS_VT); bf16_t* YA = (bf16_t*)(a->ws + WS_YATT);
    LAS bf16_t* Ks = (LAS bf16_t*)F.lds;
    LAS bf16_t* Vs = Ks + 256 * 72;
    const int tok0 = b * SEQ + n * 128;
    for (int c = F.tid; c < 2048; c += NTHREADS) { const int kj = c >> 3, ch = c & 7; u32x4 kv = (u32x4){0u, 0u, 0u, 0u};
        if (n > 0 || kj >= 128) kv = *(const u32x4*)(Z + (size_t)(tok0 - 128 + kj) * NZ + ZK + kvh * 64 + ch * 8);
        *(LAS u32x4*)(Ks + kj * 72 + ch * 8) = kv; }
    for (int c = F.tid; c < 2048; c += NTHREADS) { const int d = c >> 5, ch = c & 31; u32x4 vv = (u32x4){0u, 0u, 0u, 0u};
        if (n > 0 || ch >= 16) vv = *(const u32x4*)(VT + (size_t)(b * 128 + kvh * 64 + d) * SEQ + (n - 1) * 128 + ch * 8);
        *(LAS u32x4*)(Vs + d * 264 + ch * 8) = vv; }
    __syncthreads();
    const int r = F.lane & 31, h = F.lane >> 5;
    const int pr = (r & ~12) | ((r & 4) << 1) | ((r & 8) >> 1);
#pragma unroll 1
    for (int j = 0; j < 2; ++j) {
        const int tk = F.wave * 2 + j, g = tk >> 2, qs = tk & 3, hq = kvh * 4 + g;
        const int qi = 32 * qs + r;
        const bf16_t* qp = Z + (size_t)(tok0 + qi) * NZ + ZQ + hq * 64 + 8 * h;
        bf16x8 qf[4];
#pragma unroll
        for (int ks = 0; ks < 4; ++ks) qf[ks] = *(const bf16x8*)(qp + 16 * ks);
        const float slope = exp2f(-(float)(hq + 1)), sink = a->in[8][hq];
        float mrun = sink, lsum = 0.f;
        f32x16 O[2];
#pragma unroll
        for (int dt = 0; dt < 2; ++dt)
#pragma unroll
            for (int i = 0; i < 16; ++i) O[dt][i] = 0.f;
#pragma unroll
        for (int tt = 0; tt < 5; ++tt) {
            f32x16 S;
#pragma unroll
            for (int i = 0; i < 16; ++i) S[i] = 0.f;
            const LAS bf16_t* kp = Ks + (32 * (qs + tt) + pr) * 72 + 8 * h;
#pragma unroll
            for (int ks = 0; ks < 4; ++ks) { const bf16x8 kf = *(const LAS bf16x8*)(kp + 16 * ks); S = MFMA32(kf, qf[ks], S); }
            float tmax = -1e30f;
#pragma unroll
            for (int i = 0; i < 16; ++i) { const int kj = 32 * (qs + tt) + (i & 3) + 4 * ((i >> 2) & 1) + 8 * h + 16 * (i >> 3); const int dist = qi + 128 - kj;
                const bool valid = (dist >= 0) && (dist < 128) && (n > 0 || kj >= 128);
                const float v = valid ? (S[i] - slope * (float)dist) : -1e30f; S[i] = v; tmax = fmaxf(tmax, v); }
            tmax = fmaxf(tmax, __shfl_xor(tmax, 32));
            const float mnew = fmaxf(mrun, tmax), alpha = __expf(mrun - mnew); mrun = mnew;
            float ps = 0.f;
#pragma unroll
            for (int i = 0; i < 16; ++i) { const float p = __expf(S[i] - mnew); S[i] = p; ps += p; }
            lsum = lsum * alpha + ps;
#pragma unroll
            for (int dt = 0; dt < 2; ++dt)
#pragma unroll
                for (int i = 0; i < 16; ++i) O[dt][i] *= alpha;
#pragma unroll
            for (int sx = 0; sx < 2; ++sx) {
                u32x4 pw; pw.x = cvtpk(S[8 * sx + 0], S[8 * sx + 1]); pw.y = cvtpk(S[8 * sx + 2], S[8 * sx + 3]); pw.z = cvtpk(S[8 * sx + 4], S[8 * sx + 5]); pw.w = cvtpk(S[8 * sx + 6], S[8 * sx + 7]);
                const bf16x8 pb = __builtin_bit_cast(bf16x8, pw);
#pragma unroll
                for (int dt = 0; dt < 2; ++dt) { const bf16x8 vf = *(const LAS bf16x8*)(Vs + (32 * dt + r) * 264 + 32 * (qs + tt) + 16 * sx + 8 * h); O[dt] = MFMA32(vf, pb, O[dt]); }
            }
        }
        const float l = lsum + __shfl_xor(lsum, 32) + __expf(sink - mrun);
        const float inv = 1.f / l;
        bf16_t* yp = YA + (size_t)(tok0 + qi) * 512 + hq * 64;
#pragma unroll
        for (int dt = 0; dt < 2; ++dt)
#pragma unroll
            for (int a4 = 0; a4 < 4; ++a4) { u32x2 w; w.x = cvtpk(O[dt][4 * a4] * inv, O[dt][4 * a4 + 1] * inv); w.y = cvtpk(O[dt][4 * a4 + 2] * inv, O[dt][4 * a4 + 3] * inv);
                *(u32x2*)(yp + 32 * dt + 8 * a4 + 4 * h) = w; }
    }
    __syncthreads();
}

__device__ __forceinline__ void gmlp_item_mfma(Frame& F, ArgsP a, int item) {
    const int b = item >> 4, chunk = item & 15;
    const bf16_t* Z = (const bf16_t*)(a->ws + WS_Z); const bf16_t* GVT = (const bf16_t*)(a->ws + WS_GVT); const bf16_t* SGW = (const bf16_t*)(a->ws + WS_SGW); bf16_t* YS = (bf16_t*)(a->ws + WS_YSG);
    const float* ln_g = a->in[9]; const float* ln_b = a->in[10]; const float* sg_b = a->in[12];
    LAS float* st = (LAS float*)F.lds;
    const int tok0 = b * SEQ + chunk * 128;
    for (int tt = 0; tt < 16; ++tt) { const int t = F.wave * 16 + tt; float v[8]; unpack8(*(const u32x4*)(Z + (size_t)(tok0 + t) * NZ + ZVS + F.lane * 8), v);
        float s1 = 0.f;
#pragma unroll
        for (int i = 0; i < 8; ++i) s1 += v[i];
        const float mean = wave_sum(s1) * (1.f / 512.f); float s2 = 0.f;
#pragma unroll
        for (int i = 0; i < 8; ++i) { const float d = v[i] - mean; s2 += d * d; }
        const float rstd = rsqrtf(wave_sum(s2) * (1.f / 512.f) + EPS);
        if (F.lane == 0) { st[2 * t] = mean; st[2 * t + 1] = rstd; } }
    __syncthreads();
    const int g = F.wave, r = F.lane & 31, h = F.lane >> 5;
    f32x16 acc[2][4];
#pragma unroll
    for (int dt = 0; dt < 2; ++dt)
#pragma unroll
        for (int tt = 0; tt < 4; ++tt)
#pragma unroll
            for (int i = 0; i < 16; ++i) acc[dt][tt][i] = 0.f;
    float gam[2], bet[2];
#pragma unroll
    for (int dt = 0; dt < 2; ++dt) { gam[dt] = ln_g[g * 64 + 32 * dt + r]; bet[dt] = ln_b[g * 64 + 32 * dt + r]; }
#pragma unroll 1
    for (int ks = 0; ks < 8; ++ks) {
        float mu[8], rs[8];
#pragma unroll
        for (int q4 = 0; q4 < 4; ++q4) { const f32x4 sv = *(const LAS f32x4*)(st + 2 * (16 * ks + 8 * h) + 4 * q4); mu[2 * q4] = sv[0]; rs[2 * q4] = sv[1]; mu[2 * q4 + 1] = sv[2]; rs[2 * q4 + 1] = sv[3]; }
        bf16x8 af[2];
#pragma unroll
        for (int dt = 0; dt < 2; ++dt) { float x[8]; unpack8(*(const u32x4*)(GVT + (size_t)(b * 512 + g * 64 + 32 * dt + r) * SEQ + chunk * 128 + 16 * ks + 8 * h), x);
#pragma unroll
            for (int i = 0; i < 8; ++i) x[i] = (x[i] - mu[i]) * rs[i] * gam[dt] + bet[dt];
            u32x4 pw; pw.x = cvtpk(x[0], x[1]); pw.y = cvtpk(x[2], x[3]); pw.z = cvtpk(x[4], x[5]); pw.w = cvtpk(x[6], x[7]); af[dt] = __builtin_bit_cast(bf16x8, pw); }
#pragma unroll
        for (int tt = 0; tt < 4; ++tt) if (16 * ks <= 32 * tt + 31) {
            const bf16x8 wf = *(const bf16x8*)(SGW + ((size_t)g * 128 + 32 * tt + r) * 128 + 16 * ks + 8 * h);
#pragma unroll
            for (int dt = 0; dt < 2; ++dt) acc[dt][tt] = MFMA32(af[dt], wf, acc[dt][tt]); }
    }
#pragma unroll
    for (int tt = 0; tt < 4; ++tt) { const int t = 32 * tt + r; const float bias = sg_b[g * 128 + t];
        const bf16_t* up = Z + (size_t)(tok0 + t) * NZ + ZU + g * 64; bf16_t* yp = YS + (size_t)(tok0 + t) * 512 + g * 64;
#pragma unroll
        for (int dt = 0; dt < 2; ++dt)
#pragma unroll
            for (int a4 = 0; a4 < 4; ++a4) { const int d0 = 32 * dt + 8 * a4 + 4 * h; const u32x2 uw = *(const u32x2*)(up + d0);
                const float u0 = __uint_as_float(uw.x << 16), u1 = __uint_as_float(uw.x & 0xffff0000u), u2 = __uint_as_float(uw.y << 16), u3 = __uint_as_float(uw.y & 0xffff0000u);
                u32x2 w; w.x = cvtpk(u0 * (acc[dt][tt][4 * a4] + bias), u1 * (acc[dt][tt][4 * a4 + 1] + bias)); w.y = cvtpk(u2 * (acc[dt][tt][4 * a4 + 2] + bias), u3 * (acc[dt][tt][4 * a4 + 3] + bias));
                *(u32x2*)(yp + d0) = w; } }
    __syncthreads();
}

__device__ __forceinline__ void phase5(Frame& F, ArgsP a) {
    const float* x = a->in[0]; const float* g_post = a->in[5]; const float* g_pre = a->in[17]; const float* w_r = a->in[19]; const float* b_r = a->in[20];
    const bf16_t* Y = (const bf16_t*)(a->ws + WS_Y); unsigned char* H2 = (unsigned char*)(a->ws + WS_H2); float* out = (float*)(a->ws + WS_X1);
    unsigned* gcnt = (unsigned*)(a->ws + WS_CTL) + CW_CNT; int* lists = (int*)(a->ws + WS_LISTS); int* tokinfo = (int*)(a->ws + WS_TOKINFO);
    LAS float* h2buf = (LAS float*)F.lds;
    LAS float* part = (LAS float*)(F.lds + 65536);
    LAS float* mv = (LAS float*)(F.lds + 81920);
    LAS int* hist = (LAS int*)(F.lds + 94208);
    LAS int* basep = hist + 32;
    LAS int* asg_e = hist + 64;
    LAS int* asg_l = asg_e + 512;
    LAS float* asg_g = (LAS float*)(asg_l + 512);
    const int e_l = F.lane & 31, kh = F.lane >> 5;
    float wreg[64];
#pragma unroll
    for (int i = 0; i < 64; ++i) wreg[i] = w_r[(size_t)(128 * F.wave + 64 * kh + i) * NE + e_l];
    for (int chunk = blockIdx.x; chunk < T / 128; chunk += F.G) {
        const int b = chunk / 16;
        load_mod(F, a, b, 2048, 3072, mv);
        if (F.tid < 32) hist[F.tid] = 0;
        __syncthreads();
#define P5_LOADROWS(SB, XR, YR) do { _Pragma("unroll") for (int _j = 0; _j < 2; ++_j) { const int _row = chunk * 128 + (SB) * 16 + 2 * F.wave + _j; \
            const f32x4* _xr = (const f32x4*)(x + (size_t)_row * D) + F.lane; const u32x2* _yr = (const u32x2*)(Y + (size_t)_row * D) + F.lane; \
            _Pragma("unroll") for (int _jj = 0; _jj < 4; ++_jj) { XR[_j][_jj] = _xr[64 * _jj]; YR[_j][_jj] = _yr[64 * _jj]; } } } while (0)
        f32x4 xc[2][4]; u32x2 yc[2][4];
        P5_LOADROWS(0, xc, yc);
        for (int sb = 0; sb < 8; ++sb) {
#pragma unroll
            for (int j = 0; j < 2; ++j) {
                const int tt = 2 * F.wave + j, row = chunk * 128 + sb * 16 + tt;
                f32x4 xv[4], yv[4]; float ss = 0.f;
#pragma unroll
                for (int jj = 0; jj < 4; ++jj) { xv[jj] = xc[j][jj]; const u32x2 w = yc[j][jj];
                    yv[jj][0] = __uint_as_float(w.x << 16); yv[jj][1] = __uint_as_float(w.x & 0xffff0000u); yv[jj][2] = __uint_as_float(w.y << 16); yv[jj][3] = __uint_as_float(w.y & 0xffff0000u);
                    ss += (yv[jj][0] * yv[jj][0] + yv[jj][1] * yv[jj][1]) + (yv[jj][2] * yv[jj][2] + yv[jj][3] * yv[jj][3]); }
                const float rstd = rsqrtf(wave_sum(ss) * (1.f / D) + EPS); float s1 = 0.f;
#pragma unroll
                for (int jj = 0; jj < 4; ++jj) { const int col = 4 * F.lane + 256 * jj; const f32x4 gp = *(const f32x4*)(g_post + col);
#pragma unroll
                    for (int i = 0; i < 4; ++i) { const float v = xv[jj][i] + mv[col + i] * (yv[jj][i] * rstd * gp[i]); xv[jj][i] = v; s1 += v * v; }
                    *((f32x4*)(out + (size_t)row * D) + F.lane + 64 * jj) = xv[jj]; }
                const float rstd1 = rsqrtf(wave_sum(s1) * (1.f / D) + EPS);
                unsigned* o8 = (unsigned*)(H2 + (size_t)row * D) + F.lane;
#pragma unroll
                for (int jj = 0; jj < 4; ++jj) { const int col = 4 * F.lane + 256 * jj; const f32x4 gq = *(const f32x4*)(g_pre + col); f32x4 r;
#pragma unroll
                    for (int i = 0; i < 4; ++i) r[i] = xv[jj][i] * rstd1 * gq[i] * (1.f + mv[2048 + col + i]) + mv[1024 + col + i];
                    o8[64 * jj] = cvt4_fp8(r[0], r[1], r[2], r[3], FP8_SH);
                    *(LAS f32x4*)(h2buf + tt * 1024 + col) = r; }
            }
            { const int sbn = sb < 7 ? sb + 1 : 7; P5_LOADROWS(sbn, xc, yc); }
            __syncthreads();
#pragma unroll 1
            for (int t16 = 0; t16 < 16; ++t16) { const LAS f32x4* hp = (const LAS f32x4*)(h2buf + t16 * 1024 + 128 * F.wave + 64 * kh); float acc = 0.f;
#pragma unroll
                for (int i4 = 0; i4 < 16; ++i4) { const f32x4 hv = hp[i4]; acc += hv[0] * wreg[4 * i4] + hv[1] * wreg[4 * i4 + 1] + hv[2] * wreg[4 * i4 + 2] + hv[3] * wreg[4 * i4 + 3]; }
                acc += __shfl_xor(acc, 32);
                if (F.lane < 32) part[(F.wave * 16 + t16) * 32 + F.lane] = acc; }
            __syncthreads();
#pragma unroll 1
            for (int j = 0; j < 2; ++j) {
                const int tt = 2 * F.wave + j, tokidx = sb * 16 + tt;
                float logit = b_r[e_l];
#pragma unroll
                for (int w = 0; w < 8; ++w) logit += part[(w * 16 + tt) * 32 + e_l];
                float val = logit; float tv[4]; int ti[4];
#pragma unroll
                for (int k = 0; k < 4; ++k) { float bv = val; int bi = e_l;
#pragma unroll
                    for (int o = 1; o < 32; o <<= 1) { const float ov = __shfl_xor(bv, o); const int oi = __shfl_xor(bi, o); if (ov > bv || (ov == bv && oi < bi)) { bv = ov; bi = oi; } }
                    tv[k] = bv; ti[k] = bi; if (e_l == bi) val = -3.0e38f; }
                const float p1 = __expf(tv[1] - tv[0]), p2 = __expf(tv[2] - tv[0]), p3 = __expf(tv[3] - tv[0]); const float inv = 1.f / (1.f + p1 + p2 + p3);
                if (F.lane < 4) { const int k = F.lane; const int e = k == 0 ? ti[0] : (k == 1 ? ti[1] : (k == 2 ? ti[2] : ti[3])); const float gt = (k == 0 ? 1.f : (k == 1 ? p1 : (k == 2 ? p2 : p3))) * inv;
                    const int lp = __hip_atomic_fetch_add(hist + e, 1, __ATOMIC_RELAXED, __HIP_MEMORY_SCOPE_WORKGROUP); asg_e[tokidx * 4 + k] = e; asg_l[tokidx * 4 + k] = lp; asg_g[tokidx * 4 + k] = gt; }
            }
        }
        __syncthreads();
        if (F.tid < 32) basep[F.tid] = (int)atomicAdd(gcnt + F.tid, (unsigned)hist[F.tid]);
        __syncthreads();
        { const int aidx = F.tid, tokidx = aidx >> 2, k = aidx & 3, e = asg_e[aidx], pos = basep[e] + asg_l[aidx], token = chunk * 128 + tokidx;
          lists[(size_t)e * LISTCAP + pos] = token;
          int* ti = tokinfo + ((size_t)token * 4 + k) * 4; ti[0] = e; ti[1] = pos; ti[2] = __float_as_int(asg_g[aidx]); ti[3] = 0; }
        __syncthreads();
    }
}

__device__ __forceinline__ void moe_tables(Frame& F, ArgsP a, LAS int* tab, int NT) {
    const unsigned* gcnt = (const unsigned*)(a->ws + WS_CTL) + CW_CNT;
    if (F.tid == 0) { int us = 0, ro = 0;
        for (int e = 0; e < NE; ++e) { const int c = (int)__hip_atomic_load(gcnt + e, __ATOMIC_RELAXED, __HIP_MEMORY_SCOPE_AGENT); const int tiles = (c + 255) >> 8; tab[e] = us; tab[64 + e] = ro; tab[128 + e] = c; us += tiles * NT; ro += tiles * 256; }
        tab[32] = us; tab[64 + 32] = ro; }
    __syncthreads();
}

__device__ __forceinline__ void phase9(Frame& F, ArgsP a) {
    const float* g_post = a->in[18]; const bf16_t* YS = (const bf16_t*)(a->ws + WS_YS); const int* tokinfo = (const int*)(a->ws + WS_TOKINFO); float* out = a->out;
    const float* X1 = (const float*)(a->ws + WS_X1);
    LAS int* tab = (LAS int*)(F.lds + MISC_OFF); LAS float* mv = (LAS float*)F.lds;
    moe_tables(F, a, tab, 4);
    for (int chunk = blockIdx.x; chunk < T / 128; chunk += F.G) {
        const int b = chunk / 16;
        load_mod(F, a, b, 5120, 1024, mv);
        __syncthreads();
        const int row0 = chunk * 128 + F.wave * 16;
        const u32x4 tinf = *(const u32x4*)(tokinfo + ((size_t)(row0 + (F.lane >> 2)) * 4 + (F.lane & 3)) * 4);
        const int srow = tab[64 + (int)tinf.x] + (int)tinf.y; const float sgate = __uint_as_float(tinf.z);
#define P9_LOAD(I, YR, XR) do { _Pragma("unroll") for (int _k = 0; _k < 4; ++_k) { const int _r = __shfl(srow, 4 * (I) + _k); const u32x2* _yr = (const u32x2*)(YS + (size_t)_r * D) + F.lane; \
            _Pragma("unroll") for (int _jj = 0; _jj < 4; ++_jj) YR[_k][_jj] = _yr[64 * _jj]; } \
            const f32x4* _xr = (const f32x4*)(X1 + (size_t)(row0 + (I)) * D) + F.lane; _Pragma("unroll") for (int _jj = 0; _jj < 4; ++_jj) XR[_jj] = _xr[64 * _jj]; } while (0)
        u32x2 yc[4][4], yn[4][4]; f32x4 xc[4], xn[4];
        P9_LOAD(0, yc, xc);
#pragma unroll 1
        for (int i = 0; i < 16; ++i) {
            { const int in_ = i < 15 ? i + 1 : 15; P9_LOAD(in_, yn, xn); }
            f32x4 yv[4];
#pragma unroll
            for (int jj = 0; jj < 4; ++jj) yv[jj] = (f32x4){0.f, 0.f, 0.f, 0.f};
#pragma unroll
            for (int k = 0; k < 4; ++k) { const float gt = __shfl(sgate, 4 * i + k);
#pragma unroll
                for (int jj = 0; jj < 4; ++jj) { const u32x2 w = yc[k][jj];
                    yv[jj][0] += gt * __uint_as_float(w.x << 16); yv[jj][1] += gt * __uint_as_float(w.x & 0xffff0000u); yv[jj][2] += gt * __uint_as_float(w.y << 16); yv[jj][3] += gt * __uint_as_float(w.y & 0xffff0000u); } }
            float ss = 0.f;
#pragma unroll
            for (int jj = 0; jj < 4; ++jj) ss += (yv[jj][0] * yv[jj][0] + yv[jj][1] * yv[jj][1]) + (yv[jj][2] * yv[jj][2] + yv[jj][3] * yv[jj][3]);
            const float rstd = rsqrtf(wave_sum(ss) * (1.f / D) + EPS);
            f32x4* orow = (f32x4*)(out + (size_t)(row0 + i) * D) + F.lane;
#pragma unroll
            for (int jj = 0; jj < 4; ++jj) { const int col = 4 * F.lane + 256 * jj; const f32x4 gp = *(const f32x4*)(g_post + col); f32x4 xv = xc[jj];
#pragma unroll
                for (int ii = 0; ii < 4; ++ii) xv[ii] += mv[col + ii] * (yv[jj][ii] * rstd * gp[ii]);
                orow[64 * jj] = xv; }
#pragma unroll
            for (int k = 0; k < 4; ++k)
#pragma unroll
                for (int jj = 0; jj < 4; ++jj) yc[k][jj] = yn[k][jj];
#pragma unroll
            for (int jj = 0; jj < 4; ++jj) xc[jj] = xn[jj];
        }
        __syncthreads();
    }
}

#define XB_TMO      128
#define XB_XCNT(j)  (256  + 64 * (j))
#define XB_XSUB(j)  (1280 + 64 * (j))
#define XB_XGEN(j)  (2304 + 64 * (j))
#define XB_TOP      3328
#define XB_TOPGEN   3392
#define XCD_BAR_WORDS 3456
#define XB_SPIN_CAP (1u << 18)
__device__ __forceinline__ unsigned xb_ld(unsigned* p)              { return __hip_atomic_load(p, __ATOMIC_RELAXED, __HIP_MEMORY_SCOPE_AGENT); }
__device__ __forceinline__ unsigned xb_add(unsigned* p, unsigned v) { return __hip_atomic_fetch_add(p, v, __ATOMIC_RELAXED, __HIP_MEMORY_SCOPE_AGENT); }
__device__ __forceinline__ unsigned xb_xcc_id() { return (unsigned)__builtin_amdgcn_s_getreg((3 << 11) | 20) & 0xFu; }
#define XB_SPIN(cond, bar) do { unsigned _sp = 0; while (cond) { __builtin_amdgcn_s_sleep(1); \
    if ((++_sp & 255u) == 0u) { if (xb_ld(&(bar)[XB_TMO])) break; if (_sp > XB_SPIN_CAP) { atomicAdd(&(bar)[XB_TMO], 1u); break; } } } } while (0)
struct XcdBarrier { unsigned* bar; unsigned x; volatile LAS unsigned* st; };
__device__ __forceinline__ XcdBarrier xcd_barrier_post(unsigned* bar, volatile LAS unsigned* st) {
    XcdBarrier b; b.bar = bar; b.x = xb_xcc_id(); b.st = st;
    if (threadIdx.x == 0) (void)xb_add(&bar[XB_XCNT(b.x)], 1u);
    return b;
}
__device__ __forceinline__ void xcd_barrier_complete(unsigned* bar, unsigned x, unsigned& nloc, unsigned& nx) {
    const unsigned G = gridDim.x * gridDim.y * gridDim.z;
    unsigned sum, cnt, mine, sp = 0u;
    for (;;) {
        sum = 0u; cnt = 0u; mine = 0u;
#pragma unroll
        for (unsigned j = 0; j < 16; ++j) { const unsigned c = xb_ld(&bar[XB_XCNT(j)]); sum += c; cnt += (c > 0u) ? 1u : 0u; mine = (j == x) ? c : mine; }
        if (sum == G) break;
        __builtin_amdgcn_s_sleep(1);
        if ((++sp & 255u) == 0u) { if (xb_ld(&bar[XB_TMO])) break; if (sp > XB_SPIN_CAP) { atomicAdd(&bar[XB_TMO], 1u); break; } }
    }
    nloc = mine > 0u ? mine : 1u; nx = cnt > 0u ? cnt : 1u;
}
__device__ __forceinline__ void xcd_barrier(const XcdBarrier& b, const int wave_s) {
    asm volatile("s_waitcnt vmcnt(0)" ::: "memory");
    __syncthreads();
    int ln_; asm volatile("v_mbcnt_lo_u32_b32 %0, -1, 0\n\tv_mbcnt_hi_u32_b32 %0, -1, %0" : "=v"(ln_));
    if (wave_s == 0 && ln_ == 0) {
        unsigned* bar = b.bar;
        __builtin_amdgcn_s_waitcnt(0);
        unsigned nloc = b.st[0], nx = b.st[1];
        if (nloc == 0u) { xcd_barrier_complete(bar, b.x, nloc, nx); b.st[0] = nloc; b.st[1] = nx; }
        const unsigned old = xb_add(&bar[XB_XSUB(b.x)], 1u);
        const unsigned gen = old / nloc;
        if (old + 1u == (gen + 1u) * nloc) {
            __builtin_amdgcn_fence(__ATOMIC_RELEASE, "agent");
            asm volatile("s_waitcnt vmcnt(0)" ::: "memory");
            const unsigned og = xb_add(&bar[XB_TOP], 1u);
            const unsigned tg = og / nx;
            if (og + 1u == (tg + 1u) * nx) xb_add(&bar[XB_TOPGEN], 1u);
            else XB_SPIN(xb_ld(&bar[XB_TOPGEN]) == tg, bar);
            __builtin_amdgcn_fence(__ATOMIC_ACQUIRE, "agent");
            xb_add(&bar[XB_XGEN(b.x)], 1u);
            asm volatile("s_waitcnt vmcnt(0)" ::: "memory");
        } else {
            XB_SPIN(xb_ld(&bar[XB_XGEN(b.x)]) == gen, bar);
            __builtin_amdgcn_fence(__ATOMIC_ACQUIRE, "agent");
            asm volatile("s_waitcnt vmcnt(0)" ::: "memory");
        }
    }
    __syncthreads();
}

constexpr int NPHASE = 10;
__global__ void __launch_bounds__(NTHREADS, 2) fwd_kernel(Args a_unused) {
    extern __shared__ __attribute__((aligned(16))) unsigned char lds_raw[];
    Frame F; F.lds = (LAS unsigned char*)lds_raw; F.G = gridDim.x;
    ArgsP a = (ArgsP)__builtin_amdgcn_kernarg_segment_ptr();
    volatile LAS unsigned* bst = (volatile LAS unsigned*)(F.lds + MISC_OFF + 1024);
    XcdBarrier xbar; xbar.bar = (unsigned*)(a->ws + WS_CTL) + CW_BAR; xbar.x = 0; xbar.st = bst;
    const int nprog = a->nprog;
    const int wave_s = __builtin_amdgcn_readfirstlane((int)threadIdx.x >> 6);
    if (nprog > 1) { if (threadIdx.x == 0) { bst[0] = 0u; bst[1] = 0u; } __syncthreads(); xbar = xcd_barrier_post((unsigned*)(a->ws + WS_CTL) + CW_BAR, bst); if (nprog < 0) cg::this_grid().sync(); }
#pragma nounroll
    for (int pi = 0; pi < nprog; ++pi) {
        { unsigned long long _p = (unsigned long long)__builtin_amdgcn_kernarg_segment_ptr(); asm volatile("" : "+s"(_p)); a = (ArgsP)_p; }
        { int _l; asm volatile("v_mbcnt_lo_u32_b32 %0, -1, 0\n\tv_mbcnt_hi_u32_b32 %0, -1, %0" : "=v"(_l)); F.lane = _l; F.wave = wave_s; F.tid = wave_s * 64 + _l; }
        { int _g = gridDim.x; asm volatile("" : "+s"(_g)); F.G = _g; }
        int bid = blockIdx.x; asm volatile("" : "+s"(bid));
        unsigned char* ws = a->ws;
        const int ph = (int)((a->prog[pi >> 3] >> ((pi & 7) * 8)) & 0xffull);
        switch (ph) {
        case 0: phase0(F, a); break;
        case 1: phase0b(F, a); break;
        case 2: {
            pg8::SchedDense S{(const char*)(ws + WS_H), (const char*)(ws + WS_WIN), T / 256, NZ / 256, F.G, bid, (size_t)256 * D * 2};
            pg8::EpiInProj E{(bf16_t*)(ws + WS_Z), a->in[7], (bf16_t*)(ws + WS_VT), (bf16_t*)(ws + WS_GVT)};
            pg8::gemm_phase<pg8::EpiInProj, pg8::SchedDense, false>(F.lds, F.tid, D * 2, S, E);
        } break;
        case 3: {
            for (int it = bid; it < 256 + 512; it += F.G) { if (it < 256) gmlp_item_mfma(F, a, it); else attn_item_mfma(F, a, it - 256); }
        } break;
        case 4: {
            pg8::SchedBranch S{(const char*)(ws + WS_YATT), (const char*)(ws + WS_WBA), (const char*)(ws + WS_YSG), (const char*)(ws + WS_WBS), T / 256, D / 256, F.G, bid, (size_t)256 * 512 * 2};
            pg8::EpiBranch E{(const bf16_t*)(ws + WS_Z), (bf16_t*)(ws + WS_H)};
            pg8::gemm_phase<pg8::EpiBranch, pg8::SchedBranch, false>(F.lds, F.tid, 512 * 2, S, E);
        } break;
        case 5: {
            pg8::SchedDense S{(const char*)(ws + WS_H), (const char*)(ws + WS_WOUT), T / 256, D / 256, F.G, bid, (size_t)256 * D * 2};
            pg8::EpiBiasBf16 E{(bf16_t*)(ws + WS_Y), D, a->in[16], 0, 1.f};
            pg8::gemm_phase<pg8::EpiBiasBf16, pg8::SchedDense, false>(F.lds, F.tid, D * 2, S, E);
        } break;
        case 6: phase5(F, a); break;
        case 7: {
            LAS int* tab = (LAS int*)(F.lds + MISC_OFF); moe_tables(F, a, tab, 8);
            pg8::SchedMoE S{tab, (const char*)(ws + WS_H2), (const char*)(ws + WS_W1), (size_t)2 * DE * D, (const int*)(ws + WS_LISTS), 8, F.G, bid, (size_t)256 * D, true};
            pg8::EpiSwiGLU E{(unsigned char*)(ws + WS_ACT), a->in[22]};
            pg8::gemm_phase<pg8::EpiSwiGLU, pg8::SchedMoE, true, true>(F.lds, F.tid, D, S, E);
        } break;
        case 8: {
            LAS int* tab = (LAS int*)(F.lds + MISC_OFF); moe_tables(F, a, tab, 4);
            pg8::SchedMoE S{tab, (const char*)(ws + WS_ACT), (const char*)(ws + WS_W2), (size_t)D * DE, nullptr, 4, F.G, bid, (size_t)256 * DE, false};
            pg8::EpiBiasBf16 E{(bf16_t*)(ws + WS_YS), D, a->in[24], D, 1.f / (FP8_SA * FP8_SW)};
            pg8::gemm_phase<pg8::EpiBiasBf16, pg8::SchedMoE, false, true>(F.lds, F.tid, DE, S, E);
        } break;
        case 9: phase9(F, a); break;
        default: if (bid == 0 && F.tid < 32) ((unsigned*)(ws + WS_CTL))[CW_CNT + F.tid] = 0u; break;
        }
        if (pi + 1 < nprog) xcd_barrier(xbar, wave_s);
    }
}

extern "C" void kernel_launch(void* const* d_in, const int* in_sizes, int n_in, void* d_out, int out_size, void* d_ws, size_t ws_size, hipStream_t stream) {
    const void* kfn = (const void*)fwd_kernel;
    static int grid = 0;
    if (grid == 0) {
        if (n_in != 25 || out_size != T * D || ws_size < WS_END) { fprintf(stderr, "kernel_launch: unexpected problem (n_in %d out %d ws %zu)\n", n_in, out_size, ws_size); grid = -1; return; }
        int dev = 0, cus = 0, per_cu = 0;
        (void)hipGetDevice(&dev); (void)hipDeviceGetAttribute(&cus, hipDeviceAttributeMultiprocessorCount, dev);
        (void)hipFuncSetAttribute(kfn, hipFuncAttributeMaxDynamicSharedMemorySize, LDS_BYTES);
        (void)hipOccupancyMaxActiveBlocksPerMultiprocessor(&per_cu, kfn, NTHREADS, LDS_BYTES);
        (void)hipGetLastError();
        if (per_cu < 1) { fprintf(stderr, "kernel_launch: occupancy query says %d blocks per CU\n", per_cu); grid = -1; return; }
        grid = cus;
    }
    if (grid < 0) return;
    (void)hipMemsetAsync((char*)d_ws + WS_CTL, 0, CTL_BYTES, stream);
    Args a{};
    for (int i = 0; i < 25; ++i) a.in[i] = (const float*)d_in[i];
    a.out = (float*)d_out; a.ws = (unsigned char*)d_ws;
    static const unsigned char program[] = PHASE_PROGRAM;
    const int np = (int)sizeof(program);
#if MK_ONE_LAUNCH
    a.nprog = np; for (int i = 0; i < np; ++i) a.prog[i >> 3] |= (unsigned long long)program[i] << ((i & 7) * 8);
    void* args[] = {&a};
    hipError_t e = hipLaunchCooperativeKernel(kfn, dim3(grid), dim3(NTHREADS), args, LDS_BYTES, stream);
    if (e != hipSuccess) fprintf(stderr, "cooperative launch failed: %s (grid %d)\n", hipGetErrorString(e), grid);
#else
    for (int p = 0; p < np; ++p) { a.nprog = 1; a.prog[0] = program[p]; void* args[] = {&a}; (void)hipLaunchKernel(kfn, dim3(grid), dim3(NTHREADS), args, LDS_BYTES, stream); }
#endif
}
```

```cpp
#include <hip/hip_runtime.h>
#include <hip/hip_cooperative_groups.h>
#include <cstdio>
#include <cstdint>
namespace cg = cooperative_groups;

#ifndef PHASE_PROGRAM
#define PHASE_PROGRAM {0, 1, 2, 3, 4, 5, 6, 7, 8, 9}
#endif
#ifndef MK_ONE_LAUNCH
#define MK_ONE_LAUNCH 1
#endif

#define LAS __attribute__((address_space(3)))
typedef unsigned short bf16_t;
typedef short bf16x8 __attribute__((ext_vector_type(8)));
typedef float f32x4 __attribute__((ext_vector_type(4)));
typedef unsigned u32x4 __attribute__((ext_vector_type(4)));
typedef unsigned u32x2 __attribute__((ext_vector_type(2)));
typedef float f32x16 __attribute__((ext_vector_type(16)));
typedef float f32x2_t __attribute__((ext_vector_type(2)));
typedef __bf16 bf16x2_t __attribute__((ext_vector_type(2)));
typedef int i32x4 __attribute__((ext_vector_type(4)));
typedef int i32x8 __attribute__((ext_vector_type(8)));

constexpr int D = 1024, BATCH = 16, SEQ = 2048, T = BATCH * SEQ;
constexpr int NZ = 3840;
constexpr int ZQ = 0, ZK = 512, ZV = 640, ZU = 768, ZVS = 1280, ZGA = 1792, ZGS = 2816;
constexpr int NE = 32, TOPK = 4, DE = 1024;
constexpr int KSPLIT = 16;
constexpr float EPS = 1e-6f;
constexpr int LISTCAP = T;
constexpr int APAD = T * TOPK + NE * 256;

constexpr size_t MiB = 1u << 20;
constexpr size_t WS_CTL = 0, CTL_BYTES = 1 * MiB;
constexpr size_t WS_MODP = 1 * MiB;
constexpr size_t WS_WIN = 8 * MiB;
constexpr size_t WS_WBA = 16 * MiB, WS_WBS = 17 * MiB;
constexpr size_t WS_WOUT = 18 * MiB;
constexpr size_t WS_SGW = 20 * MiB;
constexpr size_t WS_W1 = 24 * MiB;
constexpr size_t WS_W2 = 152 * MiB;
constexpr size_t WS_H2 = 216 * MiB;
constexpr size_t WS_Z = 280 * MiB;
constexpr size_t WS_YATT = 520 * MiB, WS_YSG = 552 * MiB;
constexpr size_t WS_H = 584 * MiB;
constexpr size_t WS_Y = 648 * MiB;
constexpr size_t WS_ACT = 280 * MiB;
constexpr size_t WS_YS = 552 * MiB;
constexpr size_t WS_LISTS = 824 * MiB;
constexpr size_t WS_TOKINFO = 828 * MiB;
constexpr size_t WS_X1 = 832 * MiB;
constexpr size_t WS_VT = 960 * MiB;
constexpr size_t WS_GVT = 968 * MiB;
constexpr size_t WS_END = 1000 * MiB;
constexpr int CW_CNT = 64;
constexpr int CW_BAR = 4096;

constexpr int RING_BYTES = 131072;
constexpr int MISC_OFF = RING_BYTES;
constexpr int LDS_BYTES = 147456;
constexpr int NWAVES = 8, NTHREADS = 512;

__device__ __forceinline__ float bf2f(unsigned h) { return __uint_as_float(h << 16); }
__device__ __forceinline__ unsigned f2bf(float f) { unsigned u = __float_as_uint(f); return (u + 0x7fffu + ((u >> 16) & 1u)) >> 16; }
__device__ __forceinline__ unsigned pk2(float lo, float hi) { return f2bf(lo) | (f2bf(hi) << 16); }
__device__ __forceinline__ void unpack8(const u32x4 r, float* o) {
    o[0] = __uint_as_float(r.x << 16); o[1] = __uint_as_float(r.x & 0xffff0000u);
    o[2] = __uint_as_float(r.y << 16); o[3] = __uint_as_float(r.y & 0xffff0000u);
    o[4] = __uint_as_float(r.z << 16); o[5] = __uint_as_float(r.z & 0xffff0000u);
    o[6] = __uint_as_float(r.w << 16); o[7] = __uint_as_float(r.w & 0xffff0000u);
}
__device__ __forceinline__ unsigned cvtpk(float lo, float hi) { const f32x2_t v = {lo, hi}; const bf16x2_t b = __builtin_convertvector(v, bf16x2_t); return __builtin_bit_cast(unsigned, b); }
constexpr float FP8_SW = 64.f, FP8_SH = 4.f, FP8_SA = 4.f;
__device__ __forceinline__ float fp8_clamp(float v) { return fminf(fmaxf(v, -448.f), 448.f); }
__device__ __forceinline__ unsigned cvt4_fp8(float a, float b, float c, float d, float sc) {
    unsigned w = 0; w = __builtin_amdgcn_cvt_pk_fp8_f32(fp8_clamp(a * sc), fp8_clamp(b * sc), w, false); w = __builtin_amdgcn_cvt_pk_fp8_f32(fp8_clamp(c * sc), fp8_clamp(d * sc), w, true); return w; }
#define MFMA32(a, b, c) __builtin_amdgcn_mfma_f32_32x32x16_bf16((a), (b), (c), 0, 0, 0)
__device__ __forceinline__ float wave_sum(float v) {
#pragma unroll
    for (int o = 1; o < 64; o <<= 1) v += __shfl_xor(v, o);
    return v;
}
__device__ __forceinline__ float sigmoidf_(float x) { return __builtin_amdgcn_rcpf(1.f + __expf(-x)); }
__device__ __forceinline__ float gelu_tanh(float x) { const float u = 0.7978845608028654f * (x + 0.044715f * x * x * x); return x * __builtin_amdgcn_rcpf(1.f + __expf(-2.f * u)); }

struct Frame { LAS unsigned char* lds; int tid, lane, wave, G; };

namespace pg8 {
constexpr int BM = 256, BK = 64, HALF = 128, HTB = HALF * BK * 2, STAGE_BYTES = 8 * HTB, NXCD = 8, WGM = 8;
__host__ __device__ __forceinline__ int lds_byte(int r, int c) { const int st = (r >> 4) * 2 + (c >> 5), rr = r & 15, cc = c & 31, ob = rr * 64 + cc * 2; return st * 1024 + (ob ^ (((ob >> 9) & 1) << 5)); }
__host__ __device__ __forceinline__ void stage_rc(int b, int& R, int& C) { const int st = b / 1024, sb = b % 1024, swz = sb ^ (((sb >> 9) & 1) << 5); R = (st >> 1) * 16 + swz / 64; C = (st & 1) * 32 + (swz % 64) / 2; }
__host__ __device__ __forceinline__ int perm32(int rho) { const int n = rho >> 4, i = rho & 15; return 8 * (i >> 2) + 4 * n + (i & 3); }
__device__ __forceinline__ unsigned cvt_pk_bf16(float lo, float hi) { unsigned r; asm volatile("v_cvt_pk_bf16_f32 %0, %1, %2" : "=v"(r) : "v"(lo), "v"(hi)); return r; }

struct Unit { const char* A; const char* B; const int* tl; int pm, pn, e, kind, rowbase, nvalid; };
__device__ __forceinline__ const char* uptr(const char* p) { const unsigned long long v = (unsigned long long)p;
    const unsigned lo = __builtin_amdgcn_readfirstlane((unsigned)v), hi = __builtin_amdgcn_readfirstlane((unsigned)(v >> 32)); return (const char*)(((unsigned long long)hi << 32) | lo); }

__device__ __forceinline__ void tile_map(int L, int nM, int nN, int& pm, int& pn) {
    const int nwg = nM * nN;
    int wgid = L; { const int q = nwg / NXCD, r = nwg % NXCD, xcd = wgid % NXCD, off = wgid / NXCD; wgid = (xcd < r ? xcd * (q + 1) : r * (q + 1) + (xcd - r) * q) + off; }
    const int nig = WGM * nN, gid = wgid / nig, fm = gid * WGM, gsz = (nM - fm) < WGM ? (nM - fm) : WGM;
    pm = fm + ((wgid % nig) % gsz); pn = (wgid % nig) / gsz;
}

template <class Epi, class Sched, bool GATHER, bool FP8 = false>
__device__ __forceinline__ void gemm_phase(LAS unsigned char* lds, const int wid, const int Kb, const Sched& S, const Epi& E) {
#define PG8_LANE() ({ int _l; asm volatile("v_mbcnt_lo_u32_b32 %0, -1, 0\n\tv_mbcnt_hi_u32_b32 %0, -1, %0" : "=v"(_l)); _l; })
    const int lane = PG8_LANE(), tid = wid * 64 + lane, wr = wid >> 2, wc = wid & 3, fr = lane & 15, fq = lane >> 4;
    const int nt = Kb / 128;
    unsigned voffB[2]; unsigned oc[2][2], o2[2][2];
#define PG8_ONL() ((LAS u32x4*)(lds + MISC_OFF + 2048) + (wid * 64 + PG8_LANE()))
    const size_t kstep = (size_t)(BK * 2);
    const size_t hstep = (size_t)HALF * Kb;
#pragma unroll
    for (int i = 0; i < 2; ++i) { int R, C; stage_rc(tid * 16 + i * 8192, R, C); const int Rb = (R & ~31) + perm32(R & 31);
        voffB[i] = (unsigned)(Rb * Kb) + (unsigned)C * 2u;
        oc[0][i] = (unsigned)(R * Kb) + (unsigned)C * 2u; oc[1][i] = oc[0][i] + (unsigned)hstep; o2[0][i] = oc[0][i]; o2[1][i] = oc[1][i]; }
    const unsigned ldsw = (unsigned)wid * 1024u;
    const int aoff = lds_byte(wr * 64 + fr, fq * 8), boff = lds_byte(wc * 32 + fr, fq * 8);
#define PG8_SA(b, h) (((b) * 2 + (h)) * HTB)
#define PG8_SB(b, h) ((4 + (b) * 2 + (h)) * HTB)
#define PG8_STAGE(bufoff, gbase, voff) do { const char* _g = uptr((const char*)(gbase)); _Pragma("unroll") for (int _i = 0; _i < 2; ++_i) { unsigned _o = (voff)[_i]; asm volatile("" : "+v"(_o)); \
        __builtin_amdgcn_global_load_lds((const unsigned*)(_g + _o), (LAS unsigned*)(lds + (bufoff) + ldsw + _i * 8192), 16, 0, 0); } } while (0)
#define PG8_STAGE_A(bufoff, gbase, h, O) do { const char* _g = uptr((const char*)(gbase) + (GATHER ? (size_t)0 : (size_t)(h) * hstep)); _Pragma("unroll") for (int _i = 0; _i < 2; ++_i) { unsigned _o = (O)[GATHER ? (h) : 0][_i]; asm volatile("" : "+v"(_o)); \
        __builtin_amdgcn_global_load_lds((const unsigned*)(_g + _o), (LAS unsigned*)(lds + (bufoff) + ldsw + _i * 8192), 16, 0, 0); } } while (0)
#define PG8_CAT2(x, y) __builtin_shufflevector(__builtin_bit_cast(i32x4, (x)), __builtin_bit_cast(i32x4, (y)), 0, 1, 2, 3, 4, 5, 6, 7)
#define PG8_RDA(b, h, m, k) (*(const LAS bf16x8*)(lds + PG8_SA(b, h) + aoff + (m) * 2048 + (k) * 1024))
#define PG8_RDB(b, h, n, k) (*(const LAS bf16x8*)(lds + PG8_SB(b, h) + boff + (n) * 2048 + (k) * 1024))
#define PG8_LDA(dst, b, h) do { _Pragma("unroll") for (int m = 0; m < 4; ++m) { \
        if constexpr (FP8) { dst##8[m] = PG8_CAT2(PG8_RDA(b, h, m, 0), PG8_RDA(b, h, m, 1)); } else { dst[m][0] = PG8_RDA(b, h, m, 0); dst[m][1] = PG8_RDA(b, h, m, 1); } } } while (0)
#define PG8_LDB(dst, b, h) do { _Pragma("unroll") for (int n = 0; n < 2; ++n) { \
        if constexpr (FP8) { dst##8[n] = PG8_CAT2(PG8_RDB(b, h, n, 0), PG8_RDB(b, h, n, 1)); } else { dst[n][0] = PG8_RDB(b, h, n, 0); dst[n][1] = PG8_RDB(b, h, n, 1); } } } while (0)
#define PG8_MMA(ai, bj, At, Bt) do { __builtin_amdgcn_s_setprio(1); \
        if constexpr (FP8) { _Pragma("unroll") for (int m = 0; m < 4; ++m) _Pragma("unroll") for (int n = 0; n < 2; ++n) \
            asm volatile("v_mfma_f32_16x16x128_f8f6f4 %0, %1, %2, %0" : "+v"(acc[ai][bj][m][n]) : "v"(Bt##8[n]), "v"(At##8[m])); } \
        else { _Pragma("unroll") for (int m = 0; m < 4; ++m) _Pragma("unroll") for (int n = 0; n < 2; ++n) _Pragma("unroll") for (int k = 0; k < 2; ++k) \
            acc[ai][bj][m][n] = __builtin_amdgcn_mfma_f32_16x16x32_bf16(Bt[n][k], At[m][k], acc[ai][bj][m][n], 0, 0, 0); } \
        __builtin_amdgcn_s_setprio(0); } while (0)
#define PG8_WAIT_V(n) asm volatile("s_waitcnt vmcnt(" #n ")" ::: "memory")
#define PG8_WAIT_L(n) asm volatile("s_waitcnt lgkmcnt(" #n ")" ::: "memory")
#define PG8_BAR __builtin_amdgcn_s_barrier()
#define PG8_SCHED __builtin_amdgcn_sched_barrier(0)
#define PG8_LOADOFFS(u, o) do { const int _t = wid * 64 + PG8_LANE(); _Pragma("unroll") for (int _i = 0; _i < 2; ++_i) { int _R, _C; stage_rc(_t * 16 + _i * 8192, _R, _C); \
        _Pragma("unroll") for (int _h = 0; _h < 2; ++_h) { int _row = _h * HALF + _R; _row = _row < (u).nvalid ? _row : (u).nvalid - 1; const int _tok = (u).tl[_row]; o[_h][_i] = (unsigned)_tok * (unsigned)Kb + (unsigned)_C * 2u; } } } while (0)
#define PG8_KITER(LAST) do { \
            const char* a1 = cA + (size_t)(t + 1) * kstep; \
            const char* a2 = (LAST) ? nA : cA + (size_t)(t + 2) * kstep; const char* b2 = (LAST) ? nB : cB + (size_t)(t + 2) * kstep; \
            const char* a3 = a2 + kstep; const char* b3 = b2 + kstep; \
            PG8_LDB(B0, 0, 0); PG8_LDB(B1, 0, 1); PG8_SCHED; PG8_LDA(At, 0, 0); PG8_STAGE_A(PG8_SA(1, 1), a1, 1, oc); \
            if constexpr (GATHER && (LAST)) { const u32x4 _n = *PG8_ONL(); o2[0][0] = _n.x; o2[0][1] = _n.y; o2[1][0] = _n.z; o2[1][1] = _n.w; } \
            else { _Pragma("unroll") for (int _h = 0; _h < 2; ++_h) _Pragma("unroll") for (int _i = 0; _i < 2; ++_i) o2[_h][_i] = oc[_h][_i]; } \
            PG8_WAIT_V(8); PG8_WAIT_L(0); PG8_BAR; PG8_MMA(0, 0, At, B0); PG8_MMA(0, 1, At, B1); PG8_BAR; PG8_SCHED; \
            PG8_LDA(At, 0, 1); PG8_STAGE(PG8_SB(0, 0), b2, voffB); PG8_STAGE(PG8_SB(0, 1), b2 + hstep, voffB); PG8_STAGE_A(PG8_SA(0, 0), a2, 0, o2); \
            PG8_WAIT_V(8); PG8_WAIT_L(0); PG8_BAR; PG8_MMA(1, 0, At, B0); PG8_MMA(1, 1, At, B1); PG8_BAR; PG8_SCHED; \
            PG8_LDB(B0, 1, 0); PG8_LDB(B1, 1, 1); PG8_SCHED; PG8_LDA(At, 1, 0); PG8_STAGE_A(PG8_SA(0, 1), a2, 1, o2); \
            PG8_WAIT_V(8); PG8_WAIT_L(0); PG8_BAR; PG8_MMA(0, 0, At, B0); PG8_MMA(0, 1, At, B1); PG8_BAR; PG8_SCHED; \
            PG8_LDA(At, 1, 1); PG8_STAGE(PG8_SB(1, 0), b3, voffB); PG8_STAGE(PG8_SB(1, 1), b3 + hstep, voffB); PG8_STAGE_A(PG8_SA(1, 0), a3, 0, o2); \
            PG8_WAIT_V(8); PG8_WAIT_L(0); PG8_BAR; PG8_MMA(1, 0, At, B0); PG8_MMA(1, 1, At, B1); PG8_BAR; PG8_SCHED; \
        } while (0)
    Unit cur, nxt; int ui = 0;
    if (!S.next(0, cur)) return;
    f32x4 acc[2][2][4][2];
#pragma unroll
    for (int a = 0; a < 2; ++a)
#pragma unroll
        for (int b = 0; b < 2; ++b)
#pragma unroll
            for (int m = 0; m < 4; ++m)
#pragma unroll
                for (int n = 0; n < 2; ++n) acc[a][b][m][n] = (f32x4){0.f, 0.f, 0.f, 0.f};
    bf16x8 At[4][2], B0[2][2], B1[2][2]; i32x8 At8[4], B08[2], B18[2];
    const char* cA = cur.A; const char* cB = cur.B;
    if constexpr (GATHER) { PG8_LOADOFFS(cur, oc); }
    PG8_STAGE(PG8_SB(0, 0), cB, voffB); PG8_STAGE(PG8_SB(0, 1), cB + hstep, voffB); PG8_STAGE_A(PG8_SA(0, 0), cA, 0, oc); PG8_STAGE_A(PG8_SA(0, 1), cA, 1, oc);
    if (wr == 1) PG8_BAR;
    PG8_WAIT_V(2); PG8_BAR;
    PG8_STAGE(PG8_SB(1, 0), cB + kstep, voffB); PG8_STAGE_A(PG8_SA(1, 0), cA + kstep, 0, oc); PG8_STAGE(PG8_SB(1, 1), cB + hstep + kstep, voffB);
    PG8_WAIT_V(6); PG8_BAR;
    for (;;) {
        const bool has_next = S.next(ui + 1, nxt);
        const char* nA = has_next ? nxt.A : cA; const char* nB = has_next ? nxt.B : cB;
        if constexpr (GATHER) {
            unsigned onx[2][2];
            if (has_next) { PG8_LOADOFFS(nxt, onx); }
            else {
#pragma unroll
                for (int h = 0; h < 2; ++h)
#pragma unroll
                    for (int i = 0; i < 2; ++i) onx[h][i] = oc[h][i];
            }
            *PG8_ONL() = (u32x4){onx[0][0], onx[0][1], onx[1][0], onx[1][1]};
        }
        int t = 0;
#pragma nounroll
        for (; t < nt - 2; t += 2) PG8_KITER(false);
        PG8_KITER(true);
        if (wr == 0) PG8_BAR;
        if constexpr (FP8) asm volatile("s_nop 15\n\ts_nop 15" ::: "memory");
        const int lane_e = PG8_LANE();
        const bool keep = E(acc, cur, wr, wc, lane_e & 15, lane_e >> 4);
        if (!has_next) break;
        if (!keep) {
#pragma unroll
            for (int a = 0; a < 2; ++a)
#pragma unroll
                for (int b = 0; b < 2; ++b)
#pragma unroll
                    for (int m = 0; m < 4; ++m)
#pragma unroll
                        for (int n = 0; n < 2; ++n) acc[a][b][m][n] = (f32x4){0.f, 0.f, 0.f, 0.f};
        }
        cur = nxt; cA = nA; cB = nB; ++ui;
        if constexpr (GATHER) {
#pragma unroll
            for (int h = 0; h < 2; ++h)
#pragma unroll
                for (int i = 0; i < 2; ++i) oc[h][i] = o2[h][i];
        }
        if (wr == 1) PG8_BAR;
    }
    PG8_WAIT_V(0);
    PG8_BAR;
#undef PG8_SA
#undef PG8_SB
#undef PG8_STAGE
#undef PG8_STAGE_A
#undef PG8_LDA
#undef PG8_LDB
#undef PG8_MMA
#undef PG8_CAT2
#undef PG8_RDA
#undef PG8_RDB
#undef PG8_WAIT_V
#undef PG8_WAIT_L
#undef PG8_BAR
#undef PG8_SCHED
#undef PG8_LOADOFFS
#undef PG8_LANE
#undef PG8_ONL
#undef PG8_KITER
}

struct SchedDense {
    const char* A; const char* B; int nM, nN, G, c; size_t tstep;
    __device__ __forceinline__ bool next(int i, Unit& u) const {
        const long L = (long)i * G + c; if (L >= (long)nM * nN) return false;
        tile_map((int)L, nM, nN, u.pm, u.pn); u.A = A + (size_t)u.pm * tstep; u.B = B + (size_t)u.pn * tstep;
        u.tl = nullptr; u.e = 0; u.kind = 0; u.rowbase = u.pm * BM; u.nvalid = BM; return true; }
};
struct SchedBranch {
    const char* A0; const char* B0; const char* A1; const char* B1; int nM, nN, G, c; size_t tstep;
    __device__ __forceinline__ bool next(int i, Unit& u) const {
        const long L = (long)(i >> 1) * G + c; if (L >= (long)nM * nN) return false;
        tile_map((int)L, nM, nN, u.pm, u.pn); u.kind = i & 1;
        u.A = (u.kind ? A1 : A0) + (size_t)u.pm * tstep; u.B = (u.kind ? B1 : B0) + (size_t)u.pn * tstep;
        u.tl = nullptr; u.e = 0; u.rowbase = u.pm * BM; u.nvalid = BM; return true; }
};
struct SchedMoE {
    const LAS int* tab;
    const char* A; const char* B; size_t bexp; const int* lists; int NT, G, c; size_t tstep; bool gather;
    __device__ __forceinline__ bool next(int i, Unit& u) const {
        const int nwg = __builtin_amdgcn_readfirstlane(tab[32]);
        const long L = (long)i * G + c; if (L >= nwg) return false;
        int wgid = (int)L; { const int q = nwg / NXCD, r = nwg % NXCD, xcd = wgid % NXCD, off = wgid / NXCD; wgid = (xcd < r ? xcd * (q + 1) : r * (q + 1) + (xcd - r) * q) + off; }
        const int ln = (int)__builtin_amdgcn_mbcnt_hi(~0u, __builtin_amdgcn_mbcnt_lo(~0u, 0u)), le = ln < 32 ? ln : 31;
        const int ulo = tab[le], uhi = tab[le + 1];
        const unsigned long long mm = __ballot(ln < 32 && ulo <= wgid && wgid < uhi);
        const int e = __builtin_amdgcn_readfirstlane((int)__builtin_ctzll(mm | (1ull << 31)));
        const int local = wgid - __builtin_amdgcn_readfirstlane(tab[e]); u.e = e; u.pm = local / NT; u.pn = local % NT; u.kind = 0;
        u.rowbase = __builtin_amdgcn_readfirstlane(tab[64 + e]) + u.pm * BM; int nv = __builtin_amdgcn_readfirstlane(tab[128 + e]) - u.pm * BM; u.nvalid = nv > BM ? BM : nv;
        u.B = B + (size_t)e * bexp + (size_t)u.pn * tstep;
        if (gather) { u.A = A; u.tl = lists + (size_t)e * LISTCAP + u.pm * BM; }
        else { u.A = A + (size_t)u.rowbase * (tstep / BM); u.tl = nullptr; }
        return true; }
};

#define EPI_FOR_ROWS  _Pragma("unroll") for (int ai = 0; ai < 2; ++ai) _Pragma("unroll") for (int m = 0; m < 4; ++m)
struct EpiInProj {
    bf16_t* Z; const float* bias; bf16_t* VT; bf16_t* GVT;
    __device__ __forceinline__ bool operator()(f32x4 (&acc)[2][2][4][2], const Unit& u, int wr, int wc, int fr, int fq) const {
        const int pn = u.pn, act = pn < 2 ? 0 : (pn == 2 ? 1 : (pn < 7 ? 2 : 3));
        const int col0 = pn * BM + wc * 32 + 8 * fq;
        f32x4 bv[2][2];
#pragma unroll
        for (int bj = 0; bj < 2; ++bj)
#pragma unroll
            for (int n = 0; n < 2; ++n) bv[bj][n] = *(const f32x4*)(bias + col0 + bj * HALF + 4 * n);
        EPI_FOR_ROWS { const int row = u.rowbase + ai * HALF + wr * 64 + m * 16 + fr; bf16_t* rowp = Z + (size_t)row * NZ + col0;
#pragma unroll
            for (int bj = 0; bj < 2; ++bj) { f32x4 v0 = acc[ai][bj][m][0] + bv[bj][0], v1 = acc[ai][bj][m][1] + bv[bj][1];
                if (act == 0) { v0 = v0 * 0.125f; v1 = v1 * 0.125f; }
                else if (act == 2) {
#pragma unroll
                    for (int i = 0; i < 4; ++i) { v0[i] = gelu_tanh(v0[i]); v1[i] = gelu_tanh(v1[i]); } }
                else if (act == 3) {
#pragma unroll
                    for (int i = 0; i < 4; ++i) { v0[i] = sigmoidf_(v0[i]); v1[i] = sigmoidf_(v1[i]); } }
                u32x4 w; w.x = cvt_pk_bf16(v0[0], v0[1]); w.y = cvt_pk_bf16(v0[2], v0[3]); w.z = cvt_pk_bf16(v1[0], v1[1]); w.w = cvt_pk_bf16(v1[2], v1[3]);
                *(u32x4*)(rowp + bj * HALF) = w;
                if ((pn == 2 && bj == 1) || pn == 5 || pn == 6) {
                    const int bt = row >> 11, sq = row & (SEQ - 1);
                    bf16_t* tp = (pn == 2) ? VT + ((size_t)(bt * 128 + wc * 32 + 8 * fq)) * SEQ + sq : GVT + ((size_t)(bt * 512 + (pn - 5) * 256 + bj * HALF + wc * 32 + 8 * fq)) * SEQ + sq;
                    tp[0 * SEQ] = (bf16_t)(w.x & 0xffffu); tp[1 * SEQ] = (bf16_t)(w.x >> 16); tp[2 * SEQ] = (bf16_t)(w.y & 0xffffu); tp[3 * SEQ] = (bf16_t)(w.y >> 16);
                    tp[4 * SEQ] = (bf16_t)(w.z & 0xffffu); tp[5 * SEQ] = (bf16_t)(w.z >> 16); tp[6 * SEQ] = (bf16_t)(w.w & 0xffffu); tp[7 * SEQ] = (bf16_t)(w.w >> 16); } } }
        return false;
    }
};
struct EpiBranch {
    const bf16_t* Z; bf16_t* O;
    __device__ __forceinline__ bool operator()(f32x4 (&acc)[2][2][4][2], const Unit& u, int wr, int wc, int fr, int fq) const {
        const int col0 = u.pn * BM + wc * 32 + 8 * fq;
        if (u.kind == 0) {
            EPI_FOR_ROWS { const int row = u.rowbase + ai * HALF + wr * 64 + m * 16 + fr; const bf16_t* zr = Z + (size_t)row * NZ + col0;
#pragma unroll
                for (int bj = 0; bj < 2; ++bj) { float ga[8], gs[8]; unpack8(*(const u32x4*)(zr + ZGA + bj * HALF), ga); unpack8(*(const u32x4*)(zr + ZGS + bj * HALF), gs);
#pragma unroll
                    for (int i = 0; i < 4; ++i) { acc[ai][bj][m][0][i] *= ga[i] / gs[i]; acc[ai][bj][m][1][i] *= ga[4 + i] / gs[4 + i]; } } }
            return true;
        }
        EPI_FOR_ROWS { const int row = u.rowbase + ai * HALF + wr * 64 + m * 16 + fr; const bf16_t* zr = Z + (size_t)row * NZ + col0; bf16_t* op = O + (size_t)row * D + col0;
#pragma unroll
            for (int bj = 0; bj < 2; ++bj) { float gs[8]; unpack8(*(const u32x4*)(zr + ZGS + bj * HALF), gs);
                const f32x4 v0 = acc[ai][bj][m][0], v1 = acc[ai][bj][m][1];
                u32x4 w; w.x = cvt_pk_bf16(v0[0] * gs[0], v0[1] * gs[1]); w.y = cvt_pk_bf16(v0[2] * gs[2], v0[3] * gs[3]); w.z = cvt_pk_bf16(v1[0] * gs[4], v1[1] * gs[5]); w.w = cvt_pk_bf16(v1[2] * gs[6], v1[3] * gs[7]);
                *(u32x4*)(op + bj * HALF) = w; } }
        return false;
    }
};
struct EpiBiasBf16 {
    bf16_t* O; int ldo; const float* bias; int bstride; float sc; int mode;
    __device__ __forceinline__ bool operator()(f32x4 (&acc)[2][2][4][2], const Unit& u, int wr, int wc, int fr, int fq) const {
        if (mode & 4) return false;
        const int col0 = u.pn * BM + wc * 32 + 8 * fq; const float* bp = bias + (size_t)u.e * bstride + col0;
        f32x4 bv[2][2];
#pragma unroll
        for (int bj = 0; bj < 2; ++bj)
#pragma unroll
            for (int n = 0; n < 2; ++n) bv[bj][n] = (f32x4){0.f, 0.f, 0.f, 0.f};
        if (!(mode & 1)) {
#pragma unroll
        for (int bj = 0; bj < 2; ++bj)
#pragma unroll
            for (int n = 0; n < 2; ++n) bv[bj][n] = *(const f32x4*)(bp + bj * HALF + 4 * n);
        }
        EPI_FOR_ROWS { const int row = u.rowbase + ai * HALF + wr * 64 + m * 16 + fr; bf16_t* op = O + (size_t)row * ldo + col0;
#pragma unroll
            for (int bj = 0; bj < 2; ++bj) { const f32x4 v0 = acc[ai][bj][m][0] * sc + bv[bj][0], v1 = acc[ai][bj][m][1] * sc + bv[bj][1];
                u32x4 w; w.x = cvt_pk_bf16(v0[0], v0[1]); w.y = cvt_pk_bf16(v0[2], v0[3]); w.z = cvt_pk_bf16(v1[0], v1[1]); w.w = cvt_pk_bf16(v1[2], v1[3]);
                if (mode & 2) asm volatile("" :: "v"(w)); else *(u32x4*)(op + bj * HALF) = w; } }
        return false;
    }
};
struct EpiSwiGLU {
    unsigned char* O; const float* b1;
    __device__ __forceinline__ bool operator()(f32x4 (&acc)[2][2][4][2], const Unit& u, int wr, int wc, int fr, int fq) const {
        const int cl = wc * 32 + 8 * fq, colo = u.pn * HALF + cl; const float* bp = b1 + (size_t)u.e * (2 * DE) + colo;
        const float isc = 1.f / (FP8_SH * FP8_SW);
        f32x4 bg[2], bl[2];
#pragma unroll
        for (int n = 0; n < 2; ++n) { bg[n] = *(const f32x4*)(bp + 4 * n); bl[n] = *(const f32x4*)(bp + DE + 4 * n); }
        EPI_FOR_ROWS { const int row = u.rowbase + ai * HALF + wr * 64 + m * 16 + fr; float r[8];
#pragma unroll
            for (int n = 0; n < 2; ++n) { const f32x4 g4 = acc[ai][0][m][n] * isc + bg[n], l4 = acc[ai][1][m][n] * isc + bl[n];
#pragma unroll
                for (int i = 0; i < 4; ++i) { const float g = fminf(g4[i], 7.f), l = fminf(fmaxf(l4[i], -7.f), 7.f); r[4 * n + i] = g * sigmoidf_(1.702f * g) * (l + 1.f); } }
            u32x2 w; w.x = cvt4_fp8(r[0], r[1], r[2], r[3], FP8_SA); w.y = cvt4_fp8(r[4], r[5], r[6], r[7], FP8_SA);
            *(u32x2*)(O + (size_t)row * DE + colo) = w; }
        return false;
    }
};
}

__device__ __forceinline__ void p0_transpose_item(const float* W, int K, int N, bf16_t* WT, int k0, int n0, int drow0, LAS float* scr, int lane) {
#pragma unroll 8
    for (int i = 0; i < 32; ++i) { const int kk = 2 * i + (lane >> 5); scr[kk * 33 + (lane & 31)] = W[(size_t)(k0 + kk) * N + n0 + (lane & 31)]; }
    asm volatile("s_waitcnt lgkmcnt(0)" ::: "memory");
    const int c = lane & 7;
#pragma unroll
    for (int j = 0; j < 4; ++j) { const int n = (lane >> 3) + 8 * j; const LAS float* s = scr + (8 * c) * 33 + n;
        u32x4 o; o.x = pk2(s[0 * 33], s[1 * 33]); o.y = pk2(s[2 * 33], s[3 * 33]); o.z = pk2(s[4 * 33], s[5 * 33]); o.w = pk2(s[6 * 33], s[7 * 33]);
        *(u32x4*)(WT + (size_t)(drow0 + n) * K + k0 + 8 * c) = o; }
    asm volatile("s_waitcnt lgkmcnt(0)" ::: "memory");
}
__device__ __forceinline__ void p0_transpose_item_fp8(const float* W, int K, int N, unsigned char* WT, int k0, int n0, int drow0, LAS float* scr, int lane, float sc) {
#pragma unroll 8
    for (int i = 0; i < 32; ++i) { const int kk = 2 * i + (lane >> 5); scr[kk * 33 + (lane & 31)] = W[(size_t)(k0 + kk) * N + n0 + (lane & 31)]; }
    asm volatile("s_waitcnt lgkmcnt(0)" ::: "memory");
    const int c = lane & 7;
#pragma unroll
    for (int j = 0; j < 4; ++j) { const int n = (lane >> 3) + 8 * j; const LAS float* s = scr + (8 * c) * 33 + n;
        u32x2 o; o.x = cvt4_fp8(s[0 * 33], s[1 * 33], s[2 * 33], s[3 * 33], sc); o.y = cvt4_fp8(s[4 * 33], s[5 * 33], s[6 * 33], s[7 * 33], sc);
        *(u32x2*)(WT + (size_t)(drow0 + n) * K + k0 + 8 * c) = o; }
    asm volatile("s_waitcnt lgkmcnt(0)" ::: "memory");
}
template <bool FP8W>
__device__ __forceinline__ void transpose_matrix(Frame& F, const float* W, int K, int N, void* WT, int& itbase, int gw, int NGW, bool w1map) {
    LAS float* scr = (LAS float*)(F.lds + F.wave * 16384);
    const int nblk = N / 32, nitems = (K / 64) * nblk;
    int first = (gw - (itbase % NGW) + NGW) % NGW;
    for (int it = first; it < nitems; it += NGW) {
        const int kb = it / nblk, nb = it % nblk, n0 = nb * 32;
        int drow0 = n0;
        if (w1map) drow0 = (n0 < DE) ? ((n0 >> 7) * 256 + (n0 & 127)) : (((n0 - DE) >> 7) * 256 + 128 + ((n0 - DE) & 127));
        if constexpr (FP8W) p0_transpose_item_fp8(W, K, N, (unsigned char*)WT, kb * 64, n0, drow0, scr, F.lane, FP8_SW);
        else p0_transpose_item(W, K, N, (bf16_t*)WT, kb * 64, n0, drow0, scr, F.lane);
    }
    itbase += nitems;
}

struct Args { const float* in[25]; float* out; unsigned char* ws; unsigned long long prog[3]; int nprog, pad; };
typedef const __attribute__((address_space(4))) Args* ArgsP;

__device__ __forceinline__ void phase0(Frame& F, ArgsP a) {
    unsigned char* ws = a->ws;
    {
        const float* c_in = a->in[1]; const float* w_mod = a->in[2]; float* modp = (float*)(ws + WS_MODP);
        LAS float* cact = (LAS float*)F.lds;
        for (int it = blockIdx.x; it < KSPLIT * 12; it += F.G) {
            const int ks = it / 12, nc = it % 12, n = nc * 512 + F.tid, k0 = ks * 64;
            for (int idx = F.tid; idx < 1024; idx += NTHREADS) { const int b = idx & 15, kk = idx >> 4; const float cv = c_in[b * D + k0 + kk]; cact[kk * 16 + b] = cv * sigmoidf_(cv); }
            __syncthreads();
            float acc[16];
#pragma unroll
            for (int b = 0; b < 16; ++b) acc[b] = 0.f;
#pragma unroll 8
            for (int kk = 0; kk < 64; ++kk) { const float w = w_mod[(size_t)(k0 + kk) * 6144 + n];
#pragma unroll
                for (int b4 = 0; b4 < 4; ++b4) { const f32x4 cv = *(const LAS f32x4*)(cact + kk * 16 + 4 * b4);
                    acc[4 * b4 + 0] += cv[0] * w; acc[4 * b4 + 1] += cv[1] * w; acc[4 * b4 + 2] += cv[2] * w; acc[4 * b4 + 3] += cv[3] * w; } }
#pragma unroll
            for (int b = 0; b < 16; ++b) modp[((size_t)ks * 16 + b) * 6144 + n] = acc[b];
            __syncthreads();
        }
    }
    { const float* sg_w = a->in[11]; bf16_t* SGW = (bf16_t*)(ws + WS_SGW);
      for (int idx = blockIdx.x * NTHREADS + F.tid; idx < 8 * 128 * 128 / 2; idx += F.G * NTHREADS) { const int e0 = 2 * idx, t = (e0 >> 7) & 127, sc = e0 & 127;
          const float w0 = sc <= t ? sg_w[e0] : 0.f, w1 = sc + 1 <= t ? sg_w[e0 + 1] : 0.f; ((unsigned*)SGW)[idx] = pk2(w0, w1); } }
    const int gw = blockIdx.x * NWAVES + F.wave, NGW = F.G * NWAVES;
    int itbase = 0;
    transpose_matrix<false>(F, a->in[6], D, NZ, (bf16_t*)(ws + WS_WIN), itbase, gw, NGW, false);
    transpose_matrix<false>(F, a->in[13], 512, D, (bf16_t*)(ws + WS_WBA), itbase, gw, NGW, false);
    transpose_matrix<false>(F, a->in[14], 512, D, (bf16_t*)(ws + WS_WBS), itbase, gw, NGW, false);
    transpose_matrix<false>(F, a->in[15], D, D, (bf16_t*)(ws + WS_WOUT), itbase, gw, NGW, false);
    for (int e = 0; e < NE; ++e) transpose_matrix<true>(F, a->in[21] + (size_t)e * D * 2 * DE, D, 2 * DE, (unsigned char*)(ws + WS_W1) + (size_t)e * 2 * DE * D, itbase, gw, NGW, true);
    for (int e = 0; e < NE; ++e) transpose_matrix<true>(F, a->in[23] + (size_t)e * DE * D, DE, D, (unsigned char*)(ws + WS_W2) + (size_t)e * D * DE, itbase, gw, NGW, false);
}

__device__ __forceinline__ void load_mod(Frame& F, ArgsP a, int b, int col0, int n, LAS float* dst) {
    const float* modp = (const float*)(a->ws + WS_MODP); const float* b_mod = a->in[3];
    for (int idx = F.tid; idx < n; idx += NTHREADS) { const int col = col0 + idx; float s = b_mod[col];
#pragma unroll
        for (int ks = 0; ks < KSPLIT; ++ks) s += modp[((size_t)ks * 16 + b) * 6144 + col];
        dst[idx] = s; }
}

__device__ __forceinline__ void phase0b(Frame& F, ArgsP a) {
    const float* x = a->in[0]; const float* g = a->in[4]; bf16_t* H = (bf16_t*)(a->ws + WS_H);
    LAS float* mv = (LAS float*)F.lds;
    for (int chunk = blockIdx.x; chunk < T / 128; chunk += F.G) {
        const int b = chunk / 16;
        load_mod(F, a, b, 0, 2048, mv);
        __syncthreads();
        for (int tt = 0; tt < 16; ++tt) {
            const int row = chunk * 128 + F.wave * 16 + tt;
            const f32x4* xr = (const f32x4*)(x + (size_t)row * D) + F.lane;
            f32x4 v[4]; float ss = 0.f;
#pragma unroll
            for (int j = 0; j < 4; ++j) { v[j] = xr[64 * j]; ss += (v[j][0] * v[j][0] + v[j][1] * v[j][1]) + (v[j][2] * v[j][2] + v[j][3] * v[j][3]); }
            const float rstd = rsqrtf(wave_sum(ss) * (1.f / D) + EPS);
            u32x2* o8 = (u32x2*)(H + (size_t)row * D) + F.lane;
#pragma unroll
            for (int j = 0; j < 4; ++j) { const int col = 4 * F.lane + 256 * j; const f32x4 gg = *(const f32x4*)(g + col); float r[4];
#pragma unroll
                for (int i = 0; i < 4; ++i) r[i] = v[j][i] * rstd * gg[i] * (1.f + mv[1024 + col + i]) + mv[col + i];
                u32x2 w; w.x = pk2(r[0], r[1]); w.y = pk2(r[2], r[3]); o8[64 * j] = w; }
        }
        __syncthreads();
    }
}

__device__ __forceinline__ void attn_item(Frame& F, ArgsP a, int item) {
    const int hq = item & 7, n = (item >> 3) & 15, b = item >> 7, kvh = hq >> 2;
    const bf16_t* Z = (const bf16_t*)(a->ws + WS_Z); bf16_t* YA = (bf16_t*)(a->ws + WS_YATT);
    LAS bf16_t* Ks = (LAS bf16_t*)F.lds;
    LAS bf16_t* Vs = Ks + 256 * 72;
    const int tok0 = b * SEQ + n * 128;
    for (int c = F.tid; c < 2048; c += NTHREADS) { const int kj = c >> 3, ch = c & 7; const int tk = tok0 - 128 + kj;
        u32x4 kv = (u32x4){0u, 0u, 0u, 0u}, vv = kv;
        if (n > 0 || kj >= 128) { const bf16_t* zr = Z + (size_t)tk * NZ + kvh * 64 + ch * 8; kv = *(const u32x4*)(zr + ZK); vv = *(const u32x4*)(zr + ZV); }
        *(LAS u32x4*)(Ks + kj * 72 + ch * 8) = kv; *(LAS u32x4*)(Vs + kj * 72 + ch * 8) = vv; }
    __syncthreads();
    const int qi = F.tid >> 2, j4 = F.tid & 3;
    float q[64];
    { const bf16_t* qr = Z + (size_t)(tok0 + qi) * NZ + ZQ + hq * 64;
#pragma unroll
      for (int c = 0; c < 8; ++c) unpack8(*(const u32x4*)(qr + c * 8), q + c * 8); }
    const float slope = exp2f(-(float)(hq + 1)), sink = a->in[8][hq];
    float s[32]; float mx = -1e30f;
#pragma unroll
    for (int i = 0; i < 32; ++i) { const int kj = qi + 1 + j4 + 4 * i; const LAS bf16_t* kr = Ks + kj * 72; float dot = 0.f;
#pragma unroll
        for (int c = 0; c < 8; ++c) { float kf[8]; unpack8(*(const LAS u32x4*)(kr + c * 8), kf);
#pragma unroll
            for (int d = 0; d < 8; ++d) dot += q[c * 8 + d] * kf[d]; }
        const float dist = (float)(127 - j4 - 4 * i); const bool valid = (n > 0) || (kj >= 128);
        s[i] = valid ? (dot - slope * dist) : -1e30f; mx = fmaxf(mx, s[i]); }
    mx = fmaxf(mx, __shfl_xor(mx, 1)); mx = fmaxf(mx, __shfl_xor(mx, 2)); mx = fmaxf(mx, sink);
    float l = 0.f;
#pragma unroll
    for (int i = 0; i < 32; ++i) { const float p = __expf(s[i] - mx); s[i] = p; l += p; }
    l += __shfl_xor(l, 1); l += __shfl_xor(l, 2); l += __expf(sink - mx);
    float o[64];
#pragma unroll
    for (int d = 0; d < 64; ++d) o[d] = 0.f;
#pragma unroll 4
    for (int i = 0; i < 32; ++i) { const int kj = qi + 1 + j4 + 4 * i; const LAS bf16_t* vr = Vs + kj * 72; const float p = s[i];
#pragma unroll
        for (int c = 0; c < 8; ++c) { float vf[8]; unpack8(*(const LAS u32x4*)(vr + c * 8), vf);
#pragma unroll
            for (int d = 0; d < 8; ++d) o[c * 8 + d] += p * vf[d]; } }
    const float inv = 1.f / l;
#pragma unroll
    for (int d = 0; d < 64; ++d) { float v = o[d]; v += __shfl_xor(v, 1); v += __shfl_xor(v, 2); o[d] = v * inv; }
    bf16_t* yr = YA + (size_t)(tok0 + qi) * 512 + hq * 64;
#pragma unroll
    for (int jj = 0; jj < 4; ++jj) if (j4 == jj) {
        u32x4 w0, w1; w0.x = pk2(o[16 * jj + 0], o[16 * jj + 1]); w0.y = pk2(o[16 * jj + 2], o[16 * jj + 3]); w0.z = pk2(o[16 * jj + 4], o[16 * jj + 5]); w0.w = pk2(o[16 * jj + 6], o[16 * jj + 7]);
        w1.x = pk2(o[16 * jj + 8], o[16 * jj + 9]); w1.y = pk2(o[16 * jj + 10], o[16 * jj + 11]); w1.z = pk2(o[16 * jj + 12], o[16 * jj + 13]); w1.w = pk2(o[16 * jj + 14], o[16 * jj + 15]);
        *(u32x4*)(yr + 16 * jj) = w0; *(u32x4*)(yr + 16 * jj + 8) = w1; }
    __syncthreads();
}

__device__ __forceinline__ void gmlp_item(Frame& F, ArgsP a, int item) {
    const int b = item >> 4, chunk = item & 15;
    const bf16_t* Z = (const bf16_t*)(a->ws + WS_Z); bf16_t* YS = (bf16_t*)(a->ws + WS_YSG);
    const float* ln_g = a->in[9]; const float* ln_b = a->in[10]; const float* sg_w = a->in[11]; const float* sg_b = a->in[12];
    LAS float* Wl = (LAS float*)F.lds;
    LAS float* Vn = Wl + 128 * 129;
    LAS float* st = Vn + 128 * 64;
    const int tok0 = b * SEQ + chunk * 128;
    for (int tt = 0; tt < 16; ++tt) { const int t = F.wave * 16 + tt; float v[8]; unpack8(*(const u32x4*)(Z + (size_t)(tok0 + t) * NZ + ZVS + F.lane * 8), v);
        float s1 = 0.f;
#pragma unroll
        for (int i = 0; i < 8; ++i) s1 += v[i];
        const float mean = wave_sum(s1) * (1.f / 512.f); float s2 = 0.f;
#pragma unroll
        for (int i = 0; i < 8; ++i) { const float d = v[i] - mean; s2 += d * d; }
        const float rstd = rsqrtf(wave_sum(s2) * (1.f / 512.f) + EPS);
        if (F.lane == 0) { st[2 * t] = mean; st[2 * t + 1] = rstd; } }
    __syncthreads();
    for (int g = 0; g < 8; ++g) {
        for (int idx = F.tid; idx < 16384; idx += NTHREADS) { const int t = idx >> 7, s = idx & 127; Wl[t * 129 + s] = (s <= t) ? sg_w[(size_t)g * 16384 + idx] : 0.f; }
        for (int idx = F.tid; idx < 8192; idx += NTHREADS) { const int s = idx >> 6, d = idx & 63; const float gv = bf2f(Z[(size_t)(tok0 + s) * NZ + ZVS + g * 64 + d]);
            Vn[idx] = (gv - st[2 * s]) * st[2 * s + 1] * ln_g[g * 64 + d] + ln_b[g * 64 + d]; }
        __syncthreads();
        const int t = F.tid >> 2, dq = F.tid & 3;
        float acc[16];
#pragma unroll
        for (int i = 0; i < 16; ++i) acc[i] = 0.f;
        for (int s = 0; s <= t; ++s) { const float w = Wl[t * 129 + s]; const LAS f32x4* vp = (const LAS f32x4*)(Vn + s * 64 + dq * 16);
#pragma unroll
            for (int c = 0; c < 4; ++c) { const f32x4 vv = vp[c]; acc[4 * c] += w * vv[0]; acc[4 * c + 1] += w * vv[1]; acc[4 * c + 2] += w * vv[2]; acc[4 * c + 3] += w * vv[3]; } }
        const float bias = sg_b[g * 128 + t];
        const bf16_t* ur = Z + (size_t)(tok0 + t) * NZ + ZU + g * 64 + dq * 16; float gu[16]; unpack8(*(const u32x4*)ur, gu); unpack8(*(const u32x4*)(ur + 8), gu + 8);
        float r[16];
#pragma unroll
        for (int i = 0; i < 16; ++i) r[i] = gu[i] * (acc[i] + bias);
        bf16_t* yr = YS + (size_t)(tok0 + t) * 512 + g * 64 + dq * 16;
        u32x4 w0, w1; w0.x = pk2(r[0], r[1]); w0.y = pk2(r[2], r[3]); w0.z = pk2(r[4], r[5]); w0.w = pk2(r[6], r[7]); w1.x = pk2(r[8], r[9]); w1.y = pk2(r[10], r[11]); w1.z = pk2(r[12], r[13]); w1.w = pk2(r[14], r[15]);
        *(u32x4*)yr = w0; *(u32x4*)(yr + 8) = w1;
        __syncthreads();
    }
}


__device__ __forceinline__ void attn_item_mfma(Frame& F, ArgsP a, int item) {
    const int kvh = item & 1, n = (item >> 1) & 15, b = item >> 5;
    const bf16_t* Z = (const bf16_t*)(a->ws + WS_Z); const bf16_t* VT = (const bf16_t*)(a->ws + WS_VT); bf16_t* YA = (bf16_t*)(a->ws + WS_YATT);
    LAS bf16_t* Ks = (LAS bf16_t*)F.lds;
    LAS bf16_t* Vs = Ks + 256 * 72;
    const int tok0 = b * SEQ + n * 128;
    for (int c = F.tid; c < 2048; c += NTHREADS) { const int kj = c >> 3, ch = c & 7; u32x4 kv = (u32x4){0u, 0u, 0u, 0u};
        if (n > 0 || kj >= 128) kv = *(const u32x4*)(Z + (size_t)(tok0 - 128 + kj) * NZ + ZK + kvh * 64 + ch * 8);
        *(LAS u32x4*)(Ks + kj * 72 + ch * 8) = kv; }
    for (int c = F.tid; c < 2048; c += NTHREADS) { const int d = c >> 5, ch = c & 31; u32x4 vv = (u32x4){0u, 0u, 0u, 0u};
        if (n > 0 || ch >= 16) vv = *(const u32x4*)(VT + (size_t)(b * 128 + kvh * 64 + d) * SEQ + (n - 1) * 128 + ch * 8);
        *(LAS u32x4*)(Vs + d * 264 + ch * 8) = vv; }
    __syncthreads();
    const int r = F.lane & 31, h = F.lane >> 5;
    const int pr = (r & ~12) | ((r & 4) << 1) | ((r & 8) >> 1);
#pragma unroll 1
    for (int j = 0; j < 2; ++j) {
        const int tk = F.wave * 2 + j, g = tk >> 2, qs = tk & 3, hq = kvh * 4 + g;
        const int qi = 32 * qs + r;
        const bf16_t* qp = Z + (size_t)(tok0 + qi) * NZ + ZQ + hq * 64 + 8 * h;
        bf16x8 qf[4];
#pragma unroll
        for (int ks = 0; ks < 4; ++ks) qf[ks] = *(const bf16x8*)(qp + 16 * ks);
        const float slope = exp2f(-(float)(hq + 1)), sink = a->in[8][hq];
        float mrun = sink, lsum = 0.f;
        f32x16 O[2];
#pragma unroll
        for (int dt = 0; dt < 2; ++dt)
#pragma unroll
            for (int i = 0; i < 16; ++i) O[dt][i] = 0.f;
#pragma unroll
        for (int tt = 0; tt < 5; ++tt) {
            f32x16 S;
#pragma unroll
            for (int i = 0; i < 16; ++i) S[i] = 0.f;
            const LAS bf16_t* kp = Ks + (32 * (qs + tt) + pr) * 72 + 8 * h;
#pragma unroll
            for (int ks = 0; ks < 4; ++ks) { const bf16x8 kf = *(const LAS bf16x8*)(kp + 16 * ks); S = MFMA32(kf, qf[ks], S); }
            float tmax = -1e30f;
#pragma unroll
            for (int i = 0; i < 16; ++i) { const int kj = 32 * (qs + tt) + (i & 3) + 4 * ((i >> 2) & 1) + 8 * h + 16 * (i >> 3); const int dist = qi + 128 - kj;
                const bool valid = (dist >= 0) && (dist < 128) && (n > 0 || kj >= 128);
                const float v = valid ? (S[i] - slope * (float)dist) : -1e30f; S[i] = v; tmax = fmaxf(tmax, v); }
            tmax = fmaxf(tmax, __shfl_xor(tmax, 32));
            const float mnew = fmaxf(mrun, tmax), alpha = __expf(mrun - mnew); mrun = mnew;
            float ps = 0.f;
#pragma unroll
            for (int i = 0; i < 16; ++i) { const float p = __expf(S[i] - mnew); S[i] = p; ps += p; }
            lsum = lsum * alpha + ps;
#pragma unroll
            for (int dt = 0; dt < 2; ++dt)
#pragma unroll
                for (int i = 0; i < 16; ++i) O[dt][i] *= alpha;
#pragma unroll
            for (int sx = 0; sx < 2; ++sx) {
                u32x4 pw; pw.x = cvtpk(S[8 * sx + 0], S[8 * sx + 1]); pw.y = cvtpk(S[8 * sx + 2], S[8 * sx + 3]); pw.z = cvtpk(S[8 * sx + 4], S[8 * sx + 5]); pw.w = cvtpk(S[8 * sx + 6], S[8 * sx + 7]);
                const bf16x8 pb = __builtin_bit_cast(bf16x8, pw);
#pragma unroll
                for (int dt = 0; dt < 2; ++dt) { const bf16x8 vf = *(const LAS bf16x8*)(Vs + (32 * dt + r) * 264 + 32 * (qs + tt) + 16 * sx + 8 * h); O[dt] = MFMA32(vf, pb, O[dt]); }
            }
        }
        const float l = lsum + __shfl_xor(lsum, 32) + __expf(sink - mrun);
        const float inv = 1.f / l;
        bf16_t* yp = YA + (size_t)(tok0 + qi) * 512 + hq * 64;
#pragma unroll
        for (int dt = 0; dt < 2; ++dt)
#pragma unroll
            for (int a4 = 0; a4 < 4; ++a4) { u32x2 w; w.x = cvtpk(O[dt][4 * a4] * inv, O[dt][4 * a4 + 1] * inv); w.y = cvtpk(O[dt][4 * a4 + 2] * inv, O[dt][4 * a4 + 3] * inv);
                *(u32x2*)(yp + 32 * dt + 8 * a4 + 4 * h) = w; }
    }
    __syncthreads();
}

__device__ __forceinline__ void gmlp_item_mfma(Frame& F, ArgsP a, int item) {
    const int b = item >> 4, chunk = item & 15;
    const bf16_t* Z = (const bf16_t*)(a->ws + WS_Z); const bf16_t* GVT = (const bf16_t*)(a->ws + WS_GVT); const bf16_t* SGW = (const bf16_t*)(a->ws + WS_SGW); bf16_t* YS = (bf16_t*)(a->ws + WS_YSG);
    const float* ln_g = a->in[9]; const float* ln_b = a->in[10]; const float* sg_b = a->in[12];
    LAS float* st = (LAS float*)F.lds;
    const int tok0 = b * SEQ + chunk * 128;
    for (int tt = 0; tt < 16; ++tt) { const int t = F.wave * 16 + tt; float v[8]; unpack8(*(const u32x4*)(Z + (size_t)(tok0 + t) * NZ + ZVS + F.lane * 8), v);
        float s1 = 0.f;
#pragma unroll
        for (int i = 0; i < 8; ++i) s1 += v[i];
        const float mean = wave_sum(s1) * (1.f / 512.f); float s2 = 0.f;
#pragma unroll
        for (int i = 0; i < 8; ++i) { const float d = v[i] - mean; s2 += d * d; }
        const float rstd = rsqrtf(wave_sum(s2) * (1.f / 512.f) + EPS);
        if (F.lane == 0) { st[2 * t] = mean; st[2 * t + 1] = rstd; } }
    __syncthreads();
    const int g = F.wave, r = F.lane & 31, h = F.lane >> 5;
    f32x16 acc[2][4];
#pragma unroll
    for (int dt = 0; dt < 2; ++dt)
#pragma unroll
        for (int tt = 0; tt < 4; ++tt)
#pragma unroll
            for (int i = 0; i < 16; ++i) acc[dt][tt][i] = 0.f;
    float gam[2], bet[2];
#pragma unroll
    for (int dt = 0; dt < 2; ++dt) { gam[dt] = ln_g[g * 64 + 32 * dt + r]; bet[dt] = ln_b[g * 64 + 32 * dt + r]; }
#pragma unroll 1
    for (int ks = 0; ks < 8; ++ks) {
        float mu[8], rs[8];
#pragma unroll
        for (int q4 = 0; q4 < 4; ++q4) { const f32x4 sv = *(const LAS f32x4*)(st + 2 * (16 * ks + 8 * h) + 4 * q4); mu[2 * q4] = sv[0]; rs[2 * q4] = sv[1]; mu[2 * q4 + 1] = sv[2]; rs[2 * q4 + 1] = sv[3]; }
        bf16x8 af[2];
#pragma unroll
        for (int dt = 0; dt < 2; ++dt) { float x[8]; unpack8(*(const u32x4*)(GVT + (size_t)(b * 512 + g * 64 + 32 * dt + r) * SEQ + chunk * 128 + 16 * ks + 8 * h), x);
#pragma unroll
            for (int i = 0; i < 8; ++i) x[i] = (x[i] - mu[i]) * rs[i] * gam[dt] + bet[dt];
            u32x4 pw; pw.x = cvtpk(x[0], x[1]); pw.y = cvtpk(x[2], x[3]); pw.z = cvtpk(x[4], x[5]); pw.w = cvtpk(x[6], x[7]); af[dt] = __builtin_bit_cast(bf16x8, pw); }
#pragma unroll
        for (int tt = 0; tt < 4; ++tt) if (16 * ks <= 32 * tt + 31) {
            const bf16x8 wf = *(const bf16x8*)(SGW + ((size_t)g * 128 + 32 * tt + r) * 128 + 16 * ks + 8 * h);
#pragma unroll
            for (int dt = 0; dt < 2; ++dt) acc[dt][tt] = MFMA32(af[dt], wf, acc[dt][tt]); }
    }
#pragma unroll
    for (int tt = 0; tt < 4; ++tt) { const int t = 32 * tt + r; const float bias = sg_b[g * 128 + t];
        const bf16_t* up = Z + (size_t)(tok0 + t) * NZ + ZU + g * 64; bf16_t* yp = YS + (size_t)(tok0 + t) * 512 + g * 64;
#pragma unroll
        for (int dt = 0; dt < 2; ++dt)
#pragma unroll
            for (int a4 = 0; a4 < 4; ++a4) { const int d0 = 32 * dt + 8 * a4 + 4 * h; const u32x2 uw = *(const u32x2*)(up + d0);
                const float u0 = __uint_as_float(uw.x << 16), u1 = __uint_as_float(uw.x & 0xffff0000u), u2 = __uint_as_float(uw.y << 16), u3 = __uint_as_float(uw.y & 0xffff0000u);
                u32x2 w; w.x = cvtpk(u0 * (acc[dt][tt][4 * a4] + bias), u1 * (acc[dt][tt][4 * a4 + 1] + bias)); w.y = cvtpk(u2 * (acc[dt][tt][4 * a4 + 2] + bias), u3 * (acc[dt][tt][4 * a4 + 3] + bias));
                *(u32x2*)(yp + d0) = w; } }
    __syncthreads();
}

__device__ __forceinline__ void phase5(Frame& F, ArgsP a, const int pmode) {
    const float* x = a->in[0]; const float* g_post = a->in[5]; const float* g_pre = a->in[17]; const float* w_r = a->in[19]; const float* b_r = a->in[20];
    const bf16_t* Y = (const bf16_t*)(a->ws + WS_Y); unsigned char* H2 = (unsigned char*)(a->ws + WS_H2); float* out = (float*)(a->ws + WS_X1);
    unsigned* gcnt = (unsigned*)(a->ws + WS_CTL) + CW_CNT; int* lists = (int*)(a->ws + WS_LISTS); int* tokinfo = (int*)(a->ws + WS_TOKINFO);
    LAS float* h2buf = (LAS float*)F.lds;
    LAS float* part = (LAS float*)(F.lds + 65536);
    LAS float* mv = (LAS float*)(F.lds + 81920);
    LAS int* hist = (LAS int*)(F.lds + 94208);
    LAS int* basep = hist + 32;
    LAS int* asg_e = hist + 64;
    LAS int* asg_l = asg_e + 512;
    LAS float* asg_g = (LAS float*)(asg_l + 512);
    LAS float* lgs = asg_g + 512;
    LAS float* sel_v = lgs + 512;
    LAS int* sel_e = (LAS int*)(sel_v + 64);
    const int e_l = F.lane & 31, kh = F.lane >> 5;
    float wreg[64];
#pragma unroll
    for (int i = 0; i < 64; ++i) wreg[i] = w_r[(size_t)(128 * F.wave + 64 * kh + i) * NE + e_l];
    for (int chunk = blockIdx.x; chunk < T / 128; chunk += F.G) {
        const int b = chunk / 16;
        load_mod(F, a, b, 2048, 3072, mv);
        if (F.tid < 32) hist[F.tid] = 0;
        __syncthreads();
#define P5_LOADROWS(SB, XR, YR) do { _Pragma("unroll") for (int _j = 0; _j < 2; ++_j) { const int _row = chunk * 128 + (SB) * 16 + 2 * F.wave + _j; \
            const f32x4* _xr = (const f32x4*)(x + (size_t)_row * D) + F.lane; const u32x2* _yr = (const u32x2*)(Y + (size_t)_row * D) + F.lane; \
            _Pragma("unroll") for (int _jj = 0; _jj < 4; ++_jj) { XR[_j][_jj] = _xr[64 * _jj]; YR[_j][_jj] = _yr[64 * _jj]; } } } while (0)
        f32x4 xc[2][4]; u32x2 yc[2][4];
        P5_LOADROWS(0, xc, yc);
        for (int sb = 0; sb < 8; ++sb) {
#pragma unroll
            for (int j = 0; j < 2; ++j) {
                const int tt = 2 * F.wave + j, row = chunk * 128 + sb * 16 + tt;
                f32x4 xv[4], yv[4]; float ss = 0.f;
#pragma unroll
                for (int jj = 0; jj < 4; ++jj) { xv[jj] = xc[j][jj]; const u32x2 w = yc[j][jj];
                    yv[jj][0] = __uint_as_float(w.x << 16); yv[jj][1] = __uint_as_float(w.x & 0xffff0000u); yv[jj][2] = __uint_as_float(w.y << 16); yv[jj][3] = __uint_as_float(w.y & 0xffff0000u);
                    ss += (yv[jj][0] * yv[jj][0] + yv[jj][1] * yv[jj][1]) + (yv[jj][2] * yv[jj][2] + yv[jj][3] * yv[jj][3]); }
                const float rstd = rsqrtf(wave_sum(ss) * (1.f / D) + EPS); float s1 = 0.f;
#pragma unroll
                for (int jj = 0; jj < 4; ++jj) { const int col = 4 * F.lane + 256 * jj; const f32x4 gp = *(const f32x4*)(g_post + col);
#pragma unroll
                    for (int i = 0; i < 4; ++i) { const float v = xv[jj][i] + mv[col + i] * (yv[jj][i] * rstd * gp[i]); xv[jj][i] = v; s1 += v * v; }
                    *((f32x4*)(out + (size_t)row * D) + F.lane + 64 * jj) = xv[jj]; }
                const float rstd1 = rsqrtf(wave_sum(s1) * (1.f / D) + EPS);
                unsigned* o8 = (unsigned*)(H2 + (size_t)row * D) + F.lane;
#pragma unroll
                for (int jj = 0; jj < 4; ++jj) { const int col = 4 * F.lane + 256 * jj; const f32x4 gq = *(const f32x4*)(g_pre + col); f32x4 r;
#pragma unroll
                    for (int i = 0; i < 4; ++i) r[i] = xv[jj][i] * rstd1 * gq[i] * (1.f + mv[2048 + col + i]) + mv[1024 + col + i];
                    o8[64 * jj] = cvt4_fp8(r[0], r[1], r[2], r[3], FP8_SH);
                    *(LAS f32x4*)(h2buf + tt * 1024 + col) = r; }
            }
            { const int sbn = sb < 7 ? sb + 1 : 7; P5_LOADROWS(sbn, xc, yc); }
            __syncthreads();
            if (pmode & 1) continue;
#pragma unroll 1
            for (int tg = 0; tg < 8; ++tg) { const LAS f32x4* hp = (const LAS f32x4*)(h2buf + (2 * tg) * 1024 + 128 * F.wave + 64 * kh); float acc[2][2];
#pragma unroll
                for (int q = 0; q < 2; ++q) { acc[q][0] = 0.f; acc[q][1] = 0.f; }
#pragma unroll
                for (int i4 = 0; i4 < 16; ++i4) {
                    if ((i4 & 3) == 0) __builtin_amdgcn_sched_barrier(0);
#pragma unroll
                    for (int q = 0; q < 2; ++q) { const f32x4 hv = hp[q * 256 + i4];
                        acc[q][0] = fmaf(hv[0], wreg[4 * i4], acc[q][0]); acc[q][1] = fmaf(hv[1], wreg[4 * i4 + 1], acc[q][1]);
                        acc[q][0] = fmaf(hv[2], wreg[4 * i4 + 2], acc[q][0]); acc[q][1] = fmaf(hv[3], wreg[4 * i4 + 3], acc[q][1]); } }
#pragma unroll
                for (int q = 0; q < 2; ++q) { float t = acc[q][0] + acc[q][1]; t += __shfl_xor(t, 32); if (F.lane < 32) part[(F.wave * 16 + 2 * tg + q) * 32 + F.lane] = t; } }
            __syncthreads();
            if (pmode & 2) continue;
            { const int tt = 2 * F.wave + kh, tokidx = sb * 16 + tt;
              float logit = b_r[e_l];
#pragma unroll
              for (int w = 0; w < 8; ++w) logit += part[(w * 16 + tt) * 32 + e_l];
              lgs[tt * 32 + e_l] = logit;
              int rank = 0;
#pragma unroll
              for (int q8 = 0; q8 < 8; ++q8) { const f32x4 v = *(const LAS f32x4*)(lgs + tt * 32 + 4 * q8);
#pragma unroll
                  for (int i = 0; i < 4; ++i) { const int eo = 4 * q8 + i; rank += (v[i] > logit || (v[i] == logit && eo < e_l)) ? 1 : 0; } }
              if (rank < 4) { sel_v[tt * 4 + rank] = logit; sel_e[tt * 4 + rank] = e_l; }
              if (e_l < 4) { const f32x4 sv = *(const LAS f32x4*)(sel_v + tt * 4); const int k = e_l;
                  const float p0 = 1.f, p1 = __expf(sv[1] - sv[0]), p2 = __expf(sv[2] - sv[0]), p3 = __expf(sv[3] - sv[0]); const float inv = 1.f / (p0 + p1 + p2 + p3);
                  const int e = sel_e[tt * 4 + k]; const float gt = (k == 0 ? p0 : (k == 1 ? p1 : (k == 2 ? p2 : p3))) * inv;
                  const int lp = __hip_atomic_fetch_add(hist + e, 1, __ATOMIC_RELAXED, __HIP_MEMORY_SCOPE_WORKGROUP); asg_e[tokidx * 4 + k] = e; asg_l[tokidx * 4 + k] = lp; asg_g[tokidx * 4 + k] = gt; }
            }
        }
        __syncthreads();
        if (pmode) continue;
        if (F.tid < 32) basep[F.tid] = (int)atomicAdd(gcnt + F.tid, (unsigned)hist[F.tid]);
        __syncthreads();
        { const int aidx = F.tid, tokidx = aidx >> 2, k = aidx & 3, e = asg_e[aidx], pos = basep[e] + asg_l[aidx], token = chunk * 128 + tokidx;
          lists[(size_t)e * LISTCAP + pos] = token;
          int* ti = tokinfo + ((size_t)token * 4 + k) * 4; ti[0] = e; ti[1] = pos; ti[2] = __float_as_int(asg_g[aidx]); ti[3] = 0; }
        __syncthreads();
    }
}

__device__ __forceinline__ void moe_tables(Frame& F, ArgsP a, LAS int* tab, int NT) {
    const unsigned* gcnt = (const unsigned*)(a->ws + WS_CTL) + CW_CNT;
    if (F.tid == 0) { int us = 0, ro = 0;
        for (int e = 0; e < NE; ++e) { const int c = (int)__hip_atomic_load(gcnt + e, __ATOMIC_RELAXED, __HIP_MEMORY_SCOPE_AGENT); const int tiles = (c + 255) >> 8; tab[e] = us; tab[64 + e] = ro; tab[128 + e] = c; us += tiles * NT; ro += tiles * 256; }
        tab[32] = us; tab[64 + 32] = ro; }
    __syncthreads();
}

__device__ __forceinline__ void phase9(Frame& F, ArgsP a) {
    const float* g_post = a->in[18]; const bf16_t* YS = (const bf16_t*)(a->ws + WS_YS); const int* tokinfo = (const int*)(a->ws + WS_TOKINFO); float* out = a->out;
    const float* X1 = (const float*)(a->ws + WS_X1);
    LAS int* tab = (LAS int*)(F.lds + MISC_OFF); LAS float* mv = (LAS float*)F.lds;
    moe_tables(F, a, tab, 4);
    for (int chunk = blockIdx.x; chunk < T / 128; chunk += F.G) {
        const int b = chunk / 16;
        load_mod(F, a, b, 5120, 1024, mv);
        __syncthreads();
        const int row0 = chunk * 128 + F.wave * 16;
        const u32x4 tinf = *(const u32x4*)(tokinfo + ((size_t)(row0 + (F.lane >> 2)) * 4 + (F.lane & 3)) * 4);
        const int srow = tab[64 + (int)tinf.x] + (int)tinf.y; const float sgate = __uint_as_float(tinf.z);
#define P9_LOAD(I, YR, XR) do { _Pragma("unroll") for (int _k = 0; _k < 4; ++_k) { const int _r = __shfl(srow, 4 * (I) + _k); const u32x2* _yr = (const u32x2*)(YS + (size_t)_r * D) + F.lane; \
            _Pragma("unroll") for (int _jj = 0; _jj < 4; ++_jj) YR[_k][_jj] = _yr[64 * _jj]; } \
            const f32x4* _xr = (const f32x4*)(X1 + (size_t)(row0 + (I)) * D) + F.lane; _Pragma("unroll") for (int _jj = 0; _jj < 4; ++_jj) XR[_jj] = _xr[64 * _jj]; } while (0)
        u32x2 yc[4][4], yn[4][4]; f32x4 xc[4], xn[4];
        P9_LOAD(0, yc, xc);
#pragma unroll 1
        for (int i = 0; i < 16; ++i) {
            { const int in_ = i < 15 ? i + 1 : 15; P9_LOAD(in_, yn, xn); }
            f32x4 yv[4];
#pragma unroll
            for (int jj = 0; jj < 4; ++jj) yv[jj] = (f32x4){0.f, 0.f, 0.f, 0.f};
#pragma unroll
            for (int k = 0; k < 4; ++k) { const float gt = __shfl(sgate, 4 * i + k);
#pragma unroll
                for (int jj = 0; jj < 4; ++jj) { const u32x2 w = yc[k][jj];
                    yv[jj][0] += gt * __uint_as_float(w.x << 16); yv[jj][1] += gt * __uint_as_float(w.x & 0xffff0000u); yv[jj][2] += gt * __uint_as_float(w.y << 16); yv[jj][3] += gt * __uint_as_float(w.y & 0xffff0000u); } }
            float ss = 0.f;
#pragma unroll
            for (int jj = 0; jj < 4; ++jj) ss += (yv[jj][0] * yv[jj][0] + yv[jj][1] * yv[jj][1]) + (yv[jj][2] * yv[jj][2] + yv[jj][3] * yv[jj][3]);
            const float rstd = rsqrtf(wave_sum(ss) * (1.f / D) + EPS);
            f32x4* orow = (f32x4*)(out + (size_t)(row0 + i) * D) + F.lane;
#pragma unroll
            for (int jj = 0; jj < 4; ++jj) { const int col = 4 * F.lane + 256 * jj; const f32x4 gp = *(const f32x4*)(g_post + col); f32x4 xv = xc[jj];
#pragma unroll
                for (int ii = 0; ii < 4; ++ii) xv[ii] += mv[col + ii] * (yv[jj][ii] * rstd * gp[ii]);
                orow[64 * jj] = xv; }
#pragma unroll
            for (int k = 0; k < 4; ++k)
#pragma unroll
                for (int jj = 0; jj < 4; ++jj) yc[k][jj] = yn[k][jj];
#pragma unroll
            for (int jj = 0; jj < 4; ++jj) xc[jj] = xn[jj];
        }
        __syncthreads();
    }
}

#define XB_TMO      128
#define XB_XCNT(j)  (256  + 64 * (j))
#define XB_XSUB(j)  (1280 + 64 * (j))
#define XB_XGEN(j)  (2304 + 64 * (j))
#define XB_TOP      3328
#define XB_TOPGEN   3392
#define XCD_BAR_WORDS 3456
#define XB_SPIN_CAP (1u << 18)
__device__ __forceinline__ unsigned xb_ld(unsigned* p)              { return __hip_atomic_load(p, __ATOMIC_RELAXED, __HIP_MEMORY_SCOPE_AGENT); }
__device__ __forceinline__ unsigned xb_add(unsigned* p, unsigned v) { return __hip_atomic_fetch_add(p, v, __ATOMIC_RELAXED, __HIP_MEMORY_SCOPE_AGENT); }
__device__ __forceinline__ unsigned xb_xcc_id() { return (unsigned)__builtin_amdgcn_s_getreg((3 << 11) | 20) & 0xFu; }
#define XB_SPIN(cond, bar) do { unsigned _sp = 0; while (cond) { __builtin_amdgcn_s_sleep(1); \
    if ((++_sp & 255u) == 0u) { if (xb_ld(&(bar)[XB_TMO])) break; if (_sp > XB_SPIN_CAP) { atomicAdd(&(bar)[XB_TMO], 1u); break; } } } } while (0)
struct XcdBarrier { unsigned* bar; unsigned x; volatile LAS unsigned* st; };
__device__ __forceinline__ XcdBarrier xcd_barrier_post(unsigned* bar, volatile LAS unsigned* st) {
    XcdBarrier b; b.bar = bar; b.x = xb_xcc_id(); b.st = st;
    if (threadIdx.x == 0) (void)xb_add(&bar[XB_XCNT(b.x)], 1u);
    return b;
}
__device__ __forceinline__ void xcd_barrier_complete(unsigned* bar, unsigned x, unsigned& nloc, unsigned& nx) {
    const unsigned G = gridDim.x * gridDim.y * gridDim.z;
    unsigned sum, cnt, mine, sp = 0u;
    for (;;) {
        sum = 0u; cnt = 0u; mine = 0u;
#pragma unroll
        for (unsigned j = 0; j < 16; ++j) { const unsigned c = xb_ld(&bar[XB_XCNT(j)]); sum += c; cnt += (c > 0u) ? 1u : 0u; mine = (j == x) ? c : mine; }
        if (sum == G) break;
        __builtin_amdgcn_s_sleep(1);
        if ((++sp & 255u) == 0u) { if (xb_ld(&bar[XB_TMO])) break; if (sp > XB_SPIN_CAP) { atomicAdd(&bar[XB_TMO], 1u); break; } }
    }
    nloc = mine > 0u ? mine : 1u; nx = cnt > 0u ? cnt : 1u;
}
__device__ __forceinline__ void xcd_barrier(const XcdBarrier& b, const int wave_s) {
    asm volatile("s_waitcnt vmcnt(0)" ::: "memory");
    __syncthreads();
    int ln_; asm volatile("v_mbcnt_lo_u32_b32 %0, -1, 0\n\tv_mbcnt_hi_u32_b32 %0, -1, %0" : "=v"(ln_));
    if (wave_s == 0 && ln_ == 0) {
        unsigned* bar = b.bar;
        __builtin_amdgcn_s_waitcnt(0);
        unsigned nloc = b.st[0], nx = b.st[1];
        if (nloc == 0u) { xcd_barrier_complete(bar, b.x, nloc, nx); b.st[0] = nloc; b.st[1] = nx; }
        const unsigned old = xb_add(&bar[XB_XSUB(b.x)], 1u);
        const unsigned gen = old / nloc;
        if (old + 1u == (gen + 1u) * nloc) {
            __builtin_amdgcn_fence(__ATOMIC_RELEASE, "agent");
            asm volatile("s_waitcnt vmcnt(0)" ::: "memory");
            const unsigned og = xb_add(&bar[XB_TOP], 1u);
            const unsigned tg = og / nx;
            if (og + 1u == (tg + 1u) * nx) xb_add(&bar[XB_TOPGEN], 1u);
            else XB_SPIN(xb_ld(&bar[XB_TOPGEN]) == tg, bar);
            __builtin_amdgcn_fence(__ATOMIC_ACQUIRE, "agent");
            xb_add(&bar[XB_XGEN(b.x)], 1u);
            asm volatile("s_waitcnt vmcnt(0)" ::: "memory");
        } else {
            XB_SPIN(xb_ld(&bar[XB_XGEN(b.x)]) == gen, bar);
            __builtin_amdgcn_fence(__ATOMIC_ACQUIRE, "agent");
            asm volatile("s_waitcnt vmcnt(0)" ::: "memory");
        }
    }
    __syncthreads();
}

constexpr int NPHASE = 10;
__global__ void __launch_bounds__(NTHREADS, 2) fwd_kernel(Args a_unused) {
    extern __shared__ __attribute__((aligned(16))) unsigned char lds_raw[];
    Frame F; F.lds = (LAS unsigned char*)lds_raw; F.G = gridDim.x;
    ArgsP a = (ArgsP)__builtin_amdgcn_kernarg_segment_ptr();
    volatile LAS unsigned* bst = (volatile LAS unsigned*)(F.lds + MISC_OFF + 1024);
    XcdBarrier xbar; xbar.bar = (unsigned*)(a->ws + WS_CTL) + CW_BAR; xbar.x = 0; xbar.st = bst;
    const int nprog = a->nprog;
    const int wave_s = __builtin_amdgcn_readfirstlane((int)threadIdx.x >> 6);
    if (nprog > 1) { if (threadIdx.x == 0) { bst[0] = 0u; bst[1] = 0u; } __syncthreads(); xbar = xcd_barrier_post((unsigned*)(a->ws + WS_CTL) + CW_BAR, bst); if (nprog < 0) cg::this_grid().sync(); }
#pragma nounroll
    for (int pi = 0; pi < nprog; ++pi) {
        { unsigned long long _p = (unsigned long long)__builtin_amdgcn_kernarg_segment_ptr(); asm volatile("" : "+s"(_p)); a = (ArgsP)_p; }
        { int _l; asm volatile("v_mbcnt_lo_u32_b32 %0, -1, 0\n\tv_mbcnt_hi_u32_b32 %0, -1, %0" : "=v"(_l)); F.lane = _l; F.wave = wave_s; F.tid = wave_s * 64 + _l; }
        { int _g = gridDim.x; asm volatile("" : "+s"(_g)); F.G = _g; }
        int bid = blockIdx.x; asm volatile("" : "+s"(bid));
        unsigned char* ws = a->ws;
        const int pe = (int)((a->prog[pi >> 3] >> ((pi & 7) * 8)) & 0xffull), ph = pe & 15, pmode = pe >> 4;
        switch (ph) {
        case 0: phase0(F, a); break;
        case 1: phase0b(F, a); break;
        case 2: {
            pg8::SchedDense S{(const char*)(ws + WS_H), (const char*)(ws + WS_WIN), T / 256, NZ / 256, F.G, bid, (size_t)256 * D * 2};
            pg8::EpiInProj E{(bf16_t*)(ws + WS_Z), a->in[7], (bf16_t*)(ws + WS_VT), (bf16_t*)(ws + WS_GVT)};
            pg8::gemm_phase<pg8::EpiInProj, pg8::SchedDense, false>(F.lds, F.wave, D * 2, S, E);
        } break;
        case 3: {
            for (int it = bid; it < 256 + 512; it += F.G) { if (it < 256) gmlp_item_mfma(F, a, it); else attn_item_mfma(F, a, it - 256); }
        } break;
        case 4: {
            pg8::SchedBranch S{(const char*)(ws + WS_YATT), (const char*)(ws + WS_WBA), (const char*)(ws + WS_YSG), (const char*)(ws + WS_WBS), T / 256, D / 256, F.G, bid, (size_t)256 * 512 * 2};
            pg8::EpiBranch E{(const bf16_t*)(ws + WS_Z), (bf16_t*)(ws + WS_H)};
            pg8::gemm_phase<pg8::EpiBranch, pg8::SchedBranch, false>(F.lds, F.wave, 512 * 2, S, E);
        } break;
        case 5: {
            pg8::SchedDense S{(const char*)(ws + WS_H), (const char*)(ws + WS_WOUT), T / 256, D / 256, F.G, bid, (size_t)256 * D * 2};
            pg8::EpiBiasBf16 E{(bf16_t*)(ws + WS_Y), D, a->in[16], 0, 1.f, pmode};
            pg8::gemm_phase<pg8::EpiBiasBf16, pg8::SchedDense, false>(F.lds, F.wave, D * 2, S, E);
        } break;
        case 6: phase5(F, a, pmode); break;
        case 7: {
            LAS int* tab = (LAS int*)(F.lds + MISC_OFF); moe_tables(F, a, tab, 8);
            pg8::SchedMoE S{tab, (const char*)(ws + WS_H2), (const char*)(ws + WS_W1), (size_t)2 * DE * D, (const int*)(ws + WS_LISTS), 8, F.G, bid, (size_t)256 * D, true};
            pg8::EpiSwiGLU E{(unsigned char*)(ws + WS_ACT), a->in[22]};
            pg8::gemm_phase<pg8::EpiSwiGLU, pg8::SchedMoE, true, true>(F.lds, F.wave, D, S, E);
        } break;
        case 8: {
            LAS int* tab = (LAS int*)(F.lds + MISC_OFF); moe_tables(F, a, tab, 4);
            pg8::SchedMoE S{tab, (const char*)(ws + WS_ACT), (const char*)(ws + WS_W2), (size_t)D * DE, nullptr, 4, F.G, bid, (size_t)256 * DE, false};
            pg8::EpiBiasBf16 E{(bf16_t*)(ws + WS_YS), D, a->in[24], D, 1.f / (FP8_SA * FP8_SW), pmode};
            pg8::gemm_phase<pg8::EpiBiasBf16, pg8::SchedMoE, false, true>(F.lds, F.wave, DE, S, E);
        } break;
        case 9: phase9(F, a); break;
        default: if (bid == 0 && F.tid < 32) ((unsigned*)(ws + WS_CTL))[CW_CNT + F.tid] = 0u; break;
        }
        if (pi + 1 < nprog) xcd_barrier(xbar, wave_s);
    }
}

extern "C" void kernel_launch(void* const* d_in, const int* in_sizes, int n_in, void* d_out, int out_size, void* d_ws, size_t ws_size, hipStream_t stream) {
    const void* kfn = (const void*)fwd_kernel;
    static int grid = 0;
    if (grid == 0) {
        if (n_in != 25 || out_size != T * D || ws_size < WS_END) { fprintf(stderr, "kernel_launch: unexpected problem (n_in %d out %d ws %zu)\n", n_in, out_size, ws_size); grid = -1; return; }
        int dev = 0, cus = 0, per_cu = 0;
        (void)hipGetDevice(&dev); (void)hipDeviceGetAttribute(&cus, hipDeviceAttributeMultiprocessorCount, dev);
        (void)hipFuncSetAttribute(kfn, hipFuncAttributeMaxDynamicSharedMemorySize, LDS_BYTES);
        (void)hipOccupancyMaxActiveBlocksPerMultiprocessor(&per_cu, kfn, NTHREADS, LDS_BYTES);
        (void)hipGetLastError();
        if (per_cu < 1) { fprintf(stderr, "kernel_launch: occupancy query says %d blocks per CU\n", per_cu); grid = -1; return; }
        grid = cus;
    }
    if (grid < 0) return;
    (void)hipMemsetAsync((char*)d_ws + WS_CTL, 0, CTL_BYTES, stream);
    Args a{};
    for (int i = 0; i < 25; ++i) a.in[i] = (const float*)d_in[i];
    a.out = (float*)d_out; a.ws = (unsigned char*)d_ws;
    static const unsigned char program[] = PHASE_PROGRAM;
    const int np = (int)sizeof(program);
#if MK_ONE_LAUNCH
    a.nprog = np; for (int i = 0; i < np; ++i) a.prog[i >> 3] |= (unsigned long long)program[i] << ((i & 7) * 8);
    void* args[] = {&a};
    hipError_t e = hipLaunchCooperativeKernel(kfn, dim3(grid), dim3(NTHREADS), args, LDS_BYTES, stream);
    if (e != hipSuccess) fprintf(stderr, "cooperative launch failed: %s (grid %d)\n", hipGetErrorString(e), grid);
#else
    for (int p = 0; p < np; ++p) { a.nprog = 1; a.prog[0] = program[p]; void* args[] = {&a}; (void)hipLaunchKernel(kfn, dim3(grid), dim3(NTHREADS), args, LDS_BYTES, stream); }
#endif
}
```

```cpp
#include <hip/hip_runtime.h>
#include <hip/hip_cooperative_groups.h>
#include <cstdio>
#include <cstdint>
namespace cg = cooperative_groups;

#ifndef PHASE_PROGRAM
#define PHASE_PROGRAM {0, 1, 2, 3, 4, 5, 6, 7, 8, 9}
#endif
#ifndef MK_ONE_LAUNCH
#define MK_ONE_LAUNCH 1
#endif

#define LAS __attribute__((address_space(3)))
typedef unsigned short bf16_t;
typedef short bf16x8 __attribute__((ext_vector_type(8)));
typedef float f32x4 __attribute__((ext_vector_type(4)));
typedef unsigned u32x4 __attribute__((ext_vector_type(4)));
typedef unsigned u32x2 __attribute__((ext_vector_type(2)));
typedef float f32x16 __attribute__((ext_vector_type(16)));
typedef float f32x2_t __attribute__((ext_vector_type(2)));
typedef __bf16 bf16x2_t __attribute__((ext_vector_type(2)));
typedef int i32x4 __attribute__((ext_vector_type(4)));
typedef int i32x8 __attribute__((ext_vector_type(8)));

constexpr int D = 1024, BATCH = 16, SEQ = 2048, T = BATCH * SEQ;
constexpr int NZ = 3840;
constexpr int ZQ = 0, ZK = 512, ZV = 640, ZU = 768, ZVS = 1280, ZGA = 1792, ZGS = 2816;
constexpr int NE = 32, TOPK = 4, DE = 1024;
constexpr int KSPLIT = 16;
constexpr float EPS = 1e-6f;
constexpr int LISTCAP = T;
constexpr int APAD = T * TOPK + NE * 256;
constexpr int PF8 = 1280;

constexpr size_t MiB = 1u << 20;
constexpr size_t WS_CTL = 0, CTL_BYTES = 1 * MiB;
constexpr size_t WS_MODP = 1 * MiB;
constexpr size_t WS_WIN = 8 * MiB;
constexpr size_t WS_WBA = 16 * MiB, WS_WBS = 17 * MiB;
constexpr size_t WS_WOUT = 18 * MiB;
constexpr size_t WS_SGW = 20 * MiB;
constexpr size_t WS_W1 = 24 * MiB;
constexpr size_t WS_W2 = 152 * MiB;
constexpr size_t WS_HF8 = 216 * MiB;
constexpr size_t WS_WING8 = 8 * MiB + (size_t)1792 * 2048;
constexpr size_t WS_H2 = 216 * MiB;
constexpr size_t WS_Z = 280 * MiB;
constexpr size_t WS_YATT = 520 * MiB, WS_YSG = 552 * MiB;
constexpr size_t WS_X1B = 520 * MiB;
constexpr size_t WS_H = 584 * MiB;
constexpr size_t WS_Y = 648 * MiB;
constexpr size_t WS_G8 = 648 * MiB;
constexpr size_t WS_ACT = 280 * MiB;
constexpr size_t WS_YS = 584 * MiB;
constexpr size_t WS_LISTS = 824 * MiB;
constexpr size_t WS_TOKINFO = 828 * MiB;
constexpr size_t WS_VT = 960 * MiB;
constexpr size_t WS_GVT = 968 * MiB;
constexpr size_t WS_END = 1000 * MiB;
constexpr size_t CTL_LNSTAT = 256 * 1024;
constexpr int CW_CNT = 64;
constexpr int CW_BAR = 4096;

constexpr int RING_BYTES = 131072;
constexpr int MISC_OFF = RING_BYTES;
constexpr int LDS_BYTES = 147456;
constexpr int NWAVES = 8, NTHREADS = 512;

__device__ __forceinline__ float bf2f(unsigned h) { return __uint_as_float(h << 16); }
__device__ __forceinline__ unsigned f2bf(float f) { unsigned u = __float_as_uint(f); return (u + 0x7fffu + ((u >> 16) & 1u)) >> 16; }
__device__ __forceinline__ unsigned pk2(float lo, float hi) { return f2bf(lo) | (f2bf(hi) << 16); }
__device__ __forceinline__ void unpack8(const u32x4 r, float* o) {
    o[0] = __uint_as_float(r.x << 16); o[1] = __uint_as_float(r.x & 0xffff0000u);
    o[2] = __uint_as_float(r.y << 16); o[3] = __uint_as_float(r.y & 0xffff0000u);
    o[4] = __uint_as_float(r.z << 16); o[5] = __uint_as_float(r.z & 0xffff0000u);
    o[6] = __uint_as_float(r.w << 16); o[7] = __uint_as_float(r.w & 0xffff0000u);
}
__device__ __forceinline__ unsigned cvtpk(float lo, float hi) { const f32x2_t v = {lo, hi}; const bf16x2_t b = __builtin_convertvector(v, bf16x2_t); return __builtin_bit_cast(unsigned, b); }
constexpr float FP8_SW = 64.f, FP8_SH = 4.f, FP8_SA = 4.f, FP8_SY = 16.f;
__device__ __forceinline__ float fp8_clamp(float v) { return fminf(fmaxf(v, -448.f), 448.f); }
__device__ __forceinline__ unsigned cvt4_fp8(float a, float b, float c, float d, float sc) {
    unsigned w = 0; w = __builtin_amdgcn_cvt_pk_fp8_f32(fp8_clamp(a * sc), fp8_clamp(b * sc), w, false); w = __builtin_amdgcn_cvt_pk_fp8_f32(fp8_clamp(c * sc), fp8_clamp(d * sc), w, true); return w; }
#define MFMA32(a, b, c) __builtin_amdgcn_mfma_f32_32x32x16_bf16((a), (b), (c), 0, 0, 0)
#define VCONST2(x, f) do { float _c; asm volatile("v_mov_b32 %0, %1" : "=v"(_c) : "i"(__builtin_bit_cast(int, (float)(f)))); x[0] = _c; x[1] = _c; } while (0)
#define WS_DPP(v, CTRL) (v + __int_as_float(__builtin_amdgcn_update_dpp(0, __float_as_int(v), (CTRL), 0xf, 0xf, false)))
__device__ __forceinline__ float wave_sum(float v) {
    v = WS_DPP(v, 0xB1);
    v = WS_DPP(v, 0x4E);
    v = WS_DPP(v, 0x141);
    v = WS_DPP(v, 0x140);
    v += __shfl_xor(v, 16); v += __shfl_xor(v, 32);
    return v;
}
__device__ __forceinline__ float sigmoidf_(float x) { return __builtin_amdgcn_rcpf(1.f + __builtin_amdgcn_exp2f(-1.4426950408889634f * x)); }
__device__ __forceinline__ float gelu_tanh(float x) { const float t = x * fmaf(0.044715f * x, x, 1.f); return x * __builtin_amdgcn_rcpf(1.f + __builtin_amdgcn_exp2f(-2.302208198144325f * t)); }

struct Frame { LAS unsigned char* lds; int tid, lane, wave, G; };

namespace pg8 {
constexpr int BM = 256, BK = 64, HALF = 128, HTB = HALF * BK * 2, STAGE_BYTES = 8 * HTB, NXCD = 8, WGM = 8;
__host__ __device__ __forceinline__ int lds_byte(int r, int c) { return (r >> 3) * 1024 + (r & 7) * 128 + ((((c >> 3) ^ r) & 7) << 4) + (c & 7) * 2; }
__host__ __device__ __forceinline__ void stage_rc(int b, int& R, int& C) { const int piece = b >> 10, l16 = (b & 1023) >> 4, r8 = l16 >> 3, cp = l16 & 7; R = piece * 8 + r8; C = ((cp ^ r8) & 7) << 3; }
__host__ __device__ __forceinline__ int perm32(int rho) { const int n = rho >> 4, i = rho & 15; return 8 * (i >> 2) + 4 * n + (i & 3); }
__device__ __forceinline__ unsigned cvt_pk_bf16(float lo, float hi) { unsigned r; asm volatile("v_cvt_pk_bf16_f32 %0, %1, %2" : "=v"(r) : "v"(lo), "v"(hi)); return r; }

struct Unit { const char* A; const char* B; const int* tl; int pm, pn, e, kind, rowbase, nvalid; };
__device__ __forceinline__ const char* uptr(const char* p) { const unsigned long long v = (unsigned long long)p;
    const unsigned lo = __builtin_amdgcn_readfirstlane((unsigned)v), hi = __builtin_amdgcn_readfirstlane((unsigned)(v >> 32)); return (const char*)(((unsigned long long)hi << 32) | lo); }

__device__ __forceinline__ void tile_map(int L, int nM, int nN, int& pm, int& pn) {
    const int nwg = nM * nN;
    int wgid = L; { const int q = nwg / NXCD, r = nwg % NXCD, xcd = wgid % NXCD, off = wgid / NXCD; wgid = (xcd < r ? xcd * (q + 1) : r * (q + 1) + (xcd - r) * q) + off; }
    const int nig = WGM * nN, gid = wgid / nig, fm = gid * WGM, gsz = (nM - fm) < WGM ? (nM - fm) : WGM;
    pm = fm + ((wgid % nig) % gsz); pn = (wgid % nig) / gsz;
}

template <class Epi, class Sched, bool GATHER, bool FP8 = false>
__device__ __forceinline__ void gemm_phase(LAS unsigned char* lds, const int wid, const int Kb, const int Pa, const Sched& S, const Epi& E) {
#define PG8_LANE() ({ int _l; asm volatile("v_mbcnt_lo_u32_b32 %0, -1, 0\n\tv_mbcnt_hi_u32_b32 %0, -1, %0" : "=v"(_l)); _l; })
    const int lane = PG8_LANE(), tid = wid * 64 + lane, wr = wid >> 2, wc = wid & 3, fr = lane & 15, fq = lane >> 4;
    const int nt = Kb / 128;
    unsigned voffB[2]; unsigned oc[2][2], o2[2][2];
    LAS int* ids = (LAS int*)(lds + MISC_OFF + 2048);
    const size_t kstep = (size_t)(BK * 2);
    const size_t hstep = (size_t)HALF * Kb, hstepA = (size_t)HALF * Pa;
#pragma unroll
    for (int i = 0; i < 2; ++i) { int R, C; stage_rc(tid * 16 + i * 8192, R, C); const int Rb = (R & ~31) + perm32(R & 31);
        voffB[i] = (unsigned)(Rb * Kb) + (unsigned)C * 2u;
        oc[0][i] = (unsigned)(R * Pa) + (unsigned)C * 2u; oc[1][i] = oc[0][i] + (unsigned)hstepA; o2[0][i] = oc[0][i]; o2[1][i] = oc[1][i]; }
    const unsigned ldsw = (unsigned)wid * 1024u;
    const int aoff0 = lds_byte(wr * 64 + fr, fq * 8), aoff1 = lds_byte(wr * 64 + fr, fq * 8 + 32), boff0 = lds_byte(wc * 32 + fr, fq * 8), boff1 = lds_byte(wc * 32 + fr, fq * 8 + 32);
#define PG8_SA(b, h) (((b) * 2 + (h)) * HTB)
#define PG8_SB(b, h) ((4 + (b) * 2 + (h)) * HTB)
#define PG8_STAGE(bufoff, gbase, voff) do { const char* _g = uptr((const char*)(gbase)); _Pragma("unroll") for (int _i = 0; _i < 2; ++_i) { unsigned _o = (voff)[_i]; asm volatile("" : "+v"(_o)); \
        __builtin_amdgcn_global_load_lds((const unsigned*)(_g + _o), (LAS unsigned*)(lds + (bufoff) + ldsw + _i * 8192), 16, 0, 0); } } while (0)
#define PG8_STAGE_A(bufoff, gbase, h, O) do { const char* _g = uptr((const char*)(gbase) + (GATHER ? (size_t)0 : (size_t)(h) * hstepA)); _Pragma("unroll") for (int _i = 0; _i < 2; ++_i) { unsigned _o = (O)[GATHER ? (h) : 0][_i]; asm volatile("" : "+v"(_o)); \
        __builtin_amdgcn_global_load_lds((const unsigned*)(_g + _o), (LAS unsigned*)(lds + (bufoff) + ldsw + _i * 8192), 16, 0, 0); } } while (0)
#define PG8_CAT2(x, y) __builtin_shufflevector(__builtin_bit_cast(i32x4, (x)), __builtin_bit_cast(i32x4, (y)), 0, 1, 2, 3, 4, 5, 6, 7)
#define PG8_RDA(b, h, m, k) (*(const LAS bf16x8*)(lds + PG8_SA(b, h) + ((k) ? aoff1 : aoff0) + (m) * 2048))
#define PG8_RDB(b, h, n, k) (*(const LAS bf16x8*)(lds + PG8_SB(b, h) + ((k) ? boff1 : boff0) + (n) * 2048))
#define PG8_LDA(dst, b, h) do { _Pragma("unroll") for (int m = 0; m < 4; ++m) { \
        if constexpr (FP8) { dst##8[m] = PG8_CAT2(PG8_RDA(b, h, m, 0), PG8_RDA(b, h, m, 1)); } else { dst[m][0] = PG8_RDA(b, h, m, 0); dst[m][1] = PG8_RDA(b, h, m, 1); } } } while (0)
#define PG8_LDB(dst, b, h) do { _Pragma("unroll") for (int n = 0; n < 2; ++n) { \
        if constexpr (FP8) { dst##8[n] = PG8_CAT2(PG8_RDB(b, h, n, 0), PG8_RDB(b, h, n, 1)); } else { dst[n][0] = PG8_RDB(b, h, n, 0); dst[n][1] = PG8_RDB(b, h, n, 1); } } } while (0)
#define PG8_MMA(ai, bj, At, Bt) do { __builtin_amdgcn_s_setprio(1); \
        if constexpr (FP8) { _Pragma("unroll") for (int m = 0; m < 4; ++m) _Pragma("unroll") for (int n = 0; n < 2; ++n) \
            asm volatile(".p2align 3\n\tv_mfma_f32_16x16x128_f8f6f4 %0, %1, %2, %0" : "+v"(acc[ai][bj][m][n]) : "v"(Bt##8[n]), "v"(At##8[m])); } \
        else { _Pragma("unroll") for (int m = 0; m < 4; ++m) _Pragma("unroll") for (int n = 0; n < 2; ++n) _Pragma("unroll") for (int k = 0; k < 2; ++k) \
            asm volatile(".p2align 3\n\tv_mfma_f32_16x16x32_bf16 %0, %1, %2, %0" : "+v"(acc[ai][bj][m][n]) : "v"(Bt[n][k]), "v"(At[m][k])); } \
        __builtin_amdgcn_s_setprio(0); } while (0)
#define PG8_WAIT_V(n) asm volatile("s_waitcnt vmcnt(" #n ")" ::: "memory")
#define PG8_WAIT_L(n) asm volatile("s_waitcnt lgkmcnt(" #n ")" ::: "memory")
#define PG8_BAR __builtin_amdgcn_s_barrier()
#define PG8_SCHED __builtin_amdgcn_sched_barrier(0)
#define PG8_LOADOFFS(u, o) do { const int _t = wid * 64 + PG8_LANE(); _Pragma("unroll") for (int _i = 0; _i < 2; ++_i) { int _R, _C; stage_rc(_t * 16 + _i * 8192, _R, _C); \
        _Pragma("unroll") for (int _h = 0; _h < 2; ++_h) { int _row = _h * HALF + _R; _row = _row < (u).nvalid ? _row : (u).nvalid - 1; const int _tok = (u).tl[_row]; o[_h][_i] = (unsigned)_tok * (unsigned)Pa + (unsigned)_C * 2u; } } } while (0)
#define PG8_KITER(LAST) do { \
            const char* a1 = cA + (size_t)(t + 1) * kstep; \
            const char* a2 = (LAST) ? nA : cA + (size_t)(t + 2) * kstep; const char* b2 = (LAST) ? nB : cB + (size_t)(t + 2) * kstep; \
            const char* a3 = a2 + kstep; const char* b3 = b2 + kstep; \
            PG8_LDB(B0, 0, 0); PG8_LDB(B1, 0, 1); PG8_SCHED; PG8_LDA(At, 0, 0); PG8_STAGE_A(PG8_SA(1, 1), a1, 1, oc); \
            if constexpr (GATHER && (LAST)) { if (has_next) { const int _t = wid * 64 + PG8_LANE(); _Pragma("unroll") for (int _i = 0; _i < 2; ++_i) { int _R, _C; stage_rc(_t * 16 + _i * 8192, _R, _C); \
                _Pragma("unroll") for (int _h = 0; _h < 2; ++_h) { int _row = _h * HALF + _R; _row = _row < nxt.nvalid ? _row : nxt.nvalid - 1; o2[_h][_i] = (unsigned)ids[_row] * (unsigned)Pa + (unsigned)_C * 2u; } } } \
                else { _Pragma("unroll") for (int _h = 0; _h < 2; ++_h) _Pragma("unroll") for (int _i = 0; _i < 2; ++_i) o2[_h][_i] = oc[_h][_i]; } } \
            else { _Pragma("unroll") for (int _h = 0; _h < 2; ++_h) _Pragma("unroll") for (int _i = 0; _i < 2; ++_i) o2[_h][_i] = oc[_h][_i]; } \
            PG8_WAIT_V(8); PG8_WAIT_L(0); PG8_BAR; PG8_MMA(0, 0, At, B0); PG8_MMA(0, 1, At, B1); PG8_BAR; PG8_SCHED; \
            PG8_LDA(At, 0, 1); PG8_STAGE(PG8_SB(0, 0), b2, voffB); PG8_STAGE(PG8_SB(0, 1), b2 + hstep, voffB); PG8_STAGE_A(PG8_SA(0, 0), a2, 0, o2); \
            PG8_WAIT_V(8); PG8_WAIT_L(0); PG8_BAR; PG8_MMA(1, 0, At, B0); PG8_MMA(1, 1, At, B1); PG8_BAR; PG8_SCHED; \
            PG8_LDB(B0, 1, 0); PG8_LDB(B1, 1, 1); PG8_SCHED; PG8_LDA(At, 1, 0); PG8_STAGE_A(PG8_SA(0, 1), a2, 1, o2); \
            PG8_WAIT_V(8); PG8_WAIT_L(0); PG8_BAR; PG8_MMA(0, 0, At, B0); PG8_MMA(0, 1, At, B1); PG8_BAR; PG8_SCHED; \
            PG8_LDA(At, 1, 1); PG8_STAGE(PG8_SB(1, 0), b3, voffB); PG8_STAGE(PG8_SB(1, 1), b3 + hstep, voffB); PG8_STAGE_A(PG8_SA(1, 0), a3, 0, o2); \
            PG8_WAIT_V(8); PG8_WAIT_L(0); PG8_BAR; PG8_MMA(1, 0, At, B0); PG8_MMA(1, 1, At, B1); PG8_BAR; PG8_SCHED; \
        } while (0)
    Unit cur, nxt; int ui = 0;
    if (!S.next(0, cur)) return;
    f32x4 acc[2][2][4][2];
#pragma unroll
    for (int a = 0; a < 2; ++a)
#pragma unroll
        for (int b = 0; b < 2; ++b)
#pragma unroll
            for (int m = 0; m < 4; ++m)
#pragma unroll
                for (int n = 0; n < 2; ++n) acc[a][b][m][n] = (f32x4){0.f, 0.f, 0.f, 0.f};
    bf16x8 At[4][2], B0[2][2], B1[2][2]; i32x8 At8[4], B08[2], B18[2];
    const char* cA = cur.A; const char* cB = cur.B;
    if constexpr (GATHER) { PG8_LOADOFFS(cur, oc); }
    PG8_STAGE(PG8_SB(0, 0), cB, voffB); PG8_STAGE(PG8_SB(0, 1), cB + hstep, voffB); PG8_STAGE_A(PG8_SA(0, 0), cA, 0, oc); PG8_STAGE_A(PG8_SA(0, 1), cA, 1, oc);
    if (wr == 1) PG8_BAR;
    PG8_WAIT_V(2); PG8_BAR;
    PG8_STAGE(PG8_SB(1, 0), cB + kstep, voffB); PG8_STAGE_A(PG8_SA(1, 0), cA + kstep, 0, oc); PG8_STAGE(PG8_SB(1, 1), cB + hstep + kstep, voffB);
    PG8_WAIT_V(6); PG8_BAR;
    for (;;) {
        const bool has_next = S.next(ui + 1, nxt);
        const char* nA = has_next ? nxt.A : cA; const char* nB = has_next ? nxt.B : cB;
        if constexpr (GATHER) {
            if (has_next && wid < 4) __builtin_amdgcn_global_load_lds((const unsigned*)(nxt.tl + wid * 64 + PG8_LANE()), (LAS unsigned*)(ids + wid * 64), 4, 0, 0);
        }
        int t = 0;
#pragma nounroll
        for (; t < nt - 2; t += 2) PG8_KITER(false);
        PG8_KITER(true);
        if (wr == 0) PG8_BAR;
        asm volatile("s_nop 15\n\ts_nop 15" ::: "memory");
        const int lane_e = PG8_LANE();
        const bool keep = E(acc, cur, wr, wc, lane_e & 15, lane_e >> 4);
        if (!has_next) break;
        if (!keep) {
#pragma unroll
            for (int a = 0; a < 2; ++a)
#pragma unroll
                for (int b = 0; b < 2; ++b)
#pragma unroll
                    for (int m = 0; m < 4; ++m)
#pragma unroll
                        for (int n = 0; n < 2; ++n) acc[a][b][m][n] = (f32x4){0.f, 0.f, 0.f, 0.f};
        }
        cur = nxt; cA = nA; cB = nB; ++ui;
        if constexpr (GATHER) {
#pragma unroll
            for (int h = 0; h < 2; ++h)
#pragma unroll
                for (int i = 0; i < 2; ++i) oc[h][i] = o2[h][i];
        }
        if (wr == 1) PG8_BAR;
    }
    PG8_WAIT_V(0);
    PG8_BAR;
#undef PG8_SA
#undef PG8_SB
#undef PG8_STAGE
#undef PG8_STAGE_A
#undef PG8_LDA
#undef PG8_LDB
#undef PG8_MMA
#undef PG8_CAT2
#undef PG8_RDA
#undef PG8_RDB
#undef PG8_WAIT_V
#undef PG8_WAIT_L
#undef PG8_BAR
#undef PG8_SCHED
#undef PG8_LOADOFFS
#undef PG8_LANE
#undef PG8_KITER
}

struct SchedDense {
    const char* A; const char* B; int nM, nN, G, c; size_t tstepA, tstep;
    __device__ __forceinline__ bool next(int i, Unit& u) const {
        const long L = (long)i * G + c; if (L >= (long)nM * nN) return false;
        tile_map((int)L, nM, nN, u.pm, u.pn); u.A = A + (size_t)u.pm * tstepA; u.B = B + (size_t)u.pn * tstep;
        u.tl = nullptr; u.e = 0; u.kind = 0; u.rowbase = u.pm * BM; u.nvalid = BM; return true; }
};
struct SchedGate {
    const char* A; const char* B; int nM, nN, G, c; size_t tstepA, tstep;
    __device__ __forceinline__ bool next(int i, Unit& u) const {
        long L;
        if (G == 256) { if (i < 3) L = (long)i * G + c; else { if (c < 128 || i > 4) return false; L = 3L * G + (long)(i - 3) * 128 + (c - 128); } }
        else L = (long)i * G + c;
        if (L >= (long)nM * nN) return false;
        tile_map((int)L, nM, nN, u.pm, u.pn); u.A = A + (size_t)u.pm * tstepA; u.B = B + (size_t)u.pn * tstep;
        u.tl = nullptr; u.e = 0; u.kind = 0; u.rowbase = u.pm * BM; u.nvalid = BM; return true; }
};
struct SchedBranch {
    const char* A0; const char* B0; const char* A1; const char* B1; int nM, nN, G, c; size_t tstepA, tstep;
    __device__ __forceinline__ bool next(int i, Unit& u) const {
        const long L = (long)(i >> 1) * G + c; if (L >= (long)nM * nN) return false;
        tile_map((int)L, nM, nN, u.pm, u.pn); u.kind = i & 1;
        u.A = (u.kind ? A1 : A0) + (size_t)u.pm * tstepA; u.B = (u.kind ? B1 : B0) + (size_t)u.pn * tstep;
        u.tl = nullptr; u.e = 0; u.rowbase = u.pm * BM; u.nvalid = BM; return true; }
};
struct SchedMoE {
    const LAS int* tab;
    const char* A; const char* B; size_t bexp; const int* lists; int NT, G, c; size_t tstep; int pa; bool gather;
    __device__ __forceinline__ bool next(int i, Unit& u) const {
        const int nwg = __builtin_amdgcn_readfirstlane(tab[32]);
        const long L = (long)i * G + c; if (L >= nwg) return false;
        int wgid = (int)L; { const int q = nwg / NXCD, r = nwg % NXCD, xcd = wgid % NXCD, off = wgid / NXCD; wgid = (xcd < r ? xcd * (q + 1) : r * (q + 1) + (xcd - r) * q) + off; }
        const int ln = (int)__builtin_amdgcn_mbcnt_hi(~0u, __builtin_amdgcn_mbcnt_lo(~0u, 0u)), le = ln < 32 ? ln : 31;
        const int ulo = tab[le], uhi = tab[le + 1];
        const unsigned long long mm = __ballot(ln < 32 && ulo <= wgid && wgid < uhi);
        const int e = __builtin_amdgcn_readfirstlane((int)__builtin_ctzll(mm | (1ull << 31)));
        const int local = wgid - __builtin_amdgcn_readfirstlane(tab[e]); u.e = e; u.pm = local / NT; u.pn = local % NT; u.kind = 0;
        u.rowbase = __builtin_amdgcn_readfirstlane(tab[64 + e]) + u.pm * BM; int nv = __builtin_amdgcn_readfirstlane(tab[128 + e]) - u.pm * BM; u.nvalid = nv > BM ? BM : nv;
        u.B = B + (size_t)e * bexp + (size_t)u.pn * tstep;
        if (gather) { u.A = A; u.tl = lists + (size_t)e * LISTCAP + u.pm * BM; }
        else { u.A = A + (size_t)u.rowbase * pa; u.tl = nullptr; }
        return true; }
};

#define EPI_FOR_ROWS  _Pragma("unroll") for (int ai = 0; ai < 2; ++ai) _Pragma("unroll") for (int m = 0; m < 4; ++m)
struct EpiInProj {
    bf16_t* Z; const float* bias; bf16_t* VT; bf16_t* GVT; unsigned long long* lnstat;
    __device__ __forceinline__ bool operator()(f32x4 (&acc)[2][2][4][2], const Unit& u, int wr, int wc, int fr, int fq) const {
        const int pn = u.pn, act = pn < 2 ? 0 : (pn == 2 ? 1 : 2);
        const int col0 = pn * BM + wc * 32 + 8 * fq;
        f32x4 bv[2][2];
#pragma unroll
        for (int bj = 0; bj < 2; ++bj)
#pragma unroll
            for (int n = 0; n < 2; ++n) bv[bj][n] = *(const f32x4*)(bias + col0 + bj * HALF + 4 * n);
        EPI_FOR_ROWS { const int row = u.rowbase + ai * HALF + wr * 64 + m * 16 + fr; bf16_t* rowp = Z + (size_t)row * NZ + col0; float ls1 = 0.f, ls2 = 0.f;
#pragma unroll
            for (int bj = 0; bj < 2; ++bj) { f32x4 v0 = acc[ai][bj][m][0] + bv[bj][0], v1 = acc[ai][bj][m][1] + bv[bj][1];
                if (act == 0) { v0 = v0 * 0.125f; v1 = v1 * 0.125f; }
                else if (act == 2) {
#pragma unroll
                    for (int i = 0; i < 4; ++i) { v0[i] = gelu_tanh(v0[i]); v1[i] = gelu_tanh(v1[i]); } }
                u32x4 w; w.x = cvt_pk_bf16(v0[0], v0[1]); w.y = cvt_pk_bf16(v0[2], v0[3]); w.z = cvt_pk_bf16(v1[0], v1[1]); w.w = cvt_pk_bf16(v1[2], v1[3]);
                if (pn == 5 || pn == 6) {
                    float xv[8]; unpack8(w, xv);
#pragma unroll
                    for (int i = 0; i < 8; ++i) { ls1 += xv[i]; ls2 = fmaf(xv[i], xv[i], ls2); } }
                else *(u32x4*)(rowp + bj * HALF) = w;
                if ((pn == 2 && bj == 1) || pn == 5 || pn == 6) {
                    const int bt = row >> 11, sq = row & (SEQ - 1);
                    bf16_t* tp; int cs;
                    if (pn == 2) { tp = VT + ((size_t)(bt * 128 + wc * 32 + 8 * fq)) * SEQ + sq; cs = SEQ; }
                    else { const int gg = 4 * (pn - 5) + 2 * bj + (wc >> 1), dtt = wc & 1, chunk = sq >> 7, ks = (sq >> 4) & 7, hh = (sq >> 3) & 1, jj = sq & 7;
                        tp = GVT + ((size_t)(((((bt * 16 + chunk) * 8 + gg) * 8 + ks) * 2 + dtt)) * 512 + (hh * 32 + 8 * fq) * 8 + jj); cs = 8; }
                    tp[0 * cs] = (bf16_t)(w.x & 0xffffu); tp[1 * cs] = (bf16_t)(w.x >> 16); tp[2 * cs] = (bf16_t)(w.y & 0xffffu); tp[3 * cs] = (bf16_t)(w.y >> 16);
                    tp[4 * cs] = (bf16_t)(w.z & 0xffffu); tp[5 * cs] = (bf16_t)(w.z >> 16); tp[6 * cs] = (bf16_t)(w.w & 0xffffu); tp[7 * cs] = (bf16_t)(w.w >> 16); } }
            if (pn == 5 || pn == 6) {
                ls1 += __shfl_xor(ls1, 16); ls2 += __shfl_xor(ls2, 16); ls1 += __shfl_xor(ls1, 32); ls2 += __shfl_xor(ls2, 32);
                if (fq == 0) { atomicAdd(lnstat + (size_t)row * 2, (unsigned long long)(long long)rintf(ls1 * 1048576.f)); atomicAdd(lnstat + (size_t)row * 2 + 1, (unsigned long long)(long long)rintf(ls2 * 1048576.f)); } } }
        return false;
    }
};
struct EpiGate8 {
    unsigned char* G8; const float* bias;
    __device__ __forceinline__ bool operator()(f32x4 (&acc)[2][2][4][2], const Unit& u, int wr, int wc, int fr, int fq) const {
        const int col0 = u.pn * BM + wc * 32 + 8 * fq;
        const float ke = -1.4426950408889634f / (FP8_SH * FP8_SW);
        f32x4 bv[2][2];
#pragma unroll
        for (int bj = 0; bj < 2; ++bj)
#pragma unroll
            for (int n = 0; n < 2; ++n) bv[bj][n] = *(const f32x4*)(bias + col0 + bj * HALF + 4 * n) * -1.4426950408889634f;
        unsigned char* gp = G8 + ((size_t)((u.pm * 8 + u.pn) * 8 + wr * 4 + wc)) * 8192 + (fq * 16 + fr) * 8;
        EPI_FOR_ROWS {
#pragma unroll
            for (int bj = 0; bj < 2; ++bj) { u32x2 gq; gq.x = 0u; gq.y = 0u;
#pragma unroll
                for (int n = 0; n < 2; ++n) { unsigned pw = 0u;
#pragma unroll
                    for (int i = 0; i < 4; ++i) { const float e = __builtin_amdgcn_exp2f(fmaf(acc[ai][bj][m][n][i], ke, bv[bj][n][i]));
                        const float q = fmaxf(fmaf(__builtin_amdgcn_rcpf(1.f + e), 255.f, 0.5f), 1.f);
                        pw = __builtin_amdgcn_cvt_pk_u8_f32(q, i, pw); }
                    if (n == 0) gq.x = pw; else gq.y = pw; }
                *(u32x2*)(gp + ((ai * 4 + m) * 2 + bj) * 512) = gq; } }
        return false;
    }
};
struct EpiBranch {
    const unsigned char* G8; bf16_t* O;
    __device__ __forceinline__ bool operator()(f32x4 (&acc)[2][2][4][2], const Unit& u, int wr, int wc, int fr, int fq) const {
        const int col0 = u.pn * BM + wc * 32 + 8 * fq;
        const unsigned char* ga = G8 + ((size_t)((u.pm * 8 + u.pn) * 8 + wr * 4 + wc)) * 8192 + (fq * 16 + fr) * 8;
        const unsigned char* gs = ga + (size_t)4 * 8 * 8192;
#define EPI_CL16(g, o) asm volatile("" : "+v"(g[o + 0]), "+v"(g[o + 1]), "+v"(g[o + 2]), "+v"(g[o + 3]), "+v"(g[o + 4]), "+v"(g[o + 5]), "+v"(g[o + 6]), "+v"(g[o + 7]), \
            "+v"(g[o + 8]), "+v"(g[o + 9]), "+v"(g[o + 10]), "+v"(g[o + 11]), "+v"(g[o + 12]), "+v"(g[o + 13]), "+v"(g[o + 14]), "+v"(g[o + 15]))
        if (u.kind == 0) {
            u32x2 qa[16], qs[16];
#pragma unroll
            for (int k = 0; k < 16; ++k) { qa[k] = *(const u32x2*)(ga + k * 512); qs[k] = *(const u32x2*)(gs + k * 512); }
            EPI_CL16(qa, 0); EPI_CL16(qs, 0);
#pragma unroll
            for (int ai = 0; ai < 2; ++ai)
#pragma unroll
                for (int m = 0; m < 4; ++m)
#pragma unroll
                    for (int bj = 0; bj < 2; ++bj) { const int k = (ai * 4 + m) * 2 + bj;
#pragma unroll
                        for (int n = 0; n < 2; ++n) { const unsigned wa = n ? qa[k].y : qa[k].x, wsg = n ? qs[k].y : qs[k].x;
#pragma unroll
                            for (int i = 0; i < 4; ++i) acc[ai][bj][m][n][i] *= (float)((wa >> (8 * i)) & 255u) * __builtin_amdgcn_rcpf((float)((wsg >> (8 * i)) & 255u)); } }
            return true;
        }
        { u32x2 qs[16];
#pragma unroll
          for (int k = 0; k < 16; ++k) qs[k] = *(const u32x2*)(gs + k * 512);
          EPI_CL16(qs, 0);
#pragma unroll
          for (int ai = 0; ai < 2; ++ai)
#pragma unroll
            for (int m = 0; m < 4; ++m) { const int row = u.rowbase + ai * HALF + wr * 64 + m * 16 + fr; bf16_t* op = O + (size_t)row * D + col0;
#pragma unroll
                for (int bj = 0; bj < 2; ++bj) { const int k = (ai * 4 + m) * 2 + bj; float g[8];
#pragma unroll
                    for (int i = 0; i < 4; ++i) { g[i] = (float)((qs[k].x >> (8 * i)) & 255u) * (1.f / 255.f); g[4 + i] = (float)((qs[k].y >> (8 * i)) & 255u) * (1.f / 255.f); }
                    const f32x4 v0 = acc[ai][bj][m][0], v1 = acc[ai][bj][m][1];
                    u32x4 w; w.x = cvt_pk_bf16(v0[0] * g[0], v0[1] * g[1]); w.y = cvt_pk_bf16(v0[2] * g[2], v0[3] * g[3]); w.z = cvt_pk_bf16(v1[0] * g[4], v1[1] * g[5]); w.w = cvt_pk_bf16(v1[2] * g[6], v1[3] * g[7]);
                    *(u32x4*)(op + bj * HALF) = w; } } }
#undef EPI_CL16
        return false;
    }
};
struct EpiBiasBf16 {
    bf16_t* O; int ldo; const float* bias; int bstride; float sc; int mode;
    __device__ __forceinline__ bool operator()(f32x4 (&acc)[2][2][4][2], const Unit& u, int wr, int wc, int fr, int fq) const {
        if (mode & 4) return false;
        const int col0 = u.pn * BM + wc * 32 + 8 * fq; const float* bp = bias + (size_t)u.e * bstride + col0;
        f32x4 bv[2][2];
#pragma unroll
        for (int bj = 0; bj < 2; ++bj)
#pragma unroll
            for (int n = 0; n < 2; ++n) bv[bj][n] = (f32x4){0.f, 0.f, 0.f, 0.f};
        if (!(mode & 1)) {
#pragma unroll
        for (int bj = 0; bj < 2; ++bj)
#pragma unroll
            for (int n = 0; n < 2; ++n) bv[bj][n] = *(const f32x4*)(bp + bj * HALF + 4 * n);
        }
        EPI_FOR_ROWS { const int row = u.rowbase + ai * HALF + wr * 64 + m * 16 + fr; bf16_t* op = O + (size_t)row * ldo + col0;
#pragma unroll
            for (int bj = 0; bj < 2; ++bj) { const f32x4 v0 = acc[ai][bj][m][0] * sc + bv[bj][0], v1 = acc[ai][bj][m][1] * sc + bv[bj][1];
                u32x4 w; w.x = cvt_pk_bf16(v0[0], v0[1]); w.y = cvt_pk_bf16(v0[2], v0[3]); w.z = cvt_pk_bf16(v1[0], v1[1]); w.w = cvt_pk_bf16(v1[2], v1[3]);
                if (mode & 2) asm volatile("" :: "v"(w)); else *(u32x4*)(op + bj * HALF) = w; } }
        return false;
    }
};
struct EpiBiasFp8 {
    unsigned char* O; const float* bias; int bstride; float sc; int mode;
    __device__ __forceinline__ bool operator()(f32x4 (&acc)[2][2][4][2], const Unit& u, int wr, int wc, int fr, int fq) const {
        if (mode & 4) return false;
        const int col0 = u.pn * BM + wc * 32 + 8 * fq; const float* bp = bias + (size_t)u.e * bstride + col0;
        f32x2_t sc2; VCONST2(sc2, FP8_SY / (FP8_SA * FP8_SW));
        f32x2_t bv[2][4];
#pragma unroll
        for (int bj = 0; bj < 2; ++bj)
#pragma unroll
            for (int n = 0; n < 2; ++n) { const f32x4 t = *(const f32x4*)(bp + bj * HALF + 4 * n);
                bv[bj][2 * n][0] = t[0] * FP8_SY; bv[bj][2 * n][1] = t[1] * FP8_SY; bv[bj][2 * n + 1][0] = t[2] * FP8_SY; bv[bj][2 * n + 1][1] = t[3] * FP8_SY; }
        const int odd = fq & 1;
#pragma unroll
        for (int ai = 0; ai < 2; ++ai)
#pragma unroll
            for (int mp = 0; mp < 2; ++mp) { const int row = u.rowbase + ai * HALF + wr * 64 + (2 * mp + odd) * 16 + fr; unsigned char* op = O + (size_t)row * PF8 + (col0 - 8 * odd);
#pragma unroll
                for (int bj = 0; bj < 2; ++bj) { u32x2 w[2];
#pragma unroll
                    for (int q = 0; q < 2; ++q) { const int m = 2 * mp + q; unsigned wq[2];
#pragma unroll
                        for (int n = 0; n < 2; ++n) { unsigned pw = 0;
#pragma unroll
                            for (int hh = 0; hh < 2; ++hh) { f32x2_t a2; a2[0] = acc[ai][bj][m][n][2 * hh]; a2[1] = acc[ai][bj][m][n][2 * hh + 1];
                                f32x2_t v2 = a2 * sc2 + bv[bj][2 * n + hh]; v2[0] = __builtin_amdgcn_fmed3f(v2[0], -448.f, 448.f); v2[1] = __builtin_amdgcn_fmed3f(v2[1], -448.f, 448.f);
                                pw = hh ? __builtin_amdgcn_cvt_pk_fp8_f32(v2[0], v2[1], pw, true) : __builtin_amdgcn_cvt_pk_fp8_f32(v2[0], v2[1], pw, false); }
                            wq[n] = pw; }
                        w[q].x = wq[0]; w[q].y = wq[1]; }
                    const auto rx = __builtin_amdgcn_permlane16_swap(w[0].x, w[1].x, false, false); const auto ry = __builtin_amdgcn_permlane16_swap(w[0].y, w[1].y, false, false);
                    const u32x4 o = (u32x4){rx[0], ry[0], rx[1], ry[1]};
                    if (mode & 2) asm volatile("" :: "v"(o));
                    else if (mode & 1) { const int ln = fq * 16 + fr; *(u32x4*)(O + (size_t)(u.rowbase + ai * HALF + wr * 64 + (wc & 1) * 32 + (mp * 2 + bj) * 8 + (ln >> 3)) * PF8 + u.pn * BM + (wc >> 1) * 128 + (ln & 7) * 16) = o; }
                    else *(u32x4*)(op + bj * HALF) = o; } }
        return false;
    }
};
struct EpiSwiGLU {
    unsigned char* O; const float* b1; int mode;
    __device__ __forceinline__ bool operator()(f32x4 (&acc)[2][2][4][2], const Unit& u, int wr, int wc, int fr, int fq) const {
        if (mode & 4) return false;
        const int cl = wc * 32 + 8 * fq, colo = u.pn * HALF + cl; const float* bp = b1 + (size_t)u.e * (2 * DE) + colo;
        f32x2_t isc2, sa2, nc2, one2;
        VCONST2(isc2, 1.f / (FP8_SH * FP8_SW)); VCONST2(sa2, FP8_SA); VCONST2(nc2, -2.4554669595930157f); VCONST2(one2, 1.f);
        f32x2_t bg[4], bl[4];
        { f32x4 t[4];
#pragma unroll
          for (int n = 0; n < 2; ++n) { t[n] = *(const f32x4*)(bp + 4 * n); t[2 + n] = *(const f32x4*)(bp + DE + 4 * n); }
#pragma unroll
          for (int n = 0; n < 2; ++n) { bg[2 * n][0] = t[n][0]; bg[2 * n][1] = t[n][1]; bg[2 * n + 1][0] = t[n][2]; bg[2 * n + 1][1] = t[n][3];
              bl[2 * n][0] = t[2 + n][0]; bl[2 * n][1] = t[2 + n][1]; bl[2 * n + 1][0] = t[2 + n][2]; bl[2 * n + 1][1] = t[2 + n][3]; } }
        const int odd = fq & 1;
#pragma unroll
        for (int ai = 0; ai < 2; ++ai)
#pragma unroll
            for (int mp = 0; mp < 2; ++mp) { const int row = u.rowbase + ai * HALF + wr * 64 + (2 * mp + odd) * 16 + fr; u32x2 w[2];
#pragma unroll
                for (int q = 0; q < 2; ++q) { const int m = 2 * mp + q; unsigned wq[2];
#pragma unroll
                    for (int n = 0; n < 2; ++n) { unsigned pw = 0;
#pragma unroll
                        for (int hh = 0; hh < 2; ++hh) { f32x2_t a2, c2; a2[0] = acc[ai][0][m][n][2 * hh]; a2[1] = acc[ai][0][m][n][2 * hh + 1]; c2[0] = acc[ai][1][m][n][2 * hh]; c2[1] = acc[ai][1][m][n][2 * hh + 1];
                            f32x2_t g2 = a2 * isc2 + bg[2 * n + hh], l2 = c2 * isc2 + bl[2 * n + hh];
                            g2[0] = fminf(g2[0], 7.f); g2[1] = fminf(g2[1], 7.f); l2[0] = __builtin_amdgcn_fmed3f(l2[0], -7.f, 7.f); l2[1] = __builtin_amdgcn_fmed3f(l2[1], -7.f, 7.f);
                            const f32x2_t l1 = l2 * sa2 + sa2;
                            f32x2_t e2 = g2 * nc2; e2[0] = __builtin_amdgcn_exp2f(e2[0]); e2[1] = __builtin_amdgcn_exp2f(e2[1]);
                            f32x2_t d2 = e2 + one2; d2[0] = __builtin_amdgcn_rcpf(d2[0]); d2[1] = __builtin_amdgcn_rcpf(d2[1]);
                            const f32x2_t r2 = (g2 * l1) * d2;
                            pw = hh ? __builtin_amdgcn_cvt_pk_fp8_f32(r2[0], r2[1], pw, true) : __builtin_amdgcn_cvt_pk_fp8_f32(r2[0], r2[1], pw, false); }
                        wq[n] = pw; }
                    w[q].x = wq[0]; w[q].y = wq[1]; }
                const auto rx = __builtin_amdgcn_permlane16_swap(w[0].x, w[1].x, false, false); const auto ry = __builtin_amdgcn_permlane16_swap(w[0].y, w[1].y, false, false);
                const u32x4 o = (u32x4){rx[0], ry[0], rx[1], ry[1]};
                if (mode & 2) asm volatile("" :: "v"(o)); else *(u32x4*)(O + (size_t)row * PF8 + (colo - 8 * odd)) = o; }
        return false;
    }
};
}

struct P0Item { const float* src; unsigned char* dst; int N, K, fp8; };
constexpr int NZB = 1792, NZG = NZ - NZB;
constexpr int P0_N_WIN = (D / 64) * (NZB / 32), P0_N_WING = (D / 64) * (NZG / 32), P0_N_WB = (512 / 64) * (D / 32), P0_N_WOUT = (D / 64) * (D / 32), P0_N_W1 = (D / 64) * (2 * DE / 32), P0_N_W2 = (DE / 64) * (D / 32);
constexpr int P0_B0 = P0_N_WIN, P0_B1 = P0_B0 + P0_N_WING, P0_B2 = P0_B1 + P0_N_WB, P0_B3 = P0_B2 + P0_N_WB, P0_B4 = P0_B3 + P0_N_WOUT, P0_B5 = P0_B4 + NE * P0_N_W1, P0_TOTAL = P0_B5 + NE * P0_N_W2;
struct Args { const float* in[25]; float* out; unsigned char* ws; unsigned long long prog[3]; int nprog, pad; };
typedef const __attribute__((address_space(4))) Args* ArgsP;

__device__ __forceinline__ void p0_decode(ArgsP a, unsigned char* ws, int g, P0Item& I) {
    const float* W; unsigned char* WT; int K, N, l, fp8 = 0, w1 = 0, nblk = 0;
    if (g < P0_B0)      { l = g;         W = a->in[6];  WT = ws + WS_WIN;  K = D;   N = NZ; nblk = NZB / 32; }
    else if (g < P0_B1) { l = g - P0_B0; W = a->in[6] + NZB; WT = ws + WS_WING8; K = D; N = NZ; nblk = NZG / 32; fp8 = 1; }
    else if (g < P0_B2) { l = g - P0_B1; W = a->in[13]; WT = ws + WS_WBA;  K = 512; N = D; }
    else if (g < P0_B3) { l = g - P0_B2; W = a->in[14]; WT = ws + WS_WBS;  K = 512; N = D; }
    else if (g < P0_B4) { l = g - P0_B3; W = a->in[15]; WT = ws + WS_WOUT; K = D;   N = D; }
    else if (g < P0_B5) { const int q = g - P0_B4, e = q / P0_N_W1; l = q - e * P0_N_W1; W = a->in[21] + (size_t)e * D * 2 * DE; WT = ws + WS_W1 + (size_t)e * 2 * DE * D; K = D; N = 2 * DE; fp8 = 1; w1 = 1; }
    else                { const int q = g - P0_B5, e = q / P0_N_W2; l = q - e * P0_N_W2; W = a->in[23] + (size_t)e * DE * D;     WT = ws + WS_W2 + (size_t)e * D * DE;      K = DE; N = D; fp8 = 1; }
    if (nblk == 0) nblk = N >> 5;
    int kb, nb;
    if (fp8) { const int q = l >> 1, kbp = q / nblk; nb = q - kbp * nblk; kb = 2 * kbp + (l & 1); } else { kb = l / nblk; nb = l - kb * nblk; }
    const int n0 = nb * 32, k0 = kb * 64;
    int drow0 = n0;
    if (w1) drow0 = (n0 < DE) ? ((n0 >> 7) * 256 + (n0 & 127)) : (((n0 - DE) >> 7) * 256 + 128 + ((n0 - DE) & 127));
    I.src = W + (size_t)k0 * N + n0; I.dst = WT + ((size_t)drow0 * K + k0) * (fp8 ? 1 : 2); I.N = N; I.K = K; I.fp8 = fp8;
}
#define P0_LOAD(I, R) do { const float* _s = (I).src + (size_t)(lane >> 3) * (I).N + 4 * (lane & 7); const size_t _st = (size_t)8 * (I).N; \
        _Pragma("unroll") for (int _i = 0; _i < 8; ++_i) R[_i] = __builtin_nontemporal_load((const f32x4*)(_s + _i * _st)); } while (0)
#define P0_PIN(R) asm volatile("" : "+v"(R[0]), "+v"(R[1]), "+v"(R[2]), "+v"(R[3]), "+v"(R[4]), "+v"(R[5]), "+v"(R[6]), "+v"(R[7]) :: "memory")
__device__ __forceinline__ void p0_to_lds(f32x4 (&R)[8], LAS float* scr, int lane) {
#pragma unroll
    for (int i = 0; i < 8; ++i) { LAS float* d = scr + ((lane >> 3) + 8 * i) * 33 + 4 * (lane & 7); d[0] = R[i][0]; d[1] = R[i][1]; d[2] = R[i][2]; d[3] = R[i][3]; }
    asm volatile("s_waitcnt lgkmcnt(0)" ::: "memory");
}
__device__ __forceinline__ void p0_from_lds(const P0Item& I, LAS float* scr, int lane) {
    const int c = lane & 7;
    if (I.fp8) {
#pragma unroll
        for (int j = 0; j < 4; ++j) { const int n = (lane >> 3) + 8 * j; const LAS float* t = scr + (8 * c) * 33 + n;
            u32x2 o; o.x = cvt4_fp8(t[0 * 33], t[1 * 33], t[2 * 33], t[3 * 33], FP8_SW); o.y = cvt4_fp8(t[4 * 33], t[5 * 33], t[6 * 33], t[7 * 33], FP8_SW);
            __builtin_nontemporal_store(o, (u32x2*)(I.dst + (size_t)n * I.K + 8 * c)); }
    } else {
#pragma unroll
        for (int j = 0; j < 4; ++j) { const int n = (lane >> 3) + 8 * j; const LAS float* t = scr + (8 * c) * 33 + n;
            u32x4 o; o.x = pk2(t[0 * 33], t[1 * 33]); o.y = pk2(t[2 * 33], t[3 * 33]); o.z = pk2(t[4 * 33], t[5 * 33]); o.w = pk2(t[6 * 33], t[7 * 33]);
            *(u32x4*)(I.dst + ((size_t)n * I.K + 8 * c) * 2) = o; }
    }
    asm volatile("s_waitcnt lgkmcnt(0)" ::: "memory");
}

__device__ __forceinline__ void phase0(Frame& F, ArgsP a) {
    unsigned char* ws = a->ws;
    {
        const float* c_in = a->in[1]; const float* w_mod = a->in[2]; float* modp = (float*)(ws + WS_MODP);
        LAS float* cact = (LAS float*)F.lds;
        for (int it = blockIdx.x; it < KSPLIT * 16; it += F.G) {
            const int ks = it >> 4, nc = it & 15, k0 = ks * 64; const bool act = F.tid < 384; const int n = nc * 384 + (act ? F.tid : 0);
            for (int idx = F.tid; idx < 1024; idx += NTHREADS) { const int b = idx & 15, kk = idx >> 4; const float cv = c_in[b * D + k0 + kk]; cact[kk * 16 + b] = cv * sigmoidf_(cv); }
            __syncthreads();
            float acc[16];
#pragma unroll
            for (int b = 0; b < 16; ++b) acc[b] = 0.f;
#pragma unroll 1
            for (int kb = 0; kb < 4; ++kb) { float wv[16];
#pragma unroll
                for (int j = 0; j < 16; ++j) wv[j] = __builtin_nontemporal_load(w_mod + (size_t)(k0 + 16 * kb + j) * 6144 + n);
                asm volatile("" : "+v"(wv[0]), "+v"(wv[1]), "+v"(wv[2]), "+v"(wv[3]), "+v"(wv[4]), "+v"(wv[5]), "+v"(wv[6]), "+v"(wv[7]), "+v"(wv[8]), "+v"(wv[9]), "+v"(wv[10]), "+v"(wv[11]), "+v"(wv[12]), "+v"(wv[13]), "+v"(wv[14]), "+v"(wv[15]));
#pragma unroll
                for (int j = 0; j < 16; ++j) { const int kk = 16 * kb + j; const float w = wv[j];
#pragma unroll
                    for (int b4 = 0; b4 < 4; ++b4) { const f32x4 cv = *(const LAS f32x4*)(cact + kk * 16 + 4 * b4);
                        acc[4 * b4 + 0] += cv[0] * w; acc[4 * b4 + 1] += cv[1] * w; acc[4 * b4 + 2] += cv[2] * w; acc[4 * b4 + 3] += cv[3] * w; } } }
            if (act) {
#pragma unroll
                for (int b = 0; b < 16; ++b) modp[((size_t)ks * 16 + b) * 6144 + n] = acc[b]; }
            __syncthreads();
        }
    }
    { const float* sg_w = a->in[11]; bf16_t* SGW = (bf16_t*)(ws + WS_SGW);
      for (int idx = blockIdx.x * NTHREADS + F.tid; idx < 8 * 128 * 128 / 2; idx += F.G * NTHREADS) { const int e0 = 2 * idx, j = e0 & 7, L = (e0 >> 3) & 63, tt = (e0 >> 9) & 3, ks = (e0 >> 11) & 7, g = e0 >> 14;
          const int t = 32 * tt + (L & 31), sc = 16 * ks + 8 * (L >> 5) + j; const float* src = sg_w + ((size_t)g * 128 + t) * 128 + sc;
          const float w0 = sc <= t ? src[0] : 0.f, w1 = sc + 1 <= t ? src[1] : 0.f; ((unsigned*)SGW)[idx] = pk2(w0, w1); } }
    { int gw = blockIdx.x * NWAVES + F.wave; asm volatile("" : "+s"(gw));
      const int NGW = F.G * NWAVES; const int lane = F.lane;
      LAS float* scr = (LAS float*)(F.lds + F.wave * 16384);
      P0Item IA, IB, IC; f32x4 ra[8], rb[8];
      int g = gw;
      { const int g2 = g + NGW; p0_decode(a, ws, g < P0_TOTAL ? g : 0, IA); P0_LOAD(IA, ra); p0_decode(a, ws, g2 < P0_TOTAL ? g2 : 0, IB); P0_LOAD(IB, rb); }
#pragma unroll 1
      while (g < P0_TOTAL) {
          const int g2 = g + NGW, g3 = g2 + NGW, g4 = g3 + NGW;
          P0_PIN(ra); p0_to_lds(ra, scr, lane); IC = IA; p0_decode(a, ws, g3 < P0_TOTAL ? g3 : 0, IA); P0_LOAD(IA, ra); p0_from_lds(IC, scr, lane);
          if (g2 >= P0_TOTAL) break;
          P0_PIN(rb); p0_to_lds(rb, scr, lane); IC = IB; p0_decode(a, ws, g4 < P0_TOTAL ? g4 : 0, IB); P0_LOAD(IB, rb); p0_from_lds(IC, scr, lane);
          g = g3;
      }
    }
}

template <int NI>
__device__ __forceinline__ void load_mod(Frame& F, ArgsP a, int b, int col0, LAS float* dst) {
    const float* modp = (const float*)(a->ws + WS_MODP); const float* b_mod = a->in[3];
    static_assert(KSPLIT == 16, "the clustering statement below names 16 values");
    float pv[NI][KSPLIT], s[NI];
#pragma unroll
    for (int j = 0; j < NI; ++j) { const int col = col0 + F.tid + j * NTHREADS; s[j] = b_mod[col];
#pragma unroll
        for (int ks = 0; ks < KSPLIT; ++ks) pv[j][ks] = modp[((size_t)ks * 16 + b) * 6144 + col]; }
#pragma unroll
    for (int j = 0; j < NI; ++j)
        asm volatile("" : "+v"(pv[j][0]), "+v"(pv[j][1]), "+v"(pv[j][2]), "+v"(pv[j][3]), "+v"(pv[j][4]), "+v"(pv[j][5]), "+v"(pv[j][6]), "+v"(pv[j][7]), "+v"(pv[j][8]), "+v"(pv[j][9]), "+v"(pv[j][10]), "+v"(pv[j][11]), "+v"(pv[j][12]), "+v"(pv[j][13]), "+v"(pv[j][14]), "+v"(pv[j][15]));
#pragma unroll
    for (int j = 0; j < NI; ++j) { float t = s[j];
#pragma unroll
        for (int ks = 0; ks < KSPLIT; ++ks) t += pv[j][ks];
        dst[F.tid + j * NTHREADS] = t; }
}

__device__ __forceinline__ void phase0b(Frame& F, ArgsP a) {
    const float* x = a->in[0]; const float* g = a->in[4]; bf16_t* H = (bf16_t*)(a->ws + WS_H); unsigned char* HF8 = a->ws + WS_HF8;
    LAS float* mv = (LAS float*)F.lds;
    for (int chunk = blockIdx.x; chunk < T / 128; chunk += F.G) {
        const int b = chunk / 16;
        load_mod<4>(F, a, b, 0, mv);
        for (int idx = F.tid; idx < 1024; idx += NTHREADS) mv[1024 + idx] = g[idx] * (1.f + mv[1024 + idx]);
        __syncthreads();
        for (int tt = 0; tt < 16; ++tt) {
            const int row = chunk * 128 + F.wave * 16 + tt;
            const f32x4* xr = (const f32x4*)(x + (size_t)row * D) + F.lane;
            f32x4 v[4]; float ss = 0.f;
#pragma unroll
            for (int j = 0; j < 4; ++j) { v[j] = __builtin_nontemporal_load(xr + 64 * j); ss += (v[j][0] * v[j][0] + v[j][1] * v[j][1]) + (v[j][2] * v[j][2] + v[j][3] * v[j][3]); }
            const float rstd = rsqrtf(wave_sum(ss) * (1.f / D) + EPS);
            u32x2* o8 = (u32x2*)(H + (size_t)row * D) + F.lane;
#pragma unroll
            for (int j = 0; j < 4; ++j) { const int col = 4 * F.lane + 256 * j; float r[4];
#pragma unroll
                for (int i = 0; i < 4; ++i) r[i] = (v[j][i] * rstd) * mv[1024 + col + i] + mv[col + i];
                u32x2 w; w.x = pk2(r[0], r[1]); w.y = pk2(r[2], r[3]); o8[64 * j] = w;
                ((unsigned*)(HF8 + (size_t)row * PF8))[F.lane + 64 * j] = cvt4_fp8(r[0], r[1], r[2], r[3], FP8_SH); }
        }
        __syncthreads();
    }
}

__device__ __forceinline__ void attn_item_mfma(Frame& F, ArgsP a, int item) {
    const int kvh = item & 1, n = (item >> 1) & 15, b = item >> 5;
    const bf16_t* Z = (const bf16_t*)(a->ws + WS_Z); const bf16_t* VT = (const bf16_t*)(a->ws + WS_VT); bf16_t* YA = (bf16_t*)(a->ws + WS_YATT);
    LAS bf16_t* Ks = (LAS bf16_t*)F.lds;
    LAS bf16_t* Vs = Ks + 256 * 72;
    const int tok0 = b * SEQ + n * 128;
    {
        u32x4 kr[4], vr[4]; int tid_o = F.tid; asm volatile("" : "+v"(tid_o));
#pragma unroll
        for (int it = 0; it < 4; ++it) { const int c = tid_o + it * NTHREADS, kj = c >> 3, ch = c & 7; const bool ok = n > 0 || kj >= 128;
            kr[it] = *(const u32x4*)(Z + (size_t)(tok0 + (ok ? kj - 128 : kj)) * NZ + ZK + kvh * 64 + ch * 8); }
#pragma unroll
        for (int it = 0; it < 4; ++it) { const int c = tid_o + it * NTHREADS, d = c >> 5, ch = c & 31; const bool ok = n > 0 || ch >= 16;
            vr[it] = *(const u32x4*)(VT + (size_t)(b * 128 + kvh * 64 + d) * SEQ + n * 128 + (ok ? ch - 16 : ch) * 8); }
        asm volatile("" : "+v"(kr[0]), "+v"(kr[1]), "+v"(kr[2]), "+v"(kr[3]), "+v"(vr[0]), "+v"(vr[1]), "+v"(vr[2]), "+v"(vr[3]));
#pragma unroll
        for (int it = 0; it < 4; ++it) { const int c = tid_o + it * NTHREADS, kj = c >> 3, ch = c & 7; const bool ok = n > 0 || kj >= 128;
            *(LAS u32x4*)(Ks + kj * 72 + ch * 8) = ok ? kr[it] : (u32x4){0u, 0u, 0u, 0u}; }
#pragma unroll
        for (int it = 0; it < 4; ++it) { const int c = tid_o + it * NTHREADS, d = c >> 5, ch = c & 31; const bool ok = n > 0 || ch >= 16;
            *(LAS u32x4*)(Vs + d * 264 + ch * 8) = ok ? vr[it] : (u32x4){0u, 0u, 0u, 0u}; }
    }
    __syncthreads();
    const int r = F.lane & 31, h = F.lane >> 5;
    const int pr = (r & ~12) | ((r & 4) << 1) | ((r & 8) >> 1);
#pragma unroll 1
    for (int j = 0; j < 2; ++j) {
        const int tk = F.wave * 2 + j, g = tk >> 2, qs = tk & 3, hq = kvh * 4 + g;
        const int qi = 32 * qs + r;
        const bf16_t* qp = Z + (size_t)(tok0 + qi) * NZ + ZQ + hq * 64 + 8 * h;
        bf16x8 qf[4];
#pragma unroll
        for (int ks = 0; ks < 4; ++ks) qf[ks] = *(const bf16x8*)(qp + 16 * ks);
        const float slope = exp2f(-(float)(hq + 1)), sink = a->in[8][hq];
        float mrun = sink, lsum = 0.f;
        f32x16 O[2];
#pragma unroll
        for (int dt = 0; dt < 2; ++dt)
#pragma unroll
            for (int i = 0; i < 16; ++i) O[dt][i] = 0.f;
        const float nsl2 = -slope * 1.4426950408889634f;
        const float sink2 = sink * 1.4426950408889634f;
        mrun = sink2;
#pragma unroll
        for (int tt = 0; tt < 5; ++tt) {
            if (n == 0 && qs + tt < 4) continue;
            f32x16 S;
#pragma unroll
            for (int i = 0; i < 16; ++i) S[i] = 0.f;
            const LAS bf16_t* kp = Ks + (32 * (qs + tt) + pr) * 72 + 8 * h;
#pragma unroll
            for (int ks = 0; ks < 4; ++ks) { const bf16x8 kf = *(const LAS bf16x8*)(kp + 16 * ks); S = MFMA32(kf, qf[ks], S); }
            const int dbase = r + 128 - 32 * tt - 8 * h; const float fb = nsl2 * (float)dbase;
            float tmax = -1e30f;
#pragma unroll
            for (int i = 0; i < 16; ++i) { const int kjl = (i & 3) + 4 * ((i >> 2) & 1) + 16 * (i >> 3);
                float v = fmaf(S[i], 1.4426950408889634f, fb - nsl2 * (float)kjl);
                if (tt == 0) { if (!(dbase - kjl < 128)) v = -1e30f; }
                if (tt == 4) { if (!(dbase - kjl >= 0)) v = -1e30f; }
                S[i] = v; tmax = fmaxf(tmax, v); }
            tmax = fmaxf(tmax, __shfl_xor(tmax, 32));
            const float mnew = fmaxf(mrun, tmax), alpha = __builtin_amdgcn_exp2f(mrun - mnew); mrun = mnew;
            float ps = 0.f;
#pragma unroll
            for (int i = 0; i < 16; ++i) { const float p = __builtin_amdgcn_exp2f(S[i] - mnew); S[i] = p; ps += p; }
            lsum = lsum * alpha + ps;
#pragma unroll
            for (int dt = 0; dt < 2; ++dt)
#pragma unroll
                for (int i = 0; i < 16; ++i) O[dt][i] *= alpha;
#pragma unroll
            for (int sx = 0; sx < 2; ++sx) {
                u32x4 pw; pw.x = cvtpk(S[8 * sx + 0], S[8 * sx + 1]); pw.y = cvtpk(S[8 * sx + 2], S[8 * sx + 3]); pw.z = cvtpk(S[8 * sx + 4], S[8 * sx + 5]); pw.w = cvtpk(S[8 * sx + 6], S[8 * sx + 7]);
                const bf16x8 pb = __builtin_bit_cast(bf16x8, pw);
#pragma unroll
                for (int dt = 0; dt < 2; ++dt) { const bf16x8 vf = *(const LAS bf16x8*)(Vs + (32 * dt + r) * 264 + 32 * (qs + tt) + 16 * sx + 8 * h); O[dt] = MFMA32(vf, pb, O[dt]); }
            }
        }
        const float l = lsum + __shfl_xor(lsum, 32) + __builtin_amdgcn_exp2f(sink2 - mrun);
        const float inv = 1.f / l;
        bf16_t* yp = YA + (size_t)(tok0 + qi) * 512 + hq * 64;
#pragma unroll
        for (int dt = 0; dt < 2; ++dt)
#pragma unroll
            for (int a4 = 0; a4 < 4; ++a4) { u32x2 w; w.x = cvtpk(O[dt][4 * a4] * inv, O[dt][4 * a4 + 1] * inv); w.y = cvtpk(O[dt][4 * a4 + 2] * inv, O[dt][4 * a4 + 3] * inv);
                *(u32x2*)(yp + 32 * dt + 8 * a4 + 4 * h) = w; }
    }
    __syncthreads();
}

__device__ __forceinline__ void gmlp_item_mfma(Frame& F, ArgsP a, int item) {
    const int b = item >> 4, chunk = item & 15;
    const bf16_t* Z = (const bf16_t*)(a->ws + WS_Z); const bf16_t* GVT = (const bf16_t*)(a->ws + WS_GVT); const bf16_t* SGW = (const bf16_t*)(a->ws + WS_SGW); bf16_t* YS = (bf16_t*)(a->ws + WS_YSG);
    const float* ln_g = a->in[9]; const float* ln_b = a->in[10]; const float* sg_b = a->in[12];
    LAS float* st = (LAS float*)(F.lds + MISC_OFF + 4096);
    const int tok0 = b * SEQ + chunk * 128;
    int tid_o = F.tid; asm volatile("" : "+v"(tid_o));
    if (tid_o < 128) {
        const long long* sp = (const long long*)(a->ws + WS_CTL + CTL_LNSTAT) + (size_t)(tok0 + tid_o) * 2;
        const float s1 = (float)sp[0] * (1.f / 1048576.f), s2 = (float)sp[1] * (1.f / 1048576.f);
        const float mean = s1 * (1.f / 512.f), var = fmaxf(s2 * (1.f / 512.f) - mean * mean, 0.f);
        st[2 * tid_o] = mean; st[2 * tid_o + 1] = rsqrtf(var + EPS); }
    __syncthreads();
    const int g = F.wave, r = F.lane & 31, h = F.lane >> 5;
    f32x16 acc[2][4];
#pragma unroll
    for (int dt = 0; dt < 2; ++dt)
#pragma unroll
        for (int tt = 0; tt < 4; ++tt)
#pragma unroll
            for (int i = 0; i < 16; ++i) acc[dt][tt][i] = 0.f;
    float gam[2], bet[2];
#pragma unroll
    for (int dt = 0; dt < 2; ++dt) { gam[dt] = ln_g[g * 64 + 32 * dt + r]; bet[dt] = ln_b[g * 64 + 32 * dt + r]; }
    const char* gS = pg8::uptr((const char*)(GVT + (size_t)(((b * 16 + chunk) * 8 + g) * 8) * 1024));
    const char* wS = pg8::uptr((const char*)(SGW + (size_t)(g * 8) * 2048));
    unsigned lo16 = (unsigned)F.lane * 16u; asm volatile("" : "+v"(lo16));
#define GM_LOADA(KS, RAW) do { _Pragma("unroll") for (int _dt = 0; _dt < 2; ++_dt) RAW[_dt] = *(const u32x4*)(gS + (KS) * 2048 + _dt * 1024 + lo16); } while (0)
#define GM_LOADW(KS, W) do { _Pragma("unroll") for (int _tt = 0; _tt < 4; ++_tt) if ((KS) <= 2 * _tt + 1) W[_tt] = *(const bf16x8*)(wS + (KS) * 4096 + _tt * 1024 + lo16); } while (0)
#define GM_PIN(RAW, W) asm volatile("" : "+v"(RAW[0]), "+v"(RAW[1]), "+v"(W[0]), "+v"(W[1]), "+v"(W[2]), "+v"(W[3]) :: "memory")
#define GM_STEP(KS, RAW, W) do { float x0[8], x1[8]; unpack8(RAW[0], x0); unpack8(RAW[1], x1); \
        _Pragma("unroll") for (int q4 = 0; q4 < 4; ++q4) { const f32x4 sv = *(const LAS f32x4*)(st + 2 * (16 * (KS) + 8 * h) + 4 * q4); \
            x0[2 * q4] = (x0[2 * q4] - sv[0]) * sv[1] * gam[0] + bet[0]; x0[2 * q4 + 1] = (x0[2 * q4 + 1] - sv[2]) * sv[3] * gam[0] + bet[0]; \
            x1[2 * q4] = (x1[2 * q4] - sv[0]) * sv[1] * gam[1] + bet[1]; x1[2 * q4 + 1] = (x1[2 * q4 + 1] - sv[2]) * sv[3] * gam[1] + bet[1]; } \
        bf16x8 af[2]; \
        { u32x4 pw; pw.x = cvtpk(x0[0], x0[1]); pw.y = cvtpk(x0[2], x0[3]); pw.z = cvtpk(x0[4], x0[5]); pw.w = cvtpk(x0[6], x0[7]); af[0] = __builtin_bit_cast(bf16x8, pw); } \
        { u32x4 pw; pw.x = cvtpk(x1[0], x1[1]); pw.y = cvtpk(x1[2], x1[3]); pw.z = cvtpk(x1[4], x1[5]); pw.w = cvtpk(x1[6], x1[7]); af[1] = __builtin_bit_cast(bf16x8, pw); } \
        _Pragma("unroll") for (int tt = 0; tt < 4; ++tt) if ((KS) <= 2 * tt + 1) { \
            _Pragma("unroll") for (int dt = 0; dt < 2; ++dt) acc[dt][tt] = MFMA32(af[dt], W[tt], acc[dt][tt]); } } while (0)
    u32x4 rA[2], rB[2]; bf16x8 wA[4], wB[4];
#pragma unroll
    for (int tt = 0; tt < 4; ++tt) { wA[tt] = (bf16x8){0, 0, 0, 0, 0, 0, 0, 0}; wB[tt] = wA[tt]; }
    GM_LOADA(0, rA); GM_LOADW(0, wA);
#pragma unroll
    for (int ks = 0; ks < 8; ks += 2) {
        GM_LOADA(ks + 1, rB); GM_LOADW(ks + 1, wB);
        GM_PIN(rA, wA); GM_STEP(ks, rA, wA);
        if (ks < 6) { GM_LOADA(ks + 2, rA); GM_LOADW(ks + 2, wA); }
        GM_PIN(rB, wB); GM_STEP(ks + 1, rB, wB);
    }
#undef GM_LOADW
#undef GM_PIN
#undef GM_STEP
#undef GM_LOADA
    LAS bf16_t* tb = (LAS bf16_t*)(F.lds + F.wave * 9216);
#pragma unroll
    for (int tp = 0; tp < 2; ++tp) {
        u32x4 uw[8];
#pragma unroll
        for (int i = 0; i < 8; ++i) { const int t = 64 * tp + 8 * i + (F.lane >> 3); uw[i] = *(const u32x4*)(Z + (size_t)(tok0 + t) * NZ + ZU + g * 64 + 8 * (F.lane & 7)); }
#pragma unroll
        for (int tq = 0; tq < 2; ++tq) { const int tt = 2 * tp + tq; const float bias = sg_b[g * 128 + 32 * tt + r];
#pragma unroll
            for (int dt = 0; dt < 2; ++dt)
#pragma unroll
                for (int a4 = 0; a4 < 4; ++a4) { u32x2 w; w.x = cvtpk(acc[dt][tt][4 * a4] + bias, acc[dt][tt][4 * a4 + 1] + bias); w.y = cvtpk(acc[dt][tt][4 * a4 + 2] + bias, acc[dt][tt][4 * a4 + 3] + bias);
                    *(LAS u32x2*)(tb + (32 * tq + r) * 72 + 32 * dt + 8 * a4 + 4 * h) = w; } }
        asm volatile("s_waitcnt lgkmcnt(0)" ::: "memory");
#pragma unroll
        for (int i = 0; i < 8; ++i) { const int tr = 8 * i + (F.lane >> 3), t = 64 * tp + tr; float m[8], uu[8];
            unpack8(*(const LAS u32x4*)(tb + tr * 72 + 8 * (F.lane & 7)), m); unpack8(uw[i], uu);
            u32x4 o; o.x = cvtpk(uu[0] * m[0], uu[1] * m[1]); o.y = cvtpk(uu[2] * m[2], uu[3] * m[3]); o.z = cvtpk(uu[4] * m[4], uu[5] * m[5]); o.w = cvtpk(uu[6] * m[6], uu[7] * m[7]);
            *(u32x4*)(YS + (size_t)(tok0 + t) * 512 + g * 64 + 8 * (F.lane & 7)) = o; }
        asm volatile("s_waitcnt lgkmcnt(0)" ::: "memory");
    }
    __syncthreads();
}

__device__ __forceinline__ void phase5(Frame& F, ArgsP a, const int pmode) {
    const float* x = a->in[0]; const float* g_post = a->in[5]; const float* g_pre = a->in[17]; const float* w_r = a->in[19]; const float* b_r = a->in[20];
    const bf16_t* Y = (const bf16_t*)(a->ws + WS_Y); unsigned char* H2 = (unsigned char*)(a->ws + WS_H2); bf16_t* X1B = (bf16_t*)(a->ws + WS_X1B);
    unsigned* gcnt = (unsigned*)(a->ws + WS_CTL) + CW_CNT; int* lists = (int*)(a->ws + WS_LISTS); int* tokinfo = (int*)(a->ws + WS_TOKINFO);
    constexpr int H2P = 1032;
    LAS float* h2buf = (LAS float*)F.lds;
    LAS float* part = (LAS float*)(F.lds + 66560);
    LAS float* mv = (LAS float*)(F.lds + 82944);
    LAS int* hist = (LAS int*)(F.lds + 95232);
    LAS int* basep = hist + 32;
    LAS int* asg_e = hist + 64;
    LAS int* asg_l = asg_e + 512;
    LAS float* asg_g = (LAS float*)(asg_l + 512);
    LAS float* lgs = asg_g + 512;
    LAS float* sel_v = lgs + 512;
    LAS int* sel_e = (LAS int*)(sel_v + 64);
    const int e_l = F.lane & 31, kh = F.lane >> 5, n_l = F.lane & 15, kq = F.lane >> 4;
    float wreg[2][32];
#pragma unroll
    for (int hf = 0; hf < 2; ++hf)
#pragma unroll
        for (int j = 0; j < 32; ++j) wreg[hf][j] = w_r[(size_t)(128 * F.wave + 16 * (j >> 2) + 4 * kq + (j & 3)) * NE + 16 * hf + n_l];
    float br_l = b_r[e_l]; asm volatile("" : "+v"(br_l));
    for (int chunk = blockIdx.x; chunk < T / 128; chunk += F.G) {
        const int b = chunk / 16;
        {
#pragma unroll 1
          for (int j = 0; j < 6; ++j) load_mod<1>(F, a, b, 2048 + j * NTHREADS, mv + j * NTHREADS); }
        for (int idx = F.tid; idx < 1024; idx += NTHREADS) { mv[idx] *= g_post[idx]; mv[2048 + idx] = g_pre[idx] * (1.f + mv[2048 + idx]); }
        if (F.tid < 32) hist[F.tid] = 0;
        __syncthreads();
#define P5_LOADROWS(SB, XR, YR) do { _Pragma("unroll") for (int _j = 0; _j < 2; ++_j) { const int _row = chunk * 128 + (SB) * 16 + 2 * F.wave + _j; \
            const f32x4* _xr = (const f32x4*)(x + (size_t)_row * D) + F.lane; const u32x2* _yr = (const u32x2*)(Y + (size_t)_row * D) + F.lane; \
            _Pragma("unroll") for (int _jj = 0; _jj < 4; ++_jj) { XR[_j][_jj] = __builtin_nontemporal_load(_xr + 64 * _jj); YR[_j][_jj] = __builtin_nontemporal_load(_yr + 64 * _jj); } } } while (0)
        f32x4 xc[2][4]; u32x2 yc[2][4];
        P5_LOADROWS(0, xc, yc);
        for (int sb = 0; sb < 8; ++sb) {
#pragma unroll
            for (int j = 0; j < 2; ++j) {
                const int tt = 2 * F.wave + j, row = chunk * 128 + sb * 16 + tt;
                f32x4 xv[4], yv[4]; float ss = 0.f;
#pragma unroll
                for (int jj = 0; jj < 4; ++jj) { xv[jj] = xc[j][jj]; const u32x2 w = yc[j][jj];
                    yv[jj][0] = __uint_as_float(w.x << 16); yv[jj][1] = __uint_as_float(w.x & 0xffff0000u); yv[jj][2] = __uint_as_float(w.y << 16); yv[jj][3] = __uint_as_float(w.y & 0xffff0000u);
                    ss += (yv[jj][0] * yv[jj][0] + yv[jj][1] * yv[jj][1]) + (yv[jj][2] * yv[jj][2] + yv[jj][3] * yv[jj][3]); }
                const float rstd = rsqrtf(wave_sum(ss) * (1.f / D) + EPS); float s1 = 0.f;
#pragma unroll
                for (int jj = 0; jj < 4; ++jj) { const int col = 4 * F.lane + 256 * jj;
#pragma unroll
                    for (int i = 0; i < 4; ++i) { const float v = xv[jj][i] + mv[col + i] * (yv[jj][i] * rstd); xv[jj][i] = v; s1 += v * v; }
                    u32x2 xw; xw.x = cvtpk(xv[jj][0], xv[jj][1]); xw.y = cvtpk(xv[jj][2], xv[jj][3]); __builtin_nontemporal_store(xw, (u32x2*)(X1B + (size_t)row * D) + F.lane + 64 * jj); }
                const float rstd1 = rsqrtf(wave_sum(s1) * (1.f / D) + EPS);
                unsigned* o8 = (unsigned*)(H2 + (size_t)row * PF8) + F.lane;
#pragma unroll
                for (int jj = 0; jj < 4; ++jj) { const int col = 4 * F.lane + 256 * jj; f32x4 r;
#pragma unroll
                    for (int i = 0; i < 4; ++i) r[i] = (xv[jj][i] * rstd1) * mv[2048 + col + i] + mv[1024 + col + i];
                    o8[64 * jj] = cvt4_fp8(r[0], r[1], r[2], r[3], FP8_SH);
                    *(LAS f32x4*)(h2buf + tt * H2P + col) = r; }
            }
            { const int sbn = sb < 7 ? sb + 1 : 7; P5_LOADROWS(sbn, xc, yc); }
            __syncthreads();
            if (pmode & 1) continue;
            { const LAS f32x4* hp = (const LAS f32x4*)(h2buf + n_l * H2P + 128 * F.wave + 4 * kq);
              f32x4 lg0 = (f32x4){0.f, 0.f, 0.f, 0.f}, lg1 = (f32x4){0.f, 0.f, 0.f, 0.f};
#pragma unroll
              for (int jb = 0; jb < 8; ++jb) { const f32x4 hv = hp[4 * jb];
#pragma unroll
                  for (int i = 0; i < 4; ++i) { lg0 = __builtin_amdgcn_mfma_f32_16x16x4f32(hv[i], wreg[0][4 * jb + i], lg0, 0, 0, 0); lg1 = __builtin_amdgcn_mfma_f32_16x16x4f32(hv[i], wreg[1][4 * jb + i], lg1, 0, 0, 0); } }
#pragma unroll
              for (int i = 0; i < 4; ++i) { part[(F.wave * 16 + 4 * kq + i) * 32 + n_l] = lg0[i]; part[(F.wave * 16 + 4 * kq + i) * 32 + 16 + n_l] = lg1[i]; } }
            __syncthreads();
            if (pmode & 2) continue;
            { const int tt = 2 * F.wave + kh, tokidx = sb * 16 + tt;
              float logit = br_l;
#pragma unroll
              for (int w = 0; w < 8; ++w) logit += part[(w * 16 + tt) * 32 + e_l];
              lgs[tt * 32 + e_l] = logit;
              int rank = 0;
#pragma unroll
              for (int q8 = 0; q8 < 8; ++q8) { const f32x4 v = *(const LAS f32x4*)(lgs + tt * 32 + 4 * q8);
#pragma unroll
                  for (int i = 0; i < 4; ++i) { const int eo = 4 * q8 + i; rank += (v[i] > logit || (v[i] == logit && eo < e_l)) ? 1 : 0; } }
              if (rank < 4) { sel_v[tt * 4 + rank] = logit; sel_e[tt * 4 + rank] = e_l; }
              if (e_l < 4) { const f32x4 sv = *(const LAS f32x4*)(sel_v + tt * 4); const int k = e_l;
                  const float p0 = 1.f, p1 = __expf(sv[1] - sv[0]), p2 = __expf(sv[2] - sv[0]), p3 = __expf(sv[3] - sv[0]); const float inv = 1.f / (p0 + p1 + p2 + p3);
                  const int e = sel_e[tt * 4 + k]; const float gt = (k == 0 ? p0 : (k == 1 ? p1 : (k == 2 ? p2 : p3))) * inv;
                  const int lp = __hip_atomic_fetch_add(hist + e, 1, __ATOMIC_RELAXED, __HIP_MEMORY_SCOPE_WORKGROUP); asg_e[tokidx * 4 + k] = e; asg_l[tokidx * 4 + k] = lp; asg_g[tokidx * 4 + k] = gt; }
            }
        }
        __syncthreads();
        if (pmode) continue;
        if (F.tid < 32) basep[F.tid] = (int)atomicAdd(gcnt + F.tid, (unsigned)hist[F.tid]);
        __syncthreads();
        { const int aidx = F.tid, tokidx = aidx >> 2, k = aidx & 3, e = asg_e[aidx], pos = basep[e] + asg_l[aidx], token = chunk * 128 + tokidx;
          lists[(size_t)e * LISTCAP + pos] = token;
          int* ti = tokinfo + ((size_t)token * 4 + k) * 4; ti[0] = e; ti[1] = pos; ti[2] = __float_as_int(asg_g[aidx]); ti[3] = 0; }
        __syncthreads();
    }
}

__device__ __forceinline__ void moe_tables(Frame& F, ArgsP a, LAS int* tab, int NT) {
    const unsigned* gcnt = (const unsigned*)(a->ws + WS_CTL) + CW_CNT;
    if (F.tid < NE) tab[128 + F.tid] = (int)__hip_atomic_load(gcnt + F.tid, __ATOMIC_RELAXED, __HIP_MEMORY_SCOPE_AGENT);
    if (F.tid == 0) { int us = 0, ro = 0;
        for (int e = 0; e < NE; ++e) { const int c = tab[128 + e]; const int tiles = (c + 255) >> 8; tab[e] = us; tab[64 + e] = ro; us += tiles * NT; ro += tiles * 256; }
        tab[32] = us; tab[64 + 32] = ro; }
    __syncthreads();
}

__device__ __forceinline__ void phase9(Frame& F, ArgsP a) {
    const float* g_pf = a->in[18]; const bf16_t* X1B = (const bf16_t*)(a->ws + WS_X1B);
    const unsigned char* YS = (const unsigned char*)(a->ws + WS_YS); const int* tokinfo = (const int*)(a->ws + WS_TOKINFO); float* out = a->out;
    LAS int* tab = (LAS int*)(F.lds + MISC_OFF); LAS float* mv = (LAS float*)F.lds;
    moe_tables(F, a, tab, 4);
    for (int chunk = blockIdx.x; chunk < T / 128; chunk += F.G) {
        const int b = chunk / 16;
        load_mod<2>(F, a, b, 5120, mv);
        for (int idx = F.tid; idx < 1024; idx += NTHREADS) mv[idx] *= g_pf[idx];
        __syncthreads();
        const int row0 = chunk * 128 + F.wave * 16;
        const u32x4 tinf = *(const u32x4*)(tokinfo + ((size_t)(row0 + (F.lane >> 2)) * 4 + (F.lane & 3)) * 4);
        const int srow = tab[64 + (int)tinf.x] + (int)tinf.y; const float sgate = __uint_as_float(tinf.z) * (1.f / FP8_SY);
#define P9_LOAD(I, SR, XR) do { _Pragma("unroll") for (int _k = 0; _k < 4; ++_k) { const int _r = __shfl(srow, 4 * (I) + _k); const unsigned* _sr = (const unsigned*)(YS + (size_t)_r * PF8) + F.lane; \
            _Pragma("unroll") for (int _jj = 0; _jj < 4; ++_jj) SR[_k][_jj] = __builtin_nontemporal_load(_sr + 64 * _jj); } \
            const u32x2* _xr = (const u32x2*)(X1B + (size_t)(row0 + (I)) * D) + F.lane; \
            _Pragma("unroll") for (int _jj = 0; _jj < 4; ++_jj) XR[_jj] = __builtin_nontemporal_load(_xr + 64 * _jj); } while (0)
#define P9_PIN(SR, XR) asm volatile("" : "+v"(SR[0][0]), "+v"(SR[0][1]), "+v"(SR[0][2]), "+v"(SR[0][3]), "+v"(SR[1][0]), "+v"(SR[1][1]), "+v"(SR[1][2]), "+v"(SR[1][3]), \
            "+v"(SR[2][0]), "+v"(SR[2][1]), "+v"(SR[2][2]), "+v"(SR[2][3]), "+v"(SR[3][0]), "+v"(SR[3][1]), "+v"(SR[3][2]), "+v"(SR[3][3]), "+v"(XR[0]), "+v"(XR[1]), "+v"(XR[2]), "+v"(XR[3]) :: "memory")
#define P9_ROW(I, SR, XR) do { P9_PIN(SR, XR); f32x4 yv[4]; \
            _Pragma("unroll") for (int jj = 0; jj < 4; ++jj) yv[jj] = (f32x4){0.f, 0.f, 0.f, 0.f}; \
            _Pragma("unroll") for (int k = 0; k < 4; ++k) { const float gt = __shfl(sgate, 4 * (I) + k); \
                _Pragma("unroll") for (int jj = 0; jj < 4; ++jj) { const unsigned w = SR[k][jj]; const f32x2_t lo = __builtin_amdgcn_cvt_pk_f32_fp8((int)w, false), hi = __builtin_amdgcn_cvt_pk_f32_fp8((int)w, true); \
                    yv[jj][0] += gt * lo[0]; yv[jj][1] += gt * lo[1]; yv[jj][2] += gt * hi[0]; yv[jj][3] += gt * hi[1]; } } \
            float s1 = 0.f; \
            _Pragma("unroll") for (int jj = 0; jj < 4; ++jj) s1 += (yv[jj][0] * yv[jj][0] + yv[jj][1] * yv[jj][1]) + (yv[jj][2] * yv[jj][2] + yv[jj][3] * yv[jj][3]); \
            const float rstd1 = rsqrtf(wave_sum(s1) * (1.f / D) + EPS); \
            _Pragma("unroll") for (int jj = 0; jj < 4; ++jj) { const int col = 4 * F.lane + 256 * jj; const u32x2 xw = XR[jj]; \
                f32x4 xv; xv[0] = __uint_as_float(xw.x << 16); xv[1] = __uint_as_float(xw.x & 0xffff0000u); xv[2] = __uint_as_float(xw.y << 16); xv[3] = __uint_as_float(xw.y & 0xffff0000u); \
                _Pragma("unroll") for (int ii = 0; ii < 4; ++ii) xv[ii] += mv[col + ii] * (yv[jj][ii] * rstd1); \
                yv[jj] = xv; } \
            asm volatile("" : "+v"(yv[0]), "+v"(yv[1]), "+v"(yv[2]), "+v"(yv[3]) :: "memory"); \
            { const int in_ = (I) < 14 ? (I) + 2 : 15; P9_LOAD(in_, SR, XR); } \
            f32x4* orow = (f32x4*)(out + (size_t)(row0 + (I)) * D) + F.lane; \
            _Pragma("unroll") for (int jj = 0; jj < 4; ++jj) __builtin_nontemporal_store(yv[jj], orow + 64 * jj); } while (0)
        unsigned sA[4][4], sB[4][4]; u32x2 xA[4], xB[4];
        P9_LOAD(0, sA, xA); P9_LOAD(1, sB, xB);
#pragma unroll 1
        for (int i = 0; i < 16; i += 2) { P9_ROW(i, sA, xA); P9_ROW(i + 1, sB, xB); }
#undef P9_PIN
#undef P9_ROW
        __syncthreads();
    }
}

#define XB_TMO      128
#define XB_XCNT(j)  (256  + 64 * (j))
#define XB_XSUB(j)  (1280 + 64 * (j))
#define XB_XGEN(j)  (2304 + 64 * (j))
#define XB_TOP      3328
#define XB_TOPGEN   3392
#define XCD_BAR_WORDS 3456
#define XB_SPIN_CAP (1u << 18)
__device__ __forceinline__ unsigned xb_ld(unsigned* p)              { return __hip_atomic_load(p, __ATOMIC_RELAXED, __HIP_MEMORY_SCOPE_AGENT); }
__device__ __forceinline__ unsigned xb_add(unsigned* p, unsigned v) { return __hip_atomic_fetch_add(p, v, __ATOMIC_RELAXED, __HIP_MEMORY_SCOPE_AGENT); }
__device__ __forceinline__ unsigned xb_xcc_id() { return (unsigned)__builtin_amdgcn_s_getreg((3 << 11) | 20) & 0xFu; }
#define XB_SPIN(cond, bar) do { unsigned _sp = 0; while (cond) { __builtin_amdgcn_s_sleep(1); \
    if ((++_sp & 255u) == 0u) { if (xb_ld(&(bar)[XB_TMO])) break; if (_sp > XB_SPIN_CAP) { atomicAdd(&(bar)[XB_TMO], 1u); break; } } } } while (0)
struct XcdBarrier { unsigned* bar; unsigned x; volatile LAS unsigned* st; };
__device__ __forceinline__ XcdBarrier xcd_barrier_post(unsigned* bar, volatile LAS unsigned* st) {
    XcdBarrier b; b.bar = bar; b.x = xb_xcc_id(); b.st = st;
    if (threadIdx.x == 0) (void)xb_add(&bar[XB_XCNT(b.x)], 1u);
    return b;
}
__device__ __forceinline__ void xcd_barrier_complete(unsigned* bar, unsigned x, unsigned& nloc, unsigned& nx) {
    const unsigned G = gridDim.x * gridDim.y * gridDim.z;
    unsigned sum, cnt, mine, sp = 0u;
    for (;;) {
        sum = 0u; cnt = 0u; mine = 0u;
#pragma unroll
        for (unsigned j = 0; j < 16; ++j) { const unsigned c = xb_ld(&bar[XB_XCNT(j)]); sum += c; cnt += (c > 0u) ? 1u : 0u; mine = (j == x) ? c : mine; }
        if (sum == G) break;
        __builtin_amdgcn_s_sleep(1);
        if ((++sp & 255u) == 0u) { if (xb_ld(&bar[XB_TMO])) break; if (sp > XB_SPIN_CAP) { atomicAdd(&bar[XB_TMO], 1u); break; } }
    }
    nloc = mine > 0u ? mine : 1u; nx = cnt > 0u ? cnt : 1u;
}
__device__ __forceinline__ void xcd_barrier(const XcdBarrier& b, const int wave_s) {
    asm volatile("s_waitcnt vmcnt(0)" ::: "memory");
    __syncthreads();
    int ln_; asm volatile("v_mbcnt_lo_u32_b32 %0, -1, 0\n\tv_mbcnt_hi_u32_b32 %0, -1, %0" : "=v"(ln_));
    if (wave_s == 0 && ln_ == 0) {
        unsigned* bar = b.bar;
        __builtin_amdgcn_s_waitcnt(0);
        unsigned nloc = b.st[0], nx = b.st[1];
        if (nloc == 0u) { xcd_barrier_complete(bar, b.x, nloc, nx); b.st[0] = nloc; b.st[1] = nx; }
        const unsigned old = xb_add(&bar[XB_XSUB(b.x)], 1u);
        const unsigned gen = old / nloc;
        if (old + 1u == (gen + 1u) * nloc) {
            __builtin_amdgcn_fence(__ATOMIC_RELEASE, "agent");
            asm volatile("s_waitcnt vmcnt(0)" ::: "memory");
            const unsigned og = xb_add(&bar[XB_TOP], 1u);
            const unsigned tg = og / nx;
            if (og + 1u == (tg + 1u) * nx) xb_add(&bar[XB_TOPGEN], 1u);
            else XB_SPIN(xb_ld(&bar[XB_TOPGEN]) == tg, bar);
            __builtin_amdgcn_fence(__ATOMIC_ACQUIRE, "agent");
            xb_add(&bar[XB_XGEN(b.x)], 1u);
            asm volatile("s_waitcnt vmcnt(0)" ::: "memory");
        } else {
            XB_SPIN(xb_ld(&bar[XB_XGEN(b.x)]) == gen, bar);
            __builtin_amdgcn_fence(__ATOMIC_ACQUIRE, "agent");
            asm volatile("s_waitcnt vmcnt(0)" ::: "memory");
        }
    }
    __syncthreads();
}

constexpr int NPHASE = 10;
__global__ void __launch_bounds__(NTHREADS, 2) fwd_kernel(Args a_unused) {
    extern __shared__ __attribute__((aligned(16))) unsigned char lds_raw[];
    Frame F; F.lds = (LAS unsigned char*)lds_raw; F.G = gridDim.x;
    ArgsP a = (ArgsP)__builtin_amdgcn_kernarg_segment_ptr();
    volatile LAS unsigned* bst = (volatile LAS unsigned*)(F.lds + MISC_OFF + 1024);
    XcdBarrier xbar; xbar.bar = (unsigned*)(a->ws + WS_CTL) + CW_BAR; xbar.x = 0; xbar.st = bst;
    const int nprog = a->nprog;
    const int wave_s = __builtin_amdgcn_readfirstlane((int)threadIdx.x >> 6);
    if (nprog > 1) { if (threadIdx.x == 0) { bst[0] = 0u; bst[1] = 0u; } __syncthreads(); xbar = xcd_barrier_post((unsigned*)(a->ws + WS_CTL) + CW_BAR, bst); if (nprog < 0) cg::this_grid().sync(); }
#pragma nounroll
    for (int pi = 0; pi < nprog; ++pi) {
        { unsigned long long _p = (unsigned long long)__builtin_amdgcn_kernarg_segment_ptr(); asm volatile("" : "+s"(_p)); a = (ArgsP)_p; }
        { int _l; asm volatile("v_mbcnt_lo_u32_b32 %0, -1, 0\n\tv_mbcnt_hi_u32_b32 %0, -1, %0" : "=v"(_l)); F.lane = _l; F.wave = wave_s; F.tid = wave_s * 64 + _l; }
        { int _g = gridDim.x; asm volatile("" : "+s"(_g)); F.G = _g; }
        int bid = blockIdx.x; asm volatile("" : "+s"(bid));
        unsigned char* ws = a->ws;
        const int pe = (int)((a->prog[pi >> 3] >> ((pi & 7) * 8)) & 0xffull), ph = pe & 15, pmode = pe >> 4;
        switch (ph) {
        case 0: phase0(F, a); break;
        case 1: phase0b(F, a); break;
        case 2: {
            pg8::SchedDense S{(const char*)(ws + WS_H), (const char*)(ws + WS_WIN), T / 256, NZB / 256, F.G, bid, (size_t)256 * D * 2, (size_t)256 * D * 2};
            pg8::EpiInProj E{(bf16_t*)(ws + WS_Z), a->in[7], (bf16_t*)(ws + WS_VT), (bf16_t*)(ws + WS_GVT), (unsigned long long*)(ws + WS_CTL + CTL_LNSTAT)};
            pg8::gemm_phase<pg8::EpiInProj, pg8::SchedDense, false>(F.lds, F.wave, D * 2, D * 2, S, E);
            pg8::SchedGate S2{(const char*)(ws + WS_HF8), (const char*)(ws + WS_WING8), T / 256, NZG / 256, F.G, bid, (size_t)256 * PF8, (size_t)256 * D};
            pg8::EpiGate8 E2{ws + WS_G8, a->in[7] + NZB};
            pg8::gemm_phase<pg8::EpiGate8, pg8::SchedGate, false, true>(F.lds, F.wave, D, PF8, S2, E2);
        } break;
        case 3: {
            for (int it = bid; it < 256 + 512; it += F.G) { if (it < 256) gmlp_item_mfma(F, a, it); else attn_item_mfma(F, a, it - 256); }
        } break;
        case 4: {
            pg8::SchedBranch S{(const char*)(ws + WS_YATT), (const char*)(ws + WS_WBA), (const char*)(ws + WS_YSG), (const char*)(ws + WS_WBS), T / 256, D / 256, F.G, bid, (size_t)256 * 512 * 2, (size_t)256 * 512 * 2};
            pg8::EpiBranch E{ws + WS_G8, (bf16_t*)(ws + WS_H)};
            pg8::gemm_phase<pg8::EpiBranch, pg8::SchedBranch, false>(F.lds, F.wave, 512 * 2, 512 * 2, S, E);
        } break;
        case 5: {
            pg8::SchedDense S{(const char*)(ws + WS_H), (const char*)(ws + WS_WOUT), T / 256, D / 256, F.G, bid, (size_t)256 * D * 2, (size_t)256 * D * 2};
            pg8::EpiBiasBf16 E{(bf16_t*)(ws + WS_Y), D, a->in[16], 0, 1.f, pmode};
            pg8::gemm_phase<pg8::EpiBiasBf16, pg8::SchedDense, false>(F.lds, F.wave, D * 2, D * 2, S, E);
        } break;
        case 6: phase5(F, a, pmode); break;
        case 7: {
            LAS int* tab = (LAS int*)(F.lds + MISC_OFF); moe_tables(F, a, tab, 8);
            pg8::SchedMoE S{tab, (const char*)(ws + WS_H2), (const char*)(ws + WS_W1), (size_t)2 * DE * D, (const int*)(ws + WS_LISTS), 8, F.G, bid, (size_t)256 * D, PF8, true};
            pg8::EpiSwiGLU E{(unsigned char*)(ws + WS_ACT), a->in[22], pmode};
            pg8::gemm_phase<pg8::EpiSwiGLU, pg8::SchedMoE, true, true>(F.lds, F.wave, D, PF8, S, E);
        } break;
        case 8: {
            LAS int* tab = (LAS int*)(F.lds + MISC_OFF); moe_tables(F, a, tab, 4);
            pg8::SchedMoE S{tab, (const char*)(ws + WS_ACT), (const char*)(ws + WS_W2), (size_t)D * DE, nullptr, 4, F.G, bid, (size_t)256 * DE, PF8, false};
            pg8::EpiBiasFp8 E{(unsigned char*)(ws + WS_YS), a->in[24], D, 1.f / (FP8_SA * FP8_SW), pmode};
            pg8::gemm_phase<pg8::EpiBiasFp8, pg8::SchedMoE, false, true>(F.lds, F.wave, DE, PF8, S, E);
        } break;
        case 9: phase9(F, a); break;
        default: if (bid == 0 && F.tid < 32) ((unsigned*)(ws + WS_CTL))[CW_CNT + F.tid] = 0u; break;
        }
        if (pi + 1 < nprog) xcd_barrier(xbar, wave_s);
    }
}

extern "C" void kernel_launch(void* const* d_in, const int* in_sizes, int n_in, void* d_out, int out_size, void* d_ws, size_t ws_size, hipStream_t stream) {
    const void* kfn = (const void*)fwd_kernel;
    static int grid = 0;
    if (grid == 0) {
        if (n_in != 25 || out_size != T * D || ws_size < WS_END) { fprintf(stderr, "kernel_launch: unexpected problem (n_in %d out %d ws %zu)\n", n_in, out_size, ws_size); grid = -1; return; }
        int dev = 0, cus = 0, per_cu = 0;
        (void)hipGetDevice(&dev); (void)hipDeviceGetAttribute(&cus, hipDeviceAttributeMultiprocessorCount, dev);
        (void)hipFuncSetAttribute(kfn, hipFuncAttributeMaxDynamicSharedMemorySize, LDS_BYTES);
        (void)hipOccupancyMaxActiveBlocksPerMultiprocessor(&per_cu, kfn, NTHREADS, LDS_BYTES);
        (void)hipGetLastError();
        if (per_cu < 1) { fprintf(stderr, "kernel_launch: occupancy query says %d blocks per CU\n", per_cu); grid = -1; return; }
        grid = cus;
    }
    if (grid < 0) return;
    (void)hipMemsetAsync((char*)d_ws + WS_CTL, 0, CTL_BYTES, stream);
    Args a{};
    for (int i = 0; i < 25; ++i) a.in[i] = (const float*)d_in[i];
    a.out = (float*)d_out; a.ws = (unsigned char*)d_ws;
    static const unsigned char program[] = PHASE_PROGRAM;
    const int np = (int)sizeof(program);
#if MK_ONE_LAUNCH
    a.nprog = np; for (int i = 0; i < np; ++i) a.prog[i >> 3] |= (unsigned long long)program[i] << ((i & 7) * 8);
    void* args[] = {&a};
    hipError_t e = hipLaunchCooperativeKernel(kfn, dim3(grid), dim3(NTHREADS), args, LDS_BYTES, stream);
    if (e != hipSuccess) fprintf(stderr, "cooperative launch failed: %s (grid %d)\n", hipGetErrorString(e), grid);
#else
    for (int p = 0; p < np; ++p) { a.nprog = 1; a.prog[0] = program[p]; void* args[] = {&a}; (void)hipLaunchKernel(kfn, dim3(grid), dim3(NTHREADS), args, LDS_BYTES, stream); }
#endif
}
```

```cpp
#include <hip/hip_runtime.h>
#include <hip/hip_cooperative_groups.h>
#include <cstdio>
#include <cstdint>
namespace cg = cooperative_groups;

#ifndef PHASE_PROGRAM
#define PHASE_PROGRAM {0, 1, 2, 3, 4, 5, 6, 7, 8, 9}
#endif
#ifndef MK_ONE_LAUNCH
#define MK_ONE_LAUNCH 1
#endif

#define LAS __attribute__((address_space(3)))
typedef unsigned short bf16_t;
typedef short bf16x8 __attribute__((ext_vector_type(8)));
typedef float f32x4 __attribute__((ext_vector_type(4)));
typedef unsigned u32x4 __attribute__((ext_vector_type(4)));
typedef unsigned u32x2 __attribute__((ext_vector_type(2)));
typedef float f32x16 __attribute__((ext_vector_type(16)));
typedef float f32x2_t __attribute__((ext_vector_type(2)));
typedef __bf16 bf16x2_t __attribute__((ext_vector_type(2)));
typedef int i32x4 __attribute__((ext_vector_type(4)));
typedef int i32x8 __attribute__((ext_vector_type(8)));

constexpr int D = 1024, BATCH = 16, SEQ = 2048, T = BATCH * SEQ;
constexpr int NZ = 3840;
constexpr int ZQ = 0, ZK = 512, ZV = 640, ZU = 768, ZVS = 1280, ZGA = 1792, ZGS = 2816;
constexpr int NE = 32, TOPK = 4, DE = 1024;
constexpr int KSPLIT = 16;
constexpr float EPS = 1e-6f;
constexpr int LISTCAP = T;
constexpr int APAD = T * TOPK + NE * 256;
constexpr int PF8 = 1280;

constexpr size_t MiB = 1u << 20;
constexpr size_t WS_CTL = 0, CTL_BYTES = 1 * MiB;
constexpr size_t WS_MODP = 1 * MiB;
constexpr size_t WS_WIN = 8 * MiB;
constexpr size_t WS_WBA = 16 * MiB, WS_WBS = 17 * MiB;
constexpr size_t WS_WOUT = 18 * MiB;
constexpr size_t WS_SGW = 20 * MiB;
constexpr size_t WS_W1 = 24 * MiB;
constexpr size_t WS_W2 = 152 * MiB;
constexpr size_t WS_HF8 = 216 * MiB;
constexpr size_t WS_WING8 = 8 * MiB + (size_t)1792 * 2048;
constexpr size_t WS_H2 = 216 * MiB;
constexpr size_t WS_Z = 280 * MiB;
constexpr size_t WS_YATT = 520 * MiB, WS_YSG = 552 * MiB;
constexpr size_t WS_X1B = 520 * MiB;
constexpr size_t WS_H = 584 * MiB;
constexpr size_t WS_Y = 648 * MiB;
constexpr size_t WS_G8 = 648 * MiB;
constexpr size_t WS_ACT = 280 * MiB;
constexpr size_t WS_YS = 584 * MiB;
constexpr size_t WS_LISTS = 824 * MiB;
constexpr size_t WS_TOKINFO = 828 * MiB;
constexpr size_t WS_VT = 960 * MiB;
constexpr size_t WS_GVT = 968 * MiB;
constexpr size_t WS_END = 1000 * MiB;
constexpr size_t CTL_LNSTAT = 256 * 1024;
constexpr int CW_CNT = 64;
constexpr int CW_BAR = 4096;

constexpr int RING_BYTES = 131072;
constexpr int MISC_OFF = RING_BYTES;
constexpr int LDS_BYTES = 147456;
constexpr int NWAVES = 8, NTHREADS = 512;

__device__ __forceinline__ float bf2f(unsigned h) { return __uint_as_float(h << 16); }
__device__ __forceinline__ unsigned f2bf(float f) { unsigned u = __float_as_uint(f); return (u + 0x7fffu + ((u >> 16) & 1u)) >> 16; }
__device__ __forceinline__ unsigned pk2(float lo, float hi) { return f2bf(lo) | (f2bf(hi) << 16); }
__device__ __forceinline__ void unpack8(const u32x4 r, float* o) {
    o[0] = __uint_as_float(r.x << 16); o[1] = __uint_as_float(r.x & 0xffff0000u);
    o[2] = __uint_as_float(r.y << 16); o[3] = __uint_as_float(r.y & 0xffff0000u);
    o[4] = __uint_as_float(r.z << 16); o[5] = __uint_as_float(r.z & 0xffff0000u);
    o[6] = __uint_as_float(r.w << 16); o[7] = __uint_as_float(r.w & 0xffff0000u);
}
__device__ __forceinline__ unsigned cvtpk(float lo, float hi) { const f32x2_t v = {lo, hi}; const bf16x2_t b = __builtin_convertvector(v, bf16x2_t); return __builtin_bit_cast(unsigned, b); }
constexpr float FP8_SW = 64.f, FP8_SH = 4.f, FP8_SA = 4.f, FP8_SY = 16.f;
__device__ __forceinline__ float fp8_clamp(float v) { return fminf(fmaxf(v, -448.f), 448.f); }
__device__ __forceinline__ unsigned cvt4_fp8(float a, float b, float c, float d, float sc) {
    unsigned w = 0; w = __builtin_amdgcn_cvt_pk_fp8_f32(fp8_clamp(a * sc), fp8_clamp(b * sc), w, false); w = __builtin_amdgcn_cvt_pk_fp8_f32(fp8_clamp(c * sc), fp8_clamp(d * sc), w, true); return w; }
#define MFMA32(a, b, c) __builtin_amdgcn_mfma_f32_32x32x16_bf16((a), (b), (c), 0, 0, 0)
#define VCONST2(x, f) do { float _c; asm volatile("v_mov_b32 %0, %1" : "=v"(_c) : "i"(__builtin_bit_cast(int, (float)(f)))); x[0] = _c; x[1] = _c; } while (0)
#define WS_DPP(v, CTRL) (v + __int_as_float(__builtin_amdgcn_update_dpp(0, __float_as_int(v), (CTRL), 0xf, 0xf, false)))
__device__ __forceinline__ float wave_sum(float v) {
    v = WS_DPP(v, 0xB1);
    v = WS_DPP(v, 0x4E);
    v = WS_DPP(v, 0x141);
    v = WS_DPP(v, 0x140);
    v += __shfl_xor(v, 16); v += __shfl_xor(v, 32);
    return v;
}
__device__ __forceinline__ float sigmoidf_(float x) { return __builtin_amdgcn_rcpf(1.f + __builtin_amdgcn_exp2f(-1.4426950408889634f * x)); }
__device__ __forceinline__ float gelu_tanh(float x) { const float t = x * fmaf(0.044715f * x, x, 1.f); return x * __builtin_amdgcn_rcpf(1.f + __builtin_amdgcn_exp2f(-2.302208198144325f * t)); }

struct Frame { LAS unsigned char* lds; int tid, lane, wave, G; };

namespace pg8 {
constexpr int BM = 256, BK = 64, HALF = 128, HTB = HALF * BK * 2, STAGE_BYTES = 8 * HTB, NXCD = 8, WGM = 8;
__host__ __device__ __forceinline__ int lds_byte(int r, int c) { return (r >> 3) * 1024 + (r & 7) * 128 + ((((c >> 3) ^ r) & 7) << 4) + (c & 7) * 2; }
__host__ __device__ __forceinline__ void stage_rc(int b, int& R, int& C) { const int piece = b >> 10, l16 = (b & 1023) >> 4, r8 = l16 >> 3, cp = l16 & 7; R = piece * 8 + r8; C = ((cp ^ r8) & 7) << 3; }
__host__ __device__ __forceinline__ int perm32(int rho) { const int n = rho >> 4, i = rho & 15; return 8 * (i >> 2) + 4 * n + (i & 3); }
__device__ __forceinline__ unsigned cvt_pk_bf16(float lo, float hi) { unsigned r; asm volatile("v_cvt_pk_bf16_f32 %0, %1, %2" : "=v"(r) : "v"(lo), "v"(hi)); return r; }

struct Unit { const char* A; const char* B; const int* tl; int pm, pn, e, kind, rowbase, nvalid; };
__device__ __forceinline__ const char* uptr(const char* p) { const unsigned long long v = (unsigned long long)p;
    const unsigned lo = __builtin_amdgcn_readfirstlane((unsigned)v), hi = __builtin_amdgcn_readfirstlane((unsigned)(v >> 32)); return (const char*)(((unsigned long long)hi << 32) | lo); }

__device__ __forceinline__ void tile_map(int L, int nM, int nN, int& pm, int& pn) {
    const int nwg = nM * nN;
    int wgid = L; { const int q = nwg / NXCD, r = nwg % NXCD, xcd = wgid % NXCD, off = wgid / NXCD; wgid = (xcd < r ? xcd * (q + 1) : r * (q + 1) + (xcd - r) * q) + off; }
    const int nig = WGM * nN, gid = wgid / nig, fm = gid * WGM, gsz = (nM - fm) < WGM ? (nM - fm) : WGM;
    pm = fm + ((wgid % nig) % gsz); pn = (wgid % nig) / gsz;
}

template <class Epi, class Sched, bool GATHER, bool FP8 = false>
__device__ __forceinline__ void gemm_phase(LAS unsigned char* lds, const int wid, const int Kb, const int Pa, const Sched& S, const Epi& E) {
#define PG8_LANE() ({ int _l; asm volatile("v_mbcnt_lo_u32_b32 %0, -1, 0\n\tv_mbcnt_hi_u32_b32 %0, -1, %0" : "=v"(_l)); _l; })
    const int lane = PG8_LANE(), tid = wid * 64 + lane, wr = wid >> 2, wc = wid & 3, fr = lane & 15, fq = lane >> 4;
    const int nt = Kb / 128;
    unsigned voffB[2]; unsigned oc[2][2], o2[2][2];
    LAS int* ids = (LAS int*)(lds + MISC_OFF + 2048);
    const size_t kstep = (size_t)(BK * 2);
    const size_t hstep = (size_t)HALF * Kb, hstepA = (size_t)HALF * Pa;
#pragma unroll
    for (int i = 0; i < 2; ++i) { int R, C; stage_rc(tid * 16 + i * 8192, R, C); const int Rb = (R & ~31) + perm32(R & 31);
        voffB[i] = (unsigned)(Rb * Kb) + (unsigned)C * 2u;
        oc[0][i] = (unsigned)(R * Pa) + (unsigned)C * 2u; oc[1][i] = oc[0][i] + (unsigned)hstepA; o2[0][i] = oc[0][i]; o2[1][i] = oc[1][i]; }
    const unsigned ldsw = (unsigned)wid * 1024u;
    const int aoff0 = lds_byte(wr * 64 + fr, fq * 8), aoff1 = lds_byte(wr * 64 + fr, fq * 8 + 32), boff0 = lds_byte(wc * 32 + fr, fq * 8), boff1 = lds_byte(wc * 32 + fr, fq * 8 + 32);
#define PG8_SA(b, h) (((b) * 2 + (h)) * HTB)
#define PG8_SB(b, h) ((4 + (b) * 2 + (h)) * HTB)
#define PG8_STAGE(bufoff, gbase, voff) do { const char* _g = uptr((const char*)(gbase)); _Pragma("unroll") for (int _i = 0; _i < 2; ++_i) { unsigned _o = (voff)[_i]; asm volatile("" : "+v"(_o)); \
        __builtin_amdgcn_global_load_lds((const unsigned*)(_g + _o), (LAS unsigned*)(lds + (bufoff) + ldsw + _i * 8192), 16, 0, 0); } } while (0)
#define PG8_STAGE_A(bufoff, gbase, h, O) do { const char* _g = uptr((const char*)(gbase) + (GATHER ? (size_t)0 : (size_t)(h) * hstepA)); _Pragma("unroll") for (int _i = 0; _i < 2; ++_i) { unsigned _o = (O)[GATHER ? (h) : 0][_i]; asm volatile("" : "+v"(_o)); \
        __builtin_amdgcn_global_load_lds((const unsigned*)(_g + _o), (LAS unsigned*)(lds + (bufoff) + ldsw + _i * 8192), 16, 0, 0); } } while (0)
#define PG8_CAT2(x, y) __builtin_shufflevector(__builtin_bit_cast(i32x4, (x)), __builtin_bit_cast(i32x4, (y)), 0, 1, 2, 3, 4, 5, 6, 7)
#define PG8_RDA(b, h, m, k) (*(const LAS bf16x8*)(lds + PG8_SA(b, h) + ((k) ? aoff1 : aoff0) + (m) * 2048))
#define PG8_RDB(b, h, n, k) (*(const LAS bf16x8*)(lds + PG8_SB(b, h) + ((k) ? boff1 : boff0) + (n) * 2048))
#define PG8_LDA(dst, b, h) do { _Pragma("unroll") for (int m = 0; m < 4; ++m) { \
        if constexpr (FP8) { dst##8[m] = PG8_CAT2(PG8_RDA(b, h, m, 0), PG8_RDA(b, h, m, 1)); } else { dst[m][0] = PG8_RDA(b, h, m, 0); dst[m][1] = PG8_RDA(b, h, m, 1); } } } while (0)
#define PG8_LDB(dst, b, h) do { _Pragma("unroll") for (int n = 0; n < 2; ++n) { \
        if constexpr (FP8) { dst##8[n] = PG8_CAT2(PG8_RDB(b, h, n, 0), PG8_RDB(b, h, n, 1)); } else { dst[n][0] = PG8_RDB(b, h, n, 0); dst[n][1] = PG8_RDB(b, h, n, 1); } } } while (0)
#define PG8_MMA(ai, bj, At, Bt) do { __builtin_amdgcn_s_setprio(1); \
        if constexpr (FP8) { _Pragma("unroll") for (int m = 0; m < 4; ++m) _Pragma("unroll") for (int n = 0; n < 2; ++n) \
            asm volatile(".p2align 3\n\tv_mfma_f32_16x16x128_f8f6f4 %0, %1, %2, %0" : "+v"(acc[ai][bj][m][n]) : "v"(Bt##8[n]), "v"(At##8[m])); } \
        else { _Pragma("unroll") for (int m = 0; m < 4; ++m) _Pragma("unroll") for (int n = 0; n < 2; ++n) _Pragma("unroll") for (int k = 0; k < 2; ++k) \
            asm volatile(".p2align 3\n\tv_mfma_f32_16x16x32_bf16 %0, %1, %2, %0" : "+v"(acc[ai][bj][m][n]) : "v"(Bt[n][k]), "v"(At[m][k])); } \
        __builtin_amdgcn_s_setprio(0); } while (0)
#define PG8_WAIT_V(n) asm volatile("s_waitcnt vmcnt(" #n ")" ::: "memory")
#define PG8_WAIT_L(n) asm volatile("s_waitcnt lgkmcnt(" #n ")" ::: "memory")
#define PG8_BAR __builtin_amdgcn_s_barrier()
#define PG8_SCHED __builtin_amdgcn_sched_barrier(0)
#define PG8_LOADOFFS(u, o) do { const int _t = wid * 64 + PG8_LANE(); _Pragma("unroll") for (int _i = 0; _i < 2; ++_i) { int _R, _C; stage_rc(_t * 16 + _i * 8192, _R, _C); \
        _Pragma("unroll") for (int _h = 0; _h < 2; ++_h) { int _row = _h * HALF + _R; _row = _row < (u).nvalid ? _row : (u).nvalid - 1; const int _tok = (u).tl[_row]; o[_h][_i] = (unsigned)_tok * (unsigned)Pa + (unsigned)_C * 2u; } } } while (0)
#define PG8_KITER(LAST) do { \
            const char* a1 = cA + (size_t)(t + 1) * kstep; \
            const char* a2 = (LAST) ? nA : cA + (size_t)(t + 2) * kstep; const char* b2 = (LAST) ? nB : cB + (size_t)(t + 2) * kstep; \
            const char* a3 = a2 + kstep; const char* b3 = b2 + kstep; \
            PG8_LDB(B0, 0, 0); PG8_LDB(B1, 0, 1); PG8_SCHED; PG8_LDA(At, 0, 0); PG8_STAGE_A(PG8_SA(1, 1), a1, 1, oc); \
            if constexpr (GATHER && (LAST)) { if (has_next) { const int _t = wid * 64 + PG8_LANE(); _Pragma("unroll") for (int _i = 0; _i < 2; ++_i) { int _R, _C; stage_rc(_t * 16 + _i * 8192, _R, _C); \
                _Pragma("unroll") for (int _h = 0; _h < 2; ++_h) { int _row = _h * HALF + _R; _row = _row < nxt.nvalid ? _row : nxt.nvalid - 1; o2[_h][_i] = (unsigned)ids[_row] * (unsigned)Pa + (unsigned)_C * 2u; } } } \
                else { _Pragma("unroll") for (int _h = 0; _h < 2; ++_h) _Pragma("unroll") for (int _i = 0; _i < 2; ++_i) o2[_h][_i] = oc[_h][_i]; } } \
            else { _Pragma("unroll") for (int _h = 0; _h < 2; ++_h) _Pragma("unroll") for (int _i = 0; _i < 2; ++_i) o2[_h][_i] = oc[_h][_i]; } \
            PG8_WAIT_V(8); PG8_WAIT_L(0); PG8_BAR; PG8_MMA(0, 0, At, B0); PG8_MMA(0, 1, At, B1); PG8_BAR; PG8_SCHED; \
            PG8_LDA(At, 0, 1); PG8_STAGE(PG8_SB(0, 0), b2, voffB); PG8_STAGE(PG8_SB(0, 1), b2 + hstep, voffB); PG8_STAGE_A(PG8_SA(0, 0), a2, 0, o2); \
            PG8_WAIT_V(8); PG8_WAIT_L(0); PG8_BAR; PG8_MMA(1, 0, At, B0); PG8_MMA(1, 1, At, B1); PG8_BAR; PG8_SCHED; \
            PG8_LDB(B0, 1, 0); PG8_LDB(B1, 1, 1); PG8_SCHED; PG8_LDA(At, 1, 0); PG8_STAGE_A(PG8_SA(0, 1), a2, 1, o2); \
            PG8_WAIT_V(8); PG8_WAIT_L(0); PG8_BAR; PG8_MMA(0, 0, At, B0); PG8_MMA(0, 1, At, B1); PG8_BAR; PG8_SCHED; \
            PG8_LDA(At, 1, 1); PG8_STAGE(PG8_SB(1, 0), b3, voffB); PG8_STAGE(PG8_SB(1, 1), b3 + hstep, voffB); PG8_STAGE_A(PG8_SA(1, 0), a3, 0, o2); \
            PG8_WAIT_V(8); PG8_WAIT_L(0); PG8_BAR; PG8_MMA(1, 0, At, B0); PG8_MMA(1, 1, At, B1); PG8_BAR; PG8_SCHED; \
        } while (0)
    Unit cur, nxt; int ui = 0;
    if (!S.next(0, cur)) return;
    f32x4 acc[2][2][4][2];
#pragma unroll
    for (int a = 0; a < 2; ++a)
#pragma unroll
        for (int b = 0; b < 2; ++b)
#pragma unroll
            for (int m = 0; m < 4; ++m)
#pragma unroll
                for (int n = 0; n < 2; ++n) acc[a][b][m][n] = (f32x4){0.f, 0.f, 0.f, 0.f};
    bf16x8 At[4][2], B0[2][2], B1[2][2]; i32x8 At8[4], B08[2], B18[2];
    const char* cA = cur.A; const char* cB = cur.B;
    if constexpr (GATHER) { PG8_LOADOFFS(cur, oc); }
    PG8_STAGE(PG8_SB(0, 0), cB, voffB); PG8_STAGE(PG8_SB(0, 1), cB + hstep, voffB); PG8_STAGE_A(PG8_SA(0, 0), cA, 0, oc); PG8_STAGE_A(PG8_SA(0, 1), cA, 1, oc);
    if (wr == 1) PG8_BAR;
    PG8_WAIT_V(2); PG8_BAR;
    PG8_STAGE(PG8_SB(1, 0), cB + kstep, voffB); PG8_STAGE_A(PG8_SA(1, 0), cA + kstep, 0, oc); PG8_STAGE(PG8_SB(1, 1), cB + hstep + kstep, voffB);
    PG8_WAIT_V(6); PG8_BAR;
    for (;;) {
        const bool has_next = S.next(ui + 1, nxt);
        const char* nA = has_next ? nxt.A : cA; const char* nB = has_next ? nxt.B : cB;
        if constexpr (GATHER) {
            if (has_next && wid < 4) __builtin_amdgcn_global_load_lds((const unsigned*)(nxt.tl + wid * 64 + PG8_LANE()), (LAS unsigned*)(ids + wid * 64), 4, 0, 0);
        }
        int t = 0;
#pragma nounroll
        for (; t < nt - 2; t += 2) PG8_KITER(false);
        PG8_KITER(true);
        if (wr == 0) PG8_BAR;
        asm volatile("s_nop 15\n\ts_nop 15" ::: "memory");
        const int lane_e = PG8_LANE();
        const bool keep = E(acc, cur, wr, wc, lane_e & 15, lane_e >> 4);
        if (!has_next) break;
        if (!keep) {
#pragma unroll
            for (int a = 0; a < 2; ++a)
#pragma unroll
                for (int b = 0; b < 2; ++b)
#pragma unroll
                    for (int m = 0; m < 4; ++m)
#pragma unroll
                        for (int n = 0; n < 2; ++n) acc[a][b][m][n] = (f32x4){0.f, 0.f, 0.f, 0.f};
        }
        cur = nxt; cA = nA; cB = nB; ++ui;
        if constexpr (GATHER) {
#pragma unroll
            for (int h = 0; h < 2; ++h)
#pragma unroll
                for (int i = 0; i < 2; ++i) oc[h][i] = o2[h][i];
        }
        if (wr == 1) PG8_BAR;
    }
    PG8_WAIT_V(0);
    PG8_BAR;
#undef PG8_SA
#undef PG8_SB
#undef PG8_STAGE
#undef PG8_STAGE_A
#undef PG8_LDA
#undef PG8_LDB
#undef PG8_MMA
#undef PG8_CAT2
#undef PG8_RDA
#undef PG8_RDB
#undef PG8_WAIT_V
#undef PG8_WAIT_L
#undef PG8_BAR
#undef PG8_SCHED
#undef PG8_LOADOFFS
#undef PG8_LANE
#undef PG8_KITER
}

struct SchedDense {
    const char* A; const char* B; int nM, nN, G, c; size_t tstepA, tstep;
    __device__ __forceinline__ bool next(int i, Unit& u) const {
        const long L = (long)i * G + c; if (L >= (long)nM * nN) return false;
        tile_map((int)L, nM, nN, u.pm, u.pn); u.A = A + (size_t)u.pm * tstepA; u.B = B + (size_t)u.pn * tstep;
        u.tl = nullptr; u.e = 0; u.kind = 0; u.rowbase = u.pm * BM; u.nvalid = BM; return true; }
};
struct SchedGate {
    const char* A; const char* B; int nM, nN, G, c; size_t tstepA, tstep;
    __device__ __forceinline__ bool next(int i, Unit& u) const {
        long L;
        if (G == 256) { if (i < 3) L = (long)i * G + c; else { if (c < 128 || i > 4) return false; L = 3L * G + (long)(i - 3) * 128 + (c - 128); } }
        else L = (long)i * G + c;
        if (L >= (long)nM * nN) return false;
        tile_map((int)L, nM, nN, u.pm, u.pn); u.A = A + (size_t)u.pm * tstepA; u.B = B + (size_t)u.pn * tstep;
        u.tl = nullptr; u.e = 0; u.kind = 0; u.rowbase = u.pm * BM; u.nvalid = BM; return true; }
};
struct SchedBranch {
    const char* A0; const char* B0; const char* A1; const char* B1; int nM, nN, G, c; size_t tstepA, tstep;
    __device__ __forceinline__ bool next(int i, Unit& u) const {
        const long L = (long)(i >> 1) * G + c; if (L >= (long)nM * nN) return false;
        tile_map((int)L, nM, nN, u.pm, u.pn); u.kind = i & 1;
        u.A = (u.kind ? A1 : A0) + (size_t)u.pm * tstepA; u.B = (u.kind ? B1 : B0) + (size_t)u.pn * tstep;
        u.tl = nullptr; u.e = 0; u.rowbase = u.pm * BM; u.nvalid = BM; return true; }
};
struct SchedMoE {
    const LAS int* tab;
    const char* A; const char* B; size_t bexp; const int* lists; int NT, G, c; size_t tstep; int pa; bool gather;
    __device__ __forceinline__ bool next(int i, Unit& u) const {
        const int nwg = __builtin_amdgcn_readfirstlane(tab[32]);
        const long L = (long)i * G + c; if (L >= nwg) return false;
        int wgid = (int)L; { const int q = nwg / NXCD, r = nwg % NXCD, xcd = wgid % NXCD, off = wgid / NXCD; wgid = (xcd < r ? xcd * (q + 1) : r * (q + 1) + (xcd - r) * q) + off; }
        const int ln = (int)__builtin_amdgcn_mbcnt_hi(~0u, __builtin_amdgcn_mbcnt_lo(~0u, 0u)), le = ln < 32 ? ln : 31;
        const int ulo = tab[le], uhi = tab[le + 1];
        const unsigned long long mm = __ballot(ln < 32 && ulo <= wgid && wgid < uhi);
        const int e = __builtin_amdgcn_readfirstlane((int)__builtin_ctzll(mm | (1ull << 31)));
        const int local = wgid - __builtin_amdgcn_readfirstlane(tab[e]); u.e = e; u.pm = local / NT; u.pn = local % NT; u.kind = 0;
        u.rowbase = __builtin_amdgcn_readfirstlane(tab[64 + e]) + u.pm * BM; int nv = __builtin_amdgcn_readfirstlane(tab[128 + e]) - u.pm * BM; u.nvalid = nv > BM ? BM : nv;
        u.B = B + (size_t)e * bexp + (size_t)u.pn * tstep;
        if (gather) { u.A = A; u.tl = lists + (size_t)e * LISTCAP + u.pm * BM; }
        else { u.A = A + (size_t)u.rowbase * pa; u.tl = nullptr; }
        return true; }
};

#define EPI_FOR_ROWS  _Pragma("unroll") for (int ai = 0; ai < 2; ++ai) _Pragma("unroll") for (int m = 0; m < 4; ++m)
struct EpiInProj {
    bf16_t* Z; const float* bias; bf16_t* VT; bf16_t* GVT; unsigned long long* lnstat;
    __device__ __forceinline__ bool operator()(f32x4 (&acc)[2][2][4][2], const Unit& u, int wr, int wc, int fr, int fq) const {
        const int pn = u.pn, act = pn < 2 ? 0 : (pn == 2 ? 1 : 2);
        const int col0 = pn * BM + wc * 32 + 8 * fq;
        f32x4 bv[2][2];
#pragma unroll
        for (int bj = 0; bj < 2; ++bj)
#pragma unroll
            for (int n = 0; n < 2; ++n) bv[bj][n] = *(const f32x4*)(bias + col0 + bj * HALF + 4 * n);
        EPI_FOR_ROWS { const int row = u.rowbase + ai * HALF + wr * 64 + m * 16 + fr; bf16_t* rowp = Z + (size_t)row * NZ + col0; float ls1 = 0.f, ls2 = 0.f;
#pragma unroll
            for (int bj = 0; bj < 2; ++bj) { f32x4 v0 = acc[ai][bj][m][0] + bv[bj][0], v1 = acc[ai][bj][m][1] + bv[bj][1];
                if (act == 0) { v0 = v0 * 0.125f; v1 = v1 * 0.125f; }
                else if (act == 2) {
#pragma unroll
                    for (int i = 0; i < 4; ++i) { v0[i] = gelu_tanh(v0[i]); v1[i] = gelu_tanh(v1[i]); } }
                u32x4 w; w.x = cvt_pk_bf16(v0[0], v0[1]); w.y = cvt_pk_bf16(v0[2], v0[3]); w.z = cvt_pk_bf16(v1[0], v1[1]); w.w = cvt_pk_bf16(v1[2], v1[3]);
                if (pn == 5 || pn == 6) {
                    float xv[8]; unpack8(w, xv);
#pragma unroll
                    for (int i = 0; i < 8; ++i) { ls1 += xv[i]; ls2 = fmaf(xv[i], xv[i], ls2); } }
                else *(u32x4*)(rowp + bj * HALF) = w;
                if ((pn == 2 && bj == 1) || pn == 5 || pn == 6) {
                    const int bt = row >> 11, sq = row & (SEQ - 1);
                    bf16_t* tp; int cs;
                    if (pn == 2) { tp = VT + ((size_t)(bt * 128 + wc * 32 + 8 * fq)) * SEQ + sq; cs = SEQ; }
                    else { const int gg = 4 * (pn - 5) + 2 * bj + (wc >> 1), dtt = wc & 1, chunk = sq >> 7, ks = (sq >> 4) & 7, hh = (sq >> 3) & 1, jj = sq & 7;
                        tp = GVT + ((size_t)(((((bt * 16 + chunk) * 8 + gg) * 8 + ks) * 2 + dtt)) * 512 + (hh * 32 + 8 * fq) * 8 + jj); cs = 8; }
                    tp[0 * cs] = (bf16_t)(w.x & 0xffffu); tp[1 * cs] = (bf16_t)(w.x >> 16); tp[2 * cs] = (bf16_t)(w.y & 0xffffu); tp[3 * cs] = (bf16_t)(w.y >> 16);
                    tp[4 * cs] = (bf16_t)(w.z & 0xffffu); tp[5 * cs] = (bf16_t)(w.z >> 16); tp[6 * cs] = (bf16_t)(w.w & 0xffffu); tp[7 * cs] = (bf16_t)(w.w >> 16); } }
            if (pn == 5 || pn == 6) {
                ls1 += __shfl_xor(ls1, 16); ls2 += __shfl_xor(ls2, 16); ls1 += __shfl_xor(ls1, 32); ls2 += __shfl_xor(ls2, 32);
                if (fq == 0) { atomicAdd(lnstat + (size_t)row * 2, (unsigned long long)(long long)rintf(ls1 * 1048576.f)); atomicAdd(lnstat + (size_t)row * 2 + 1, (unsigned long long)(long long)rintf(ls2 * 1048576.f)); } } }
        return false;
    }
};
struct EpiGate8 {
    unsigned char* G8; const float* bias;
    __device__ __forceinline__ bool operator()(f32x4 (&acc)[2][2][4][2], const Unit& u, int wr, int wc, int fr, int fq) const {
        const int col0 = u.pn * BM + wc * 32 + 8 * fq;
        const float ke = -1.4426950408889634f / (FP8_SH * FP8_SW);
        f32x4 bv[2][2];
#pragma unroll
        for (int bj = 0; bj < 2; ++bj)
#pragma unroll
            for (int n = 0; n < 2; ++n) bv[bj][n] = *(const f32x4*)(bias + col0 + bj * HALF + 4 * n) * -1.4426950408889634f;
        unsigned char* gp = G8 + ((size_t)((u.pm * 8 + u.pn) * 8 + wr * 4 + wc)) * 8192 + (fq * 16 + fr) * 8;
        EPI_FOR_ROWS {
#pragma unroll
            for (int bj = 0; bj < 2; ++bj) { u32x2 gq; gq.x = 0u; gq.y = 0u;
#pragma unroll
                for (int n = 0; n < 2; ++n) { unsigned pw = 0u;
#pragma unroll
                    for (int i = 0; i < 4; ++i) { const float e = __builtin_amdgcn_exp2f(fmaf(acc[ai][bj][m][n][i], ke, bv[bj][n][i]));
                        const float q = fmaxf(fmaf(__builtin_amdgcn_rcpf(1.f + e), 255.f, 0.5f), 1.f);
                        pw = __builtin_amdgcn_cvt_pk_u8_f32(q, i, pw); }
                    if (n == 0) gq.x = pw; else gq.y = pw; }
                *(u32x2*)(gp + ((ai * 4 + m) * 2 + bj) * 512) = gq; } }
        return false;
    }
};
struct EpiBranch {
    const unsigned char* G8; bf16_t* O;
    __device__ __forceinline__ bool operator()(f32x4 (&acc)[2][2][4][2], const Unit& u, int wr, int wc, int fr, int fq) const {
        const int col0 = u.pn * BM + wc * 32 + 8 * fq;
        const unsigned char* ga = G8 + ((size_t)((u.pm * 8 + u.pn) * 8 + wr * 4 + wc)) * 8192 + (fq * 16 + fr) * 8;
        const unsigned char* gs = ga + (size_t)4 * 8 * 8192;
#define EPI_CL16(g, o) asm volatile("" : "+v"(g[o + 0]), "+v"(g[o + 1]), "+v"(g[o + 2]), "+v"(g[o + 3]), "+v"(g[o + 4]), "+v"(g[o + 5]), "+v"(g[o + 6]), "+v"(g[o + 7]), \
            "+v"(g[o + 8]), "+v"(g[o + 9]), "+v"(g[o + 10]), "+v"(g[o + 11]), "+v"(g[o + 12]), "+v"(g[o + 13]), "+v"(g[o + 14]), "+v"(g[o + 15]))
        if (u.kind == 0) {
            u32x2 qa[16], qs[16];
#pragma unroll
            for (int k = 0; k < 16; ++k) { qa[k] = *(const u32x2*)(ga + k * 512); qs[k] = *(const u32x2*)(gs + k * 512); }
            EPI_CL16(qa, 0); EPI_CL16(qs, 0);
#pragma unroll
            for (int ai = 0; ai < 2; ++ai)
#pragma unroll
                for (int m = 0; m < 4; ++m)
#pragma unroll
                    for (int bj = 0; bj < 2; ++bj) { const int k = (ai * 4 + m) * 2 + bj;
#pragma unroll
                        for (int n = 0; n < 2; ++n) { const unsigned wa = n ? qa[k].y : qa[k].x, wsg = n ? qs[k].y : qs[k].x;
#pragma unroll
                            for (int i = 0; i < 4; ++i) acc[ai][bj][m][n][i] *= (float)((wa >> (8 * i)) & 255u) * __builtin_amdgcn_rcpf((float)((wsg >> (8 * i)) & 255u)); } }
            return true;
        }
        { u32x2 qs[16];
#pragma unroll
          for (int k = 0; k < 16; ++k) qs[k] = *(const u32x2*)(gs + k * 512);
          EPI_CL16(qs, 0);
#pragma unroll
          for (int ai = 0; ai < 2; ++ai)
#pragma unroll
            for (int m = 0; m < 4; ++m) { const int row = u.rowbase + ai * HALF + wr * 64 + m * 16 + fr; bf16_t* op = O + (size_t)row * D + col0;
#pragma unroll
                for (int bj = 0; bj < 2; ++bj) { const int k = (ai * 4 + m) * 2 + bj; float g[8];
#pragma unroll
                    for (int i = 0; i < 4; ++i) { g[i] = (float)((qs[k].x >> (8 * i)) & 255u) * (1.f / 255.f); g[4 + i] = (float)((qs[k].y >> (8 * i)) & 255u) * (1.f / 255.f); }
                    const f32x4 v0 = acc[ai][bj][m][0], v1 = acc[ai][bj][m][1];
                    u32x4 w; w.x = cvt_pk_bf16(v0[0] * g[0], v0[1] * g[1]); w.y = cvt_pk_bf16(v0[2] * g[2], v0[3] * g[3]); w.z = cvt_pk_bf16(v1[0] * g[4], v1[1] * g[5]); w.w = cvt_pk_bf16(v1[2] * g[6], v1[3] * g[7]);
                    *(u32x4*)(op + bj * HALF) = w; } } }
#undef EPI_CL16
        return false;
    }
};
struct EpiBiasBf16 {
    bf16_t* O; int ldo; const float* bias; int bstride; float sc; int mode;
    __device__ __forceinline__ bool operator()(f32x4 (&acc)[2][2][4][2], const Unit& u, int wr, int wc, int fr, int fq) const {
        if (mode & 4) return false;
        const int col0 = u.pn * BM + wc * 32 + 8 * fq; const float* bp = bias + (size_t)u.e * bstride + col0;
        f32x4 bv[2][2];
#pragma unroll
        for (int bj = 0; bj < 2; ++bj)
#pragma unroll
            for (int n = 0; n < 2; ++n) bv[bj][n] = (f32x4){0.f, 0.f, 0.f, 0.f};
        if (!(mode & 1)) {
#pragma unroll
        for (int bj = 0; bj < 2; ++bj)
#pragma unroll
            for (int n = 0; n < 2; ++n) bv[bj][n] = *(const f32x4*)(bp + bj * HALF + 4 * n);
        }
        EPI_FOR_ROWS { const int row = u.rowbase + ai * HALF + wr * 64 + m * 16 + fr; bf16_t* op = O + (size_t)row * ldo + col0;
#pragma unroll
            for (int bj = 0; bj < 2; ++bj) { const f32x4 v0 = acc[ai][bj][m][0] * sc + bv[bj][0], v1 = acc[ai][bj][m][1] * sc + bv[bj][1];
                u32x4 w; w.x = cvt_pk_bf16(v0[0], v0[1]); w.y = cvt_pk_bf16(v0[2], v0[3]); w.z = cvt_pk_bf16(v1[0], v1[1]); w.w = cvt_pk_bf16(v1[2], v1[3]);
                if (mode & 2) asm volatile("" :: "v"(w)); else *(u32x4*)(op + bj * HALF) = w; } }
        return false;
    }
};
struct EpiBiasFp8 {
    unsigned char* O; const float* bias; int bstride; float sc; int mode;
    __device__ __forceinline__ bool operator()(f32x4 (&acc)[2][2][4][2], const Unit& u, int wr, int wc, int fr, int fq) const {
        if (mode & 4) return false;
        const int col0 = u.pn * BM + wc * 32 + 8 * fq; const float* bp = bias + (size_t)u.e * bstride + col0;
        f32x2_t sc2; VCONST2(sc2, FP8_SY / (FP8_SA * FP8_SW));
        f32x2_t bv[2][4];
#pragma unroll
        for (int bj = 0; bj < 2; ++bj)
#pragma unroll
            for (int n = 0; n < 2; ++n) { const f32x4 t = *(const f32x4*)(bp + bj * HALF + 4 * n);
                bv[bj][2 * n][0] = t[0] * FP8_SY; bv[bj][2 * n][1] = t[1] * FP8_SY; bv[bj][2 * n + 1][0] = t[2] * FP8_SY; bv[bj][2 * n + 1][1] = t[3] * FP8_SY; }
        const int odd = fq & 1;
#pragma unroll
        for (int ai = 0; ai < 2; ++ai)
#pragma unroll
            for (int mp = 0; mp < 2; ++mp) { const int row = u.rowbase + ai * HALF + wr * 64 + (2 * mp + odd) * 16 + fr; unsigned char* op = O + (size_t)row * PF8 + (col0 - 8 * odd);
#pragma unroll
                for (int bj = 0; bj < 2; ++bj) { u32x2 w[2];
#pragma unroll
                    for (int q = 0; q < 2; ++q) { const int m = 2 * mp + q; unsigned wq[2];
#pragma unroll
                        for (int n = 0; n < 2; ++n) { unsigned pw = 0;
#pragma unroll
                            for (int hh = 0; hh < 2; ++hh) { f32x2_t a2; a2[0] = acc[ai][bj][m][n][2 * hh]; a2[1] = acc[ai][bj][m][n][2 * hh + 1];
                                f32x2_t v2 = a2 * sc2 + bv[bj][2 * n + hh]; v2[0] = __builtin_amdgcn_fmed3f(v2[0], -448.f, 448.f); v2[1] = __builtin_amdgcn_fmed3f(v2[1], -448.f, 448.f);
                                pw = hh ? __builtin_amdgcn_cvt_pk_fp8_f32(v2[0], v2[1], pw, true) : __builtin_amdgcn_cvt_pk_fp8_f32(v2[0], v2[1], pw, false); }
                            wq[n] = pw; }
                        w[q].x = wq[0]; w[q].y = wq[1]; }
                    const auto rx = __builtin_amdgcn_permlane16_swap(w[0].x, w[1].x, false, false); const auto ry = __builtin_amdgcn_permlane16_swap(w[0].y, w[1].y, false, false);
                    const u32x4 o = (u32x4){rx[0], ry[0], rx[1], ry[1]};
                    if (mode & 2) asm volatile("" :: "v"(o));
                    else if (mode & 1) { const int ln = fq * 16 + fr; *(u32x4*)(O + (size_t)(u.rowbase + ai * HALF + wr * 64 + (wc & 1) * 32 + (mp * 2 + bj) * 8 + (ln >> 3)) * PF8 + u.pn * BM + (wc >> 1) * 128 + (ln & 7) * 16) = o; }
                    else *(u32x4*)(op + bj * HALF) = o; } }
        return false;
    }
};
struct EpiSwiGLU {
    unsigned char* O; const float* b1; int mode;
    __device__ __forceinline__ bool operator()(f32x4 (&acc)[2][2][4][2], const Unit& u, int wr, int wc, int fr, int fq) const {
        if (mode & 4) return false;
        const int cl = wc * 32 + 8 * fq, colo = u.pn * HALF + cl; const float* bp = b1 + (size_t)u.e * (2 * DE) + colo;
        f32x2_t isc2, sa2, nc2, one2;
        VCONST2(isc2, 1.f / (FP8_SH * FP8_SW)); VCONST2(sa2, FP8_SA); VCONST2(nc2, -2.4554669595930157f); VCONST2(one2, 1.f);
        f32x2_t bg[4], bl[4];
        { f32x4 t[4];
#pragma unroll
          for (int n = 0; n < 2; ++n) { t[n] = *(const f32x4*)(bp + 4 * n); t[2 + n] = *(const f32x4*)(bp + DE + 4 * n); }
#pragma unroll
          for (int n = 0; n < 2; ++n) { bg[2 * n][0] = t[n][0]; bg[2 * n][1] = t[n][1]; bg[2 * n + 1][0] = t[n][2]; bg[2 * n + 1][1] = t[n][3];
              bl[2 * n][0] = t[2 + n][0]; bl[2 * n][1] = t[2 + n][1]; bl[2 * n + 1][0] = t[2 + n][2]; bl[2 * n + 1][1] = t[2 + n][3]; } }
        const int odd = fq & 1;
#pragma unroll
        for (int ai = 0; ai < 2; ++ai)
#pragma unroll
            for (int mp = 0; mp < 2; ++mp) { const int row = u.rowbase + ai * HALF + wr * 64 + (2 * mp + odd) * 16 + fr; u32x2 w[2];
#pragma unroll
                for (int q = 0; q < 2; ++q) { const int m = 2 * mp + q; unsigned wq[2];
#pragma unroll
                    for (int n = 0; n < 2; ++n) { unsigned pw = 0;
#pragma unroll
                        for (int hh = 0; hh < 2; ++hh) { f32x2_t a2, c2; a2[0] = acc[ai][0][m][n][2 * hh]; a2[1] = acc[ai][0][m][n][2 * hh + 1]; c2[0] = acc[ai][1][m][n][2 * hh]; c2[1] = acc[ai][1][m][n][2 * hh + 1];
                            f32x2_t g2 = a2 * isc2 + bg[2 * n + hh], l2 = c2 * isc2 + bl[2 * n + hh];
                            g2[0] = fminf(g2[0], 7.f); g2[1] = fminf(g2[1], 7.f); l2[0] = __builtin_amdgcn_fmed3f(l2[0], -7.f, 7.f); l2[1] = __builtin_amdgcn_fmed3f(l2[1], -7.f, 7.f);
                            const f32x2_t l1 = l2 * sa2 + sa2;
                            f32x2_t e2 = g2 * nc2; e2[0] = __builtin_amdgcn_exp2f(e2[0]); e2[1] = __builtin_amdgcn_exp2f(e2[1]);
                            f32x2_t d2 = e2 + one2; d2[0] = __builtin_amdgcn_rcpf(d2[0]); d2[1] = __builtin_amdgcn_rcpf(d2[1]);
                            const f32x2_t r2 = (g2 * l1) * d2;
                            pw = hh ? __builtin_amdgcn_cvt_pk_fp8_f32(r2[0], r2[1], pw, true) : __builtin_amdgcn_cvt_pk_fp8_f32(r2[0], r2[1], pw, false); }
                        wq[n] = pw; }
                    w[q].x = wq[0]; w[q].y = wq[1]; }
                const auto rx = __builtin_amdgcn_permlane16_swap(w[0].x, w[1].x, false, false); const auto ry = __builtin_amdgcn_permlane16_swap(w[0].y, w[1].y, false, false);
                const u32x4 o = (u32x4){rx[0], ry[0], rx[1], ry[1]};
                if (mode & 2) asm volatile("" :: "v"(o)); else *(u32x4*)(O + (size_t)row * PF8 + (colo - 8 * odd)) = o; }
        return false;
    }
};
}

struct P0Item { const float* src; unsigned char* dst; int N, K, fp8; };
constexpr int NZB = 1792, NZG = NZ - NZB;
constexpr int P0_N_WIN = (D / 64) * (NZB / 32), P0_N_WING = (D / 64) * (NZG / 32), P0_N_WB = (512 / 64) * (D / 32), P0_N_WOUT = (D / 64) * (D / 32), P0_N_W1 = (D / 64) * (2 * DE / 32), P0_N_W2 = (DE / 64) * (D / 32);
constexpr int P0_B0 = P0_N_WIN, P0_B1 = P0_B0 + P0_N_WING, P0_B2 = P0_B1 + P0_N_WB, P0_B3 = P0_B2 + P0_N_WB, P0_B4 = P0_B3 + P0_N_WOUT, P0_B5 = P0_B4 + NE * P0_N_W1, P0_TOTAL = P0_B5 + NE * P0_N_W2;
struct Args { const float* in[25]; float* out; unsigned char* ws; unsigned long long prog[3]; int nprog, pad; };
typedef const __attribute__((address_space(4))) Args* ArgsP;

__device__ __forceinline__ void p0_decode(ArgsP a, unsigned char* ws, int g, P0Item& I) {
    const float* W; unsigned char* WT; int K, N, l, fp8 = 0, w1 = 0, nblk = 0;
    if (g < P0_B0)      { l = g;         W = a->in[6];  WT = ws + WS_WIN;  K = D;   N = NZ; nblk = NZB / 32; }
    else if (g < P0_B1) { l = g - P0_B0; W = a->in[6] + NZB; WT = ws + WS_WING8; K = D; N = NZ; nblk = NZG / 32; fp8 = 1; }
    else if (g < P0_B2) { l = g - P0_B1; W = a->in[13]; WT = ws + WS_WBA;  K = 512; N = D; }
    else if (g < P0_B3) { l = g - P0_B2; W = a->in[14]; WT = ws + WS_WBS;  K = 512; N = D; }
    else if (g < P0_B4) { l = g - P0_B3; W = a->in[15]; WT = ws + WS_WOUT; K = D;   N = D; }
    else if (g < P0_B5) { const int q = g - P0_B4, e = q / P0_N_W1; l = q - e * P0_N_W1; W = a->in[21] + (size_t)e * D * 2 * DE; WT = ws + WS_W1 + (size_t)e * 2 * DE * D; K = D; N = 2 * DE; fp8 = 1; w1 = 1; }
    else                { const int q = g - P0_B5, e = q / P0_N_W2; l = q - e * P0_N_W2; W = a->in[23] + (size_t)e * DE * D;     WT = ws + WS_W2 + (size_t)e * D * DE;      K = DE; N = D; fp8 = 1; }
    if (nblk == 0) nblk = N >> 5;
    int kb, nb;
    if (fp8) { const int q = l >> 1, kbp = q / nblk; nb = q - kbp * nblk; kb = 2 * kbp + (l & 1); } else { kb = l / nblk; nb = l - kb * nblk; }
    const int n0 = nb * 32, k0 = kb * 64;
    int drow0 = n0;
    if (w1) drow0 = (n0 < DE) ? ((n0 >> 7) * 256 + (n0 & 127)) : (((n0 - DE) >> 7) * 256 + 128 + ((n0 - DE) & 127));
    I.src = W + (size_t)k0 * N + n0; I.dst = WT + ((size_t)drow0 * K + k0) * (fp8 ? 1 : 2); I.N = N; I.K = K; I.fp8 = fp8;
}
#define P0_LOAD(I, R) do { const float* _s = (I).src + (size_t)(lane >> 3) * (I).N + 4 * (lane & 7); const size_t _st = (size_t)8 * (I).N; \
        _Pragma("unroll") for (int _i = 0; _i < 8; ++_i) R[_i] = __builtin_nontemporal_load((const f32x4*)(_s + _i * _st)); } while (0)
#define P0_PIN(R) asm volatile("" : "+v"(R[0]), "+v"(R[1]), "+v"(R[2]), "+v"(R[3]), "+v"(R[4]), "+v"(R[5]), "+v"(R[6]), "+v"(R[7]) :: "memory")
__device__ __forceinline__ void p0_to_lds(f32x4 (&R)[8], LAS float* scr, int lane) {
#pragma unroll
    for (int i = 0; i < 8; ++i) { LAS float* d = scr + ((lane >> 3) + 8 * i) * 33 + 4 * (lane & 7); d[0] = R[i][0]; d[1] = R[i][1]; d[2] = R[i][2]; d[3] = R[i][3]; }
    asm volatile("s_waitcnt lgkmcnt(0)" ::: "memory");
}
__device__ __forceinline__ void p0_from_lds(const P0Item& I, LAS float* scr, int lane) {
    const int c = lane & 7;
    if (I.fp8) {
#pragma unroll
        for (int j = 0; j < 4; ++j) { const int n = (lane >> 3) + 8 * j; const LAS float* t = scr + (8 * c) * 33 + n;
            u32x2 o; o.x = cvt4_fp8(t[0 * 33], t[1 * 33], t[2 * 33], t[3 * 33], FP8_SW); o.y = cvt4_fp8(t[4 * 33], t[5 * 33], t[6 * 33], t[7 * 33], FP8_SW);
            __builtin_nontemporal_store(o, (u32x2*)(I.dst + (size_t)n * I.K + 8 * c)); }
    } else {
#pragma unroll
        for (int j = 0; j < 4; ++j) { const int n = (lane >> 3) + 8 * j; const LAS float* t = scr + (8 * c) * 33 + n;
            u32x4 o; o.x = pk2(t[0 * 33], t[1 * 33]); o.y = pk2(t[2 * 33], t[3 * 33]); o.z = pk2(t[4 * 33], t[5 * 33]); o.w = pk2(t[6 * 33], t[7 * 33]);
            *(u32x4*)(I.dst + ((size_t)n * I.K + 8 * c) * 2) = o; }
    }
    asm volatile("s_waitcnt lgkmcnt(0)" ::: "memory");
}

__device__ __forceinline__ void phase0(Frame& F, ArgsP a) {
    unsigned char* ws = a->ws;
    {
        const float* c_in = a->in[1]; const float* w_mod = a->in[2]; float* modp = (float*)(ws + WS_MODP);
        LAS float* cact = (LAS float*)F.lds;
        for (int it = blockIdx.x; it < KSPLIT * 16; it += F.G) {
            const int ks = it >> 4, nc = it & 15, k0 = ks * 64; const bool act = F.tid < 384; const int n = nc * 384 + (act ? F.tid : 0);
            for (int idx = F.tid; idx < 1024; idx += NTHREADS) { const int b = idx & 15, kk = idx >> 4; const float cv = c_in[b * D + k0 + kk]; cact[kk * 16 + b] = cv * sigmoidf_(cv); }
            __syncthreads();
            float acc[16];
#pragma unroll
            for (int b = 0; b < 16; ++b) acc[b] = 0.f;
#pragma unroll 1
            for (int kb = 0; kb < 4; ++kb) { float wv[16];
#pragma unroll
                for (int j = 0; j < 16; ++j) wv[j] = __builtin_nontemporal_load(w_mod + (size_t)(k0 + 16 * kb + j) * 6144 + n);
                asm volatile("" : "+v"(wv[0]), "+v"(wv[1]), "+v"(wv[2]), "+v"(wv[3]), "+v"(wv[4]), "+v"(wv[5]), "+v"(wv[6]), "+v"(wv[7]), "+v"(wv[8]), "+v"(wv[9]), "+v"(wv[10]), "+v"(wv[11]), "+v"(wv[12]), "+v"(wv[13]), "+v"(wv[14]), "+v"(wv[15]));
#pragma unroll
                for (int j = 0; j < 16; ++j) { const int kk = 16 * kb + j; const float w = wv[j];
#pragma unroll
                    for (int b4 = 0; b4 < 4; ++b4) { const f32x4 cv = *(const LAS f32x4*)(cact + kk * 16 + 4 * b4);
                        acc[4 * b4 + 0] += cv[0] * w; acc[4 * b4 + 1] += cv[1] * w; acc[4 * b4 + 2] += cv[2] * w; acc[4 * b4 + 3] += cv[3] * w; } } }
            if (act) {
#pragma unroll
                for (int b = 0; b < 16; ++b) modp[((size_t)ks * 16 + b) * 6144 + n] = acc[b]; }
            __syncthreads();
        }
    }
    { const float* sg_w = a->in[11]; bf16_t* SGW = (bf16_t*)(ws + WS_SGW);
      for (int idx = blockIdx.x * NTHREADS + F.tid; idx < 8 * 128 * 128 / 2; idx += F.G * NTHREADS) { const int e0 = 2 * idx, j = e0 & 7, L = (e0 >> 3) & 63, tt = (e0 >> 9) & 3, ks = (e0 >> 11) & 7, g = e0 >> 14;
          const int t = 32 * tt + (L & 31), sc = 16 * ks + 8 * (L >> 5) + j; const float* src = sg_w + ((size_t)g * 128 + t) * 128 + sc;
          const float w0 = sc <= t ? src[0] : 0.f, w1 = sc + 1 <= t ? src[1] : 0.f; ((unsigned*)SGW)[idx] = pk2(w0, w1); } }
    { int gw = blockIdx.x * NWAVES + F.wave; asm volatile("" : "+s"(gw));
      const int NGW = F.G * NWAVES; const int lane = F.lane;
      LAS float* scr = (LAS float*)(F.lds + F.wave * 16384);
      P0Item IA, IB, IC; f32x4 ra[8], rb[8];
      int g = gw;
      { const int g2 = g + NGW; p0_decode(a, ws, g < P0_TOTAL ? g : 0, IA); P0_LOAD(IA, ra); p0_decode(a, ws, g2 < P0_TOTAL ? g2 : 0, IB); P0_LOAD(IB, rb); }
#pragma unroll 1
      while (g < P0_TOTAL) {
          const int g2 = g + NGW, g3 = g2 + NGW, g4 = g3 + NGW;
          P0_PIN(ra); p0_to_lds(ra, scr, lane); IC = IA; p0_decode(a, ws, g3 < P0_TOTAL ? g3 : 0, IA); P0_LOAD(IA, ra); p0_from_lds(IC, scr, lane);
          if (g2 >= P0_TOTAL) break;
          P0_PIN(rb); p0_to_lds(rb, scr, lane); IC = IB; p0_decode(a, ws, g4 < P0_TOTAL ? g4 : 0, IB); P0_LOAD(IB, rb); p0_from_lds(IC, scr, lane);
          g = g3;
      }
    }
}

template <int NI>
__device__ __forceinline__ void load_mod(Frame& F, ArgsP a, int b, int col0, LAS float* dst) {
    const float* modp = (const float*)(a->ws + WS_MODP); const float* b_mod = a->in[3];
    static_assert(KSPLIT == 16, "the clustering statement below names 16 values");
    float pv[NI][KSPLIT], s[NI];
#pragma unroll
    for (int j = 0; j < NI; ++j) { const int col = col0 + F.tid + j * NTHREADS; s[j] = b_mod[col];
#pragma unroll
        for (int ks = 0; ks < KSPLIT; ++ks) pv[j][ks] = modp[((size_t)ks * 16 + b) * 6144 + col]; }
#pragma unroll
    for (int j = 0; j < NI; ++j)
        asm volatile("" : "+v"(pv[j][0]), "+v"(pv[j][1]), "+v"(pv[j][2]), "+v"(pv[j][3]), "+v"(pv[j][4]), "+v"(pv[j][5]), "+v"(pv[j][6]), "+v"(pv[j][7]), "+v"(pv[j][8]), "+v"(pv[j][9]), "+v"(pv[j][10]), "+v"(pv[j][11]), "+v"(pv[j][12]), "+v"(pv[j][13]), "+v"(pv[j][14]), "+v"(pv[j][15]));
#pragma unroll
    for (int j = 0; j < NI; ++j) { float t = s[j];
#pragma unroll
        for (int ks = 0; ks < KSPLIT; ++ks) t += pv[j][ks];
        dst[F.tid + j * NTHREADS] = t; }
}

__device__ __forceinline__ void phase0b(Frame& F, ArgsP a) {
    const float* x = a->in[0]; const float* g = a->in[4]; bf16_t* H = (bf16_t*)(a->ws + WS_H); unsigned char* HF8 = a->ws + WS_HF8;
    LAS float* mv = (LAS float*)F.lds;
    for (int chunk = blockIdx.x; chunk < T / 128; chunk += F.G) {
        const int b = chunk / 16;
        load_mod<4>(F, a, b, 0, mv);
        for (int idx = F.tid; idx < 1024; idx += NTHREADS) mv[1024 + idx] = g[idx] * (1.f + mv[1024 + idx]);
        __syncthreads();
        for (int tt = 0; tt < 16; ++tt) {
            const int row = chunk * 128 + F.wave * 16 + tt;
            const f32x4* xr = (const f32x4*)(x + (size_t)row * D) + F.lane;
            f32x4 v[4]; float ss = 0.f;
#pragma unroll
            for (int j = 0; j < 4; ++j) { v[j] = __builtin_nontemporal_load(xr + 64 * j); ss += (v[j][0] * v[j][0] + v[j][1] * v[j][1]) + (v[j][2] * v[j][2] + v[j][3] * v[j][3]); }
            const float rstd = rsqrtf(wave_sum(ss) * (1.f / D) + EPS);
            u32x2* o8 = (u32x2*)(H + (size_t)row * D) + F.lane;
#pragma unroll
            for (int j = 0; j < 4; ++j) { const int col = 4 * F.lane + 256 * j; float r[4];
#pragma unroll
                for (int i = 0; i < 4; ++i) r[i] = (v[j][i] * rstd) * mv[1024 + col + i] + mv[col + i];
                u32x2 w; w.x = pk2(r[0], r[1]); w.y = pk2(r[2], r[3]); o8[64 * j] = w;
                ((unsigned*)(HF8 + (size_t)row * PF8))[F.lane + 64 * j] = cvt4_fp8(r[0], r[1], r[2], r[3], FP8_SH); }
        }
        __syncthreads();
    }
}

__device__ __forceinline__ void attn_item_mfma(Frame& F, ArgsP a, int item) {
    const int kvh = item & 1, n = (item >> 1) & 15, b = item >> 5;
    const bf16_t* Z = (const bf16_t*)(a->ws + WS_Z); const bf16_t* VT = (const bf16_t*)(a->ws + WS_VT); bf16_t* YA = (bf16_t*)(a->ws + WS_YATT);
    LAS bf16_t* Ks = (LAS bf16_t*)F.lds;
    LAS bf16_t* Vs = Ks + 256 * 72;
    const int tok0 = b * SEQ + n * 128;
    {
        u32x4 kr[4], vr[4]; int tid_o = F.tid; asm volatile("" : "+v"(tid_o));
#pragma unroll
        for (int it = 0; it < 4; ++it) { const int c = tid_o + it * NTHREADS, kj = c >> 3, ch = c & 7; const bool ok = n > 0 || kj >= 128;
            kr[it] = *(const u32x4*)(Z + (size_t)(tok0 + (ok ? kj - 128 : kj)) * NZ + ZK + kvh * 64 + ch * 8); }
#pragma unroll
        for (int it = 0; it < 4; ++it) { const int c = tid_o + it * NTHREADS, d = c >> 5, ch = c & 31; const bool ok = n > 0 || ch >= 16;
            vr[it] = *(const u32x4*)(VT + (size_t)(b * 128 + kvh * 64 + d) * SEQ + n * 128 + (ok ? ch - 16 : ch) * 8); }
        asm volatile("" : "+v"(kr[0]), "+v"(kr[1]), "+v"(kr[2]), "+v"(kr[3]), "+v"(vr[0]), "+v"(vr[1]), "+v"(vr[2]), "+v"(vr[3]));
#pragma unroll
        for (int it = 0; it < 4; ++it) { const int c = tid_o + it * NTHREADS, kj = c >> 3, ch = c & 7; const bool ok = n > 0 || kj >= 128;
            *(LAS u32x4*)(Ks + kj * 72 + ch * 8) = ok ? kr[it] : (u32x4){0u, 0u, 0u, 0u}; }
#pragma unroll
        for (int it = 0; it < 4; ++it) { const int c = tid_o + it * NTHREADS, d = c >> 5, ch = c & 31; const bool ok = n > 0 || ch >= 16;
            *(LAS u32x4*)(Vs + d * 264 + ch * 8) = ok ? vr[it] : (u32x4){0u, 0u, 0u, 0u}; }
    }
    __syncthreads();
    const int r = F.lane & 31, h = F.lane >> 5;
    const int pr = (r & ~12) | ((r & 4) << 1) | ((r & 8) >> 1);
#pragma unroll 1
    for (int j = 0; j < 2; ++j) {
        const int tk = F.wave * 2 + j, g = tk >> 2, qs = tk & 3, hq = kvh * 4 + g;
        const int qi = 32 * qs + r;
        const bf16_t* qp = Z + (size_t)(tok0 + qi) * NZ + ZQ + hq * 64 + 8 * h;
        bf16x8 qf[4];
#pragma unroll
        for (int ks = 0; ks < 4; ++ks) qf[ks] = *(const bf16x8*)(qp + 16 * ks);
        const float slope = exp2f(-(float)(hq + 1)), sink = a->in[8][hq];
        float mrun = sink, lsum = 0.f;
        f32x16 O[2];
#pragma unroll
        for (int dt = 0; dt < 2; ++dt)
#pragma unroll
            for (int i = 0; i < 16; ++i) O[dt][i] = 0.f;
        const float nsl2 = -slope * 1.4426950408889634f;
        const float sink2 = sink * 1.4426950408889634f;
        mrun = sink2;
#pragma unroll
        for (int tt = 0; tt < 5; ++tt) {
            if (n == 0 && qs + tt < 4) continue;
            f32x16 S;
#pragma unroll
            for (int i = 0; i < 16; ++i) S[i] = 0.f;
            const LAS bf16_t* kp = Ks + (32 * (qs + tt) + pr) * 72 + 8 * h;
#pragma unroll
            for (int ks = 0; ks < 4; ++ks) { const bf16x8 kf = *(const LAS bf16x8*)(kp + 16 * ks); S = MFMA32(kf, qf[ks], S); }
            const int dbase = r + 128 - 32 * tt - 8 * h; const float fb = nsl2 * (float)dbase;
            float tmax = -1e30f;
#pragma unroll
            for (int i = 0; i < 16; ++i) { const int kjl = (i & 3) + 4 * ((i >> 2) & 1) + 16 * (i >> 3);
                float v = fmaf(S[i], 1.4426950408889634f, fb - nsl2 * (float)kjl);
                if (tt == 0) { if (!(dbase - kjl < 128)) v = -1e30f; }
                if (tt == 4) { if (!(dbase - kjl >= 0)) v = -1e30f; }
                S[i] = v; tmax = fmaxf(tmax, v); }
            tmax = fmaxf(tmax, __shfl_xor(tmax, 32));
            const float mnew = fmaxf(mrun, tmax), alpha = __builtin_amdgcn_exp2f(mrun - mnew); mrun = mnew;
            float ps = 0.f;
#pragma unroll
            for (int i = 0; i < 16; ++i) { const float p = __builtin_amdgcn_exp2f(S[i] - mnew); S[i] = p; ps += p; }
            lsum = lsum * alpha + ps;
#pragma unroll
            for (int dt = 0; dt < 2; ++dt)
#pragma unroll
                for (int i = 0; i < 16; ++i) O[dt][i] *= alpha;
#pragma unroll
            for (int sx = 0; sx < 2; ++sx) {
                u32x4 pw; pw.x = cvtpk(S[8 * sx + 0], S[8 * sx + 1]); pw.y = cvtpk(S[8 * sx + 2], S[8 * sx + 3]); pw.z = cvtpk(S[8 * sx + 4], S[8 * sx + 5]); pw.w = cvtpk(S[8 * sx + 6], S[8 * sx + 7]);
                const bf16x8 pb = __builtin_bit_cast(bf16x8, pw);
#pragma unroll
                for (int dt = 0; dt < 2; ++dt) { const bf16x8 vf = *(const LAS bf16x8*)(Vs + (32 * dt + r) * 264 + 32 * (qs + tt) + 16 * sx + 8 * h); O[dt] = MFMA32(vf, pb, O[dt]); }
            }
        }
        const float l = lsum + __shfl_xor(lsum, 32) + __builtin_amdgcn_exp2f(sink2 - mrun);
        const float inv = 1.f / l;
        bf16_t* yp = YA + (size_t)(tok0 + qi) * 512 + hq * 64;
#pragma unroll
        for (int dt = 0; dt < 2; ++dt)
#pragma unroll
            for (int a4 = 0; a4 < 4; ++a4) { u32x2 w; w.x = cvtpk(O[dt][4 * a4] * inv, O[dt][4 * a4 + 1] * inv); w.y = cvtpk(O[dt][4 * a4 + 2] * inv, O[dt][4 * a4 + 3] * inv);
                *(u32x2*)(yp + 32 * dt + 8 * a4 + 4 * h) = w; }
    }
    __syncthreads();
}

__device__ __forceinline__ void gmlp_item_mfma(Frame& F, ArgsP a, int item) {
    const int b = item >> 4, chunk = item & 15;
    const bf16_t* Z = (const bf16_t*)(a->ws + WS_Z); const bf16_t* GVT = (const bf16_t*)(a->ws + WS_GVT); const bf16_t* SGW = (const bf16_t*)(a->ws + WS_SGW); bf16_t* YS = (bf16_t*)(a->ws + WS_YSG);
    const float* ln_g = a->in[9]; const float* ln_b = a->in[10]; const float* sg_b = a->in[12];
    LAS float* st = (LAS float*)(F.lds + MISC_OFF + 4096);
    const int tok0 = b * SEQ + chunk * 128;
    int tid_o = F.tid; asm volatile("" : "+v"(tid_o));
    if (tid_o < 128) {
        const long long* sp = (const long long*)(a->ws + WS_CTL + CTL_LNSTAT) + (size_t)(tok0 + tid_o) * 2;
        const float s1 = (float)sp[0] * (1.f / 1048576.f), s2 = (float)sp[1] * (1.f / 1048576.f);
        const float mean = s1 * (1.f / 512.f), var = fmaxf(s2 * (1.f / 512.f) - mean * mean, 0.f);
        st[2 * tid_o] = mean; st[2 * tid_o + 1] = rsqrtf(var + EPS); }
    __syncthreads();
    const int g = F.wave, r = F.lane & 31, h = F.lane >> 5;
    f32x16 acc[2][4];
#pragma unroll
    for (int dt = 0; dt < 2; ++dt)
#pragma unroll
        for (int tt = 0; tt < 4; ++tt)
#pragma unroll
            for (int i = 0; i < 16; ++i) acc[dt][tt][i] = 0.f;
    float gam[2], bet[2];
#pragma unroll
    for (int dt = 0; dt < 2; ++dt) { gam[dt] = ln_g[g * 64 + 32 * dt + r]; bet[dt] = ln_b[g * 64 + 32 * dt + r]; }
    const char* gS = pg8::uptr((const char*)(GVT + (size_t)(((b * 16 + chunk) * 8 + g) * 8) * 1024));
    const char* wS = pg8::uptr((const char*)(SGW + (size_t)(g * 8) * 2048));
    unsigned lo16 = (unsigned)F.lane * 16u; asm volatile("" : "+v"(lo16));
#define GM_LOADA(KS, RAW) do { _Pragma("unroll") for (int _dt = 0; _dt < 2; ++_dt) RAW[_dt] = *(const u32x4*)(gS + (KS) * 2048 + _dt * 1024 + lo16); } while (0)
#define GM_LOADW(KS, W) do { _Pragma("unroll") for (int _tt = 0; _tt < 4; ++_tt) if ((KS) <= 2 * _tt + 1) W[_tt] = *(const bf16x8*)(wS + (KS) * 4096 + _tt * 1024 + lo16); } while (0)
#define GM_PIN(RAW, W) asm volatile("" : "+v"(RAW[0]), "+v"(RAW[1]), "+v"(W[0]), "+v"(W[1]), "+v"(W[2]), "+v"(W[3]) :: "memory")
#define GM_STEP(KS, RAW, W) do { float x0[8], x1[8]; unpack8(RAW[0], x0); unpack8(RAW[1], x1); \
        _Pragma("unroll") for (int q4 = 0; q4 < 4; ++q4) { const f32x4 sv = *(const LAS f32x4*)(st + 2 * (16 * (KS) + 8 * h) + 4 * q4); \
            x0[2 * q4] = (x0[2 * q4] - sv[0]) * sv[1] * gam[0] + bet[0]; x0[2 * q4 + 1] = (x0[2 * q4 + 1] - sv[2]) * sv[3] * gam[0] + bet[0]; \
            x1[2 * q4] = (x1[2 * q4] - sv[0]) * sv[1] * gam[1] + bet[1]; x1[2 * q4 + 1] = (x1[2 * q4 + 1] - sv[2]) * sv[3] * gam[1] + bet[1]; } \
        bf16x8 af[2]; \
        { u32x4 pw; pw.x = cvtpk(x0[0], x0[1]); pw.y = cvtpk(x0[2], x0[3]); pw.z = cvtpk(x0[4], x0[5]); pw.w = cvtpk(x0[6], x0[7]); af[0] = __builtin_bit_cast(bf16x8, pw); } \
        { u32x4 pw; pw.x = cvtpk(x1[0], x1[1]); pw.y = cvtpk(x1[2], x1[3]); pw.z = cvtpk(x1[4], x1[5]); pw.w = cvtpk(x1[6], x1[7]); af[1] = __builtin_bit_cast(bf16x8, pw); } \
        _Pragma("unroll") for (int tt = 0; tt < 4; ++tt) if ((KS) <= 2 * tt + 1) { \
            _Pragma("unroll") for (int dt = 0; dt < 2; ++dt) acc[dt][tt] = MFMA32(af[dt], W[tt], acc[dt][tt]); } } while (0)
    u32x4 rA[2], rB[2]; bf16x8 wA[4], wB[4];
#pragma unroll
    for (int tt = 0; tt < 4; ++tt) { wA[tt] = (bf16x8){0, 0, 0, 0, 0, 0, 0, 0}; wB[tt] = wA[tt]; }
    GM_LOADA(0, rA); GM_LOADW(0, wA);
#pragma unroll
    for (int ks = 0; ks < 8; ks += 2) {
        GM_LOADA(ks + 1, rB); GM_LOADW(ks + 1, wB);
        GM_PIN(rA, wA); GM_STEP(ks, rA, wA);
        if (ks < 6) { GM_LOADA(ks + 2, rA); GM_LOADW(ks + 2, wA); }
        GM_PIN(rB, wB); GM_STEP(ks + 1, rB, wB);
    }
#undef GM_LOADW
#undef GM_PIN
#undef GM_STEP
#undef GM_LOADA
    LAS bf16_t* tb = (LAS bf16_t*)(F.lds + F.wave * 9216);
#pragma unroll
    for (int tp = 0; tp < 2; ++tp) {
        u32x4 uw[8];
#pragma unroll
        for (int i = 0; i < 8; ++i) { const int t = 64 * tp + 8 * i + (F.lane >> 3); uw[i] = *(const u32x4*)(Z + (size_t)(tok0 + t) * NZ + ZU + g * 64 + 8 * (F.lane & 7)); }
#pragma unroll
        for (int tq = 0; tq < 2; ++tq) { const int tt = 2 * tp + tq; const float bias = sg_b[g * 128 + 32 * tt + r];
#pragma unroll
            for (int dt = 0; dt < 2; ++dt)
#pragma unroll
                for (int a4 = 0; a4 < 4; ++a4) { u32x2 w; w.x = cvtpk(acc[dt][tt][4 * a4] + bias, acc[dt][tt][4 * a4 + 1] + bias); w.y = cvtpk(acc[dt][tt][4 * a4 + 2] + bias, acc[dt][tt][4 * a4 + 3] + bias);
                    *(LAS u32x2*)(tb + (32 * tq + r) * 72 + 32 * dt + 8 * a4 + 4 * h) = w; } }
        asm volatile("s_waitcnt lgkmcnt(0)" ::: "memory");
#pragma unroll
        for (int i = 0; i < 8; ++i) { const int tr = 8 * i + (F.lane >> 3), t = 64 * tp + tr; float m[8], uu[8];
            unpack8(*(const LAS u32x4*)(tb + tr * 72 + 8 * (F.lane & 7)), m); unpack8(uw[i], uu);
            u32x4 o; o.x = cvtpk(uu[0] * m[0], uu[1] * m[1]); o.y = cvtpk(uu[2] * m[2], uu[3] * m[3]); o.z = cvtpk(uu[4] * m[4], uu[5] * m[5]); o.w = cvtpk(uu[6] * m[6], uu[7] * m[7]);
            *(u32x4*)(YS + (size_t)(tok0 + t) * 512 + g * 64 + 8 * (F.lane & 7)) = o; }
        asm volatile("s_waitcnt lgkmcnt(0)" ::: "memory");
    }
    __syncthreads();
}

__device__ __forceinline__ void phase5(Frame& F, ArgsP a, const int pmode) {
    const float* x = a->in[0]; const float* g_post = a->in[5]; const float* g_pre = a->in[17]; const float* w_r = a->in[19]; const float* b_r = a->in[20];
    const bf16_t* Y = (const bf16_t*)(a->ws + WS_Y); unsigned char* H2 = (unsigned char*)(a->ws + WS_H2); bf16_t* X1B = (bf16_t*)(a->ws + WS_X1B);
    unsigned* gcnt = (unsigned*)(a->ws + WS_CTL) + CW_CNT; int* lists = (int*)(a->ws + WS_LISTS); int* tokinfo = (int*)(a->ws + WS_TOKINFO);
    constexpr int H2P = 1032;
    LAS float* h2buf = (LAS float*)F.lds;
    LAS float* part = (LAS float*)(F.lds + 66560);
    LAS float* mv = (LAS float*)(F.lds + 82944);
    LAS int* hist = (LAS int*)(F.lds + 95232);
    LAS int* basep = hist + 32;
    LAS int* asg_e = hist + 64;
    LAS int* asg_l = asg_e + 512;
    LAS float* asg_g = (LAS float*)(asg_l + 512);
    LAS float* lgs = asg_g + 512;
    LAS float* sel_v = lgs + 512;
    LAS int* sel_e = (LAS int*)(sel_v + 64);
    const int e_l = F.lane & 31, kh = F.lane >> 5, n_l = F.lane & 15, kq = F.lane >> 4;
    float wreg[2][32];
#pragma unroll
    for (int hf = 0; hf < 2; ++hf)
#pragma unroll
        for (int j = 0; j < 32; ++j) wreg[hf][j] = w_r[(size_t)(128 * F.wave + 16 * (j >> 2) + 4 * kq + (j & 3)) * NE + 16 * hf + n_l];
    float br_l = b_r[e_l]; asm volatile("" : "+v"(br_l));
    for (int chunk = blockIdx.x; chunk < T / 128; chunk += F.G) {
        const int b = chunk / 16;
        {
#pragma unroll 1
          for (int j = 0; j < 6; j += 2) load_mod<2>(F, a, b, 2048 + j * NTHREADS, mv + j * NTHREADS); }
        for (int idx = F.tid; idx < 1024; idx += NTHREADS) { mv[idx] *= g_post[idx]; mv[2048 + idx] = g_pre[idx] * (1.f + mv[2048 + idx]); }
        if (F.tid < 32) hist[F.tid] = 0;
        __syncthreads();
#define P5_LOADROWS(SB, XR, YR) do { _Pragma("unroll") for (int _j = 0; _j < 2; ++_j) { const int _row = chunk * 128 + (SB) * 16 + 2 * F.wave + _j; \
            const f32x4* _xr = (const f32x4*)(x + (size_t)_row * D) + F.lane; const u32x2* _yr = (const u32x2*)(Y + (size_t)_row * D) + F.lane; \
            _Pragma("unroll") for (int _jj = 0; _jj < 4; ++_jj) { XR[_j][_jj] = __builtin_nontemporal_load(_xr + 64 * _jj); YR[_j][_jj] = __builtin_nontemporal_load(_yr + 64 * _jj); } } } while (0)
        f32x4 xc[2][4]; u32x2 yc[2][4];
        P5_LOADROWS(0, xc, yc);
        for (int sb = 0; sb < 8; ++sb) {
#pragma unroll
            for (int j = 0; j < 2; ++j) {
                const int tt = 2 * F.wave + j, row = chunk * 128 + sb * 16 + tt;
                f32x4 xv[4], yv[4]; float ss = 0.f;
#pragma unroll
                for (int jj = 0; jj < 4; ++jj) { xv[jj] = xc[j][jj]; const u32x2 w = yc[j][jj];
                    yv[jj][0] = __uint_as_float(w.x << 16); yv[jj][1] = __uint_as_float(w.x & 0xffff0000u); yv[jj][2] = __uint_as_float(w.y << 16); yv[jj][3] = __uint_as_float(w.y & 0xffff0000u);
                    ss += (yv[jj][0] * yv[jj][0] + yv[jj][1] * yv[jj][1]) + (yv[jj][2] * yv[jj][2] + yv[jj][3] * yv[jj][3]); }
                const float rstd = rsqrtf(wave_sum(ss) * (1.f / D) + EPS); float s1 = 0.f;
#pragma unroll
                for (int jj = 0; jj < 4; ++jj) { const int col = 4 * F.lane + 256 * jj;
#pragma unroll
                    for (int i = 0; i < 4; ++i) { const float v = xv[jj][i] + mv[col + i] * (yv[jj][i] * rstd); xv[jj][i] = v; s1 += v * v; }
                    u32x2 xw; xw.x = cvtpk(xv[jj][0], xv[jj][1]); xw.y = cvtpk(xv[jj][2], xv[jj][3]); __builtin_nontemporal_store(xw, (u32x2*)(X1B + (size_t)row * D) + F.lane + 64 * jj); }
                const float rstd1 = rsqrtf(wave_sum(s1) * (1.f / D) + EPS);
                unsigned* o8 = (unsigned*)(H2 + (size_t)row * PF8) + F.lane;
#pragma unroll
                for (int jj = 0; jj < 4; ++jj) { const int col = 4 * F.lane + 256 * jj; f32x4 r;
#pragma unroll
                    for (int i = 0; i < 4; ++i) r[i] = (xv[jj][i] * rstd1) * mv[2048 + col + i] + mv[1024 + col + i];
                    o8[64 * jj] = cvt4_fp8(r[0], r[1], r[2], r[3], FP8_SH);
                    *(LAS f32x4*)(h2buf + tt * H2P + col) = r; }
            }
            { const int sbn = sb < 7 ? sb + 1 : 7; P5_LOADROWS(sbn, xc, yc); }
            __syncthreads();
            if (pmode & 1) continue;
            { const LAS f32x4* hp = (const LAS f32x4*)(h2buf + n_l * H2P + 128 * F.wave + 4 * kq);
              f32x4 lg0 = (f32x4){0.f, 0.f, 0.f, 0.f}, lg1 = (f32x4){0.f, 0.f, 0.f, 0.f};
#pragma unroll
              for (int jb = 0; jb < 8; ++jb) { const f32x4 hv = hp[4 * jb];
#pragma unroll
                  for (int i = 0; i < 4; ++i) { lg0 = __builtin_amdgcn_mfma_f32_16x16x4f32(hv[i], wreg[0][4 * jb + i], lg0, 0, 0, 0); lg1 = __builtin_amdgcn_mfma_f32_16x16x4f32(hv[i], wreg[1][4 * jb + i], lg1, 0, 0, 0); } }
#pragma unroll
              for (int i = 0; i < 4; ++i) { part[(F.wave * 16 + 4 * kq + i) * 32 + n_l] = lg0[i]; part[(F.wave * 16 + 4 * kq + i) * 32 + 16 + n_l] = lg1[i]; } }
            __syncthreads();
            if (pmode & 2) continue;
            { const int tt = 2 * F.wave + kh, tokidx = sb * 16 + tt;
              float logit = br_l;
#pragma unroll
              for (int w = 0; w < 8; ++w) logit += part[(w * 16 + tt) * 32 + e_l];
              lgs[tt * 32 + e_l] = logit;
              int rank = 0;
#pragma unroll
              for (int q8 = 0; q8 < 8; ++q8) { const f32x4 v = *(const LAS f32x4*)(lgs + tt * 32 + 4 * q8);
#pragma unroll
                  for (int i = 0; i < 4; ++i) { const int eo = 4 * q8 + i; rank += (v[i] > logit || (v[i] == logit && eo < e_l)) ? 1 : 0; } }
              if (rank < 4) { sel_v[tt * 4 + rank] = logit; sel_e[tt * 4 + rank] = e_l; }
              if (e_l < 4) { const f32x4 sv = *(const LAS f32x4*)(sel_v + tt * 4); const int k = e_l;
                  const float p0 = 1.f, p1 = __expf(sv[1] - sv[0]), p2 = __expf(sv[2] - sv[0]), p3 = __expf(sv[3] - sv[0]); const float inv = 1.f / (p0 + p1 + p2 + p3);
                  const int e = sel_e[tt * 4 + k]; const float gt = (k == 0 ? p0 : (k == 1 ? p1 : (k == 2 ? p2 : p3))) * inv;
                  const int lp = __hip_atomic_fetch_add(hist + e, 1, __ATOMIC_RELAXED, __HIP_MEMORY_SCOPE_WORKGROUP); asg_e[tokidx * 4 + k] = e; asg_l[tokidx * 4 + k] = lp; asg_g[tokidx * 4 + k] = gt; }
            }
        }
        __syncthreads();
        if (pmode) continue;
        if (F.tid < 32) basep[F.tid] = (int)atomicAdd(gcnt + F.tid, (unsigned)hist[F.tid]);
        __syncthreads();
        { const int aidx = F.tid, tokidx = aidx >> 2, k = aidx & 3, e = asg_e[aidx], pos = basep[e] + asg_l[aidx], token = chunk * 128 + tokidx;
          lists[(size_t)e * LISTCAP + pos] = token;
          int* ti = tokinfo + ((size_t)token * 4 + k) * 4; ti[0] = e; ti[1] = pos; ti[2] = __float_as_int(asg_g[aidx]); ti[3] = 0; }
        __syncthreads();
    }
}

__device__ __forceinline__ void moe_tables(Frame& F, ArgsP a, LAS int* tab, int NT) {
    const unsigned* gcnt = (const unsigned*)(a->ws + WS_CTL) + CW_CNT;
    if (F.tid < NE) tab[128 + F.tid] = (int)__hip_atomic_load(gcnt + F.tid, __ATOMIC_RELAXED, __HIP_MEMORY_SCOPE_AGENT);
    if (F.tid == 0) { int us = 0, ro = 0;
        for (int e = 0; e < NE; ++e) { const int c = tab[128 + e]; const int tiles = (c + 255) >> 8; tab[e] = us; tab[64 + e] = ro; us += tiles * NT; ro += tiles * 256; }
        tab[32] = us; tab[64 + 32] = ro; }
    __syncthreads();
}

__device__ __forceinline__ void phase9(Frame& F, ArgsP a) {
    const float* g_pf = a->in[18]; const bf16_t* X1B = (const bf16_t*)(a->ws + WS_X1B);
    const unsigned char* YS = (const unsigned char*)(a->ws + WS_YS); const int* tokinfo = (const int*)(a->ws + WS_TOKINFO); float* out = a->out;
    LAS int* tab = (LAS int*)(F.lds + MISC_OFF); LAS float* mv = (LAS float*)F.lds;
    moe_tables(F, a, tab, 4);
    for (int chunk = blockIdx.x; chunk < T / 128; chunk += F.G) {
        const int b = chunk / 16;
        const int row0 = chunk * 128 + F.wave * 16;
        const u32x4 tinf = *(const u32x4*)(tokinfo + ((size_t)(row0 + (F.lane >> 2)) * 4 + (F.lane & 3)) * 4);
        load_mod<2>(F, a, b, 5120, mv);
        for (int idx = F.tid; idx < 1024; idx += NTHREADS) mv[idx] *= g_pf[idx];
        __syncthreads();
        const int srow = tab[64 + (int)tinf.x] + (int)tinf.y; const float sgate = __uint_as_float(tinf.z) * (1.f / FP8_SY);
#define P9_LOAD(I, SR, XR) do { _Pragma("unroll") for (int _k = 0; _k < 4; ++_k) { const int _r = __shfl(srow, 4 * (I) + _k); const unsigned* _sr = (const unsigned*)(YS + (size_t)_r * PF8) + F.lane; \
            _Pragma("unroll") for (int _jj = 0; _jj < 4; ++_jj) SR[_k][_jj] = __builtin_nontemporal_load(_sr + 64 * _jj); } \
            const u32x2* _xr = (const u32x2*)(X1B + (size_t)(row0 + (I)) * D) + F.lane; \
            _Pragma("unroll") for (int _jj = 0; _jj < 4; ++_jj) XR[_jj] = __builtin_nontemporal_load(_xr + 64 * _jj); } while (0)
#define P9_PIN(SR, XR) asm volatile("" : "+v"(SR[0][0]), "+v"(SR[0][1]), "+v"(SR[0][2]), "+v"(SR[0][3]), "+v"(SR[1][0]), "+v"(SR[1][1]), "+v"(SR[1][2]), "+v"(SR[1][3]), \
            "+v"(SR[2][0]), "+v"(SR[2][1]), "+v"(SR[2][2]), "+v"(SR[2][3]), "+v"(SR[3][0]), "+v"(SR[3][1]), "+v"(SR[3][2]), "+v"(SR[3][3]), "+v"(XR[0]), "+v"(XR[1]), "+v"(XR[2]), "+v"(XR[3]) :: "memory")
#define P9_ROW(I, SR, XR) do { P9_PIN(SR, XR); f32x4 yv[4]; \
            _Pragma("unroll") for (int jj = 0; jj < 4; ++jj) yv[jj] = (f32x4){0.f, 0.f, 0.f, 0.f}; \
            _Pragma("unroll") for (int k = 0; k < 4; ++k) { const float gt = __shfl(sgate, 4 * (I) + k); \
                _Pragma("unroll") for (int jj = 0; jj < 4; ++jj) { const unsigned w = SR[k][jj]; const f32x2_t lo = __builtin_amdgcn_cvt_pk_f32_fp8((int)w, false), hi = __builtin_amdgcn_cvt_pk_f32_fp8((int)w, true); \
                    yv[jj][0] += gt * lo[0]; yv[jj][1] += gt * lo[1]; yv[jj][2] += gt * hi[0]; yv[jj][3] += gt * hi[1]; } } \
            float s1 = 0.f; \
            _Pragma("unroll") for (int jj = 0; jj < 4; ++jj) s1 += (yv[jj][0] * yv[jj][0] + yv[jj][1] * yv[jj][1]) + (yv[jj][2] * yv[jj][2] + yv[jj][3] * yv[jj][3]); \
            const float rstd1 = rsqrtf(wave_sum(s1) * (1.f / D) + EPS); \
            _Pragma("unroll") for (int jj = 0; jj < 4; ++jj) { const int col = 4 * F.lane + 256 * jj; const u32x2 xw = XR[jj]; \
                f32x4 xv; xv[0] = __uint_as_float(xw.x << 16); xv[1] = __uint_as_float(xw.x & 0xffff0000u); xv[2] = __uint_as_float(xw.y << 16); xv[3] = __uint_as_float(xw.y & 0xffff0000u); \
                _Pragma("unroll") for (int ii = 0; ii < 4; ++ii) xv[ii] += mv[col + ii] * (yv[jj][ii] * rstd1); \
                yv[jj] = xv; } \
            asm volatile("" : "+v"(yv[0]), "+v"(yv[1]), "+v"(yv[2]), "+v"(yv[3]) :: "memory"); \
            { const int in_ = (I) < 14 ? (I) + 2 : 15; P9_LOAD(in_, SR, XR); } \
            f32x4* orow = (f32x4*)(out + (size_t)(row0 + (I)) * D) + F.lane; \
            _Pragma("unroll") for (int jj = 0; jj < 4; ++jj) __builtin_nontemporal_store(yv[jj], orow + 64 * jj); } while (0)
        unsigned sA[4][4], sB[4][4]; u32x2 xA[4], xB[4];
        P9_LOAD(0, sA, xA); P9_LOAD(1, sB, xB);
#pragma unroll 1
        for (int i = 0; i < 16; i += 2) { P9_ROW(i, sA, xA); P9_ROW(i + 1, sB, xB); }
#undef P9_PIN
#undef P9_ROW
        __syncthreads();
    }
}

#define XB_TMO      128
#define XB_XCNT(j)  (256  + 64 * (j))
#define XB_XSUB(j)  (1280 + 64 * (j))
#define XB_XGEN(j)  (2304 + 64 * (j))
#define XB_TOP      3328
#define XB_TOPGEN   3392
#define XCD_BAR_WORDS 3456
#define XB_SPIN_CAP (1u << 18)
__device__ __forceinline__ unsigned xb_ld(unsigned* p)              { return __hip_atomic_load(p, __ATOMIC_RELAXED, __HIP_MEMORY_SCOPE_AGENT); }
__device__ __forceinline__ unsigned xb_add(unsigned* p, unsigned v) { return __hip_atomic_fetch_add(p, v, __ATOMIC_RELAXED, __HIP_MEMORY_SCOPE_AGENT); }
__device__ __forceinline__ unsigned xb_xcc_id() { return (unsigned)__builtin_amdgcn_s_getreg((3 << 11) | 20) & 0xFu; }
#define XB_SPIN(cond, bar) do { unsigned _sp = 0; while (cond) { __builtin_amdgcn_s_sleep(1); \
    if ((++_sp & 255u) == 0u) { if (xb_ld(&(bar)[XB_TMO])) break; if (_sp > XB_SPIN_CAP) { atomicAdd(&(bar)[XB_TMO], 1u); break; } } } } while (0)
struct XcdBarrier { unsigned* bar; unsigned x; volatile LAS unsigned* st; };
__device__ __forceinline__ XcdBarrier xcd_barrier_post(unsigned* bar, volatile LAS unsigned* st) {
    XcdBarrier b; b.bar = bar; b.x = xb_xcc_id(); b.st = st;
    if (threadIdx.x == 0) (void)xb_add(&bar[XB_XCNT(b.x)], 1u);
    return b;
}
__device__ __forceinline__ void xcd_barrier_complete(unsigned* bar, unsigned x, unsigned& nloc, unsigned& nx) {
    const unsigned G = gridDim.x * gridDim.y * gridDim.z;
    unsigned sum, cnt, mine, sp = 0u;
    for (;;) {
        sum = 0u; cnt = 0u; mine = 0u;
#pragma unroll
        for (unsigned j = 0; j < 16; ++j) { const unsigned c = xb_ld(&bar[XB_XCNT(j)]); sum += c; cnt += (c > 0u) ? 1u : 0u; mine = (j == x) ? c : mine; }
        if (sum == G) break;
        __builtin_amdgcn_s_sleep(1);
        if ((++sp & 255u) == 0u) { if (xb_ld(&bar[XB_TMO])) break; if (sp > XB_SPIN_CAP) { atomicAdd(&bar[XB_TMO], 1u); break; } }
    }
    nloc = mine > 0u ? mine : 1u; nx = cnt > 0u ? cnt : 1u;
}
__device__ __forceinline__ void xcd_barrier(const XcdBarrier& b, const int wave_s) {
    asm volatile("s_waitcnt vmcnt(0)" ::: "memory");
    __syncthreads();
    int ln_; asm volatile("v_mbcnt_lo_u32_b32 %0, -1, 0\n\tv_mbcnt_hi_u32_b32 %0, -1, %0" : "=v"(ln_));
    if (wave_s == 0 && ln_ == 0) {
        unsigned* bar = b.bar;
        __builtin_amdgcn_s_waitcnt(0);
        unsigned nloc = b.st[0], nx = b.st[1];
        if (nloc == 0u) { xcd_barrier_complete(bar, b.x, nloc, nx); b.st[0] = nloc; b.st[1] = nx; }
        const unsigned old = xb_add(&bar[XB_XSUB(b.x)], 1u);
        const unsigned gen = old / nloc;
        if (old + 1u == (gen + 1u) * nloc) {
            __builtin_amdgcn_fence(__ATOMIC_RELEASE, "agent");
            asm volatile("s_waitcnt vmcnt(0)" ::: "memory");
            const unsigned og = xb_add(&bar[XB_TOP], 1u);
            const unsigned tg = og / nx;
            if (og + 1u == (tg + 1u) * nx) xb_add(&bar[XB_TOPGEN], 1u);
            else XB_SPIN(xb_ld(&bar[XB_TOPGEN]) == tg, bar);
            __builtin_amdgcn_fence(__ATOMIC_ACQUIRE, "agent");
            xb_add(&bar[XB_XGEN(b.x)], 1u);
            asm volatile("s_waitcnt vmcnt(0)" ::: "memory");
        } else {
            XB_SPIN(xb_ld(&bar[XB_XGEN(b.x)]) == gen, bar);
            __builtin_amdgcn_fence(__ATOMIC_ACQUIRE, "agent");
            asm volatile("s_waitcnt vmcnt(0)" ::: "memory");
        }
    }
    __syncthreads();
}

constexpr int NPHASE = 10;
__global__ void __launch_bounds__(NTHREADS, 2) fwd_kernel(Args a_unused) {
    extern __shared__ __attribute__((aligned(16))) unsigned char lds_raw[];
    Frame F; F.lds = (LAS unsigned char*)lds_raw; F.G = gridDim.x;
    ArgsP a = (ArgsP)__builtin_amdgcn_kernarg_segment_ptr();
    volatile LAS unsigned* bst = (volatile LAS unsigned*)(F.lds + MISC_OFF + 1024);
    XcdBarrier xbar; xbar.bar = (unsigned*)(a->ws + WS_CTL) + CW_BAR; xbar.x = 0; xbar.st = bst;
    const int nprog = a->nprog;
    const int wave_s = __builtin_amdgcn_readfirstlane((int)threadIdx.x >> 6);
    if (nprog > 1) { if (threadIdx.x == 0) { bst[0] = 0u; bst[1] = 0u; } __syncthreads(); xbar = xcd_barrier_post((unsigned*)(a->ws + WS_CTL) + CW_BAR, bst); if (nprog < 0) cg::this_grid().sync(); }
#pragma nounroll
    for (int pi = 0; pi < nprog; ++pi) {
        { unsigned long long _p = (unsigned long long)__builtin_amdgcn_kernarg_segment_ptr(); asm volatile("" : "+s"(_p)); a = (ArgsP)_p; }
        { int _l; asm volatile("v_mbcnt_lo_u32_b32 %0, -1, 0\n\tv_mbcnt_hi_u32_b32 %0, -1, %0" : "=v"(_l)); F.lane = _l; F.wave = wave_s; F.tid = wave_s * 64 + _l; }
        { int _g = gridDim.x; asm volatile("" : "+s"(_g)); F.G = _g; }
        int bid = blockIdx.x; asm volatile("" : "+s"(bid));
        unsigned char* ws = a->ws;
        const int pe = (int)((a->prog[pi >> 3] >> ((pi & 7) * 8)) & 0xffull), ph = pe & 15, pmode = pe >> 4;
        switch (ph) {
        case 0: phase0(F, a); break;
        case 1: phase0b(F, a); break;
        case 2: {
            pg8::SchedDense S{(const char*)(ws + WS_H), (const char*)(ws + WS_WIN), T / 256, NZB / 256, F.G, bid, (size_t)256 * D * 2, (size_t)256 * D * 2};
            pg8::EpiInProj E{(bf16_t*)(ws + WS_Z), a->in[7], (bf16_t*)(ws + WS_VT), (bf16_t*)(ws + WS_GVT), (unsigned long long*)(ws + WS_CTL + CTL_LNSTAT)};
            pg8::gemm_phase<pg8::EpiInProj, pg8::SchedDense, false>(F.lds, F.wave, D * 2, D * 2, S, E);
            pg8::SchedGate S2{(const char*)(ws + WS_HF8), (const char*)(ws + WS_WING8), T / 256, NZG / 256, F.G, bid, (size_t)256 * PF8, (size_t)256 * D};
            pg8::EpiGate8 E2{ws + WS_G8, a->in[7] + NZB};
            pg8::gemm_phase<pg8::EpiGate8, pg8::SchedGate, false, true>(F.lds, F.wave, D, PF8, S2, E2);
        } break;
        case 3: {
            for (int it = bid; it < 256 + 512; it += F.G) { if (it < 256) gmlp_item_mfma(F, a, it); else attn_item_mfma(F, a, it - 256); }
        } break;
        case 4: {
            pg8::SchedBranch S{(const char*)(ws + WS_YATT), (const char*)(ws + WS_WBA), (const char*)(ws + WS_YSG), (const char*)(ws + WS_WBS), T / 256, D / 256, F.G, bid, (size_t)256 * 512 * 2, (size_t)256 * 512 * 2};
            pg8::EpiBranch E{ws + WS_G8, (bf16_t*)(ws + WS_H)};
            pg8::gemm_phase<pg8::EpiBranch, pg8::SchedBranch, false>(F.lds, F.wave, 512 * 2, 512 * 2, S, E);
        } break;
        case 5: {
            pg8::SchedDense S{(const char*)(ws + WS_H), (const char*)(ws + WS_WOUT), T / 256, D / 256, F.G, bid, (size_t)256 * D * 2, (size_t)256 * D * 2};
            pg8::EpiBiasBf16 E{(bf16_t*)(ws + WS_Y), D, a->in[16], 0, 1.f, pmode};
            pg8::gemm_phase<pg8::EpiBiasBf16, pg8::SchedDense, false>(F.lds, F.wave, D * 2, D * 2, S, E);
        } break;
        case 6: phase5(F, a, pmode); break;
        case 7: {
            LAS int* tab = (LAS int*)(F.lds + MISC_OFF); moe_tables(F, a, tab, 8);
            pg8::SchedMoE S{tab, (const char*)(ws + WS_H2), (const char*)(ws + WS_W1), (size_t)2 * DE * D, (const int*)(ws + WS_LISTS), 8, F.G, bid, (size_t)256 * D, PF8, true};
            pg8::EpiSwiGLU E{(unsigned char*)(ws + WS_ACT), a->in[22], pmode};
            pg8::gemm_phase<pg8::EpiSwiGLU, pg8::SchedMoE, true, true>(F.lds, F.wave, D, PF8, S, E);
        } break;
        case 8: {
            LAS int* tab = (LAS int*)(F.lds + MISC_OFF); moe_tables(F, a, tab, 4);
            pg8::SchedMoE S{tab, (const char*)(ws + WS_ACT), (const char*)(ws + WS_W2), (size_t)D * DE, nullptr, 4, F.G, bid, (size_t)256 * DE, PF8, false};
            pg8::EpiBiasFp8 E{(unsigned char*)(ws + WS_YS), a->in[24], D, 1.f / (FP8_SA * FP8_SW), pmode};
            pg8::gemm_phase<pg8::EpiBiasFp8, pg8::SchedMoE, false, true>(F.lds, F.wave, DE, PF8, S, E);
        } break;
        case 9: phase9(F, a); break;
        default: if (bid == 0 && F.tid < 32) ((unsigned*)(ws + WS_CTL))[CW_CNT + F.tid] = 0u; break;
        }
        if (pi + 1 < nprog) xcd_barrier(xbar, wave_s);
    }
}

extern "C" void kernel_launch(void* const* d_in, const int* in_sizes, int n_in, void* d_out, int out_size, void* d_ws, size_t ws_size, hipStream_t stream) {
    const void* kfn = (const void*)fwd_kernel;
    static int grid = 0;
    if (grid == 0) {
        if (n_in != 25 || out_size != T * D || ws_size < WS_END) { fprintf(stderr, "kernel_launch: unexpected problem (n_in %d out %d ws %zu)\n", n_in, out_size, ws_size); grid = -1; return; }
        int dev = 0, cus = 0, per_cu = 0;
        (void)hipGetDevice(&dev); (void)hipDeviceGetAttribute(&cus, hipDeviceAttributeMultiprocessorCount, dev);
        (void)hipFuncSetAttribute(kfn, hipFuncAttributeMaxDynamicSharedMemorySize, LDS_BYTES);
        (void)hipOccupancyMaxActiveBlocksPerMultiprocessor(&per_cu, kfn, NTHREADS, LDS_BYTES);
        (void)hipGetLastError();
        if (per_cu < 1) { fprintf(stderr, "kernel_launch: occupancy query says %d blocks per CU\n", per_cu); grid = -1; return; }
        grid = cus;
    }
    if (grid < 0) return;
    (void)hipMemsetAsync((char*)d_ws + WS_CTL, 0, CTL_BYTES, stream);
    Args a{};
    for (int i = 0; i < 25; ++i) a.in[i] = (const float*)d_in[i];
    a.out = (float*)d_out; a.ws = (unsigned char*)d_ws;
    static const unsigned char program[] = PHASE_PROGRAM;
    const int np = (int)sizeof(program);
#if MK_ONE_LAUNCH
    a.nprog = np; for (int i = 0; i < np; ++i) a.prog[i >> 3] |= (unsigned long long)program[i] << ((i & 7) * 8);
    void* args[] = {&a};
    hipError_t e = hipLaunchCooperativeKernel(kfn, dim3(grid), dim3(NTHREADS), args, LDS_BYTES, stream);
    if (e != hipSuccess) fprintf(stderr, "cooperative launch failed: %s (grid %d)\n", hipGetErrorString(e), grid);
#else
    for (int p = 0; p < np; ++p) { a.nprog = 1; a.prog[0] = program[p]; void* args[] = {&a}; (void)hipLaunchKernel(kfn, dim3(grid), dim3(NTHREADS), args, LDS_BYTES, stream); }
#endif
}
```

```cpp
#include <hip/hip_runtime.h>
#include <hip/hip_cooperative_groups.h>
#include <cstdio>
#include <cstdint>
namespace cg = cooperative_groups;

#ifndef PHASE_PROGRAM
#define PHASE_PROGRAM {0, 1, 2, 3, 4, 5, 6, 7, 8, 9}
#endif
#ifndef MK_ONE_LAUNCH
#define MK_ONE_LAUNCH 1
#endif

#define LAS __attribute__((address_space(3)))
typedef unsigned short bf16_t;
typedef short bf16x8 __attribute__((ext_vector_type(8)));
typedef float f32x4 __attribute__((ext_vector_type(4)));
typedef unsigned u32x4 __attribute__((ext_vector_type(4)));
typedef unsigned u32x2 __attribute__((ext_vector_type(2)));
typedef float f32x16 __attribute__((ext_vector_type(16)));
typedef float f32x2_t __attribute__((ext_vector_type(2)));
typedef __bf16 bf16x2_t __attribute__((ext_vector_type(2)));
typedef int i32x4 __attribute__((ext_vector_type(4)));
typedef int i32x8 __attribute__((ext_vector_type(8)));

constexpr int D = 1024, BATCH = 16, SEQ = 2048, T = BATCH * SEQ;
constexpr int NZ = 3840;
constexpr int ZQ = 0, ZK = 512, ZV = 640, ZU = 768, ZVS = 1280, ZGA = 1792, ZGS = 2816;
constexpr int NE = 32, TOPK = 4, DE = 1024;
constexpr int KSPLIT = 16;
constexpr float EPS = 1e-6f;
constexpr int LISTCAP = T;
constexpr int APAD = T * TOPK + NE * 256;
constexpr int PF8 = 1024;

constexpr size_t MiB = 1u << 20;
constexpr size_t WS_CTL = 0, CTL_BYTES = 1 * MiB;
constexpr size_t WS_MODP = 1 * MiB;
constexpr size_t WS_WIN = 8 * MiB;
constexpr size_t WS_WBA = 16 * MiB, WS_WBS = 17 * MiB;
constexpr size_t WS_WOUT = 18 * MiB;
constexpr size_t WS_SGW = 20 * MiB;
constexpr size_t WS_W1 = 24 * MiB;
constexpr size_t WS_W2 = 152 * MiB;
constexpr size_t WS_HF8 = 216 * MiB;
constexpr size_t WS_WING8 = 8 * MiB + (size_t)1792 * 2048;
constexpr size_t WS_H2 = 216 * MiB;
constexpr size_t WS_Z = 280 * MiB;
constexpr size_t WS_YATT = 520 * MiB, WS_YSG = 552 * MiB;
constexpr size_t WS_X1B = 520 * MiB;
constexpr size_t WS_H = 584 * MiB;
constexpr size_t WS_Y = 648 * MiB;
constexpr size_t WS_G8 = 648 * MiB;
constexpr size_t WS_ACT = 280 * MiB;
constexpr size_t WS_YS = 584 * MiB;
constexpr size_t WS_LISTS = 824 * MiB;
constexpr size_t WS_TOKINFO = 828 * MiB;
constexpr size_t WS_VT = 960 * MiB;
constexpr size_t WS_GVT = 968 * MiB;
constexpr size_t WS_END = 1000 * MiB;
constexpr size_t CTL_LNSTAT = 256 * 1024;
constexpr int CW_CNT = 64;
constexpr int CW_BAR = 4096;

constexpr int RING_BYTES = 131072;
constexpr int MISC_OFF = RING_BYTES;
constexpr int LDS_BYTES = 147456;
constexpr int NWAVES = 8, NTHREADS = 512;

__device__ __forceinline__ float bf2f(unsigned h) { return __uint_as_float(h << 16); }
__device__ __forceinline__ unsigned f2bf(float f) { unsigned u = __float_as_uint(f); return (u + 0x7fffu + ((u >> 16) & 1u)) >> 16; }
__device__ __forceinline__ unsigned pk2(float lo, float hi) { return f2bf(lo) | (f2bf(hi) << 16); }
__device__ __forceinline__ void unpack8(const u32x4 r, float* o) {
    o[0] = __uint_as_float(r.x << 16); o[1] = __uint_as_float(r.x & 0xffff0000u);
    o[2] = __uint_as_float(r.y << 16); o[3] = __uint_as_float(r.y & 0xffff0000u);
    o[4] = __uint_as_float(r.z << 16); o[5] = __uint_as_float(r.z & 0xffff0000u);
    o[6] = __uint_as_float(r.w << 16); o[7] = __uint_as_float(r.w & 0xffff0000u);
}
__device__ __forceinline__ unsigned cvtpk(float lo, float hi) { const f32x2_t v = {lo, hi}; const bf16x2_t b = __builtin_convertvector(v, bf16x2_t); return __builtin_bit_cast(unsigned, b); }
constexpr float FP8_SW = 64.f, FP8_SH = 4.f, FP8_SA = 4.f, FP8_SY = 16.f;
__device__ __forceinline__ float fp8_clamp(float v) { return fminf(fmaxf(v, -448.f), 448.f); }
__device__ __forceinline__ unsigned cvt4_fp8(float a, float b, float c, float d, float sc) {
    unsigned w = 0; w = __builtin_amdgcn_cvt_pk_fp8_f32(fp8_clamp(a * sc), fp8_clamp(b * sc), w, false); w = __builtin_amdgcn_cvt_pk_fp8_f32(fp8_clamp(c * sc), fp8_clamp(d * sc), w, true); return w; }
#define MFMA32(a, b, c) __builtin_amdgcn_mfma_f32_32x32x16_bf16((a), (b), (c), 0, 0, 0)
#define VCONST2(x, f) do { float _c; asm volatile("v_mov_b32 %0, %1" : "=v"(_c) : "i"(__builtin_bit_cast(int, (float)(f)))); x[0] = _c; x[1] = _c; } while (0)
#define WS_DPP(v, CTRL) (v + __int_as_float(__builtin_amdgcn_update_dpp(0, __float_as_int(v), (CTRL), 0xf, 0xf, false)))
__device__ __forceinline__ float wave_sum(float v) {
    v = WS_DPP(v, 0xB1);
    v = WS_DPP(v, 0x4E);
    v = WS_DPP(v, 0x141);
    v = WS_DPP(v, 0x140);
    v += __shfl_xor(v, 16); v += __shfl_xor(v, 32);
    return v;
}
__device__ __forceinline__ float sigmoidf_(float x) { return __builtin_amdgcn_rcpf(1.f + __builtin_amdgcn_exp2f(-1.4426950408889634f * x)); }
__device__ __forceinline__ float gelu_tanh(float x) { const float t = x * fmaf(0.044715f * x, x, 1.f); return x * __builtin_amdgcn_rcpf(1.f + __builtin_amdgcn_exp2f(-2.302208198144325f * t)); }

struct Frame { LAS unsigned char* lds; int tid, lane, wave, G; };

namespace pg8 {
constexpr int BM = 256, BK = 64, HALF = 128, HTB = HALF * BK * 2, STAGE_BYTES = 8 * HTB, NXCD = 8, WGM = 4;
__host__ __device__ __forceinline__ int lds_byte(int r, int c) { return (r >> 3) * 1024 + (r & 7) * 128 + ((((c >> 3) ^ r) & 7) << 4) + (c & 7) * 2; }
__host__ __device__ __forceinline__ void stage_rc(int b, int& R, int& C) { const int piece = b >> 10, l16 = (b & 1023) >> 4, r8 = l16 >> 3, cp = l16 & 7; R = piece * 8 + r8; C = ((cp ^ r8) & 7) << 3; }
__host__ __device__ __forceinline__ int perm32(int rho) { const int n = rho >> 4, i = rho & 15; return 8 * (i >> 2) + 4 * n + (i & 3); }
__device__ __forceinline__ unsigned cvt_pk_bf16(float lo, float hi) { unsigned r; asm volatile("v_cvt_pk_bf16_f32 %0, %1, %2" : "=v"(r) : "v"(lo), "v"(hi)); return r; }

struct Unit { const char* A; const char* B; const int* tl; int pm, pn, e, kind, rowbase, nvalid; };
__device__ __forceinline__ const char* uptr(const char* p) { const unsigned long long v = (unsigned long long)p;
    const unsigned lo = __builtin_amdgcn_readfirstlane((unsigned)v), hi = __builtin_amdgcn_readfirstlane((unsigned)(v >> 32)); return (const char*)(((unsigned long long)hi << 32) | lo); }

__device__ __forceinline__ void tile_map(int L, int nM, int nN, int& pm, int& pn) {
    const int nwg = nM * nN;
    int wgid = L; { const int q = nwg / NXCD, r = nwg % NXCD, xcd = wgid % NXCD, off = wgid / NXCD; wgid = (xcd < r ? xcd * (q + 1) : r * (q + 1) + (xcd - r) * q) + off; }
    const int nig = WGM * nN, gid = wgid / nig, fm = gid * WGM, gsz = (nM - fm) < WGM ? (nM - fm) : WGM;
    pm = fm + ((wgid % nig) % gsz); pn = (wgid % nig) / gsz;
}

template <class Epi, class Sched, bool GATHER, bool FP8 = false>
__device__ __forceinline__ void gemm_phase(LAS unsigned char* lds, const int wid, const int Kb, const int Pa, const Sched& S, const Epi& E) {
#define PG8_LANE() ({ int _l; asm volatile("v_mbcnt_lo_u32_b32 %0, -1, 0\n\tv_mbcnt_hi_u32_b32 %0, -1, %0" : "=v"(_l)); _l; })
    const int lane = PG8_LANE(), tid = wid * 64 + lane, wr = wid >> 2, wc = wid & 3, fr = lane & 15, fq = lane >> 4;
    const int nt = Kb / 128;
    unsigned voffB[2]; unsigned oc[2][2], o2[2][2];
    LAS int* ids = (LAS int*)(lds + MISC_OFF + 2048);
    const size_t kstep = (size_t)(BK * 2);
    const size_t hstep = (size_t)HALF * Kb, hstepA = (size_t)HALF * Pa;
#pragma unroll
    for (int i = 0; i < 2; ++i) { int R, C; stage_rc(tid * 16 + i * 8192, R, C); const int Rb = (R & ~31) + perm32(R & 31);
        voffB[i] = (unsigned)(Rb * Kb) + (unsigned)C * 2u;
        oc[0][i] = (unsigned)(R * Pa) + (unsigned)C * 2u; oc[1][i] = oc[0][i] + (unsigned)hstepA; o2[0][i] = oc[0][i]; o2[1][i] = oc[1][i]; }
    const unsigned ldsw = (unsigned)wid * 1024u;
    const int aoff0 = lds_byte(wr * 64 + fr, fq * 8), aoff1 = lds_byte(wr * 64 + fr, fq * 8 + 32), boff0 = lds_byte(wc * 32 + fr, fq * 8), boff1 = lds_byte(wc * 32 + fr, fq * 8 + 32);
#define PG8_SA(b, h) (((b) * 2 + (h)) * HTB)
#define PG8_SB(b, h) ((4 + (b) * 2 + (h)) * HTB)
#define PG8_STAGE(bufoff, gbase, voff) do { const char* _g = uptr((const char*)(gbase)); _Pragma("unroll") for (int _i = 0; _i < 2; ++_i) { unsigned _o = (voff)[_i]; asm volatile("" : "+v"(_o)); \
        __builtin_amdgcn_global_load_lds((const unsigned*)(_g + _o), (LAS unsigned*)(lds + (bufoff) + ldsw + _i * 8192), 16, 0, 0); } } while (0)
#define PG8_STAGE_A(bufoff, gbase, h, O) do { const char* _g = uptr((const char*)(gbase) + (GATHER ? (size_t)0 : (size_t)(h) * hstepA)); _Pragma("unroll") for (int _i = 0; _i < 2; ++_i) { unsigned _o = (O)[GATHER ? (h) : 0][_i]; asm volatile("" : "+v"(_o)); \
        __builtin_amdgcn_global_load_lds((const unsigned*)(_g + _o), (LAS unsigned*)(lds + (bufoff) + ldsw + _i * 8192), 16, 0, 0); } } while (0)
#define PG8_CAT2(x, y) __builtin_shufflevector(__builtin_bit_cast(i32x4, (x)), __builtin_bit_cast(i32x4, (y)), 0, 1, 2, 3, 4, 5, 6, 7)
#define PG8_RDA(b, h, m, k) (*(const LAS bf16x8*)(lds + PG8_SA(b, h) + ((k) ? aoff1 : aoff0) + (m) * 2048))
#define PG8_RDB(b, h, n, k) (*(const LAS bf16x8*)(lds + PG8_SB(b, h) + ((k) ? boff1 : boff0) + (n) * 2048))
#define PG8_LDA(dst, b, h) do { _Pragma("unroll") for (int m = 0; m < 4; ++m) { \
        if constexpr (FP8) { dst##8[m] = PG8_CAT2(PG8_RDA(b, h, m, 0), PG8_RDA(b, h, m, 1)); } else { dst[m][0] = PG8_RDA(b, h, m, 0); dst[m][1] = PG8_RDA(b, h, m, 1); } } } while (0)
#define PG8_LDB(dst, b, h) do { _Pragma("unroll") for (int n = 0; n < 2; ++n) { \
        if constexpr (FP8) { dst##8[n] = PG8_CAT2(PG8_RDB(b, h, n, 0), PG8_RDB(b, h, n, 1)); } else { dst[n][0] = PG8_RDB(b, h, n, 0); dst[n][1] = PG8_RDB(b, h, n, 1); } } } while (0)
#define PG8_MMA(ai, bj, At, Bt) do { __builtin_amdgcn_s_setprio(1); \
        if constexpr (FP8) { _Pragma("unroll") for (int m = 0; m < 4; ++m) _Pragma("unroll") for (int n = 0; n < 2; ++n) \
            asm volatile("v_mfma_f32_16x16x128_f8f6f4 %0, %1, %2, %0" : "+v"(acc[ai][bj][m][n]) : "v"(Bt##8[n]), "v"(At##8[m])); } \
        else { _Pragma("unroll") for (int m = 0; m < 4; ++m) _Pragma("unroll") for (int n = 0; n < 2; ++n) _Pragma("unroll") for (int k = 0; k < 2; ++k) \
            asm volatile("v_mfma_f32_16x16x32_bf16 %0, %1, %2, %0" : "+v"(acc[ai][bj][m][n]) : "v"(Bt[n][k]), "v"(At[m][k])); } \
        __builtin_amdgcn_s_setprio(0); } while (0)
#define PG8_MMAZ(ai, bj, At, Bt) do { __builtin_amdgcn_s_setprio(1); \
        if constexpr (FP8) { _Pragma("unroll") for (int m = 0; m < 4; ++m) _Pragma("unroll") for (int n = 0; n < 2; ++n) \
            asm volatile("v_mfma_f32_16x16x128_f8f6f4 %0, %1, %2, 0" : "=&v"(acc[ai][bj][m][n]) : "v"(Bt##8[n]), "v"(At##8[m])); } \
        else { _Pragma("unroll") for (int m = 0; m < 4; ++m) _Pragma("unroll") for (int n = 0; n < 2; ++n) { \
            asm volatile("v_mfma_f32_16x16x32_bf16 %0, %1, %2, 0" : "=&v"(acc[ai][bj][m][n]) : "v"(Bt[n][0]), "v"(At[m][0])); \
            asm volatile("v_mfma_f32_16x16x32_bf16 %0, %1, %2, %0" : "+v"(acc[ai][bj][m][n]) : "v"(Bt[n][1]), "v"(At[m][1])); } } \
        __builtin_amdgcn_s_setprio(0); } while (0)
#define PG8_MMA_false PG8_MMA
#define PG8_MMA_true PG8_MMAZ
#define PG8_MMAX(F, ai, bj, At, Bt) PG8_MMA_##F(ai, bj, At, Bt)
#define PG8_WAIT_V(n) asm volatile("s_waitcnt vmcnt(" #n ")" ::: "memory")
#define PG8_WAIT_L(n) asm volatile("s_waitcnt lgkmcnt(" #n ")" ::: "memory")
#define PG8_BAR __builtin_amdgcn_s_barrier()
#define PG8_SCHED __builtin_amdgcn_sched_barrier(0)
#define PG8_LOADOFFS(u, o) do { const int _t = wid * 64 + PG8_LANE(); int _tk[2][2]; int _cc[2]; \
        _Pragma("unroll") for (int _i = 0; _i < 2; ++_i) { int _R, _C; stage_rc(_t * 16 + _i * 8192, _R, _C); _cc[_i] = _C; \
            _Pragma("unroll") for (int _h = 0; _h < 2; ++_h) { int _row = _h * HALF + _R; _row = _row < (u).nvalid ? _row : (u).nvalid - 1; _tk[_h][_i] = (u).tl[_row]; } } \
        asm volatile("" : "+v"(_tk[0][0]), "+v"(_tk[0][1]), "+v"(_tk[1][0]), "+v"(_tk[1][1]));        \
        _Pragma("unroll") for (int _i = 0; _i < 2; ++_i) _Pragma("unroll") for (int _h = 0; _h < 2; ++_h) o[_h][_i] = (unsigned)_tk[_h][_i] * (unsigned)Pa + (unsigned)_cc[_i] * 2u; } while (0)
#define PG8_KITER(LAST, FIRST) do { \
            const char* a1 = cA + (size_t)(t + 1) * kstep; \
            const char* a2 = (LAST) ? nA : cA + (size_t)(t + 2) * kstep; const char* b2 = (LAST) ? nB : cB + (size_t)(t + 2) * kstep; \
            const char* a3 = a2 + kstep; const char* b3 = b2 + kstep; \
            PG8_LDB(B0, 0, 0); PG8_LDB(B1, 0, 1); PG8_SCHED; PG8_LDA(At, 0, 0); PG8_STAGE_A(PG8_SA(1, 1), a1, 1, oc); \
            if constexpr (GATHER && (LAST)) { if (has_next) { const int _t = wid * 64 + PG8_LANE(); _Pragma("unroll") for (int _i = 0; _i < 2; ++_i) { int _R, _C; stage_rc(_t * 16 + _i * 8192, _R, _C); \
                _Pragma("unroll") for (int _h = 0; _h < 2; ++_h) { int _row = _h * HALF + _R; _row = _row < nxt.nvalid ? _row : nxt.nvalid - 1; o2[_h][_i] = (unsigned)ids[_row] * (unsigned)Pa + (unsigned)_C * 2u; } } } \
                else { _Pragma("unroll") for (int _h = 0; _h < 2; ++_h) _Pragma("unroll") for (int _i = 0; _i < 2; ++_i) o2[_h][_i] = oc[_h][_i]; } } \
            else { _Pragma("unroll") for (int _h = 0; _h < 2; ++_h) _Pragma("unroll") for (int _i = 0; _i < 2; ++_i) o2[_h][_i] = oc[_h][_i]; } \
            PG8_WAIT_V(8); PG8_WAIT_L(0); PG8_BAR; PG8_MMAX(FIRST, 0, 0, At, B0); PG8_MMAX(FIRST, 0, 1, At, B1); PG8_BAR; PG8_SCHED; \
            PG8_LDA(At, 0, 1); PG8_STAGE(PG8_SB(0, 0), b2, voffB); PG8_STAGE(PG8_SB(0, 1), b2 + hstep, voffB); PG8_STAGE_A(PG8_SA(0, 0), a2, 0, o2); \
            PG8_WAIT_V(8); PG8_WAIT_L(0); PG8_BAR; PG8_MMAX(FIRST, 1, 0, At, B0); PG8_MMAX(FIRST, 1, 1, At, B1); PG8_BAR; PG8_SCHED; \
            PG8_LDB(B0, 1, 0); PG8_LDB(B1, 1, 1); PG8_SCHED; PG8_LDA(At, 1, 0); PG8_STAGE_A(PG8_SA(0, 1), a2, 1, o2); \
            PG8_WAIT_V(8); PG8_WAIT_L(0); PG8_BAR; PG8_MMA(0, 0, At, B0); PG8_MMA(0, 1, At, B1); PG8_BAR; PG8_SCHED; \
            PG8_LDA(At, 1, 1); PG8_STAGE(PG8_SB(1, 0), b3, voffB); PG8_STAGE(PG8_SB(1, 1), b3 + hstep, voffB); PG8_STAGE_A(PG8_SA(1, 0), a3, 0, o2); \
            PG8_WAIT_V(8); PG8_WAIT_L(0); PG8_BAR; PG8_MMA(1, 0, At, B0); PG8_MMA(1, 1, At, B1); PG8_BAR; PG8_SCHED; \
        } while (0)
    Unit cur, nxt; int ui = 0;
    if (!S.next(0, cur)) return;
    f32x4 acc[2][2][4][2];
    if constexpr (Epi::CHAIN) {
#pragma unroll
    for (int a = 0; a < 2; ++a)
#pragma unroll
        for (int b = 0; b < 2; ++b)
#pragma unroll
            for (int m = 0; m < 4; ++m)
#pragma unroll
                for (int n = 0; n < 2; ++n) acc[a][b][m][n] = (f32x4){0.f, 0.f, 0.f, 0.f};
    }
    bf16x8 At[4][2], B0[2][2], B1[2][2]; i32x8 At8[4], B08[2], B18[2];
    const char* cA = cur.A; const char* cB = cur.B;
    if constexpr (GATHER) { PG8_LOADOFFS(cur, oc); }
    PG8_STAGE(PG8_SB(0, 0), cB, voffB); PG8_STAGE(PG8_SB(0, 1), cB + hstep, voffB); PG8_STAGE_A(PG8_SA(0, 0), cA, 0, oc); PG8_STAGE_A(PG8_SA(0, 1), cA, 1, oc);
    PG8_STAGE(PG8_SB(1, 0), cB + kstep, voffB); PG8_STAGE_A(PG8_SA(1, 0), cA + kstep, 0, oc); PG8_STAGE(PG8_SB(1, 1), cB + hstep + kstep, voffB);
    if (wr == 1) PG8_BAR;
    PG8_WAIT_V(6); PG8_BAR;
    PG8_BAR;
    for (;;) {
        const bool has_next = S.next(ui + 1, nxt);
        const char* nA = has_next ? nxt.A : cA; const char* nB = has_next ? nxt.B : cB;
        if constexpr (GATHER) {
            if (has_next && wid < 4) __builtin_amdgcn_global_load_lds((const unsigned*)(nxt.tl + wid * 64 + PG8_LANE()), (LAS unsigned*)(ids + wid * 64), 4, 0, 0);
        }
        int t = 0;
        if constexpr (!Epi::CHAIN) { PG8_KITER(false, true); t = 2; }
#pragma nounroll
        for (; t < nt - 2; t += 2) PG8_KITER(false, false);
        PG8_KITER(true, false);
        if (wr == 0) PG8_BAR;
        asm volatile("s_nop 15\n\ts_nop 15" ::: "memory");
        const int lane_e = PG8_LANE();
        const bool keep = E(acc, cur, wr, wc, lane_e & 15, lane_e >> 4);
        if (!has_next) break;
        if (Epi::CHAIN && !keep) {
#pragma unroll
            for (int a = 0; a < 2; ++a)
#pragma unroll
                for (int b = 0; b < 2; ++b)
#pragma unroll
                    for (int m = 0; m < 4; ++m)
#pragma unroll
                        for (int n = 0; n < 2; ++n) acc[a][b][m][n] = (f32x4){0.f, 0.f, 0.f, 0.f};
        }
        cur = nxt; cA = nA; cB = nB; ++ui;
        if constexpr (GATHER) {
#pragma unroll
            for (int h = 0; h < 2; ++h)
#pragma unroll
                for (int i = 0; i < 2; ++i) oc[h][i] = o2[h][i];
        }
        if (wr == 1) PG8_BAR;
    }
    PG8_WAIT_V(0);
    PG8_BAR;
#undef PG8_SA
#undef PG8_SB
#undef PG8_STAGE
#undef PG8_STAGE_A
#undef PG8_LDA
#undef PG8_LDB
#undef PG8_MMA
#undef PG8_CAT2
#undef PG8_RDA
#undef PG8_RDB
#undef PG8_WAIT_V
#undef PG8_WAIT_L
#undef PG8_BAR
#undef PG8_SCHED
#undef PG8_LOADOFFS
#undef PG8_LANE
#undef PG8_KITER
#undef PG8_MMAZ
#undef PG8_MMAX
#undef PG8_MMA_true
#undef PG8_MMA_false
}

struct SchedDense {
    const char* A; const char* B; int nM, nN, G, c; size_t tstepA, tstep; bool rev;
    __device__ __forceinline__ bool next(int i, Unit& u) const {
        long L = (long)i * G + c; if (L >= (long)nM * nN) return false;
        if (rev) L = (long)nM * nN - 1 - L;
        tile_map((int)L, nM, nN, u.pm, u.pn); u.A = A + (size_t)u.pm * tstepA; u.B = B + (size_t)u.pn * tstep;
        u.tl = nullptr; u.e = 0; u.kind = 0; u.rowbase = u.pm * BM; u.nvalid = BM; return true; }
};
struct SchedGate {
    const char* A; const char* B; int nM, nN, G, c; size_t tstepA, tstep;
    __device__ __forceinline__ bool next(int i, Unit& u) const {
        long L;
        if (G == 256) { if (i < 3) L = (long)i * G + c; else { if (c < 128 || i > 4) return false; L = 3L * G + (long)(i - 3) * 128 + (c - 128); } }
        else L = (long)i * G + c;
        if (L >= (long)nM * nN) return false;
        tile_map((int)L, nM, nN, u.pm, u.pn); u.A = A + (size_t)u.pm * tstepA; u.B = B + (size_t)u.pn * tstep;
        u.tl = nullptr; u.e = 0; u.kind = 0; u.rowbase = u.pm * BM; u.nvalid = BM; return true; }
};
struct SchedBranch {
    const char* A0; const char* B0; const char* A1; const char* B1; int nM, nN, G, c; size_t tstepA, tstep; bool rev;
    __device__ __forceinline__ bool next(int i, Unit& u) const {
        long L = (long)(i >> 1) * G + c; if (L >= (long)nM * nN) return false;
        if (rev) L = (long)nM * nN - 1 - L;
        tile_map((int)L, nM, nN, u.pm, u.pn); u.kind = i & 1;
        u.A = (u.kind ? A1 : A0) + (size_t)u.pm * tstepA; u.B = (u.kind ? B1 : B0) + (size_t)u.pn * tstep;
        u.tl = nullptr; u.e = 0; u.rowbase = u.pm * BM; u.nvalid = BM; return true; }
};
struct SchedMoE {
    const LAS int* utab;
    const char* A; const char* B; size_t bexp; const int* lists; size_t tstep; int pa; bool gather;
    __device__ __forceinline__ bool next(int i, Unit& u) const {
        if (i >= 32) return false;
        const i32x4 d = *(const LAS i32x4*)(utab + 4 * i);
        const int e = __builtin_amdgcn_readfirstlane(d[0]); if (e < 0) return false;
        const int pp = __builtin_amdgcn_readfirstlane(d[1]); u.e = e; u.pm = pp >> 4; u.pn = pp & 15; u.kind = 0;
        u.rowbase = __builtin_amdgcn_readfirstlane(d[2]); u.nvalid = __builtin_amdgcn_readfirstlane(d[3]);
        u.B = B + (size_t)e * bexp + (size_t)u.pn * tstep;
        if (gather) { u.A = A; u.tl = lists + (size_t)e * LISTCAP + u.pm * BM; }
        else { u.A = A + (size_t)u.rowbase * pa; u.tl = nullptr; }
        return true; }
};
__device__ __forceinline__ void moe_unit_table(const LAS int* tab, LAS int* utab, int tid, int NT, int G, int c, bool rev) {
    if (tid < 32) { const int nwg = tab[32]; const long L = (long)tid * G + c; int e = -1, pp = 0, rb = 0, nv = 0;
        if (L < nwg) { int wgid = (int)L; { const int q = nwg / NXCD, r = nwg % NXCD, xcd = wgid % NXCD, off = wgid / NXCD; wgid = (xcd < r ? xcd * (q + 1) : r * (q + 1) + (xcd - r) * q) + off; }
            if (rev) wgid = nwg - 1 - wgid;
            e = 0;
#pragma unroll 1
            for (int k = 1; k < NE; ++k) e = (tab[k] <= wgid) ? k : e;
            const int local = wgid - tab[e], pm = local / NT, pn = local - pm * NT; pp = pm * 16 + pn;
            rb = tab[64 + e] + pm * BM; nv = tab[128 + e] - pm * BM; nv = nv > BM ? BM : nv; }
        utab[4 * tid] = e; utab[4 * tid + 1] = pp; utab[4 * tid + 2] = rb; utab[4 * tid + 3] = nv; }
}
#define EPI_FOR_ROWS  _Pragma("unroll") for (int ai = 0; ai < 2; ++ai) _Pragma("unroll") for (int m = 0; m < 4; ++m)
struct EpiInProj {
    static constexpr bool CHAIN = false;
    bf16_t* Z; const float* bias; bf16_t* VT; bf16_t* GVT; unsigned long long* lnstat;
    __device__ __forceinline__ bool operator()(f32x4 (&acc)[2][2][4][2], const Unit& u, int wr, int wc, int fr, int fq) const {
        const int pn = u.pn, act = pn < 2 ? 0 : (pn == 2 ? 1 : 2);
        const int col0 = pn * BM + wc * 32 + 8 * fq;
        f32x4 bv[2][2];
#pragma unroll
        for (int bj = 0; bj < 2; ++bj)
#pragma unroll
            for (int n = 0; n < 2; ++n) bv[bj][n] = *(const f32x4*)(bias + col0 + bj * HALF + 4 * n);
        EPI_FOR_ROWS { const int row = u.rowbase + ai * HALF + wr * 64 + m * 16 + fr; bf16_t* rowp = Z + (size_t)row * NZ + col0; float ls1 = 0.f, ls2 = 0.f;
#pragma unroll
            for (int bj = 0; bj < 2; ++bj) { f32x4 v0 = acc[ai][bj][m][0] + bv[bj][0], v1 = acc[ai][bj][m][1] + bv[bj][1];
                if (act == 0) { v0 = v0 * 0.125f; v1 = v1 * 0.125f; }
                else if (act == 2) {
#pragma unroll
                    for (int i = 0; i < 4; ++i) { v0[i] = gelu_tanh(v0[i]); v1[i] = gelu_tanh(v1[i]); } }
                u32x4 w; w.x = cvt_pk_bf16(v0[0], v0[1]); w.y = cvt_pk_bf16(v0[2], v0[3]); w.z = cvt_pk_bf16(v1[0], v1[1]); w.w = cvt_pk_bf16(v1[2], v1[3]);
                if (pn == 5 || pn == 6) {
                    float xv[8]; unpack8(w, xv);
#pragma unroll
                    for (int i = 0; i < 8; ++i) { ls1 += xv[i]; ls2 = fmaf(xv[i], xv[i], ls2); } }
                else *(u32x4*)(rowp + bj * HALF) = w;
                if ((pn == 2 && bj == 1) || pn == 5 || pn == 6) {
                    const int bt = row >> 11, sq = row & (SEQ - 1);
                    bf16_t* tp; int cs;
                    if (pn == 2) { tp = VT + ((size_t)(bt * 128 + wc * 32 + 8 * fq)) * SEQ + sq; cs = SEQ; }
                    else { const int gg = 4 * (pn - 5) + 2 * bj + (wc >> 1), dtt = wc & 1, chunk = sq >> 7, ks = (sq >> 4) & 7, hh = (sq >> 3) & 1, jj = sq & 7;
                        tp = GVT + ((size_t)(((((bt * 16 + chunk) * 8 + gg) * 8 + ks) * 2 + dtt)) * 512 + (hh * 32 + 8 * fq) * 8 + jj); cs = 8; }
                    tp[0 * cs] = (bf16_t)(w.x & 0xffffu); tp[1 * cs] = (bf16_t)(w.x >> 16); tp[2 * cs] = (bf16_t)(w.y & 0xffffu); tp[3 * cs] = (bf16_t)(w.y >> 16);
                    tp[4 * cs] = (bf16_t)(w.z & 0xffffu); tp[5 * cs] = (bf16_t)(w.z >> 16); tp[6 * cs] = (bf16_t)(w.w & 0xffffu); tp[7 * cs] = (bf16_t)(w.w >> 16); } }
            if (pn == 5 || pn == 6) {
                ls1 += __shfl_xor(ls1, 16); ls2 += __shfl_xor(ls2, 16); ls1 += __shfl_xor(ls1, 32); ls2 += __shfl_xor(ls2, 32);
                if (fq == 0) { atomicAdd(lnstat + (size_t)row * 2, (unsigned long long)(long long)rintf(ls1 * 1048576.f)); atomicAdd(lnstat + (size_t)row * 2 + 1, (unsigned long long)(long long)rintf(ls2 * 1048576.f)); } } }
        return false;
    }
};
struct EpiGate8 {
    static constexpr bool CHAIN = false;
    unsigned char* G8; const float* bias;
    __device__ __forceinline__ bool operator()(f32x4 (&acc)[2][2][4][2], const Unit& u, int wr, int wc, int fr, int fq) const {
        const int col0 = u.pn * BM + wc * 32 + 8 * fq;
        const float ke = -1.4426950408889634f / (FP8_SH * FP8_SW);
        f32x4 bv[2][2];
#pragma unroll
        for (int bj = 0; bj < 2; ++bj)
#pragma unroll
            for (int n = 0; n < 2; ++n) bv[bj][n] = *(const f32x4*)(bias + col0 + bj * HALF + 4 * n) * -1.4426950408889634f;
        unsigned char* gp = G8 + ((size_t)((u.pm * 8 + u.pn) * 8 + wr * 4 + wc)) * 8192 + (fq * 16 + fr) * 8;
        EPI_FOR_ROWS {
#pragma unroll
            for (int bj = 0; bj < 2; ++bj) { u32x2 gq; gq.x = 0u; gq.y = 0u;
#pragma unroll
                for (int n = 0; n < 2; ++n) { unsigned pw = 0u;
#pragma unroll
                    for (int i = 0; i < 4; ++i) { const float e = __builtin_amdgcn_exp2f(fmaf(acc[ai][bj][m][n][i], ke, bv[bj][n][i]));
                        const float q = fmaxf(fmaf(__builtin_amdgcn_rcpf(1.f + e), 255.f, 0.5f), 1.f);
                        pw = __builtin_amdgcn_cvt_pk_u8_f32(q, i, pw); }
                    if (n == 0) gq.x = pw; else gq.y = pw; }
                *(u32x2*)(gp + ((ai * 4 + m) * 2 + bj) * 512) = gq; } }
        return false;
    }
};
struct EpiBranch {
    static constexpr bool CHAIN = true;
    const unsigned char* G8; bf16_t* O;
    __device__ __forceinline__ bool operator()(f32x4 (&acc)[2][2][4][2], const Unit& u, int wr, int wc, int fr, int fq) const {
        const int col0 = u.pn * BM + wc * 32 + 8 * fq;
        const unsigned char* ga = G8 + ((size_t)((u.pm * 8 + u.pn) * 8 + wr * 4 + wc)) * 8192 + (fq * 16 + fr) * 8;
        const unsigned char* gs = ga + (size_t)4 * 8 * 8192;
#define EPI_CL16(g, o) asm volatile("" : "+v"(g[o + 0]), "+v"(g[o + 1]), "+v"(g[o + 2]), "+v"(g[o + 3]), "+v"(g[o + 4]), "+v"(g[o + 5]), "+v"(g[o + 6]), "+v"(g[o + 7]), \
            "+v"(g[o + 8]), "+v"(g[o + 9]), "+v"(g[o + 10]), "+v"(g[o + 11]), "+v"(g[o + 12]), "+v"(g[o + 13]), "+v"(g[o + 14]), "+v"(g[o + 15]))
        if (u.kind == 0) {
            u32x2 qa[16], qs[16];
#pragma unroll
            for (int k = 0; k < 16; ++k) { qa[k] = *(const u32x2*)(ga + k * 512); qs[k] = *(const u32x2*)(gs + k * 512); }
            EPI_CL16(qa, 0); EPI_CL16(qs, 0);
#pragma unroll
            for (int ai = 0; ai < 2; ++ai)
#pragma unroll
                for (int m = 0; m < 4; ++m)
#pragma unroll
                    for (int bj = 0; bj < 2; ++bj) { const int k = (ai * 4 + m) * 2 + bj;
#pragma unroll
                        for (int n = 0; n < 2; ++n) { const unsigned wa = n ? qa[k].y : qa[k].x, wsg = n ? qs[k].y : qs[k].x;
#pragma unroll
                            for (int i = 0; i < 4; ++i) acc[ai][bj][m][n][i] *= (float)((wa >> (8 * i)) & 255u) * __builtin_amdgcn_rcpf((float)((wsg >> (8 * i)) & 255u)); } }
            return true;
        }
        { u32x2 qs[16];
#pragma unroll
          for (int k = 0; k < 16; ++k) qs[k] = *(const u32x2*)(gs + k * 512);
          EPI_CL16(qs, 0);
#pragma unroll
          for (int ai = 0; ai < 2; ++ai)
#pragma unroll
            for (int m = 0; m < 4; ++m) { const int row = u.rowbase + ai * HALF + wr * 64 + m * 16 + fr; bf16_t* op = O + (size_t)row * D + col0;
#pragma unroll
                for (int bj = 0; bj < 2; ++bj) { const int k = (ai * 4 + m) * 2 + bj; float g[8];
#pragma unroll
                    for (int i = 0; i < 4; ++i) { g[i] = (float)((qs[k].x >> (8 * i)) & 255u) * (1.f / 255.f); g[4 + i] = (float)((qs[k].y >> (8 * i)) & 255u) * (1.f / 255.f); }
                    const f32x4 v0 = acc[ai][bj][m][0], v1 = acc[ai][bj][m][1];
                    u32x4 w; w.x = cvt_pk_bf16(v0[0] * g[0], v0[1] * g[1]); w.y = cvt_pk_bf16(v0[2] * g[2], v0[3] * g[3]); w.z = cvt_pk_bf16(v1[0] * g[4], v1[1] * g[5]); w.w = cvt_pk_bf16(v1[2] * g[6], v1[3] * g[7]);
                    *(u32x4*)(op + bj * HALF) = w; } } }
#undef EPI_CL16
        return false;
    }
};
struct EpiBiasBf16 {
    static constexpr bool CHAIN = false;
    bf16_t* O; int ldo; const float* bias; int bstride; float sc; int mode;
    __device__ __forceinline__ bool operator()(f32x4 (&acc)[2][2][4][2], const Unit& u, int wr, int wc, int fr, int fq) const {
        if (mode & 4) return false;
        const int col0 = u.pn * BM + wc * 32 + 8 * fq; const float* bp = bias + (size_t)u.e * bstride + col0;
        f32x4 bv[2][2];
#pragma unroll
        for (int bj = 0; bj < 2; ++bj)
#pragma unroll
            for (int n = 0; n < 2; ++n) bv[bj][n] = (f32x4){0.f, 0.f, 0.f, 0.f};
        if (!(mode & 1)) {
#pragma unroll
        for (int bj = 0; bj < 2; ++bj)
#pragma unroll
            for (int n = 0; n < 2; ++n) bv[bj][n] = *(const f32x4*)(bp + bj * HALF + 4 * n);
        }
        EPI_FOR_ROWS { const int row = u.rowbase + ai * HALF + wr * 64 + m * 16 + fr; bf16_t* op = O + (size_t)row * ldo + col0;
#pragma unroll
            for (int bj = 0; bj < 2; ++bj) { const f32x4 v0 = acc[ai][bj][m][0] * sc + bv[bj][0], v1 = acc[ai][bj][m][1] * sc + bv[bj][1];
                u32x4 w; w.x = cvt_pk_bf16(v0[0], v0[1]); w.y = cvt_pk_bf16(v0[2], v0[3]); w.z = cvt_pk_bf16(v1[0], v1[1]); w.w = cvt_pk_bf16(v1[2], v1[3]);
                if (mode & 2) asm volatile("" :: "v"(w)); else *(u32x4*)(op + bj * HALF) = w; } }
        return false;
    }
};
struct EpiBiasFp8 {
    static constexpr bool CHAIN = false;
    unsigned char* O; const float* bias; int bstride; float sc; int mode;
    __device__ __forceinline__ bool operator()(f32x4 (&acc)[2][2][4][2], const Unit& u, int wr, int wc, int fr, int fq) const {
        if (mode & 4) return false;
        const int col0 = u.pn * BM + wc * 32 + 8 * fq; const float* bp = bias + (size_t)u.e * bstride + col0;
        f32x2_t sc2; VCONST2(sc2, FP8_SY / (FP8_SA * FP8_SW));
        f32x2_t bv[2][4];
#pragma unroll
        for (int bj = 0; bj < 2; ++bj)
#pragma unroll
            for (int n = 0; n < 2; ++n) { const f32x4 t = *(const f32x4*)(bp + bj * HALF + 4 * n);
                bv[bj][2 * n][0] = t[0] * FP8_SY; bv[bj][2 * n][1] = t[1] * FP8_SY; bv[bj][2 * n + 1][0] = t[2] * FP8_SY; bv[bj][2 * n + 1][1] = t[3] * FP8_SY; }
        const int odd = fq & 1;
#pragma unroll
        for (int ai = 0; ai < 2; ++ai)
#pragma unroll
            for (int mp = 0; mp < 2; ++mp) { const int row = u.rowbase + ai * HALF + wr * 64 + (2 * mp + odd) * 16 + fr; unsigned char* op = O + (size_t)row * PF8 + (col0 - 8 * odd);
#pragma unroll
                for (int bj = 0; bj < 2; ++bj) { u32x2 w[2];
#pragma unroll
                    for (int q = 0; q < 2; ++q) { const int m = 2 * mp + q; unsigned wq[2];
#pragma unroll
                        for (int n = 0; n < 2; ++n) { unsigned pw = 0;
#pragma unroll
                            for (int hh = 0; hh < 2; ++hh) { f32x2_t a2; a2[0] = acc[ai][bj][m][n][2 * hh]; a2[1] = acc[ai][bj][m][n][2 * hh + 1];
                                f32x2_t v2 = a2 * sc2 + bv[bj][2 * n + hh]; v2[0] = __builtin_amdgcn_fmed3f(v2[0], -448.f, 448.f); v2[1] = __builtin_amdgcn_fmed3f(v2[1], -448.f, 448.f);
                                pw = hh ? __builtin_amdgcn_cvt_pk_fp8_f32(v2[0], v2[1], pw, true) : __builtin_amdgcn_cvt_pk_fp8_f32(v2[0], v2[1], pw, false); }
                            wq[n] = pw; }
                        w[q].x = wq[0]; w[q].y = wq[1]; }
                    const auto rx = __builtin_amdgcn_permlane16_swap(w[0].x, w[1].x, false, false); const auto ry = __builtin_amdgcn_permlane16_swap(w[0].y, w[1].y, false, false);
                    const u32x4 o = (u32x4){rx[0], ry[0], rx[1], ry[1]};
                    if (mode & 2) asm volatile("" :: "v"(o));
                    else if (mode & 1) { const int ln = fq * 16 + fr; *(u32x4*)(O + (size_t)(u.rowbase + ai * HALF + wr * 64 + (wc & 1) * 32 + (mp * 2 + bj) * 8 + (ln >> 3)) * PF8 + u.pn * BM + (wc >> 1) * 128 + (ln & 7) * 16) = o; }
                    else *(u32x4*)(op + bj * HALF) = o; } }
        return false;
    }
};
struct EpiSwiGLU {
    static constexpr bool CHAIN = false;
    unsigned char* O; const float* b1; int mode;
    __device__ __forceinline__ bool operator()(f32x4 (&acc)[2][2][4][2], const Unit& u, int wr, int wc, int fr, int fq) const {
        if (mode & 4) return false;
        const int cl = wc * 32 + 8 * fq, colo = u.pn * HALF + cl; const float* bp = b1 + (size_t)u.e * (2 * DE) + colo;
        f32x2_t isc2, sa2, nc2, one2;
        VCONST2(isc2, 1.f / (FP8_SH * FP8_SW)); VCONST2(sa2, FP8_SA); VCONST2(nc2, -2.4554669595930157f); VCONST2(one2, 1.f);
        f32x2_t bg[4], bl[4];
        { f32x4 t[4];
#pragma unroll
          for (int n = 0; n < 2; ++n) { t[n] = *(const f32x4*)(bp + 4 * n); t[2 + n] = *(const f32x4*)(bp + DE + 4 * n); }
#pragma unroll
          for (int n = 0; n < 2; ++n) { bg[2 * n][0] = t[n][0]; bg[2 * n][1] = t[n][1]; bg[2 * n + 1][0] = t[n][2]; bg[2 * n + 1][1] = t[n][3];
              bl[2 * n][0] = t[2 + n][0]; bl[2 * n][1] = t[2 + n][1]; bl[2 * n + 1][0] = t[2 + n][2]; bl[2 * n + 1][1] = t[2 + n][3]; } }
        const int odd = fq & 1;
#pragma unroll
        for (int ai = 0; ai < 2; ++ai)
#pragma unroll
            for (int mp = 0; mp < 2; ++mp) { const int row = u.rowbase + ai * HALF + wr * 64 + (2 * mp + odd) * 16 + fr; u32x2 w[2];
#pragma unroll
                for (int q = 0; q < 2; ++q) { const int m = 2 * mp + q; unsigned wq[2];
#pragma unroll
                    for (int n = 0; n < 2; ++n) { unsigned pw = 0;
#pragma unroll
                        for (int hh = 0; hh < 2; ++hh) { f32x2_t a2, c2; a2[0] = acc[ai][0][m][n][2 * hh]; a2[1] = acc[ai][0][m][n][2 * hh + 1]; c2[0] = acc[ai][1][m][n][2 * hh]; c2[1] = acc[ai][1][m][n][2 * hh + 1];
                            f32x2_t g2 = a2 * isc2 + bg[2 * n + hh], l2 = c2 * isc2 + bl[2 * n + hh];
                            g2[0] = fminf(g2[0], 7.f); g2[1] = fminf(g2[1], 7.f); l2[0] = __builtin_amdgcn_fmed3f(l2[0], -7.f, 7.f); l2[1] = __builtin_amdgcn_fmed3f(l2[1], -7.f, 7.f);
                            const f32x2_t l1 = l2 * sa2 + sa2;
                            f32x2_t e2 = g2 * nc2; e2[0] = __builtin_amdgcn_exp2f(e2[0]); e2[1] = __builtin_amdgcn_exp2f(e2[1]);
                            f32x2_t d2 = e2 + one2; d2[0] = __builtin_amdgcn_rcpf(d2[0]); d2[1] = __builtin_amdgcn_rcpf(d2[1]);
                            const f32x2_t r2 = (g2 * l1) * d2;
                            pw = hh ? __builtin_amdgcn_cvt_pk_fp8_f32(r2[0], r2[1], pw, true) : __builtin_amdgcn_cvt_pk_fp8_f32(r2[0], r2[1], pw, false); }
                        wq[n] = pw; }
                    w[q].x = wq[0]; w[q].y = wq[1]; }
                const auto rx = __builtin_amdgcn_permlane16_swap(w[0].x, w[1].x, false, false); const auto ry = __builtin_amdgcn_permlane16_swap(w[0].y, w[1].y, false, false);
                const u32x4 o = (u32x4){rx[0], ry[0], rx[1], ry[1]};
                if (mode & 2) asm volatile("" :: "v"(o)); else *(u32x4*)(O + (size_t)row * PF8 + (colo - 8 * odd)) = o; }
        return false;
    }
};
}

struct P0Item { const float* src; unsigned char* dst; int N, K, fp8; };
constexpr int NZB = 1792, NZG = NZ - NZB;
constexpr int P0_N_WIN = (D / 128) * (NZB / 128), P0_N_WING = (D / 128) * (NZG / 128), P0_N_WB = (512 / 128) * (D / 128), P0_N_WOUT = (D / 128) * (D / 128), P0_N_W1 = (D / 128) * (2 * DE / 128), P0_N_W2 = (DE / 128) * (D / 128);
constexpr int P0_B0 = P0_N_WIN, P0_B1 = P0_B0 + P0_N_WING, P0_B2 = P0_B1 + P0_N_WB, P0_B3 = P0_B2 + P0_N_WB, P0_B4 = P0_B3 + P0_N_WOUT, P0_B5 = P0_B4 + NE * P0_N_W1, P0_TOTAL = P0_B5 + NE * P0_N_W2;
struct Args { const float* in[25]; float* out; unsigned char* ws; unsigned long long prog[3]; int nprog, pad; };
typedef const __attribute__((address_space(4))) Args* ArgsP;

__device__ __forceinline__ void p0_decode(ArgsP a, unsigned char* ws, int g, P0Item& I) {
    const float* W; unsigned char* WT; int K, N, l, fp8 = 0, w1 = 0, nblk = 0;
    if (g < P0_B0)      { l = g;         W = a->in[6];  WT = ws + WS_WIN;  K = D;   N = NZ; nblk = NZB / 32; }
    else if (g < P0_B1) { l = g - P0_B0; W = a->in[6] + NZB; WT = ws + WS_WING8; K = D; N = NZ; nblk = NZG / 32; fp8 = 1; }
    else if (g < P0_B2) { l = g - P0_B1; W = a->in[13]; WT = ws + WS_WBA;  K = 512; N = D; }
    else if (g < P0_B3) { l = g - P0_B2; W = a->in[14]; WT = ws + WS_WBS;  K = 512; N = D; }
    else if (g < P0_B4) { l = g - P0_B3; W = a->in[15]; WT = ws + WS_WOUT; K = D;   N = D; }
    else if (g < P0_B5) { const int q = g - P0_B4, e = q / P0_N_W1; l = q - e * P0_N_W1; W = a->in[21] + (size_t)e * D * 2 * DE; WT = ws + WS_W1 + (size_t)e * 2 * DE * D; K = D; N = 2 * DE; fp8 = 1; w1 = 1; }
    else                { const int q = g - P0_B5, e = q / P0_N_W2; l = q - e * P0_N_W2; W = a->in[23] + (size_t)e * DE * D;     WT = ws + WS_W2 + (size_t)e * D * DE;      K = DE; N = D; fp8 = 1; }
    if (nblk == 0) nblk = N >> 5;
    nblk >>= 2;
    const int kb = l / nblk, nb = l - kb * nblk, n0 = nb * 128, k0 = kb * 128;
    int drow0 = n0;
    if (w1) drow0 = (n0 < DE) ? ((n0 >> 7) * 256) : (((n0 - DE) >> 7) * 256 + 128);
    I.src = W + (size_t)k0 * N + n0; I.dst = WT + ((size_t)drow0 * K + k0) * (fp8 ? 1 : 2); I.N = N; I.K = K; I.fp8 = fp8;
}
#define P0_LOAD(I, R) do { const float* _s = (I).src + (size_t)(16 * wave + (lane >> 5)) * (I).N + 4 * (lane & 31); const size_t _st = (size_t)2 * (I).N; \
        _Pragma("unroll") for (int _i = 0; _i < 8; ++_i) R[_i] = __builtin_nontemporal_load((const f32x4*)(_s + _i * _st)); } while (0)
#define P0_PIN(R) asm volatile("" : "+v"(R[0]), "+v"(R[1]), "+v"(R[2]), "+v"(R[3]), "+v"(R[4]), "+v"(R[5]), "+v"(R[6]), "+v"(R[7]) :: "memory")
#define P0_BARRIER() do { asm volatile("s_waitcnt lgkmcnt(0)" ::: "memory"); __builtin_amdgcn_s_barrier(); } while (0)
__device__ __forceinline__ void p0_to_lds(f32x4 (&R)[8], LAS float* tile, int wave, int lane) {
#pragma unroll
    for (int i = 0; i < 8; ++i) { LAS float* d = tile + (16 * wave + 2 * i + (lane >> 5)) * 129 + 4 * (lane & 31); d[0] = R[i][0]; d[1] = R[i][1]; d[2] = R[i][2]; d[3] = R[i][3]; }
}
__device__ __forceinline__ void p0_from_lds(const P0Item& I, LAS float* tile, int wave, int lane) {
    if (I.fp8) { const int kc = lane >> 3, nl = lane & 7;
#pragma unroll
        for (int j = 0; j < 2; ++j) { const int n = 16 * wave + 8 * j + nl; const LAS float* t = tile + (16 * kc) * 129 + n; u32x4 o;
            o.x = cvt4_fp8(t[0 * 129], t[1 * 129], t[2 * 129], t[3 * 129], FP8_SW); o.y = cvt4_fp8(t[4 * 129], t[5 * 129], t[6 * 129], t[7 * 129], FP8_SW);
            o.z = cvt4_fp8(t[8 * 129], t[9 * 129], t[10 * 129], t[11 * 129], FP8_SW); o.w = cvt4_fp8(t[12 * 129], t[13 * 129], t[14 * 129], t[15 * 129], FP8_SW);
            __builtin_nontemporal_store(o, (u32x4*)(I.dst + (size_t)n * I.K + 16 * kc)); }
    } else { const int kc = lane >> 2, nl = lane & 3;
#pragma unroll
        for (int j = 0; j < 4; ++j) { const int n = 16 * wave + 4 * j + nl; const LAS float* t = tile + (8 * kc) * 129 + n;
            u32x4 o; o.x = pk2(t[0 * 129], t[1 * 129]); o.y = pk2(t[2 * 129], t[3 * 129]); o.z = pk2(t[4 * 129], t[5 * 129]); o.w = pk2(t[6 * 129], t[7 * 129]);
            *(u32x4*)(I.dst + ((size_t)n * I.K + 8 * kc) * 2) = o; }
    }
}

__device__ __forceinline__ void phase0(Frame& F, ArgsP a) {
    unsigned char* ws = a->ws;
    int g = blockIdx.x; asm volatile("" : "+s"(g));
    const int G = F.G, lane = F.lane, wave = F.wave;
    P0Item IA, IB, IC; f32x4 ra[8], rb[8], rc[8];
    p0_decode(a, ws, g < P0_TOTAL ? g : 0, IA); P0_LOAD(IA, ra);
    p0_decode(a, ws, g + G < P0_TOTAL ? g + G : 0, IB); P0_LOAD(IB, rb);
    {
        const float* c_in = a->in[1]; const float* w_mod = a->in[2]; float* modp = (float*)(ws + WS_MODP);
        LAS float* cact = (LAS float*)F.lds;
        for (int it = blockIdx.x; it < KSPLIT * 16; it += F.G) {
            const int ks = it >> 4, nc = it & 15, k0 = ks * 64; const bool act = F.tid < 384; const int n = nc * 384 + (act ? F.tid : 0);
            for (int idx = F.tid; idx < 1024; idx += NTHREADS) { const int b = idx & 15, kk = idx >> 4; const float cv = c_in[b * D + k0 + kk]; cact[kk * 16 + b] = cv * sigmoidf_(cv); }
            __syncthreads();
            float acc[16];
#pragma unroll
            for (int b = 0; b < 16; ++b) acc[b] = 0.f;
#pragma unroll 1
            for (int kb = 0; kb < 4; ++kb) { float wv[16];
#pragma unroll
                for (int j = 0; j < 16; ++j) wv[j] = __builtin_nontemporal_load(w_mod + (size_t)(k0 + 16 * kb + j) * 6144 + n);
                asm volatile("" : "+v"(wv[0]), "+v"(wv[1]), "+v"(wv[2]), "+v"(wv[3]), "+v"(wv[4]), "+v"(wv[5]), "+v"(wv[6]), "+v"(wv[7]), "+v"(wv[8]), "+v"(wv[9]), "+v"(wv[10]), "+v"(wv[11]), "+v"(wv[12]), "+v"(wv[13]), "+v"(wv[14]), "+v"(wv[15]));
#pragma unroll
                for (int j = 0; j < 16; ++j) { const int kk = 16 * kb + j; const float w = wv[j];
#pragma unroll
                    for (int b4 = 0; b4 < 4; ++b4) { const f32x4 cv = *(const LAS f32x4*)(cact + kk * 16 + 4 * b4);
                        acc[4 * b4 + 0] += cv[0] * w; acc[4 * b4 + 1] += cv[1] * w; acc[4 * b4 + 2] += cv[2] * w; acc[4 * b4 + 3] += cv[3] * w; } } }
            if (act) {
#pragma unroll
                for (int b = 0; b < 16; ++b) modp[((size_t)ks * 16 + b) * 6144 + n] = acc[b]; }
            __syncthreads();
        }
    }
    { const float* sg_w = a->in[11]; bf16_t* SGW = (bf16_t*)(ws + WS_SGW);
      for (int idx = blockIdx.x * NTHREADS + F.tid; idx < 8 * 128 * 128 / 2; idx += F.G * NTHREADS) { const int e0 = 2 * idx, j = e0 & 7, L = (e0 >> 3) & 63, tt = (e0 >> 9) & 3, ks = (e0 >> 11) & 7, g = e0 >> 14;
          const int t = 32 * tt + (L & 31), sc = 16 * ks + 8 * (L >> 5) + j; const float* src = sg_w + ((size_t)g * 128 + t) * 128 + sc;
          const float w0 = sc <= t ? src[0] : 0.f, w1 = sc + 1 <= t ? src[1] : 0.f; ((unsigned*)SGW)[idx] = pk2(w0, w1); } }
    { LAS float* tile = (LAS float*)F.lds;
      __syncthreads();
#pragma unroll 1
      while (g < P0_TOTAL) {
          p0_decode(a, ws, g + 2 * G < P0_TOTAL ? g + 2 * G : 0, IC); P0_LOAD(IC, rc);
          P0_PIN(ra); p0_to_lds(ra, tile, wave, lane); P0_BARRIER(); p0_from_lds(IA, tile, wave, lane); P0_BARRIER();
          if (g + G >= P0_TOTAL) break;
          p0_decode(a, ws, g + 3 * G < P0_TOTAL ? g + 3 * G : 0, IA); P0_LOAD(IA, ra);
          P0_PIN(rb); p0_to_lds(rb, tile, wave, lane); P0_BARRIER(); p0_from_lds(IB, tile, wave, lane); P0_BARRIER();
          if (g + 2 * G >= P0_TOTAL) break;
          p0_decode(a, ws, g + 4 * G < P0_TOTAL ? g + 4 * G : 0, IB); P0_LOAD(IB, rb);
          P0_PIN(rc); p0_to_lds(rc, tile, wave, lane); P0_BARRIER(); p0_from_lds(IC, tile, wave, lane); P0_BARRIER();
          g += 3 * G;
      }
    }
}

template <int NI>
__device__ __forceinline__ void load_mod(Frame& F, ArgsP a, int b, int col0, LAS float* dst) {
    const float* modp = (const float*)(a->ws + WS_MODP); const float* b_mod = a->in[3];
    static_assert(KSPLIT == 16, "the clustering statement below names 16 values");
    float pv[NI][KSPLIT], s[NI];
#pragma unroll
    for (int j = 0; j < NI; ++j) { const int col = col0 + F.tid + j * NTHREADS; s[j] = b_mod[col];
#pragma unroll
        for (int ks = 0; ks < KSPLIT; ++ks) pv[j][ks] = modp[((size_t)ks * 16 + b) * 6144 + col]; }
#pragma unroll
    for (int j = 0; j < NI; ++j)
        asm volatile("" : "+v"(pv[j][0]), "+v"(pv[j][1]), "+v"(pv[j][2]), "+v"(pv[j][3]), "+v"(pv[j][4]), "+v"(pv[j][5]), "+v"(pv[j][6]), "+v"(pv[j][7]), "+v"(pv[j][8]), "+v"(pv[j][9]), "+v"(pv[j][10]), "+v"(pv[j][11]), "+v"(pv[j][12]), "+v"(pv[j][13]), "+v"(pv[j][14]), "+v"(pv[j][15]));
#pragma unroll
    for (int j = 0; j < NI; ++j) { float t = s[j];
#pragma unroll
        for (int ks = 0; ks < KSPLIT; ++ks) t += pv[j][ks];
        dst[F.tid + j * NTHREADS] = t; }
}

__device__ __forceinline__ void phase0b(Frame& F, ArgsP a) {
    const float* x = a->in[0]; const float* g = a->in[4]; bf16_t* H = (bf16_t*)(a->ws + WS_H); unsigned char* HF8 = a->ws + WS_HF8;
    LAS float* mv = (LAS float*)F.lds;
    for (int chunk = blockIdx.x; chunk < T / 128; chunk += F.G) {
        const int b = chunk / 16;
        load_mod<4>(F, a, b, 0, mv);
        for (int idx = F.tid; idx < 1024; idx += NTHREADS) mv[1024 + idx] = g[idx] * (1.f + mv[1024 + idx]);
        __syncthreads();
        for (int tt = 0; tt < 16; ++tt) {
            const int row = chunk * 128 + F.wave * 16 + tt;
            const f32x4* xr = (const f32x4*)(x + (size_t)row * D) + F.lane;
            f32x4 v[4]; float ss = 0.f;
#pragma unroll
            for (int j = 0; j < 4; ++j) { v[j] = __builtin_nontemporal_load(xr + 64 * j); ss += (v[j][0] * v[j][0] + v[j][1] * v[j][1]) + (v[j][2] * v[j][2] + v[j][3] * v[j][3]); }
            const float rstd = rsqrtf(wave_sum(ss) * (1.f / D) + EPS);
            u32x2* o8 = (u32x2*)(H + (size_t)row * D) + F.lane;
#pragma unroll
            for (int j = 0; j < 4; ++j) { const int col = 4 * F.lane + 256 * j; float r[4];
#pragma unroll
                for (int i = 0; i < 4; ++i) r[i] = (v[j][i] * rstd) * mv[1024 + col + i] + mv[col + i];
                u32x2 w; w.x = pk2(r[0], r[1]); w.y = pk2(r[2], r[3]); o8[64 * j] = w;
                ((unsigned*)(HF8 + (size_t)row * PF8))[F.lane + 64 * j] = cvt4_fp8(r[0], r[1], r[2], r[3], FP8_SH); }
        }
        __syncthreads();
    }
}

__device__ __forceinline__ void attn_item_mfma(Frame& F, ArgsP a, int item) {
    const int kvh = item & 1, n = (item >> 1) & 15, b = item >> 5;
    const bf16_t* Z = (const bf16_t*)(a->ws + WS_Z); const bf16_t* VT = (const bf16_t*)(a->ws + WS_VT); bf16_t* YA = (bf16_t*)(a->ws + WS_YATT);
    LAS bf16_t* Ks = (LAS bf16_t*)F.lds;
    LAS bf16_t* Vs = Ks + 256 * 72;
    const int tok0 = b * SEQ + n * 128;
    {
        u32x4 kr[4], vr[4]; int tid_o = F.tid; asm volatile("" : "+v"(tid_o));
#pragma unroll
        for (int it = 0; it < 4; ++it) { const int c = tid_o + it * NTHREADS, kj = c >> 3, ch = c & 7; const bool ok = n > 0 || kj >= 128;
            kr[it] = *(const u32x4*)(Z + (size_t)(tok0 + (ok ? kj - 128 : kj)) * NZ + ZK + kvh * 64 + ch * 8); }
#pragma unroll
        for (int it = 0; it < 4; ++it) { const int c = tid_o + it * NTHREADS, d = c >> 5, ch = c & 31; const bool ok = n > 0 || ch >= 16;
            vr[it] = *(const u32x4*)(VT + (size_t)(b * 128 + kvh * 64 + d) * SEQ + n * 128 + (ok ? ch - 16 : ch) * 8); }
        asm volatile("" : "+v"(kr[0]), "+v"(kr[1]), "+v"(kr[2]), "+v"(kr[3]), "+v"(vr[0]), "+v"(vr[1]), "+v"(vr[2]), "+v"(vr[3]));
#pragma unroll
        for (int it = 0; it < 4; ++it) { const int c = tid_o + it * NTHREADS, kj = c >> 3, ch = c & 7; const bool ok = n > 0 || kj >= 128;
            *(LAS u32x4*)(Ks + kj * 72 + ch * 8) = ok ? kr[it] : (u32x4){0u, 0u, 0u, 0u}; }
#pragma unroll
        for (int it = 0; it < 4; ++it) { const int c = tid_o + it * NTHREADS, d = c >> 5, ch = c & 31; const bool ok = n > 0 || ch >= 16;
            *(LAS u32x4*)(Vs + d * 264 + ch * 8) = ok ? vr[it] : (u32x4){0u, 0u, 0u, 0u}; }
    }
    __syncthreads();
    const int r = F.lane & 31, h = F.lane >> 5;
    const int pr = (r & ~12) | ((r & 4) << 1) | ((r & 8) >> 1);
#pragma unroll 1
    for (int j = 0; j < 2; ++j) {
        const int tk = F.wave * 2 + j, g = tk >> 2, qs = tk & 3, hq = kvh * 4 + g;
        const int qi = 32 * qs + r;
        const bf16_t* qp = Z + (size_t)(tok0 + qi) * NZ + ZQ + hq * 64 + 8 * h;
        bf16x8 qf[4];
#pragma unroll
        for (int ks = 0; ks < 4; ++ks) qf[ks] = *(const bf16x8*)(qp + 16 * ks);
        const float slope = exp2f(-(float)(hq + 1)), sink = a->in[8][hq];
        float mrun = sink, lsum = 0.f;
        f32x16 O[2];
#pragma unroll
        for (int dt = 0; dt < 2; ++dt)
#pragma unroll
            for (int i = 0; i < 16; ++i) O[dt][i] = 0.f;
        const float nsl2 = -slope * 1.4426950408889634f;
        const float sink2 = sink * 1.4426950408889634f;
        mrun = sink2;
#pragma unroll
        for (int tt = 0; tt < 5; ++tt) {
            if (n == 0 && qs + tt < 4) continue;
            f32x16 S;
#pragma unroll
            for (int i = 0; i < 16; ++i) S[i] = 0.f;
            const LAS bf16_t* kp = Ks + (32 * (qs + tt) + pr) * 72 + 8 * h;
#pragma unroll
            for (int ks = 0; ks < 4; ++ks) { const bf16x8 kf = *(const LAS bf16x8*)(kp + 16 * ks); S = MFMA32(kf, qf[ks], S); }
            const int dbase = r + 128 - 32 * tt - 8 * h; const float fb = nsl2 * (float)dbase;
            float tmax = -1e30f;
#pragma unroll
            for (int i = 0; i < 16; ++i) { const int kjl = (i & 3) + 4 * ((i >> 2) & 1) + 16 * (i >> 3);
                float v = fmaf(S[i], 1.4426950408889634f, fb - nsl2 * (float)kjl);
                if (tt == 0) { if (!(dbase - kjl < 128)) v = -1e30f; }
                if (tt == 4) { if (!(dbase - kjl >= 0)) v = -1e30f; }
                S[i] = v; tmax = fmaxf(tmax, v); }
            tmax = fmaxf(tmax, __shfl_xor(tmax, 32));
            const float mnew = fmaxf(mrun, tmax), alpha = __builtin_amdgcn_exp2f(mrun - mnew); mrun = mnew;
            float ps = 0.f;
#pragma unroll
            for (int i = 0; i < 16; ++i) { const float p = __builtin_amdgcn_exp2f(S[i] - mnew); S[i] = p; ps += p; }
            lsum = lsum * alpha + ps;
#pragma unroll
            for (int dt = 0; dt < 2; ++dt)
#pragma unroll
                for (int i = 0; i < 16; ++i) O[dt][i] *= alpha;
#pragma unroll
            for (int sx = 0; sx < 2; ++sx) {
                u32x4 pw; pw.x = cvtpk(S[8 * sx + 0], S[8 * sx + 1]); pw.y = cvtpk(S[8 * sx + 2], S[8 * sx + 3]); pw.z = cvtpk(S[8 * sx + 4], S[8 * sx + 5]); pw.w = cvtpk(S[8 * sx + 6], S[8 * sx + 7]);
                const bf16x8 pb = __builtin_bit_cast(bf16x8, pw);
#pragma unroll
                for (int dt = 0; dt < 2; ++dt) { const bf16x8 vf = *(const LAS bf16x8*)(Vs + (32 * dt + r) * 264 + 32 * (qs + tt) + 16 * sx + 8 * h); O[dt] = MFMA32(vf, pb, O[dt]); }
            }
        }
        const float l = lsum + __shfl_xor(lsum, 32) + __builtin_amdgcn_exp2f(sink2 - mrun);
        const float inv = 1.f / l;
        int lo_ = F.lane; asm volatile("" : "+v"(lo_));
        LAS bf16_t* ot = (LAS bf16_t*)(F.lds + 73728 + F.wave * 4608);
#pragma unroll
        for (int dt = 0; dt < 2; ++dt)
#pragma unroll
            for (int a4 = 0; a4 < 4; ++a4) { u32x2 w; w.x = cvtpk(O[dt][4 * a4] * inv, O[dt][4 * a4 + 1] * inv); w.y = cvtpk(O[dt][4 * a4 + 2] * inv, O[dt][4 * a4 + 3] * inv);
                *(LAS u32x2*)(ot + (lo_ & 31) * 72 + 32 * dt + 8 * a4 + 4 * (lo_ >> 5)) = w; }
        asm volatile("s_waitcnt lgkmcnt(0)" ::: "memory");
        { const int ln = lo_; bf16_t* yb = YA + (size_t)(tok0 + 32 * qs) * 512 + hq * 64 + 8 * (ln & 7);
#pragma unroll
          for (int i = 0; i < 4; ++i) { const int q = 8 * i + (ln >> 3); *(u32x4*)(yb + (size_t)q * 512) = *(const LAS u32x4*)(ot + q * 72 + 8 * (ln & 7)); } }
        asm volatile("s_waitcnt lgkmcnt(0)" ::: "memory");
    }
    __syncthreads();
}

__device__ __forceinline__ void gmlp_item_mfma(Frame& F, ArgsP a, int item) {
    const int b = item >> 4, chunk = item & 15;
    const bf16_t* Z = (const bf16_t*)(a->ws + WS_Z); const bf16_t* GVT = (const bf16_t*)(a->ws + WS_GVT); const bf16_t* SGW = (const bf16_t*)(a->ws + WS_SGW); bf16_t* YS = (bf16_t*)(a->ws + WS_YSG);
    const float* ln_g = a->in[9]; const float* ln_b = a->in[10]; const float* sg_b = a->in[12];
    LAS float* st = (LAS float*)(F.lds + MISC_OFF + 4096);
    const int tok0 = b * SEQ + chunk * 128;
    int tid_o = F.tid; asm volatile("" : "+v"(tid_o));
    if (tid_o < 128) {
        const long long* sp = (const long long*)(a->ws + WS_CTL + CTL_LNSTAT) + (size_t)(tok0 + tid_o) * 2;
        const float s1 = (float)sp[0] * (1.f / 1048576.f), s2 = (float)sp[1] * (1.f / 1048576.f);
        const float mean = s1 * (1.f / 512.f), var = fmaxf(s2 * (1.f / 512.f) - mean * mean, 0.f);
        st[2 * tid_o] = mean; st[2 * tid_o + 1] = rsqrtf(var + EPS); }
    __syncthreads();
    const int g = F.wave, r = F.lane & 31, h = F.lane >> 5;
    f32x16 acc[2][4];
#pragma unroll
    for (int dt = 0; dt < 2; ++dt)
#pragma unroll
        for (int tt = 0; tt < 4; ++tt)
#pragma unroll
            for (int i = 0; i < 16; ++i) acc[dt][tt][i] = 0.f;
    float gam[2], bet[2];
#pragma unroll
    for (int dt = 0; dt < 2; ++dt) { gam[dt] = ln_g[g * 64 + 32 * dt + r]; bet[dt] = ln_b[g * 64 + 32 * dt + r]; }
    const char* gS = pg8::uptr((const char*)(GVT + (size_t)(((b * 16 + chunk) * 8 + g) * 8) * 1024));
    const char* wS = pg8::uptr((const char*)(SGW + (size_t)(g * 8) * 2048));
    unsigned lo16 = (unsigned)F.lane * 16u; asm volatile("" : "+v"(lo16));
#define GM_LOADA(KS, RAW) do { _Pragma("unroll") for (int _dt = 0; _dt < 2; ++_dt) RAW[_dt] = *(const u32x4*)(gS + (KS) * 2048 + _dt * 1024 + lo16); } while (0)
#define GM_LOADW(KS, W) do { _Pragma("unroll") for (int _tt = 0; _tt < 4; ++_tt) if ((KS) <= 2 * _tt + 1) W[_tt] = *(const bf16x8*)(wS + (KS) * 4096 + _tt * 1024 + lo16); } while (0)
#define GM_PIN(RAW, W) asm volatile("" : "+v"(RAW[0]), "+v"(RAW[1]), "+v"(W[0]), "+v"(W[1]), "+v"(W[2]), "+v"(W[3]) :: "memory")
#define GM_STEP(KS, RAW, W) do { float x0[8], x1[8]; unpack8(RAW[0], x0); unpack8(RAW[1], x1); \
        _Pragma("unroll") for (int q4 = 0; q4 < 4; ++q4) { const f32x4 sv = *(const LAS f32x4*)(st + 2 * (16 * (KS) + 8 * h) + 4 * q4); \
            x0[2 * q4] = (x0[2 * q4] - sv[0]) * sv[1] * gam[0] + bet[0]; x0[2 * q4 + 1] = (x0[2 * q4 + 1] - sv[2]) * sv[3] * gam[0] + bet[0]; \
            x1[2 * q4] = (x1[2 * q4] - sv[0]) * sv[1] * gam[1] + bet[1]; x1[2 * q4 + 1] = (x1[2 * q4 + 1] - sv[2]) * sv[3] * gam[1] + bet[1]; } \
        bf16x8 af[2]; \
        { u32x4 pw; pw.x = cvtpk(x0[0], x0[1]); pw.y = cvtpk(x0[2], x0[3]); pw.z = cvtpk(x0[4], x0[5]); pw.w = cvtpk(x0[6], x0[7]); af[0] = __builtin_bit_cast(bf16x8, pw); } \
        { u32x4 pw; pw.x = cvtpk(x1[0], x1[1]); pw.y = cvtpk(x1[2], x1[3]); pw.z = cvtpk(x1[4], x1[5]); pw.w = cvtpk(x1[6], x1[7]); af[1] = __builtin_bit_cast(bf16x8, pw); } \
        _Pragma("unroll") for (int tt = 0; tt < 4; ++tt) if ((KS) <= 2 * tt + 1) { \
            _Pragma("unroll") for (int dt = 0; dt < 2; ++dt) acc[dt][tt] = MFMA32(af[dt], W[tt], acc[dt][tt]); } } while (0)
    u32x4 rA[2], rB[2]; bf16x8 wA[4], wB[4];
#pragma unroll
    for (int tt = 0; tt < 4; ++tt) { wA[tt] = (bf16x8){0, 0, 0, 0, 0, 0, 0, 0}; wB[tt] = wA[tt]; }
    GM_LOADA(0, rA); GM_LOADW(0, wA);
#pragma unroll
    for (int ks = 0; ks < 8; ks += 2) {
        GM_LOADA(ks + 1, rB); GM_LOADW(ks + 1, wB);
        GM_PIN(rA, wA); GM_STEP(ks, rA, wA);
        if (ks < 6) { GM_LOADA(ks + 2, rA); GM_LOADW(ks + 2, wA); }
        GM_PIN(rB, wB); GM_STEP(ks + 1, rB, wB);
    }
#undef GM_LOADW
#undef GM_PIN
#undef GM_STEP
#undef GM_LOADA
    LAS bf16_t* tb = (LAS bf16_t*)(F.lds + F.wave * 9216);
#pragma unroll
    for (int tp = 0; tp < 2; ++tp) {
        u32x4 uw[8];
#pragma unroll
        for (int i = 0; i < 8; ++i) { const int t = 64 * tp + 8 * i + (F.lane >> 3); uw[i] = *(const u32x4*)(Z + (size_t)(tok0 + t) * NZ + ZU + g * 64 + 8 * (F.lane & 7)); }
#pragma unroll
        for (int tq = 0; tq < 2; ++tq) { const int tt = 2 * tp + tq; const float bias = sg_b[g * 128 + 32 * tt + r];
#pragma unroll
            for (int dt = 0; dt < 2; ++dt)
#pragma unroll
                for (int a4 = 0; a4 < 4; ++a4) { u32x2 w; w.x = cvtpk(acc[dt][tt][4 * a4] + bias, acc[dt][tt][4 * a4 + 1] + bias); w.y = cvtpk(acc[dt][tt][4 * a4 + 2] + bias, acc[dt][tt][4 * a4 + 3] + bias);
                    *(LAS u32x2*)(tb + (32 * tq + r) * 72 + 32 * dt + 8 * a4 + 4 * h) = w; } }
        asm volatile("s_waitcnt lgkmcnt(0)" ::: "memory");
#pragma unroll
        for (int i = 0; i < 8; ++i) { const int tr = 8 * i + (F.lane >> 3), t = 64 * tp + tr; float m[8], uu[8];
            unpack8(*(const LAS u32x4*)(tb + tr * 72 + 8 * (F.lane & 7)), m); unpack8(uw[i], uu);
            u32x4 o; o.x = cvtpk(uu[0] * m[0], uu[1] * m[1]); o.y = cvtpk(uu[2] * m[2], uu[3] * m[3]); o.z = cvtpk(uu[4] * m[4], uu[5] * m[5]); o.w = cvtpk(uu[6] * m[6], uu[7] * m[7]);
            *(u32x4*)(YS + (size_t)(tok0 + t) * 512 + g * 64 + 8 * (F.lane & 7)) = o; }
        asm volatile("s_waitcnt lgkmcnt(0)" ::: "memory");
    }
    __syncthreads();
}

__device__ __forceinline__ void phase5(Frame& F, ArgsP a, const int pmode) {
    const float* x = a->in[0]; const float* g_post = a->in[5]; const float* g_pre = a->in[17]; const float* w_r = a->in[19]; const float* b_r = a->in[20];
    const bf16_t* Y = (const bf16_t*)(a->ws + WS_Y); unsigned char* H2 = (unsigned char*)(a->ws + WS_H2); bf16_t* X1B = (bf16_t*)(a->ws + WS_X1B);
    unsigned* gcnt = (unsigned*)(a->ws + WS_CTL) + CW_CNT; int* lists = (int*)(a->ws + WS_LISTS); int* tokinfo = (int*)(a->ws + WS_TOKINFO);
    constexpr int H2P = 1032;
    LAS float* h2buf = (LAS float*)F.lds;
    LAS float* part = (LAS float*)(F.lds + 66560);
    LAS float* mv = (LAS float*)(F.lds + 82944);
    LAS int* hist = (LAS int*)(F.lds + 95232);
    LAS int* basep = hist + 32;
    LAS int* asg_e = hist + 64;
    LAS int* asg_l = asg_e + 512;
    LAS float* asg_g = (LAS float*)(asg_l + 512);
    LAS float* lgs = asg_g + 512;
    LAS float* sel_v = lgs + 512;
    LAS int* sel_e = (LAS int*)(sel_v + 64);
    const int e_l = F.lane & 31, kh = F.lane >> 5, n_l = F.lane & 15, kq = F.lane >> 4;
    float wreg[2][32];
#pragma unroll
    for (int hf = 0; hf < 2; ++hf)
#pragma unroll
        for (int j = 0; j < 32; ++j) wreg[hf][j] = w_r[(size_t)(128 * F.wave + 16 * (j >> 2) + 4 * kq + (j & 3)) * NE + 16 * hf + n_l];
    float br_l = b_r[e_l]; asm volatile("" : "+v"(br_l));
    for (int chunk = blockIdx.x; chunk < T / 128; chunk += F.G) {
        const int b = chunk / 16;
        {
#pragma unroll 1
          for (int j = 0; j < 6; j += 2) load_mod<2>(F, a, b, 2048 + j * NTHREADS, mv + j * NTHREADS); }
        for (int idx = F.tid; idx < 1024; idx += NTHREADS) { mv[idx] *= g_post[idx]; mv[2048 + idx] = g_pre[idx] * (1.f + mv[2048 + idx]); }
        if (F.tid < 32) hist[F.tid] = 0;
        __syncthreads();
#define P5_LOADROWS(SB, XR, YR) do { _Pragma("unroll") for (int _j = 0; _j < 2; ++_j) { const int _row = chunk * 128 + (SB) * 16 + 2 * F.wave + _j; \
            const f32x4* _xr = (const f32x4*)(x + (size_t)_row * D) + F.lane; const u32x2* _yr = (const u32x2*)(Y + (size_t)_row * D) + F.lane; \
            _Pragma("unroll") for (int _jj = 0; _jj < 4; ++_jj) { XR[_j][_jj] = __builtin_nontemporal_load(_xr + 64 * _jj); YR[_j][_jj] = __builtin_nontemporal_load(_yr + 64 * _jj); } } } while (0)
#define P5_LOADROW(SB, J, XR, YR) do { const int _row = chunk * 128 + (SB) * 16 + 2 * F.wave + (J); \
            const f32x4* _xr = (const f32x4*)(x + (size_t)_row * D) + F.lane; const u32x2* _yr = (const u32x2*)(Y + (size_t)_row * D) + F.lane; \
            _Pragma("unroll") for (int _jj = 0; _jj < 4; ++_jj) { XR[J][_jj] = __builtin_nontemporal_load(_xr + 64 * _jj); YR[J][_jj] = __builtin_nontemporal_load(_yr + 64 * _jj); } } while (0)
        f32x4 xc[2][4]; u32x2 yc[2][4];
        P5_LOADROWS(0, xc, yc);
        for (int sb = 0; sb < 8; ++sb) {
#pragma unroll
            for (int j = 0; j < 2; ++j) {
                const int tt = 2 * F.wave + j, row = chunk * 128 + sb * 16 + tt;
                f32x4 xv[4], yv[4]; float ss = 0.f;
#pragma unroll
                for (int jj = 0; jj < 4; ++jj) { xv[jj] = xc[j][jj]; const u32x2 w = yc[j][jj];
                    yv[jj][0] = __uint_as_float(w.x << 16); yv[jj][1] = __uint_as_float(w.x & 0xffff0000u); yv[jj][2] = __uint_as_float(w.y << 16); yv[jj][3] = __uint_as_float(w.y & 0xffff0000u);
                    ss += (yv[jj][0] * yv[jj][0] + yv[jj][1] * yv[jj][1]) + (yv[jj][2] * yv[jj][2] + yv[jj][3] * yv[jj][3]); }
                const float rstd = rsqrtf(wave_sum(ss) * (1.f / D) + EPS); float s1 = 0.f;
#pragma unroll
                for (int jj = 0; jj < 4; ++jj) { const int col = 4 * F.lane + 256 * jj;
#pragma unroll
                    for (int i = 0; i < 4; ++i) { const float v = xv[jj][i] + mv[col + i] * (yv[jj][i] * rstd); xv[jj][i] = v; s1 += v * v; }
                    u32x2 xw; xw.x = cvtpk(xv[jj][0], xv[jj][1]); xw.y = cvtpk(xv[jj][2], xv[jj][3]); __builtin_nontemporal_store(xw, (u32x2*)(X1B + (size_t)row * D) + F.lane + 64 * jj); }
                const float rstd1 = rsqrtf(wave_sum(s1) * (1.f / D) + EPS);
                unsigned* o8 = (unsigned*)(H2 + (size_t)row * PF8) + F.lane;
#pragma unroll
                for (int jj = 0; jj < 4; ++jj) { const int col = 4 * F.lane + 256 * jj; f32x4 r;
#pragma unroll
                    for (int i = 0; i < 4; ++i) r[i] = (xv[jj][i] * rstd1) * mv[2048 + col + i] + mv[1024 + col + i];
                    o8[64 * jj] = cvt4_fp8(r[0], r[1], r[2], r[3], FP8_SH);
                    *(LAS f32x4*)(h2buf + tt * H2P + col) = r; }
                { const int sbn = sb < 7 ? sb + 1 : 7; if (j == 0) P5_LOADROW(sbn, 0, xc, yc); else P5_LOADROW(sbn, 1, xc, yc); }
            }
            __syncthreads();
            if (pmode & 1) continue;
            { const LAS f32x4* hp = (const LAS f32x4*)(h2buf + n_l * H2P + 128 * F.wave + 4 * kq);
              f32x4 lg0 = (f32x4){0.f, 0.f, 0.f, 0.f}, lg1 = (f32x4){0.f, 0.f, 0.f, 0.f};
#pragma unroll
              for (int jb = 0; jb < 8; ++jb) { const f32x4 hv = hp[4 * jb];
#pragma unroll
                  for (int i = 0; i < 4; ++i) { lg0 = __builtin_amdgcn_mfma_f32_16x16x4f32(hv[i], wreg[0][4 * jb + i], lg0, 0, 0, 0); lg1 = __builtin_amdgcn_mfma_f32_16x16x4f32(hv[i], wreg[1][4 * jb + i], lg1, 0, 0, 0); } }
#pragma unroll
              for (int i = 0; i < 4; ++i) { part[(F.wave * 16 + 4 * kq + i) * 32 + n_l] = lg0[i]; part[(F.wave * 16 + 4 * kq + i) * 32 + 16 + n_l] = lg1[i]; } }
            __syncthreads();
            if (pmode & 2) continue;
            { const int tt = 2 * F.wave + kh, tokidx = sb * 16 + tt;
              float logit = br_l;
#pragma unroll
              for (int w = 0; w < 8; ++w) logit += part[(w * 16 + tt) * 32 + e_l];
              lgs[tt * 32 + e_l] = logit;
              int rank = 0;
#pragma unroll
              for (int q8 = 0; q8 < 8; ++q8) { const f32x4 v = *(const LAS f32x4*)(lgs + tt * 32 + 4 * q8);
#pragma unroll
                  for (int i = 0; i < 4; ++i) { const int eo = 4 * q8 + i; rank += (v[i] > logit || (v[i] == logit && eo < e_l)) ? 1 : 0; } }
              if (rank < 4) { sel_v[tt * 4 + rank] = logit; sel_e[tt * 4 + rank] = e_l; }
              if (e_l < 4) { const f32x4 sv = *(const LAS f32x4*)(sel_v + tt * 4); const int k = e_l;
                  const float p0 = 1.f, p1 = __expf(sv[1] - sv[0]), p2 = __expf(sv[2] - sv[0]), p3 = __expf(sv[3] - sv[0]); const float inv = 1.f / (p0 + p1 + p2 + p3);
                  const int e = sel_e[tt * 4 + k]; const float gt = (k == 0 ? p0 : (k == 1 ? p1 : (k == 2 ? p2 : p3))) * inv;
                  const int lp = __hip_atomic_fetch_add(hist + e, 1, __ATOMIC_RELAXED, __HIP_MEMORY_SCOPE_WORKGROUP); asg_e[tokidx * 4 + k] = e; asg_l[tokidx * 4 + k] = lp; asg_g[tokidx * 4 + k] = gt; }
            }
        }
        __syncthreads();
        if (pmode) continue;
        if (F.tid < 32) basep[F.tid] = (int)atomicAdd(gcnt + F.tid, (unsigned)hist[F.tid]);
        __syncthreads();
        { const int aidx = F.tid, tokidx = aidx >> 2, k = aidx & 3, e = asg_e[aidx], pos = basep[e] + asg_l[aidx], token = chunk * 128 + tokidx;
          lists[(size_t)e * LISTCAP + pos] = token;
          int* ti = tokinfo + ((size_t)token * 4 + k) * 4; ti[0] = e; ti[1] = pos; ti[2] = __float_as_int(asg_g[aidx]); ti[3] = 0; }
        __syncthreads();
    }
}

__device__ __forceinline__ void moe_tables(Frame& F, ArgsP a, LAS int* tab, int NT) {
    const unsigned* gcnt = (const unsigned*)(a->ws + WS_CTL) + CW_CNT;
    if (F.tid < NE) tab[128 + F.tid] = (int)__hip_atomic_load(gcnt + F.tid, __ATOMIC_RELAXED, __HIP_MEMORY_SCOPE_AGENT);
    if (F.tid == 0) { int us = 0, ro = 0;
        for (int e = 0; e < NE; ++e) { const int c = tab[128 + e]; const int tiles = (c + 255) >> 8; tab[e] = us; tab[64 + e] = ro; us += tiles * NT; ro += tiles * 256; }
        tab[32] = us; tab[64 + 32] = ro; }
    __syncthreads();
}

__device__ __forceinline__ void phase9(Frame& F, ArgsP a) {
    const float* g_pf = a->in[18]; const bf16_t* X1B = (const bf16_t*)(a->ws + WS_X1B);
    const unsigned char* YS = (const unsigned char*)(a->ws + WS_YS); const int* tokinfo = (const int*)(a->ws + WS_TOKINFO); float* out = a->out;
    LAS int* tab = (LAS int*)(F.lds + MISC_OFF); LAS float* mv = (LAS float*)F.lds;
    moe_tables(F, a, tab, 4);
    for (int chunk = blockIdx.x; chunk < T / 128; chunk += F.G) {
        const int b = chunk / 16;
        const int row0 = chunk * 128 + F.wave * 16;
        const u32x4 tinf = *(const u32x4*)(tokinfo + ((size_t)(row0 + (F.lane >> 2)) * 4 + (F.lane & 3)) * 4);
        load_mod<2>(F, a, b, 5120, mv);
        for (int idx = F.tid; idx < 1024; idx += NTHREADS) mv[idx] *= g_pf[idx];
        __syncthreads();
        const int srow = tab[64 + (int)tinf.x] + (int)tinf.y; const float sgate = __uint_as_float(tinf.z) * (1.f / FP8_SY);
#define P9_LOAD(I, SR, XR) do { _Pragma("unroll") for (int _k = 0; _k < 4; ++_k) { const int _r = __shfl(srow, 4 * (I) + _k); const unsigned* _sr = (const unsigned*)(YS + (size_t)_r * PF8) + F.lane; \
            _Pragma("unroll") for (int _jj = 0; _jj < 4; ++_jj) SR[_k][_jj] = __builtin_nontemporal_load(_sr + 64 * _jj); } \
            const u32x2* _xr = (const u32x2*)(X1B + (size_t)(row0 + (I)) * D) + F.lane; \
            _Pragma("unroll") for (int _jj = 0; _jj < 4; ++_jj) XR[_jj] = __builtin_nontemporal_load(_xr + 64 * _jj); } while (0)
#define P9_PIN(SR, XR) asm volatile("" : "+v"(SR[0][0]), "+v"(SR[0][1]), "+v"(SR[0][2]), "+v"(SR[0][3]), "+v"(SR[1][0]), "+v"(SR[1][1]), "+v"(SR[1][2]), "+v"(SR[1][3]), \
            "+v"(SR[2][0]), "+v"(SR[2][1]), "+v"(SR[2][2]), "+v"(SR[2][3]), "+v"(SR[3][0]), "+v"(SR[3][1]), "+v"(SR[3][2]), "+v"(SR[3][3]), "+v"(XR[0]), "+v"(XR[1]), "+v"(XR[2]), "+v"(XR[3]) :: "memory")
#define P9_ROW(I, SR, XR) do { P9_PIN(SR, XR); f32x4 yv[4]; \
            _Pragma("unroll") for (int jj = 0; jj < 4; ++jj) yv[jj] = (f32x4){0.f, 0.f, 0.f, 0.f}; \
            _Pragma("unroll") for (int k = 0; k < 4; ++k) { const float gt = __shfl(sgate, 4 * (I) + k); \
                _Pragma("unroll") for (int jj = 0; jj < 4; ++jj) { const unsigned w = SR[k][jj]; const f32x2_t lo = __builtin_amdgcn_cvt_pk_f32_fp8((int)w, false), hi = __builtin_amdgcn_cvt_pk_f32_fp8((int)w, true); \
                    yv[jj][0] += gt * lo[0]; yv[jj][1] += gt * lo[1]; yv[jj][2] += gt * hi[0]; yv[jj][3] += gt * hi[1]; } } \
            float s1 = 0.f; \
            _Pragma("unroll") for (int jj = 0; jj < 4; ++jj) s1 += (yv[jj][0] * yv[jj][0] + yv[jj][1] * yv[jj][1]) + (yv[jj][2] * yv[jj][2] + yv[jj][3] * yv[jj][3]); \
            const float rstd1 = rsqrtf(wave_sum(s1) * (1.f / D) + EPS); \
            _Pragma("unroll") for (int jj = 0; jj < 4; ++jj) { const int col = 4 * F.lane + 256 * jj; const u32x2 xw = XR[jj]; \
                f32x4 xv; xv[0] = __uint_as_float(xw.x << 16); xv[1] = __uint_as_float(xw.x & 0xffff0000u); xv[2] = __uint_as_float(xw.y << 16); xv[3] = __uint_as_float(xw.y & 0xffff0000u); \
                _Pragma("unroll") for (int ii = 0; ii < 4; ++ii) xv[ii] += mv[col + ii] * (yv[jj][ii] * rstd1); \
                yv[jj] = xv; } \
            asm volatile("" : "+v"(yv[0]), "+v"(yv[1]), "+v"(yv[2]), "+v"(yv[3]) :: "memory"); \
            { const int in_ = (I) < 14 ? (I) + 2 : 15; P9_LOAD(in_, SR, XR); } \
            f32x4* orow = (f32x4*)(out + (size_t)(row0 + (I)) * D) + F.lane; \
            _Pragma("unroll") for (int jj = 0; jj < 4; ++jj) __builtin_nontemporal_store(yv[jj], orow + 64 * jj); } while (0)
        unsigned sA[4][4], sB[4][4]; u32x2 xA[4], xB[4];
        P9_LOAD(0, sA, xA); P9_LOAD(1, sB, xB);
#pragma unroll 1
        for (int i = 0; i < 16; i += 2) { P9_ROW(i, sA, xA); P9_ROW(i + 1, sB, xB); }
#undef P9_PIN
#undef P9_ROW
        __syncthreads();
    }
}

#define XB_TMO      128
#define XB_XCNT(j)  (256  + 64 * (j))
#define XB_XSUB(j)  (1280 + 64 * (j))
#define XB_XGEN(j)  (2304 + 64 * (j))
#define XB_TOP      3328
#define XB_TOPGEN   3392
#define XCD_BAR_WORDS 3456
#define XB_SPIN_CAP (1u << 18)
__device__ __forceinline__ unsigned xb_ld(unsigned* p)              { return __hip_atomic_load(p, __ATOMIC_RELAXED, __HIP_MEMORY_SCOPE_AGENT); }
__device__ __forceinline__ unsigned xb_add(unsigned* p, unsigned v) { return __hip_atomic_fetch_add(p, v, __ATOMIC_RELAXED, __HIP_MEMORY_SCOPE_AGENT); }
__device__ __forceinline__ unsigned xb_xcc_id() { return (unsigned)__builtin_amdgcn_s_getreg((3 << 11) | 20) & 0xFu; }
#define XB_SPIN(cond, bar) do { unsigned _sp = 0; while (cond) { __builtin_amdgcn_s_sleep(1); \
    if ((++_sp & 255u) == 0u) { if (xb_ld(&(bar)[XB_TMO])) break; if (_sp > XB_SPIN_CAP) { atomicAdd(&(bar)[XB_TMO], 1u); break; } } } } while (0)
struct XcdBarrier { unsigned* bar; unsigned x; volatile LAS unsigned* st; };
__device__ __forceinline__ XcdBarrier xcd_barrier_post(unsigned* bar, volatile LAS unsigned* st) {
    XcdBarrier b; b.bar = bar; b.x = xb_xcc_id(); b.st = st;
    if (threadIdx.x == 0) (void)xb_add(&bar[XB_XCNT(b.x)], 1u);
    return b;
}
__device__ __forceinline__ void xcd_barrier_complete(unsigned* bar, unsigned x, unsigned& nloc, unsigned& nx) {
    const unsigned G = gridDim.x * gridDim.y * gridDim.z;
    unsigned sum, cnt, mine, sp = 0u;
    for (;;) {
        sum = 0u; cnt = 0u; mine = 0u;
#pragma unroll
        for (unsigned j = 0; j < 16; ++j) { const unsigned c = xb_ld(&bar[XB_XCNT(j)]); sum += c; cnt += (c > 0u) ? 1u : 0u; mine = (j == x) ? c : mine; }
        if (sum == G) break;
        __builtin_amdgcn_s_sleep(1);
        if ((++sp & 255u) == 0u) { if (xb_ld(&bar[XB_TMO])) break; if (sp > XB_SPIN_CAP) { atomicAdd(&bar[XB_TMO], 1u); break; } }
    }
    nloc = mine > 0u ? mine : 1u; nx = cnt > 0u ? cnt : 1u;
}
__device__ __forceinline__ void xcd_barrier(const XcdBarrier& b, const int wave_s) {
    asm volatile("s_waitcnt vmcnt(0)" ::: "memory");
    __syncthreads();
    int ln_; asm volatile("v_mbcnt_lo_u32_b32 %0, -1, 0\n\tv_mbcnt_hi_u32_b32 %0, -1, %0" : "=v"(ln_));
    if (wave_s == 0 && ln_ == 0) {
        unsigned* bar = b.bar;
        __builtin_amdgcn_s_waitcnt(0);
        unsigned nloc = b.st[0], nx = b.st[1];
        if (nloc == 0u) { xcd_barrier_complete(bar, b.x, nloc, nx); b.st[0] = nloc; b.st[1] = nx; }
        const unsigned old = xb_add(&bar[XB_XSUB(b.x)], 1u);
        const unsigned gen = old / nloc;
        if (old + 1u == (gen + 1u) * nloc) {
            __builtin_amdgcn_fence(__ATOMIC_RELEASE, "agent");
            asm volatile("s_waitcnt vmcnt(0)" ::: "memory");
            const unsigned og = xb_add(&bar[XB_TOP], 1u);
            const unsigned tg = og / nx;
            if (og + 1u == (tg + 1u) * nx) xb_add(&bar[XB_TOPGEN], 1u);
            else XB_SPIN(xb_ld(&bar[XB_TOPGEN]) == tg, bar);
            __builtin_amdgcn_fence(__ATOMIC_ACQUIRE, "agent");
            xb_add(&bar[XB_XGEN(b.x)], 1u);
            asm volatile("s_waitcnt vmcnt(0)" ::: "memory");
        } else {
            XB_SPIN(xb_ld(&bar[XB_XGEN(b.x)]) == gen, bar);
            __builtin_amdgcn_fence(__ATOMIC_ACQUIRE, "agent");
            asm volatile("s_waitcnt vmcnt(0)" ::: "memory");
        }
    }
    __syncthreads();
}

constexpr int NPHASE = 10;
__global__ void __launch_bounds__(NTHREADS, 2) fwd_kernel(Args a_unused) {
    extern __shared__ __attribute__((aligned(16))) unsigned char lds_raw[];
    Frame F; F.lds = (LAS unsigned char*)lds_raw; F.G = gridDim.x;
    ArgsP a = (ArgsP)__builtin_amdgcn_kernarg_segment_ptr();
    volatile LAS unsigned* bst = (volatile LAS unsigned*)(F.lds + MISC_OFF + 1024);
    XcdBarrier xbar; xbar.bar = (unsigned*)(a->ws + WS_CTL) + CW_BAR; xbar.x = 0; xbar.st = bst;
    const int nprog = a->nprog;
    const int wave_s = __builtin_amdgcn_readfirstlane((int)threadIdx.x >> 6);
    if (nprog > 1) { if (threadIdx.x == 0) { bst[0] = 0u; bst[1] = 0u; } __syncthreads(); xbar = xcd_barrier_post((unsigned*)(a->ws + WS_CTL) + CW_BAR, bst); if (nprog < 0) cg::this_grid().sync(); }
#pragma nounroll
    for (int pi = 0; pi < nprog; ++pi) {
        { unsigned long long _p = (unsigned long long)__builtin_amdgcn_kernarg_segment_ptr(); asm volatile("" : "+s"(_p)); a = (ArgsP)_p; }
        { int _l; asm volatile("v_mbcnt_lo_u32_b32 %0, -1, 0\n\tv_mbcnt_hi_u32_b32 %0, -1, %0" : "=v"(_l)); F.lane = _l; F.wave = wave_s; F.tid = wave_s * 64 + _l; }
        { int _g = gridDim.x; asm volatile("" : "+s"(_g)); F.G = _g; }
        int bid = blockIdx.x; asm volatile("" : "+s"(bid));
        unsigned char* ws = a->ws;
        const int pe = (int)((a->prog[pi >> 3] >> ((pi & 7) * 8)) & 0xffull), ph = pe & 15, pmode = pe >> 4;
        switch (ph) {
        case 0: phase0(F, a); break;
        case 1: phase0b(F, a); break;
        case 2: {
            pg8::SchedDense S{(const char*)(ws + WS_H), (const char*)(ws + WS_WIN), T / 256, NZB / 256, F.G, bid, (size_t)256 * D * 2, (size_t)256 * D * 2, false};
            pg8::EpiInProj E{(bf16_t*)(ws + WS_Z), a->in[7], (bf16_t*)(ws + WS_VT), (bf16_t*)(ws + WS_GVT), (unsigned long long*)(ws + WS_CTL + CTL_LNSTAT)};
            pg8::gemm_phase<pg8::EpiInProj, pg8::SchedDense, false>(F.lds, F.wave, D * 2, D * 2, S, E);
            pg8::SchedGate S2{(const char*)(ws + WS_HF8), (const char*)(ws + WS_WING8), T / 256, NZG / 256, F.G, bid, (size_t)256 * PF8, (size_t)256 * D};
            pg8::EpiGate8 E2{ws + WS_G8, a->in[7] + NZB};
            pg8::gemm_phase<pg8::EpiGate8, pg8::SchedGate, false, true>(F.lds, F.wave, D, PF8, S2, E2);
        } break;
        case 3: {
            { const int nit = (256 + 512 - bid + F.G - 1) / F.G, rot = bid % nit;
#pragma unroll 1
              for (int k = 0; k < nit; ++k) { int kk = k + rot; if (kk >= nit) kk -= nit; const int it = bid + kk * F.G;
                  if (it < 256) gmlp_item_mfma(F, a, it); else attn_item_mfma(F, a, it - 256); } }
        } break;
        case 4: {
            pg8::SchedBranch S{(const char*)(ws + WS_YATT), (const char*)(ws + WS_WBA), (const char*)(ws + WS_YSG), (const char*)(ws + WS_WBS), T / 256, D / 256, F.G, bid, (size_t)256 * 512 * 2, (size_t)256 * 512 * 2, true};
            pg8::EpiBranch E{ws + WS_G8, (bf16_t*)(ws + WS_H)};
            pg8::gemm_phase<pg8::EpiBranch, pg8::SchedBranch, false>(F.lds, F.wave, 512 * 2, 512 * 2, S, E);
        } break;
        case 5: {
            pg8::SchedDense S{(const char*)(ws + WS_H), (const char*)(ws + WS_WOUT), T / 256, D / 256, F.G, bid, (size_t)256 * D * 2, (size_t)256 * D * 2, false};
            pg8::EpiBiasBf16 E{(bf16_t*)(ws + WS_Y), D, a->in[16], 0, 1.f, pmode};
            pg8::gemm_phase<pg8::EpiBiasBf16, pg8::SchedDense, false>(F.lds, F.wave, D * 2, D * 2, S, E);
        } break;
        case 6: phase5(F, a, pmode); break;
        case 7: {
            LAS int* tab = (LAS int*)(F.lds + MISC_OFF); LAS int* utab = tab + 768; moe_tables(F, a, tab, 8);
            pg8::moe_unit_table(tab, utab, F.tid, 8, F.G, bid, false); __syncthreads();
            pg8::SchedMoE S{utab, (const char*)(ws + WS_H2), (const char*)(ws + WS_W1), (size_t)2 * DE * D, (const int*)(ws + WS_LISTS), (size_t)256 * D, PF8, true};
            pg8::EpiSwiGLU E{(unsigned char*)(ws + WS_ACT), a->in[22], pmode};
            pg8::gemm_phase<pg8::EpiSwiGLU, pg8::SchedMoE, true, true>(F.lds, F.wave, D, PF8, S, E);
        } break;
        case 8: {
            LAS int* tab = (LAS int*)(F.lds + MISC_OFF); LAS int* utab = tab + 768; moe_tables(F, a, tab, 4);
            pg8::moe_unit_table(tab, utab, F.tid, 4, F.G, bid, true); __syncthreads();
            pg8::SchedMoE S{utab, (const char*)(ws + WS_ACT), (const char*)(ws + WS_W2), (size_t)D * DE, nullptr, (size_t)256 * DE, PF8, false};
            pg8::EpiBiasFp8 E{(unsigned char*)(ws + WS_YS), a->in[24], D, 1.f / (FP8_SA * FP8_SW), pmode};
            pg8::gemm_phase<pg8::EpiBiasFp8, pg8::SchedMoE, false, true>(F.lds, F.wave, DE, PF8, S, E);
        } break;
        case 9: phase9(F, a); break;
        default: if (bid == 0 && F.tid < 32) ((unsigned*)(ws + WS_CTL))[CW_CNT + F.tid] = 0u; break;
        }
        if (pi + 1 < nprog) xcd_barrier(xbar, wave_s);
    }
}

extern "C" void kernel_launch(void* const* d_in, const int* in_sizes, int n_in, void* d_out, int out_size, void* d_ws, size_t ws_size, hipStream_t stream) {
    const void* kfn = (const void*)fwd_kernel;
    static int grid = 0;
    if (grid == 0) {
        if (n_in != 25 || out_size != T * D || ws_size < WS_END) { fprintf(stderr, "kernel_launch: unexpected problem (n_in %d out %d ws %zu)\n", n_in, out_size, ws_size); grid = -1; return; }
        int dev = 0, cus = 0, per_cu = 0;
        (void)hipGetDevice(&dev); (void)hipDeviceGetAttribute(&cus, hipDeviceAttributeMultiprocessorCount, dev);
        (void)hipFuncSetAttribute(kfn, hipFuncAttributeMaxDynamicSharedMemorySize, LDS_BYTES);
        (void)hipOccupancyMaxActiveBlocksPerMultiprocessor(&per_cu, kfn, NTHREADS, LDS_BYTES);
        (void)hipGetLastError();
        if (per_cu < 1) { fprintf(stderr, "kernel_launch: occupancy query says %d blocks per CU\n", per_cu); grid = -1; return; }
        grid = cus;
    }
    if (grid < 0) return;
    (void)hipMemsetAsync((char*)d_ws + WS_CTL, 0, CTL_BYTES, stream);
    Args a{};
    for (int i = 0; i < 25; ++i) a.in[i] = (const float*)d_in[i];
    a.out = (float*)d_out; a.ws = (unsigned char*)d_ws;
    static const unsigned char program[] = PHASE_PROGRAM;
    const int np = (int)sizeof(program);
#if MK_ONE_LAUNCH
    a.nprog = np; for (int i = 0; i < np; ++i) a.prog[i >> 3] |= (unsigned long long)program[i] << ((i & 7) * 8);
    void* args[] = {&a};
    hipError_t e = hipLaunchCooperativeKernel(kfn, dim3(grid), dim3(NTHREADS), args, LDS_BYTES, stream);
    if (e != hipSuccess) fprintf(stderr, "cooperative launch failed: %s (grid %d)\n", hipGetErrorString(e), grid);
#else
    for (int p = 0; p < np; ++p) { a.nprog = 1; a.prog[0] = program[p]; void* args[] = {&a}; (void)hipLaunchKernel(kfn, dim3(grid), dim3(NTHREADS), args, LDS_BYTES, stream); }
#endif
}
```
